# Optimizing an MI355X kernel written in HIP

```python
import jax
import jax.numpy as jnp
from jax import lax
import numpy as np


D_MODEL = 1024
BATCH = 4
SEQ = 4096
DEPTH = 1

GLA_HEADS = 4
GLA_DK = D_MODEL // 8
GLA_DV = D_MODEL // 4
GLA_GATE_RANK = 16
GLA_TAU = 16.0
GLA_CHUNK = 64
GLA_K_WIDTH = GLA_HEADS * GLA_DK
GLA_V_WIDTH = GLA_HEADS * GLA_DV

ATT_GROUPS = ((128, 1), (512, 4), (2048, 16))
ATT_HEADS_PER_GROUP = 8
ATT_HEAD_DIM = 64
ATT_BLOCK = 128
ROT_DIM = ATT_HEAD_DIM // 4
ROPE_THETA = 500000.0
ATT_QKV_WIDTH = len(ATT_GROUPS) * ATT_HEADS_PER_GROUP * ATT_HEAD_DIM
ATT_OUT_WIDTH = ATT_HEADS_PER_GROUP * ATT_HEAD_DIM

IN_SPLIT_SIZES = (GLA_K_WIDTH, GLA_K_WIDTH, GLA_V_WIDTH, GLA_V_WIDTH, GLA_GATE_RANK,
                  ATT_QKV_WIDTH, ATT_QKV_WIDTH, ATT_QKV_WIDTH, D_MODEL, D_MODEL)
IN_WIDTH = sum(IN_SPLIT_SIZES)

N_EXPERTS = 32
TOP_K = 4
EXPERT_FF = D_MODEL
SWIGLU_LIMIT = 7.0
SWIGLU_ALPHA = 1.702
MOE_BLOCK = 128

EPS = 1e-5

kernel_name = 'hybrid_gla_dilated_attn_moe'


def rmsnorm(x, g):
    xf = x.astype(jnp.float32)
    y = xf * lax.rsqrt(jnp.mean(xf * xf, axis=-1, keepdims=True) + EPS)
    return (y * g.astype(jnp.float32)).astype(x.dtype)


def partial_rotary(t, pos):
    half = ROT_DIM // 2
    inv_freq = ROPE_THETA ** (-jnp.arange(half, dtype=jnp.float32) * (2.0 / ROT_DIM))
    ang = pos[:, None] * inv_freq[None, :]
    cos = jnp.cos(ang)[None, :, None, :]
    sin = jnp.sin(ang)[None, :, None, :]
    tf = t.astype(jnp.float32)
    r1 = tf[..., :half]
    r2 = tf[..., half:ROT_DIM]
    out = jnp.concatenate([r1 * cos - r2 * sin, r2 * cos + r1 * sin, tf[..., ROT_DIM:]], axis=-1)
    return out.astype(t.dtype)


def gla_chunked(q, k, v, log_decay):
    B, S, H, dk = q.shape
    C = GLA_CHUNK
    nc = S // C

    def chunks(t):
        return t.astype(jnp.float32).reshape(B, nc, C, H, t.shape[-1]).transpose(0, 3, 1, 2, 4)

    qc = chunks(q) * (dk ** -0.5)
    kc, vc, gc = chunks(k), chunks(v), chunks(log_decay)
    b = jnp.cumsum(gc, axis=3)
    b_last = b[:, :, :, -1:, :]
    qe = qc * jnp.exp(b)
    ke = kc * jnp.exp(-b)
    kd = kc * jnp.exp(b_last - b)
    causal = jnp.tril(jnp.ones((C, C), dtype=bool))
    A = jnp.where(causal, jnp.einsum('bhnid,bhnjd->bhnij', qe, ke), 0.0)
    o_intra = jnp.einsum('bhnij,bhnjv->bhniv', A, vc)
    U = jnp.einsum('bhnjd,bhnjv->bhndv', kd, vc)
    decay = jnp.exp(b_last[:, :, :, 0, :])

    def step(state, inp):
        dec, u = inp
        return dec[..., None] * state + u, state

    state0 = jnp.zeros((B, H, dk, vc.shape[-1]), jnp.float32)
    _, prev = lax.scan(step, state0, (decay.transpose(2, 0, 1, 3), U.transpose(2, 0, 1, 3, 4)))
    prev = prev.transpose(1, 2, 0, 3, 4)
    o_inter = jnp.einsum('bhnid,bhndv->bhniv', qe, prev)
    o = o_intra + o_inter
    return o.transpose(0, 2, 3, 1, 4).reshape(B, S, H, vc.shape[-1])


def dilated_group(q, k, v, window, dilation):
    B, S, H, hd = q.shape
    L = ATT_BLOCK
    steps = window // dilation
    unit = dilation * L
    Sp = -(-S // unit) * unit
    n = Sp // dilation
    nb = n // L

    def to_blocks(t):
        t = jnp.pad(t, ((0, 0), (0, Sp - S), (0, 0), (0, 0)))
        t = t.reshape(B, n, dilation, H, hd).transpose(0, 2, 3, 1, 4)
        return t.reshape(B, dilation, H, nb, L, hd)

    def with_prev(t):
        prev = jnp.concatenate([jnp.zeros_like(t[:, :, :, :1]), t[:, :, :, :-1]], axis=3)
        return jnp.concatenate([prev, t], axis=4)

    qb = to_blocks(q)
    kw = with_prev(to_blocks(k))
    vw = with_prev(to_blocks(v))
    s = jnp.einsum('brhnqe,brhnke->brhnqk', qb, kw, preferred_element_type=jnp.float32) * (hd ** -0.5)
    qi = jnp.arange(L)[:, None]
    ki = jnp.arange(2 * L)[None, :]
    dist = qi + L - ki
    band = (dist >= 0) & (dist <= steps)
    has_prev = (jnp.arange(nb)[:, None, None] > 0) | (ki >= L)[None]
    mask = band[None] & has_prev
    s = jnp.where(mask, s, -jnp.inf)
    mx = jnp.max(s, axis=-1, keepdims=True)
    e = jnp.exp(s - mx)
    den = jnp.sum(e, axis=-1, keepdims=True)
    o = jnp.einsum('brhnqk,brhnke->brhnqe', e / den, vw.astype(jnp.float32))
    lse = (mx + jnp.log(den))[..., 0]
    o = o.reshape(B, dilation, H, n, hd).transpose(0, 3, 1, 2, 4).reshape(B, Sp, H, hd)[:, :S]
    lse = lse.reshape(B, dilation, H, n).transpose(0, 3, 1, 2).reshape(B, Sp, H)[:, :S]
    return o, lse


def hybrid_mixer(xn, w_in, gla_gate_up, gla_gate_bias, gla_norm_g, w_branch_gla, w_branch_att, w_mix_out):
    B, S, D = xn.shape
    proj = xn @ w_in
    points = np.cumsum(IN_SPLIT_SIZES)[:-1].tolist()
    gq, gk, gv, gr, glr, aq, ak, av, gate_gla, gate_att = jnp.split(proj, points, axis=-1)

    log_decay = jax.nn.log_sigmoid((glr @ gla_gate_up + gla_gate_bias).astype(jnp.float32)) / GLA_TAU
    o = gla_chunked(gq.reshape(B, S, GLA_HEADS, GLA_DK), gk.reshape(B, S, GLA_HEADS, GLA_DK),
                    gv.reshape(B, S, GLA_HEADS, GLA_DV), log_decay.reshape(B, S, GLA_HEADS, GLA_DK))
    o = o * lax.rsqrt(jnp.mean(o * o, axis=-1, keepdims=True) + EPS) * gla_norm_g.astype(jnp.float32)
    o = o * jax.nn.silu(gr.reshape(B, S, GLA_HEADS, GLA_DV).astype(jnp.float32))
    y_gla = o.reshape(B, S, GLA_V_WIDTH).astype(xn.dtype)

    n_heads = len(ATT_GROUPS) * ATT_HEADS_PER_GROUP
    pos = jnp.arange(S, dtype=jnp.float32)
    aq = partial_rotary(aq.reshape(B, S, n_heads, ATT_HEAD_DIM), pos)
    ak = partial_rotary(ak.reshape(B, S, n_heads, ATT_HEAD_DIM), pos)
    av = av.reshape(B, S, n_heads, ATT_HEAD_DIM)
    outs, lses = [], []
    for g, (window, dilation) in enumerate(ATT_GROUPS):
        hs = slice(g * ATT_HEADS_PER_GROUP, (g + 1) * ATT_HEADS_PER_GROUP)
        o_g, lse_g = dilated_group(aq[:, :, hs], ak[:, :, hs], av[:, :, hs], window, dilation)
        outs.append(o_g)
        lses.append(lse_g)
    alpha = jax.nn.softmax(jnp.stack(lses), axis=0)
    y_att = jnp.sum(alpha[..., None] * jnp.stack(outs), axis=0)
    y_att = y_att.reshape(B, S, ATT_OUT_WIDTH).astype(xn.dtype)

    merged = (jax.nn.sigmoid(gate_gla) * (y_gla @ w_branch_gla)
              + jax.nn.sigmoid(gate_att) * (y_att @ w_branch_att))
    return merged @ w_mix_out


def moe(xn, router_w, router_b, w_gate_up, b_gate_up, w_down, b_down):
    N, D = xn.shape
    logits = (xn @ router_w + router_b).astype(jnp.float32)
    top_v, top_e = lax.top_k(logits, TOP_K)
    gates = jax.nn.softmax(top_v, axis=-1)
    M = N * TOP_K
    e_flat = top_e.reshape(M)
    g_flat = gates.reshape(M)
    tok = jnp.arange(M, dtype=jnp.int32) // TOP_K
    order = jnp.argsort(e_flat)
    e_s, tok_s, g_s = e_flat[order], tok[order], g_flat[order]
    counts = jnp.bincount(e_flat, length=N_EXPERTS)
    starts = jnp.cumsum(counts) - counts
    padded = (counts + MOE_BLOCK - 1) // MOE_BLOCK * MOE_BLOCK
    pstarts = jnp.cumsum(padded) - padded
    dest = pstarts[e_s] + jnp.arange(M, dtype=jnp.int32) - starts[e_s]
    n_blocks = -(-M // MOE_BLOCK) + N_EXPERTS
    P = n_blocks * MOE_BLOCK
    x_pad = jnp.zeros((P, D), xn.dtype).at[dest].set(xn[tok_s])
    block_end = jnp.cumsum(padded) // MOE_BLOCK
    block_expert = jnp.minimum(jnp.searchsorted(block_end, jnp.arange(n_blocks), side='right'), N_EXPERTS - 1)

    def expert_block(args):
        xb, e = args
        h = xb @ w_gate_up[e] + b_gate_up[e]
        gate = jnp.minimum(h[:, ::2], SWIGLU_LIMIT)
        up = jnp.clip(h[:, 1::2], -SWIGLU_LIMIT, SWIGLU_LIMIT)
        act = (up + 1.0) * (gate * jax.nn.sigmoid(SWIGLU_ALPHA * gate))
        return act @ w_down[e] + b_down[e]

    y_pad = lax.map(expert_block, (x_pad.reshape(n_blocks, MOE_BLOCK, D), block_expert)).reshape(P, D)
    contrib = y_pad[dest] * g_s[:, None].astype(y_pad.dtype)
    return jax.ops.segment_sum(contrib, tok_s, num_segments=N)


def setup_inputs(seed: int = 0) -> dict:
    key = jax.random.key(seed)
    ks = jax.random.split(key, 17)

    def nrm(k, shape, scale):
        return jax.random.normal(k, shape, jnp.float32) * scale

    return {
        'x': nrm(ks[0], (BATCH, SEQ, D_MODEL), 1.0),
        'norm_mix_g': 1.0 + nrm(ks[1], (DEPTH, D_MODEL), 0.02),
        'w_in': nrm(ks[2], (DEPTH, D_MODEL, IN_WIDTH), D_MODEL ** -0.5),
        'gla_gate_up': nrm(ks[3], (DEPTH, GLA_GATE_RANK, GLA_K_WIDTH), GLA_GATE_RANK ** -0.5),
        'gla_gate_bias': nrm(ks[4], (DEPTH, GLA_K_WIDTH), 0.1),
        'gla_norm_g': 1.0 + nrm(ks[5], (DEPTH, GLA_DV), 0.02),
        'w_branch_gla': nrm(ks[6], (DEPTH, GLA_V_WIDTH, D_MODEL), GLA_V_WIDTH ** -0.5),
        'w_branch_att': nrm(ks[7], (DEPTH, ATT_OUT_WIDTH, D_MODEL), ATT_OUT_WIDTH ** -0.5),
        'w_mix_out': nrm(ks[8], (DEPTH, D_MODEL, D_MODEL), D_MODEL ** -0.5),
        'norm_ffn_g': 1.0 + nrm(ks[9], (DEPTH, D_MODEL), 0.02),
        'router_w': nrm(ks[10], (DEPTH, D_MODEL, N_EXPERTS), D_MODEL ** -0.5),
        'router_b': nrm(ks[11], (DEPTH, N_EXPERTS), 0.01),
        'expert_w_gate_up': nrm(ks[12], (DEPTH, N_EXPERTS, D_MODEL, 2 * EXPERT_FF), D_MODEL ** -0.5),
        'expert_b_gate_up': nrm(ks[13], (DEPTH, N_EXPERTS, 2 * EXPERT_FF), 0.01),
        'expert_w_down': nrm(ks[14], (DEPTH, N_EXPERTS, EXPERT_FF, D_MODEL), EXPERT_FF ** -0.5),
        'expert_b_down': nrm(ks[15], (DEPTH, N_EXPERTS, D_MODEL), 0.01),
        'norm_final_g': 1.0 + nrm(ks[16], (D_MODEL,), 0.02),
    }


def reference(x, norm_mix_g, w_in, gla_gate_up, gla_gate_bias, gla_norm_g, w_branch_gla, w_branch_att,
              w_mix_out, norm_ffn_g, router_w, router_b, expert_w_gate_up, expert_b_gate_up,
              expert_w_down, expert_b_down, norm_final_g):
    B, S, D = x.shape
    h = x
    for l in range(DEPTH):
        h = h + hybrid_mixer(rmsnorm(h, norm_mix_g[l]), w_in[l], gla_gate_up[l], gla_gate_bias[l],
                             gla_norm_g[l], w_branch_gla[l], w_branch_att[l], w_mix_out[l])
        hn = rmsnorm(h, norm_ffn_g[l]).reshape(B * S, D)
        h = h + moe(hn, router_w[l], router_b[l], expert_w_gate_up[l], expert_b_gate_up[l],
                    expert_w_down[l], expert_b_down[l]).reshape(B, S, D)
    return rmsnorm(h, norm_final_g)
```

```cpp
#include <hip/hip_runtime.h>
#include <hip/hip_cooperative_groups.h>
#include <cstdio>
#include <cstdint>
namespace cg = cooperative_groups;

#define LDS3 __attribute__((address_space(3)))
typedef unsigned short bf16_t;
typedef short bf16x8 __attribute__((ext_vector_type(8)));
typedef short s16x4 __attribute__((ext_vector_type(4)));
typedef short v4i16_t __attribute__((ext_vector_type(4)));
typedef float f32x4 __attribute__((ext_vector_type(4)));
typedef float f32x2 __attribute__((ext_vector_type(2)));
typedef float f32x16 __attribute__((ext_vector_type(16)));
typedef unsigned u32x4 __attribute__((ext_vector_type(4)));
typedef unsigned u32x2 __attribute__((ext_vector_type(2)));

constexpr int NTOK = 16384, DM = 1024, SEQ = 4096, NB = 4;
constexpr int INW = 9744, INWP = 9984;
constexpr int NEXP = 32, TOPK = 4, FF = 1024;
constexpr int MAXT = 288;
constexpr float EPS = 1e-5f;
constexpr float QSCALE = 0.125f * 1.4426950408889634f;
constexpr float LN2 = 0.6931471805599453f;

constexpr size_t al256(size_t x) { return (x + 255) & ~(size_t)255; }
constexpr size_t WS_W_IN = 0;
constexpr size_t WS_W_G = WS_W_IN + (size_t)INWP * 1024 * 2;
constexpr size_t WS_W_A = WS_W_G + (size_t)1024 * 1024 * 2;
constexpr size_t WS_W_MIX = WS_W_A + (size_t)1024 * 512 * 2;
constexpr size_t WS_W_GU = WS_W_MIX + (size_t)1024 * 1024 * 2;
constexpr size_t WS_W_D = WS_W_GU + (size_t)NEXP * 2048 * 1024 * 2;
constexpr size_t WS_ROPE_C = WS_W_D + (size_t)NEXP * 1024 * 1024 * 2;
constexpr size_t WS_ROPE_S = WS_ROPE_C + (size_t)SEQ * 8 * 4;
constexpr size_t WS_RWG = WS_ROPE_S + (size_t)SEQ * 8 * 4;
constexpr size_t WS_H = WS_RWG + (size_t)1024 * 32 * 4;
constexpr size_t WS_HN = WS_H + (size_t)NTOK * 1024 * 4;
constexpr size_t WS_TOPE = WS_HN + (size_t)NTOK * 1024 * 2;
constexpr size_t WS_TOPG = WS_TOPE + (size_t)NTOK * 4 * 4;
constexpr size_t WS_TOPP = WS_TOPG + (size_t)NTOK * 4 * 4;
constexpr size_t WS_SLOT = WS_TOPP + (size_t)NTOK * 4 * 4;
constexpr size_t WS_CNT = WS_SLOT + (size_t)NTOK * 4 * 4;
constexpr size_t WS_TILEE = WS_CNT + (size_t)256 * 32 * 4;
constexpr size_t WS_REGB = al256(WS_TILEE + (size_t)(MAXT + 32) * 4);
constexpr size_t WS_XN = WS_REGB;
constexpr size_t WS_GQ = WS_XN + (size_t)NTOK * 1024 * 2;
constexpr size_t WS_GK = WS_GQ + (size_t)NTOK * 512 * 2;
constexpr size_t WS_GV = WS_GK + (size_t)NTOK * 512 * 2;
constexpr size_t WS_GR = WS_GV + (size_t)NTOK * 1024 * 2;
constexpr size_t WS_SG = WS_GR + (size_t)NTOK * 1024 * 2;
constexpr size_t WS_SA = WS_SG + (size_t)NTOK * 1024 * 2;
constexpr size_t WS_AQ = WS_SA + (size_t)NTOK * 1024 * 2;
constexpr size_t WS_AK = WS_AQ + (size_t)NTOK * 1536 * 2;
constexpr size_t WS_AV = WS_AK + (size_t)NTOK * 1536 * 2;
constexpr size_t WS_GLR = WS_AV + (size_t)NTOK * 1536 * 2;
constexpr size_t WS_OATT = WS_GLR + (size_t)NTOK * 16 * 4;
constexpr size_t WS_LSE = WS_OATT + (size_t)3 * NTOK * 512 * 2;
constexpr size_t WS_QE = WS_LSE + (size_t)3 * NTOK * 8 * 4;
constexpr size_t WS_OINTRA = WS_QE + (size_t)NTOK * 512 * 2;
constexpr size_t WS_U = WS_OINTRA + (size_t)NTOK * 1024 * 4;
constexpr size_t WS_DEC = WS_U + (size_t)1024 * 128 * 256 * 2;
constexpr size_t WS_REGB_END = WS_DEC + (size_t)1024 * 128 * 4;
constexpr size_t WS_PREV = WS_AQ;
constexpr size_t WS_YGLA = WS_AV;
constexpr size_t WS_YATT = WS_XN;
constexpr size_t WS_T1 = WS_GQ;
constexpr size_t WS_MERGED = WS_GV;
constexpr size_t PADROWS = (size_t)MAXT * 256;
constexpr size_t WS_XPAD = WS_REGB;
constexpr size_t WS_ACT = WS_XPAD + PADROWS * 1024 * 2;
constexpr size_t WS_YPAD = WS_ACT + PADROWS * 1024 * 2;
constexpr size_t WS_PAD_END = WS_YPAD + PADROWS * 1024 * 2;
constexpr size_t WS_END = WS_REGB_END > WS_PAD_END ? WS_REGB_END : WS_PAD_END;
static_assert(WS_PAD_END <= WS_REGB_END + (1u << 30), "map");

constexpr int LDS_BYTES = 147456;

struct Params {
    const float *x, *norm_mix_g, *w_in, *gla_gate_up, *gla_gate_bias, *gla_norm_g, *w_branch_gla, *w_branch_att, *w_mix_out, *norm_ffn_g,
        *router_w, *router_b, *e_w_gu, *e_b_gu, *e_w_d, *e_b_d, *norm_final_g;
    float* out;
    unsigned char* ws;
};

__device__ __forceinline__ int tid_() { int t = threadIdx.x; asm volatile("" : "+v"(t)); return t; }
__device__ __forceinline__ unsigned char* opaque(unsigned char* q) { return q; }
__device__ __forceinline__ unsigned cvt_pk_bf16(float lo, float hi) { unsigned r; asm volatile("v_cvt_pk_bf16_f32 %0, %1, %2" : "=v"(r) : "v"(lo), "v"(hi)); return r; }
__device__ __forceinline__ float bf_lo(unsigned w) { return __uint_as_float(w << 16); }
__device__ __forceinline__ float bf_hi(unsigned w) { return __uint_as_float(w & 0xffff0000u); }
__device__ __forceinline__ float bf2f(bf16_t b) { return __uint_as_float(((unsigned)b) << 16); }
__device__ __forceinline__ u32x4 pack8(const float* v) { u32x4 w; w.x = cvt_pk_bf16(v[0], v[1]); w.y = cvt_pk_bf16(v[2], v[3]); w.z = cvt_pk_bf16(v[4], v[5]); w.w = cvt_pk_bf16(v[6], v[7]); return w; }
__device__ __forceinline__ void unpack8(u32x4 w, float* v) { v[0] = bf_lo(w.x); v[1] = bf_hi(w.x); v[2] = bf_lo(w.y); v[3] = bf_hi(w.y); v[4] = bf_lo(w.z); v[5] = bf_hi(w.z); v[6] = bf_lo(w.w); v[7] = bf_hi(w.w); }
__device__ __forceinline__ float sigmoidf_(float v) { return 1.0f / (1.0f + __expf(-v)); }
__device__ __forceinline__ float wave_sum(float v) { v += __shfl_xor(v, 32); v += __shfl_xor(v, 16); v += __shfl_xor(v, 8); v += __shfl_xor(v, 4); v += __shfl_xor(v, 2); v += __shfl_xor(v, 1); return v; }
__device__ __forceinline__ s16x4 tr16(const LDS3 char* p) { return __builtin_bit_cast(s16x4, __builtin_amdgcn_ds_read_tr16_b64_v4i16((LDS3 v4i16_t*)p)); }
__device__ __forceinline__ bf16x8 cat8(s16x4 a, s16x4 b) { return (bf16x8){a[0], a[1], a[2], a[3], b[0], b[1], b[2], b[3]}; }
__device__ __forceinline__ int crow(int r, int hi) { return (r & 3) + 8 * (r >> 2) + 4 * hi; }
#define MFMA32(a, b, c) __builtin_amdgcn_mfma_f32_32x32x16_bf16(a, b, c, 0, 0, 0)

namespace pg8 {
constexpr int BM = 256, BK = 64, HALF = 128, HTB = HALF * BK * 2, STAGE_BYTES = 8 * HTB, NXCD = 8, WGM = 8;
__host__ __device__ __forceinline__ int lds_byte(int r, int c) { const int st = (r >> 4) * 2 + (c >> 5), rr = r & 15, cc = c & 31, ob = rr * 64 + cc * 2; return st * 1024 + (ob ^ (((ob >> 9) & 1) << 5)); }
__host__ __device__ __forceinline__ void stage_rc(int b, int& R, int& C) { const int st = b / 1024, sb = b % 1024, swz = sb ^ (((sb >> 9) & 1) << 5); R = (st >> 1) * 16 + swz / 64; C = (st & 1) * 32 + (swz % 64) / 2; }
__host__ __device__ __forceinline__ int perm32(int rho) { const int n = rho >> 4, i = rho & 15; return 8 * (i >> 2) + 4 * n + (i & 3); }
struct Unit { int pm, pn; };

struct DenseProb {
    const char* A; const char* Bt; int K; int nM, nN, nwg, G, c;
    __device__ void init(const void* A_, const void* Bt_, int M, int N, int K_, int G_, int c_) { A = (const char*)A_; Bt = (const char*)Bt_; K = K_; nM = M / BM; nN = N / BM; nwg = nM * nN; G = G_; c = c_; }
    __device__ __forceinline__ bool next(int i, Unit& u) const {
        const long L = (long)i * G + c; if (L >= nwg) return false;
        int wgid = (int)L; { const int q = nwg / NXCD, r = nwg % NXCD, xcd = wgid % NXCD, off = wgid / NXCD; wgid = (xcd < r ? xcd * (q + 1) : r * (q + 1) + (xcd - r) * q) + off; }
        const int nig = WGM * nN, gid = wgid / nig, fm = gid * WGM, gsz = (nM - fm) < WGM ? (nM - fm) : WGM;
        u.pm = fm + ((wgid % nig) % gsz); u.pn = (wgid % nig) / gsz; return true;
    }
    __device__ __forceinline__ const char* a_ptr(const Unit& u) const { return A + (size_t)u.pm * BM * K * 2; }
    __device__ __forceinline__ const char* b_ptr(const Unit& u) const { return Bt + (size_t)u.pn * BM * K * 2; }
};
struct MoeProb {
    const char* A; const char* Bt; int K; int nN, T, G, c; size_t estride; const int* tile_e;
    __device__ __forceinline__ bool next(int i, Unit& u) const { const long L = (long)i * G + c; if (L >= (long)T * nN) return false; u.pm = (int)(L / nN); u.pn = (int)(L % nN); return true; }
    __device__ __forceinline__ const char* a_ptr(const Unit& u) const { return A + (size_t)u.pm * BM * K * 2; }
    __device__ __forceinline__ const char* b_ptr(const Unit& u) const { return Bt + (size_t)tile_e[u.pm] * estride + (size_t)u.pn * BM * K * 2; }
};

template <class Epi, class Prob>
__device__ __forceinline__ void gemm_phase(LDS3 unsigned char* lds, const Prob& S, const Epi& E) {
    const int tid = tid_(), wid = __builtin_amdgcn_readfirstlane(tid >> 6), lane = tid & 63, wr = wid >> 2, wc = wid & 3, fr = lane & 15, fq = lane >> 4;
    const int K = S.K, nt = K / BK;
    unsigned voffA[2], voffB[2];
#pragma unroll
    for (int i = 0; i < 2; ++i) { int R, C; stage_rc(tid * 16 + i * 8192, R, C); const int Rb = Epi::PERM ? ((R & ~31) + perm32(R & 31)) : R;
        voffA[i] = (unsigned)(R * K + C) * 2u; voffB[i] = (unsigned)(Rb * K + C) * 2u; }
    const size_t kstep = (size_t)(BK * 2);
    const size_t hstep = (size_t)HALF * K * 2;
    const unsigned ldsw = (unsigned)wid * 1024u;
    const int aoff = lds_byte(wr * 64 + fr, fq * 8), boff = lds_byte(wc * 32 + fr, fq * 8);
#define PG8_SA(b, h) (((b) * 2 + (h)) * HTB)
#define PG8_SB(b, h) ((4 + (b) * 2 + (h)) * HTB)
#define PG8_STAGE(bufoff, gbase, voff) do { _Pragma("unroll") for (int _i = 0; _i < 2; ++_i) \
        __builtin_amdgcn_global_load_lds((const unsigned*)((const char*)(gbase) + (voff)[_i]), (LDS3 unsigned*)(lds + (bufoff) + ldsw + _i * 8192), 16, 0, 0); } while (0)
#define PG8_LDA(dst, b, h) do { _Pragma("unroll") for (int m = 0; m < 4; ++m) _Pragma("unroll") for (int k = 0; k < 2; ++k) dst[m][k] = *(const LDS3 bf16x8*)(lds + PG8_SA(b, h) + aoff + m * 2048 + k * 1024); } while (0)
#define PG8_LDB(dst, b, h) do { _Pragma("unroll") for (int n = 0; n < 2; ++n) _Pragma("unroll") for (int k = 0; k < 2; ++k) dst[n][k] = *(const LDS3 bf16x8*)(lds + PG8_SB(b, h) + boff + n * 2048 + k * 1024); } while (0)
#define PG8_MMA(ai, bj, At, Bt) do { __builtin_amdgcn_s_setprio(1); _Pragma("unroll") for (int m = 0; m < 4; ++m) _Pragma("unroll") for (int n = 0; n < 2; ++n) _Pragma("unroll") for (int k = 0; k < 2; ++k) \
        acc[ai][bj][m][n] = __builtin_amdgcn_mfma_f32_16x16x32_bf16(Bt[n][k], At[m][k], acc[ai][bj][m][n], 0, 0, 0); __builtin_amdgcn_s_setprio(0); } while (0)
#define PG8_WAIT_V(n) asm volatile("s_waitcnt vmcnt(" #n ")" ::: "memory")
#define PG8_WAIT_L(n) asm volatile("s_waitcnt lgkmcnt(" #n ")" ::: "memory")
#define PG8_BAR __builtin_amdgcn_s_barrier()
#define PG8_SCHED __builtin_amdgcn_sched_barrier(0)
    Unit cur, nxt; int ui = 0;
    if (!S.next(0, cur)) return;
    f32x4 acc[2][2][4][2];
#pragma unroll
    for (int a = 0; a < 2; ++a)
#pragma unroll
        for (int b = 0; b < 2; ++b)
#pragma unroll
            for (int m = 0; m < 4; ++m)
#pragma unroll
                for (int n = 0; n < 2; ++n) acc[a][b][m][n] = (f32x4){0.f, 0.f, 0.f, 0.f};
    bf16x8 At[4][2], B0[2][2], B1[2][2];
    const char* cA = S.a_ptr(cur); const char* cB = S.b_ptr(cur);
    PG8_STAGE(PG8_SB(0, 0), cB, voffB); PG8_STAGE(PG8_SA(0, 0), cA, voffA); PG8_STAGE(PG8_SB(0, 1), cB + hstep, voffB); PG8_STAGE(PG8_SA(0, 1), cA + hstep, voffA);
    if (wr == 1) PG8_BAR;
    PG8_WAIT_V(4); PG8_BAR;
    PG8_STAGE(PG8_SB(1, 0), cB + kstep, voffB); PG8_STAGE(PG8_SA(1, 0), cA + kstep, voffA); PG8_STAGE(PG8_SB(1, 1), cB + hstep + kstep, voffB);
    PG8_WAIT_V(6); PG8_BAR;
    for (;;) {
        const bool has_next = S.next(ui + 1, nxt);
        const char* nA = has_next ? S.a_ptr(nxt) : cA; const char* nB = has_next ? S.b_ptr(nxt) : cB;
        for (int t = 0; t < nt; t += 2) {
            const bool last = (t == nt - 2);
            const char* a1 = cA + (size_t)(t + 1) * kstep;
            const char* a2 = last ? nA : cA + (size_t)(t + 2) * kstep; const char* b2 = last ? nB : cB + (size_t)(t + 2) * kstep;
            const char* a3 = a2 + kstep; const char* b3 = b2 + kstep;
            PG8_LDB(B0, 0, 0); PG8_SCHED; PG8_LDA(At, 0, 0); PG8_STAGE(PG8_SA(1, 1), a1 + hstep, voffA);
            PG8_WAIT_L(8); PG8_BAR; PG8_WAIT_L(0); PG8_MMA(0, 0, At, B0); PG8_BAR; PG8_SCHED;
            PG8_LDB(B1, 0, 1); PG8_STAGE(PG8_SB(0, 0), b2, voffB);
            PG8_BAR; PG8_WAIT_L(0); PG8_MMA(0, 1, At, B1); PG8_BAR;
            PG8_LDA(At, 0, 1); PG8_STAGE(PG8_SA(0, 0), a2, voffA);
            PG8_BAR; PG8_WAIT_L(0); PG8_MMA(1, 0, At, B0); PG8_BAR; PG8_SCHED;
            PG8_STAGE(PG8_SB(0, 1), b2 + hstep, voffB);
            PG8_WAIT_V(6); PG8_BAR; PG8_MMA(1, 1, At, B1); PG8_BAR;
            PG8_LDB(B0, 1, 0); PG8_SCHED; PG8_LDA(At, 1, 0); PG8_STAGE(PG8_SA(0, 1), a2 + hstep, voffA);
            PG8_WAIT_L(8); PG8_BAR; PG8_WAIT_L(0); PG8_MMA(0, 0, At, B0); PG8_BAR; PG8_SCHED;
            PG8_LDB(B1, 1, 1); PG8_STAGE(PG8_SB(1, 0), b3, voffB);
            PG8_BAR; PG8_WAIT_L(0); PG8_MMA(0, 1, At, B1); PG8_BAR;
            PG8_LDA(At, 1, 1); PG8_STAGE(PG8_SA(1, 0), a3, voffA);
            PG8_BAR; PG8_WAIT_L(0); PG8_MMA(1, 0, At, B0); PG8_BAR; PG8_SCHED;
            PG8_STAGE(PG8_SB(1, 1), b3 + hstep, voffB);
            PG8_WAIT_V(6); PG8_BAR; PG8_MMA(1, 1, At, B1); PG8_BAR;
        }
        E(acc, cur, wr, wc, fr, fq);
        if (!has_next) break;
#pragma unroll
        for (int a = 0; a < 2; ++a)
#pragma unroll
            for (int b = 0; b < 2; ++b)
#pragma unroll
                for (int m = 0; m < 4; ++m)
#pragma unroll
                    for (int n = 0; n < 2; ++n) acc[a][b][m][n] = (f32x4){0.f, 0.f, 0.f, 0.f};
        cur = nxt; cA = nA; cB = nB; ++ui;
    }
    PG8_WAIT_V(0);
    if (wr == 0) PG8_BAR;
    PG8_BAR;
#undef PG8_SA
#undef PG8_SB
#undef PG8_STAGE
#undef PG8_LDA
#undef PG8_LDB
#undef PG8_MMA
#undef PG8_WAIT_V
#undef PG8_WAIT_L
#undef PG8_BAR
#undef PG8_SCHED
}
}
using pg8::Unit;

#define EPI_ROWS(ai, m) for (int ai = 0; ai < 2; ++ai) _Pragma("unroll") for (int m = 0; m < 4; ++m)

struct EpiProj {
    static constexpr bool PERM = true;
    unsigned char* ws;
    __device__ __forceinline__ void operator()(const f32x4 (&acc)[2][2][4][2], const Unit& u, int wr, int wc, int fr, int fq) const {
        const int pn = u.pn; const int row0 = u.pm * 256 + wr * 64 + fr; const int cw = wc * 32 + 8 * fq;
        if (pn < 12 || (pn >= 30 && pn < 38)) {
            size_t boff; int ld, col0, act;
            if (pn < 2) { boff = WS_GQ; ld = 512; col0 = pn * 256; act = 0; }
            else if (pn < 4) { boff = WS_GK; ld = 512; col0 = (pn - 2) * 256; act = 0; }
            else if (pn < 8) { boff = WS_GV; ld = 1024; col0 = (pn - 4) * 256; act = 0; }
            else if (pn < 12) { boff = WS_GR; ld = 1024; col0 = (pn - 8) * 256; act = 1; }
            else if (pn < 34) { boff = WS_SG; ld = 1024; col0 = (pn - 30) * 256; act = 2; }
            else { boff = WS_SA; ld = 1024; col0 = (pn - 34) * 256; act = 2; }
            bf16_t* base = (bf16_t*)(ws + boff);
#pragma unroll
            EPI_ROWS(ai, m) { bf16_t* rowp = base + (size_t)(row0 + ai * 128 + m * 16) * ld + col0 + cw;
#pragma unroll
                for (int bj = 0; bj < 2; ++bj) { float v[8];
#pragma unroll
                    for (int j = 0; j < 4; ++j) { v[j] = acc[ai][bj][m][0][j]; v[4 + j] = acc[ai][bj][m][1][j]; }
                    if (act == 1) {
#pragma unroll
                        for (int j = 0; j < 8; ++j) v[j] = v[j] * sigmoidf_(v[j]); }
                    if (act == 2) {
#pragma unroll
                        for (int j = 0; j < 8; ++j) v[j] = sigmoidf_(v[j]); }
                    *(u32x4*)(rowp + bj * 128) = pack8(v); } }
        } else if (pn < 30) {
            const int which = (pn - 12) / 6, t6 = (pn - 12) % 6, sh = (t6 >> 1) * 2, dmask = (1 << sh) - 1, NL = SEQ >> sh;
            bf16_t* base = (bf16_t*)(ws + WS_AQ + (size_t)which * ((size_t)NTOK * 1536 * 2));
            const float* ropec = (const float*)(ws + WS_ROPE_C); const float* ropes = (const float*)(ws + WS_ROPE_S);
            const bool rot = (which < 2) && ((wc & 1) == 0) && (fq < 2);
            const float sc = which == 0 ? QSCALE : 1.0f;
            const int hc = (wc & 1) * 32 + 8 * fq;
#pragma unroll
            EPI_ROWS(ai, m) { const int row = row0 + ai * 128 + m * 16, b = row >> 12, s = row & (SEQ - 1), r = s & dmask, n = s >> sh;
                f32x4 cs = {1.f, 1.f, 1.f, 1.f}, sn = {0.f, 0.f, 0.f, 0.f};
                if (rot) { cs = *(const f32x4*)(ropec + s * 8 + 4 * fq); sn = *(const f32x4*)(ropes + s * 8 + 4 * fq); }
#pragma unroll
                for (int bj = 0; bj < 2; ++bj) { const int head = t6 * 4 + bj * 2 + (wc >> 1); float v[8];
#pragma unroll
                    for (int j = 0; j < 4; ++j) { v[j] = acc[ai][bj][m][0][j]; v[4 + j] = acc[ai][bj][m][1][j]; }
                    { const float a0 = v[0] * cs[0] - v[1] * sn[0], a1 = v[1] * cs[0] + v[0] * sn[0], a2 = v[2] * cs[1] - v[3] * sn[1], a3 = v[3] * cs[1] + v[2] * sn[1];
                      const float a4 = v[4] * cs[2] - v[5] * sn[2], a5 = v[5] * cs[2] + v[4] * sn[2], a6 = v[6] * cs[3] - v[7] * sn[3], a7 = v[7] * cs[3] + v[6] * sn[3];
                      v[0] = a0; v[1] = a1; v[2] = a2; v[3] = a3; v[4] = a4; v[5] = a5; v[6] = a6; v[7] = a7; }
#pragma unroll
                    for (int j = 0; j < 8; ++j) v[j] *= sc;
                    *(u32x4*)(base + ((size_t)(b * 24 + head) * SEQ + (size_t)r * NL + n) * 64 + hc) = pack8(v); } }
        } else {
            if (wc == 0 && fq < 2) { float* glr = (float*)(ws + WS_GLR);
#pragma unroll
                EPI_ROWS(ai, m) { float* rowp = glr + (size_t)(row0 + ai * 128 + m * 16) * 16 + 8 * fq; *(f32x4*)rowp = acc[ai][0][m][0]; *(f32x4*)(rowp + 4) = acc[ai][0][m][1]; } }
        }
    }
};

template <int MODE> struct EpiGate {
    static constexpr bool PERM = true;
    const bf16_t* gate; const bf16_t* t1; bf16_t* out;
    __device__ __forceinline__ void operator()(const f32x4 (&acc)[2][2][4][2], const Unit& u, int wr, int wc, int fr, int fq) const {
        const int row0 = u.pm * 256 + wr * 64 + fr; const int col0 = u.pn * 256 + wc * 32 + 8 * fq;
#pragma unroll
        EPI_ROWS(ai, m) { const size_t off = (size_t)(row0 + ai * 128 + m * 16) * 1024 + col0;
#pragma unroll
            for (int bj = 0; bj < 2; ++bj) { float g[8], v[8]; unpack8(*(const u32x4*)(gate + off + bj * 128), g);
#pragma unroll
                for (int j = 0; j < 4; ++j) { v[j] = acc[ai][bj][m][0][j] * g[j]; v[4 + j] = acc[ai][bj][m][1][j] * g[4 + j]; }
                if (MODE == 1) { float t[8]; unpack8(*(const u32x4*)(t1 + off + bj * 128), t);
#pragma unroll
                    for (int j = 0; j < 8; ++j) v[j] += t[j]; }
                *(u32x4*)(out + off + bj * 128) = pack8(v); } }
    }
};

struct EpiResid {
    static constexpr bool PERM = false;
    const float* x; float* h;
    __device__ __forceinline__ void operator()(const f32x4 (&acc)[2][2][4][2], const Unit& u, int wr, int wc, int fr, int fq) const {
        const int row0 = u.pm * 256 + wr * 64 + fr; const int col0 = u.pn * 256 + wc * 32 + 4 * fq;
#pragma unroll
        EPI_ROWS(ai, m) { const size_t off = (size_t)(row0 + ai * 128 + m * 16) * 1024 + col0;
#pragma unroll
            for (int bj = 0; bj < 2; ++bj)
#pragma unroll
                for (int n = 0; n < 2; ++n) { const size_t o = off + bj * 128 + n * 16; *(f32x4*)(h + o) = *(const f32x4*)(x + o) + acc[ai][bj][m][n]; } }
    }
};

struct EpiAct {
    static constexpr bool PERM = true;
    const float* bgu; const int* tile_e; bf16_t* act;
    __device__ __forceinline__ void operator()(const f32x4 (&acc)[2][2][4][2], const Unit& u, int wr, int wc, int fr, int fq) const {
        const int e = tile_e[u.pm]; const int row0 = u.pm * 256 + wr * 64 + fr; const int j0 = u.pn * 128 + wc * 32 + 8 * fq;
        float bg[8], bu[8];
        { const float* bp = bgu + (size_t)e * 2048 + 2 * j0;
#pragma unroll
          for (int q = 0; q < 4; ++q) { const f32x4 t = *(const f32x4*)(bp + 4 * q); bg[2 * q] = t[0]; bu[2 * q] = t[1]; bg[2 * q + 1] = t[2]; bu[2 * q + 1] = t[3]; } }
#pragma unroll
        EPI_ROWS(ai, m) { float v[8];
#pragma unroll
            for (int j = 0; j < 8; ++j) { const float gt = acc[ai][0][m][j >> 2][j & 3] + bg[j], up = acc[ai][1][m][j >> 2][j & 3] + bu[j];
                const float g = fminf(gt, 7.0f), uu = fminf(fmaxf(up, -7.0f), 7.0f); v[j] = (uu + 1.0f) * (g * sigmoidf_(1.702f * g)); }
            *(u32x4*)(act + (size_t)(row0 + ai * 128 + m * 16) * 1024 + j0) = pack8(v); }
    }
};

struct EpiDown {
    static constexpr bool PERM = true;
    const float* bd; const int* tile_e; bf16_t* y;
    __device__ __forceinline__ void operator()(const f32x4 (&acc)[2][2][4][2], const Unit& u, int wr, int wc, int fr, int fq) const {
        const int e = tile_e[u.pm]; const int row0 = u.pm * 256 + wr * 64 + fr; const int col0 = u.pn * 256 + wc * 32 + 8 * fq;
        f32x4 b[2][2];
#pragma unroll
        for (int bj = 0; bj < 2; ++bj)
#pragma unroll
            for (int n = 0; n < 2; ++n) b[bj][n] = *(const f32x4*)(bd + (size_t)e * 1024 + col0 + bj * 128 + 4 * n);
#pragma unroll
        EPI_ROWS(ai, m) { bf16_t* rowp = y + (size_t)(row0 + ai * 128 + m * 16) * 1024 + col0;
#pragma unroll
            for (int bj = 0; bj < 2; ++bj) { const f32x4 v0 = acc[ai][bj][m][0] + b[bj][0], v1 = acc[ai][bj][m][1] + b[bj][1];
                u32x4 w; w.x = cvt_pk_bf16(v0[0], v0[1]); w.y = cvt_pk_bf16(v0[2], v0[3]); w.z = cvt_pk_bf16(v1[0], v1[1]); w.w = cvt_pk_bf16(v1[2], v1[3]);
                *(u32x4*)(rowp + bj * 128) = w; } }
    }
};

__device__ __forceinline__ int win_colmap(int n) {
    if (n < 3072) return n;
    if (n < 7680) { const int off = n - 3072, which = off / 1536, hcol = off % 1536, head = hcol >> 6, p = hcol & 63;
        int dim = p; if (which < 2 && p < 16) dim = (p & 1) ? (p >> 1) + 8 : (p >> 1);
        return 3088 + which * 1536 + head * 64 + dim; }
    if (n < 9728) return 7696 + (n - 7680);
    if (n < 9744) return 3072 + (n - 9728);
    return -1;
}
__device__ __forceinline__ int gu_colmap(int n) { const int t = n >> 8, w = n & 255; return w < 128 ? 2 * (128 * t + w) : 2 * (128 * t + w - 128) + 1; }

__device__ __forceinline__ void transpose_tile(const float* src, int ld_src, bf16_t* dst, int K, int n0, int k0, int scol, char* lds) {
    const int t = tid_(), nl = t & 127, kq = t >> 7;
#pragma unroll
    for (int cc = 0; cc < 4; ++cc) { const int c = kq * 4 + cc; float v[8];
#pragma unroll
        for (int j = 0; j < 8; ++j) v[j] = scol >= 0 ? src[(size_t)(k0 + c * 8 + j) * ld_src + scol] : 0.f;
        *(u32x4*)(lds + nl * 256 + ((c ^ (nl & 15)) << 4)) = pack8(v); }
    __syncthreads();
#pragma unroll
    for (int pass = 0; pass < 4; ++pass) { const int idx = t + 512 * pass, n2 = idx >> 4, c2 = idx & 15;
        *(u32x4*)(dst + (size_t)(n0 + n2) * K + k0 + c2 * 8) = *(const u32x4*)(lds + n2 * 256 + ((c2 ^ (n2 & 15)) << 4)); }
    __syncthreads();
}

__device__ __forceinline__ void phase_prologue(const Params& p, char* lds) {
    unsigned char* ws = opaque(p.ws);
    const int tid = tid_(), lane = tid & 63, wid = tid >> 6, G = gridDim.x, bid = blockIdx.x;
    { bf16_t* xn = (bf16_t*)(ws + WS_XN);
      for (int row = bid * 8 + wid; row < NTOK; row += G * 8) { const float* xr = p.x + (size_t)row * 1024; f32x4 v[4]; float ss = 0.f;
#pragma unroll
          for (int i = 0; i < 4; ++i) { v[i] = *(const f32x4*)(xr + i * 256 + lane * 4); ss += v[i][0] * v[i][0] + v[i][1] * v[i][1] + v[i][2] * v[i][2] + v[i][3] * v[i][3]; }
          ss = wave_sum(ss); const float rs = rsqrtf(ss * (1.0f / 1024.0f) + EPS);
#pragma unroll
          for (int i = 0; i < 4; ++i) { const f32x4 g = *(const f32x4*)(p.norm_mix_g + i * 256 + lane * 4); u32x2 w; w.x = cvt_pk_bf16(v[i][0] * rs * g[0], v[i][1] * rs * g[1]); w.y = cvt_pk_bf16(v[i][2] * rs * g[2], v[i][3] * rs * g[3]);
              *(u32x2*)(xn + (size_t)row * 1024 + i * 256 + lane * 4) = w; } } }
    { float* rc = (float*)(ws + WS_ROPE_C); float* rsn = (float*)(ws + WS_ROPE_S); float* rwg = (float*)(ws + WS_RWG);
      for (int i = bid * 512 + tid; i < SEQ * 8; i += G * 512) { const int s = i >> 3, f = i & 7; const double inv = pow(500000.0, -(double)f * 0.125); const float ang = (float)s * (float)inv; rc[i] = (float)cos((double)ang); rsn[i] = (float)sin((double)ang); }
      for (int i = bid * 512 + tid; i < 1024 * 32; i += G * 512) rwg[i] = p.router_w[i] * p.norm_ffn_g[i >> 5]; }
    { constexpr int T0 = 78 * 8, T1 = T0 + 64, T2 = T1 + 32, T3 = T2 + 64, T4 = T3 + 32 * 128, T5 = T4 + 32 * 64;
      const int nl = tid & 127;
      for (int tile = bid; tile < T5; tile += G) {
          if (tile < T0) { const int nt_ = tile >> 3, kt = tile & 7; transpose_tile(p.w_in, INW, (bf16_t*)(ws + WS_W_IN), 1024, nt_ * 128, kt * 128, win_colmap(nt_ * 128 + nl), lds); }
          else if (tile < T1) { const int q = tile - T0, nt_ = q >> 3, kt = q & 7; transpose_tile(p.w_branch_gla, 1024, (bf16_t*)(ws + WS_W_G), 1024, nt_ * 128, kt * 128, nt_ * 128 + nl, lds); }
          else if (tile < T2) { const int q = tile - T1, nt_ = q >> 2, kt = q & 3; transpose_tile(p.w_branch_att, 1024, (bf16_t*)(ws + WS_W_A), 512, nt_ * 128, kt * 128, nt_ * 128 + nl, lds); }
          else if (tile < T3) { const int q = tile - T2, nt_ = q >> 3, kt = q & 7; transpose_tile(p.w_mix_out, 1024, (bf16_t*)(ws + WS_W_MIX), 1024, nt_ * 128, kt * 128, nt_ * 128 + nl, lds); }
          else if (tile < T4) { const int q = tile - T3, e = q >> 7, r = q & 127, nt_ = r >> 3, kt = r & 7;
              transpose_tile(p.e_w_gu + (size_t)e * 1024 * 2048, 2048, (bf16_t*)(ws + WS_W_GU) + (size_t)e * 2048 * 1024, 1024, nt_ * 128, kt * 128, gu_colmap(nt_ * 128 + nl), lds); }
          else { const int q = tile - T4, e = q >> 6, r = q & 63, nt_ = r >> 3, kt = r & 7;
              transpose_tile(p.e_w_d + (size_t)e * 1024 * 1024, 1024, (bf16_t*)(ws + WS_W_D) + (size_t)e * 1024 * 1024, 1024, nt_ * 128, kt * 128, nt_ * 128 + nl, lds); }
      } }
}

constexpr int AT_KCS = 385 * 16;
constexpr int AT_VH = 385 * 64;
constexpr int AT_K = 0, AT_V = 8 * AT_KCS, AT_WL = AT_V + 2 * AT_VH, AT_STG = AT_WL + 8 * 128, AT_END = AT_STG + 8 * 4096;
static_assert(AT_END <= LDS_BYTES, "attention LDS");
__device__ __forceinline__ void attn_item(const Params& p, int item, char* lds) {
    unsigned char* ws = opaque(p.ws);
    const int tid = tid_(), lane = tid & 63, r32 = lane & 31, hi = lane >> 5; const int w = __builtin_amdgcn_readfirstlane(tid >> 6);
    const int jj = item & 15, bh = item >> 4, head = bh % 24, b = bh / 24, g = head >> 3, sh = 2 * g, d = 1 << sh, NL = SEQ >> sh, ppr = 16 >> sh;
    const int r = jj / ppr, j = jj % ppr;
    const size_t hb = ((size_t)bh * SEQ + (size_t)r * NL) * 64;
    const bf16_t* Q = (const bf16_t*)(ws + WS_AQ) + hb; const bf16_t* Kg = (const bf16_t*)(ws + WS_AK) + hb; const bf16_t* Vg = (const bf16_t*)(ws + WS_AV) + hb;
    const int kn0 = 256 * j - 128;
#pragma unroll
    for (int i = 0; i < 6; ++i) { const int idx = tid + 512 * i, key = idx >> 3, c = idx & 7;
        if (kn0 + key >= 0) { const u32x4 kv = *(const u32x4*)(Kg + (ptrdiff_t)(kn0 + key) * 64 + c * 8); const u32x4 vv = *(const u32x4*)(Vg + (ptrdiff_t)(kn0 + key) * 64 + c * 8);
            *(u32x4*)(lds + AT_K + c * AT_KCS + key * 16) = kv; *(u32x4*)(lds + AT_V + (c >> 2) * AT_VH + key * 64 + (c & 3) * 16) = vv; } }
    bf16x8 qf[4];
#pragma unroll
    for (int d0 = 0; d0 < 4; ++d0) qf[d0] = *(const bf16x8*)(Q + (size_t)(256 * j + 32 * w + r32) * 64 + d0 * 16 + hi * 8);
    __syncthreads();
    const LDS3 char* l3 = (const LDS3 char*)lds;
    f32x16 s[5]; const int ktmin = (j == 0) ? 4 : 0;
#pragma unroll
    for (int t5 = 0; t5 < 5; ++t5) { const int kt = w + t5;
        if (kt >= ktmin) { f32x16 a = {};
#pragma unroll
            for (int d0 = 0; d0 < 4; ++d0) { const bf16x8 kf = *(const LDS3 bf16x8*)(l3 + AT_K + (2 * d0 + hi) * AT_KCS + (kt * 32 + r32) * 16); a = MFMA32(kf, qf[d0], a); }
            s[t5] = a; }
        else {
#pragma unroll
            for (int rr = 0; rr < 16; ++rr) s[t5][rr] = -1e30f; } }
#pragma unroll
    for (int rr = 0; rr < 16; ++rr) { const int c = crow(rr, hi); if (c < r32) s[0][rr] = -1e30f; if (c > r32) s[4][rr] = -1e30f; }
    float mx = -1e30f;
#pragma unroll
    for (int t5 = 0; t5 < 5; ++t5)
#pragma unroll
        for (int rr = 0; rr < 16; ++rr) mx = fmaxf(mx, s[t5][rr]);
    mx = fmaxf(mx, __shfl_xor(mx, 32));
    float l = 0.f;
#pragma unroll
    for (int t5 = 0; t5 < 5; ++t5)
#pragma unroll
        for (int rr = 0; rr < 16; ++rr) { const float e = __builtin_amdgcn_exp2f(s[t5][rr] - mx); s[t5][rr] = e; l += e; }
    l += __shfl_xor(l, 32);
    f32x16 o[2]; o[0] = f32x16{}; o[1] = f32x16{};
    const int blk = (lane >> 4) & 1, q4 = (lane & 15) >> 2, p4 = lane & 3;
#pragma unroll
    for (int t5 = 0; t5 < 5; ++t5) { const int kt = w + t5;
        if (kt >= ktmin) {
#pragma unroll
            for (int ss = 0; ss < 2; ++ss) { float pv[8];
#pragma unroll
                for (int q = 0; q < 8; ++q) pv[q] = s[t5][8 * ss + q];
                const bf16x8 pa = __builtin_bit_cast(bf16x8, pack8(pv));
#pragma unroll
                for (int dh = 0; dh < 2; ++dh) { const LDS3 char* vp = l3 + AT_V + dh * AT_VH + (kt * 32 + 16 * ss + 4 * hi + q4) * 64 + (16 * blk + 4 * p4) * 2;
                    const bf16x8 vf = cat8(tr16(vp), tr16(vp + 8 * 64)); o[dh] = MFMA32(pa, vf, o[dh]); } } } }
    const int n_q = 256 * j + 32 * w + r32; const int tok = b * SEQ + n_q * d + r;
    if (hi == 0) { ((float*)(ws + WS_LSE))[((size_t)g * NTOK + tok) * 8 + (head & 7)] = (mx + __builtin_amdgcn_logf(l)) * LN2;
        ((float*)(lds + AT_WL))[w * 32 + r32] = 1.0f / l; }
    bf16_t* stg = (bf16_t*)(lds + AT_STG) + w * 2048;
#pragma unroll
    for (int rr = 0; rr < 16; ++rr) { const int qr = crow(rr, hi); const float rl = ((const float*)(lds + AT_WL))[w * 32 + qr];
#pragma unroll
        for (int dh = 0; dh < 2; ++dh) stg[qr * 64 + dh * 32 + r32] = (bf16_t)(cvt_pk_bf16(o[dh][rr] * rl, 0.f) & 0xffffu); }
    bf16_t* og = (bf16_t*)(ws + WS_OATT) + (size_t)g * NTOK * 512;
#pragma unroll
    for (int i = 0; i < 4; ++i) { const int idx = i * 64 + lane, row = idx >> 3, ch = idx & 7; const int tk = b * SEQ + (256 * j + 32 * w + row) * d + r;
        *(u32x4*)(og + (size_t)tk * 512 + (head & 7) * 64 + ch * 8) = *(const u32x4*)(stg + row * 64 + ch * 8); }
    __syncthreads();
}

constexpr int G1_BB = 0;
constexpr int G1_QE = G1_BB + 64 * 128 * 4;
constexpr int G1_KE = G1_QE + 64 * 272;
constexpr int G1_KD = G1_KE + 64 * 272;
constexpr int G1_V = G1_KD + 64 * 320;
constexpr int G1_GLR = G1_V + 64 * 576;
constexpr int G1_GUP = G1_GLR + 64 * 16 * 4;
constexpr int G1_SEG = G1_GUP + 16 * 128 * 4;
constexpr int G1_BIAS = G1_SEG + 4 * 128 * 4;
constexpr int G1_END = G1_BIAS + 128 * 4;
static_assert(G1_END <= LDS_BYTES, "gla1 LDS");
__device__ __forceinline__ float logsigmoidf_(float z) { return fminf(z, 0.f) - log1pf(__expf(-fabsf(z))); }
__device__ __forceinline__ void gla1_item(const Params& p, int item, char* lds) {
    unsigned char* ws = opaque(p.ws);
    const int tid = tid_(), lane = tid & 63, r32 = lane & 31, hi = lane >> 5; const int w = __builtin_amdgcn_readfirstlane(tid >> 6);
    const int n = item & 63, bh = item >> 6, h = bh & 3, b = bh >> 2; const int tok0 = b * SEQ + n * 64;
    float* BB = (float*)(lds + G1_BB); float* GLRs = (float*)(lds + G1_GLR); float* GUP = (float*)(lds + G1_GUP); float* SEGs = (float*)(lds + G1_SEG); float* BIAS = (float*)(lds + G1_BIAS);
    for (int i = tid; i < 64 * 16; i += 512) GLRs[i] = ((const float*)(ws + WS_GLR))[(size_t)tok0 * 16 + i];
    for (int i = tid; i < 16 * 128; i += 512) GUP[i] = p.gla_gate_up[(i >> 7) * 512 + h * 128 + (i & 127)];
    if (tid < 128) BIAS[tid] = p.gla_gate_bias[h * 128 + tid];
    __syncthreads();
    { const int d = tid & 127, seg = tid >> 7; float gu[16];
#pragma unroll
      for (int r = 0; r < 16; ++r) gu[r] = GUP[r * 128 + d];
      const float bias = BIAS[d]; float run = 0.f;
#pragma unroll 4
      for (int ii = 0; ii < 16; ++ii) { const int i = seg * 16 + ii; float z = bias;
#pragma unroll
          for (int r4 = 0; r4 < 4; ++r4) { const f32x4 gl = *(const f32x4*)(GLRs + i * 16 + r4 * 4); z += gl[0] * gu[r4 * 4] + gl[1] * gu[r4 * 4 + 1] + gl[2] * gu[r4 * 4 + 2] + gl[3] * gu[r4 * 4 + 3]; }
          run += logsigmoidf_(z) * (1.0f / 16.0f); BB[i * 128 + d] = run; }
      SEGs[seg * 128 + d] = run;
      __syncthreads();
      float off = 0.f; for (int s2 = 0; s2 < seg; ++s2) off += SEGs[s2 * 128 + d];
      if (seg > 0) { for (int ii = 0; ii < 16; ++ii) BB[(seg * 16 + ii) * 128 + d] += off; }
      __syncthreads(); }
    { const bf16_t* gq = (const bf16_t*)(ws + WS_GQ); const bf16_t* gk = (const bf16_t*)(ws + WS_GK); const bf16_t* gv = (const bf16_t*)(ws + WS_GV); bf16_t* qeg = (bf16_t*)(ws + WS_QE);
#pragma unroll
      for (int pp = 0; pp < 2; ++pp) { const int idx = tid + 512 * pp, i = idx >> 4, c = idx & 15, d0 = c * 8; const size_t go = (size_t)(tok0 + i) * 512 + h * 128 + d0;
          float q[8], k[8], qe[8], ke[8], kd[8]; unpack8(*(const u32x4*)(gq + go), q); unpack8(*(const u32x4*)(gk + go), k);
#pragma unroll
          for (int j = 0; j < 8; ++j) { const float bb = BB[i * 128 + d0 + j], bl = BB[63 * 128 + d0 + j]; qe[j] = q[j] * __expf(bb) * 0.08838834764831845f; ke[j] = k[j] * __expf(-bb); kd[j] = k[j] * __expf(bl - bb); }
          const u32x4 qw = pack8(qe); *(u32x4*)(lds + G1_QE + i * 272 + c * 16) = qw; *(u32x4*)(qeg + go) = qw;
          *(u32x4*)(lds + G1_KE + i * 272 + c * 16) = pack8(ke); *(u32x4*)(lds + G1_KD + i * 320 + c * 16) = pack8(kd); }
#pragma unroll
      for (int pp = 0; pp < 4; ++pp) { const int idx = tid + 512 * pp, jv = idx >> 5, c = idx & 31; *(u32x4*)(lds + G1_V + jv * 576 + c * 16) = *(const u32x4*)(gv + (size_t)(tok0 + jv) * 1024 + h * 256 + c * 8); }
      if (tid < 128) ((float*)(ws + WS_DEC))[(size_t)item * 128 + tid] = __expf(BB[63 * 128 + tid]);
      __syncthreads(); }
    const LDS3 char* l3 = (const LDS3 char*)lds; const int blk = (lane >> 4) & 1, q4 = (lane & 15) >> 2, p4 = lane & 3;
    {
      const int it = w & 1, vq = w >> 1; f32x16 oi[2]; oi[0] = f32x16{}; oi[1] = f32x16{};
#pragma unroll
      for (int jt = 0; jt < 2; ++jt) { if (jt <= it) { f32x16 x = {};
#pragma unroll
          for (int s = 0; s < 8; ++s) { const bf16x8 a = *(const LDS3 bf16x8*)(l3 + G1_KE + (jt * 32 + r32) * 272 + (16 * s + 8 * hi) * 2), bq = *(const LDS3 bf16x8*)(l3 + G1_QE + (it * 32 + r32) * 272 + (16 * s + 8 * hi) * 2); x = MFMA32(a, bq, x); }
          if (jt == it) {
#pragma unroll
              for (int rr = 0; rr < 16; ++rr) if (crow(rr, hi) > r32) x[rr] = 0.f; }
#pragma unroll
          for (int ss = 0; ss < 2; ++ss) { float xv[8];
#pragma unroll
              for (int q = 0; q < 8; ++q) xv[q] = x[8 * ss + q];
              const bf16x8 xa = __builtin_bit_cast(bf16x8, pack8(xv));
#pragma unroll
              for (int vi = 0; vi < 2; ++vi) { const int vt = 2 * vq + vi; const LDS3 char* vp = l3 + G1_V + (jt * 32 + 16 * ss + 4 * hi + q4) * 576 + (vt * 32 + 16 * blk + 4 * p4) * 2;
                  const bf16x8 vf = cat8(tr16(vp), tr16(vp + 8 * 576)); oi[vi] = MFMA32(xa, vf, oi[vi]); } } } }
      float* og = (float*)(ws + WS_OINTRA);
#pragma unroll
      for (int vi = 0; vi < 2; ++vi)
#pragma unroll
          for (int rr = 0; rr < 16; ++rr) og[(size_t)(tok0 + it * 32 + crow(rr, hi)) * 1024 + h * 256 + (2 * vq + vi) * 32 + r32] = oi[vi][rr]; }
    {
      const int dt = w & 3, vg = w >> 2; f32x16 uu[4]; uu[0] = f32x16{}; uu[1] = f32x16{}; uu[2] = f32x16{}; uu[3] = f32x16{};
#pragma unroll
      for (int ks = 0; ks < 4; ++ks) { const LDS3 char* ap = l3 + G1_KD + (16 * ks + 8 * hi + q4) * 320 + (dt * 32 + 16 * blk + 4 * p4) * 2; const bf16x8 a = cat8(tr16(ap), tr16(ap + 4 * 320));
#pragma unroll
          for (int vi = 0; vi < 4; ++vi) { const int vt = 4 * vg + vi; const LDS3 char* vp = l3 + G1_V + (16 * ks + 8 * hi + q4) * 576 + (vt * 32 + 16 * blk + 4 * p4) * 2; const bf16x8 vf = cat8(tr16(vp), tr16(vp + 4 * 576)); uu[vi] = MFMA32(a, vf, uu[vi]); } }
      bf16_t* ug = (bf16_t*)(ws + WS_U) + (size_t)item * 128 * 256;
#pragma unroll
      for (int vi = 0; vi < 4; ++vi)
#pragma unroll
          for (int rr = 0; rr < 16; ++rr) ug[(size_t)(dt * 32 + crow(rr, hi)) * 256 + (4 * vg + vi) * 32 + r32] = (bf16_t)(cvt_pk_bf16(uu[vi][rr], 0.f) & 0xffffu); }
    __syncthreads();
}

__device__ __forceinline__ void phase_scan_combine(const Params& p) {
    unsigned char* ws = opaque(p.ws); const int G = gridDim.x;
    { const bf16_t* U = (const bf16_t*)(ws + WS_U); bf16_t* PV = (bf16_t*)(ws + WS_PREV); const float* DEC = (const float*)(ws + WS_DEC);
      for (int idx = blockIdx.x * 512 + tid_(); idx < 16 * 128 * 64; idx += G * 512) { const int bh = idx >> 13, rem = idx & 8191, d = rem >> 6, vq = rem & 63;
          float st[4] = {0.f, 0.f, 0.f, 0.f}; const size_t e0 = ((size_t)bh * 64 * 128 + d) * 256 + vq * 4;
#pragma unroll 8
          for (int n = 0; n < 64; ++n) { const size_t e = e0 + (size_t)n * 128 * 256; const u32x2 uw = *(const u32x2*)(U + e); const float dc = DEC[(size_t)(bh * 64 + n) * 128 + d];
              u32x2 pw; pw.x = cvt_pk_bf16(st[0], st[1]); pw.y = cvt_pk_bf16(st[2], st[3]); *(u32x2*)(PV + e) = pw;
              st[0] = dc * st[0] + bf_lo(uw.x); st[1] = dc * st[1] + bf_hi(uw.x); st[2] = dc * st[2] + bf_lo(uw.y); st[3] = dc * st[3] + bf_hi(uw.y); } } }
    { const bf16_t* OG = (const bf16_t*)(ws + WS_OATT); const float* LSE = (const float*)(ws + WS_LSE); bf16_t* YA = (bf16_t*)(ws + WS_YATT);
      for (int idx = blockIdx.x * 512 + tid_(); idx < NTOK * 64; idx += G * 512) { const int tok = idx >> 6, jc = idx & 63, jh = jc >> 3;
          const float l0 = LSE[(size_t)tok * 8 + jh], l1 = LSE[((size_t)NTOK + tok) * 8 + jh], l2 = LSE[((size_t)2 * NTOK + tok) * 8 + jh];
          const float m = fmaxf(l0, fmaxf(l1, l2)); float a0 = __expf(l0 - m), a1 = __expf(l1 - m), a2 = __expf(l2 - m); const float inv = 1.0f / (a0 + a1 + a2); a0 *= inv; a1 *= inv; a2 *= inv;
          float o0[8], o1[8], o2[8], y[8]; const size_t off = (size_t)tok * 512 + jc * 8;
          unpack8(*(const u32x4*)(OG + off), o0); unpack8(*(const u32x4*)(OG + (size_t)NTOK * 512 + off), o1); unpack8(*(const u32x4*)(OG + (size_t)2 * NTOK * 512 + off), o2);
#pragma unroll
          for (int q = 0; q < 8; ++q) y[q] = a0 * o0[q] + a1 * o1[q] + a2 * o2[q];
          *(u32x4*)(YA + off) = pack8(y); } }
}

constexpr int G3_PREV = 0;
constexpr int G3_SS = G3_PREV + 128 * 576;
constexpr int G3_END = G3_SS + 8 * 32 * 4;
static_assert(G3_END <= LDS_BYTES, "gla3 LDS");
__device__ __forceinline__ void gla3_item(const Params& p, int item, char* lds) {
    unsigned char* ws = opaque(p.ws);
    const int tid = tid_(), lane = tid & 63, r32 = lane & 31, hi = lane >> 5; const int w = __builtin_amdgcn_readfirstlane(tid >> 6);
    const int n = item & 63, bh = item >> 6, h = bh & 3, b = bh >> 2; const int tok0 = b * SEQ + n * 64;
    const bf16_t* PV = (const bf16_t*)(ws + WS_PREV) + (size_t)item * 128 * 256;
#pragma unroll
    for (int pp = 0; pp < 8; ++pp) { const int idx = tid + 512 * pp, d = idx >> 5, c = idx & 31; *(u32x4*)(lds + G3_PREV + d * 576 + c * 16) = *(const u32x4*)(PV + (size_t)d * 256 + c * 8); }
    const int it = w & 1, vq = w >> 1; const bf16_t* qeg = (const bf16_t*)(ws + WS_QE) + (size_t)(tok0 + it * 32 + r32) * 512 + h * 128;
    bf16x8 qa[8];
#pragma unroll
    for (int s = 0; s < 8; ++s) qa[s] = *(const bf16x8*)(qeg + 16 * s + 8 * hi);
    __syncthreads();
    const LDS3 char* l3 = (const LDS3 char*)lds; const int blk = (lane >> 4) & 1, q4 = (lane & 15) >> 2, p4 = lane & 3;
    f32x16 o[2]; const float* oig = (const float*)(ws + WS_OINTRA);
#pragma unroll
    for (int vi = 0; vi < 2; ++vi)
#pragma unroll
        for (int rr = 0; rr < 16; ++rr) o[vi][rr] = oig[(size_t)(tok0 + it * 32 + crow(rr, hi)) * 1024 + h * 256 + (2 * vq + vi) * 32 + r32];
#pragma unroll
    for (int s = 0; s < 8; ++s)
#pragma unroll
        for (int vi = 0; vi < 2; ++vi) { const int vt = 2 * vq + vi; const LDS3 char* pp_ = l3 + G3_PREV + (16 * s + 8 * hi + q4) * 576 + (vt * 32 + 16 * blk + 4 * p4) * 2; const bf16x8 pf = cat8(tr16(pp_), tr16(pp_ + 4 * 576)); o[vi] = MFMA32(qa[s], pf, o[vi]); }
    float* SS = (float*)(lds + G3_SS);
#pragma unroll
    for (int rr = 0; rr < 16; ++rr) { float q = o[0][rr] * o[0][rr] + o[1][rr] * o[1][rr]; q += __shfl_xor(q, 16); q += __shfl_xor(q, 8); q += __shfl_xor(q, 4); q += __shfl_xor(q, 2); q += __shfl_xor(q, 1);
        if (r32 == 0) SS[w * 32 + crow(rr, hi)] = q; }
    __syncthreads();
    const bf16_t* grg = (const bf16_t*)(ws + WS_GR); bf16_t* yg = (bf16_t*)(ws + WS_YGLA);
    float ng[2]; ng[0] = p.gla_norm_g[(2 * vq) * 32 + r32]; ng[1] = p.gla_norm_g[(2 * vq + 1) * 32 + r32];
#pragma unroll
    for (int rr = 0; rr < 16; ++rr) { const int row = crow(rr, hi); const float tot = SS[(it + 0) * 32 + row] + SS[(it + 2) * 32 + row] + SS[(it + 4) * 32 + row] + SS[(it + 6) * 32 + row];
        const float rs = rsqrtf(tot * (1.0f / 256.0f) + EPS); const size_t ro = (size_t)(tok0 + it * 32 + row) * 1024 + h * 256;
#pragma unroll
        for (int vi = 0; vi < 2; ++vi) { const int col = (2 * vq + vi) * 32 + r32; const float y = o[vi][rr] * rs * ng[vi] * bf2f(grg[ro + col]); yg[ro + col] = (bf16_t)(cvt_pk_bf16(y, 0.f) & 0xffffu); } }
    __syncthreads();
}

constexpr int RT_RSTD = 0;
constexpr int RT_LOG = 256;
constexpr int RT_CNT = RT_LOG + 64 * 32 * 4;
__device__ __forceinline__ void route_group(const Params& p, int grp, char* lds) {
    unsigned char* ws = opaque(p.ws); const int tid = tid_(), lane = tid & 63; const int w = __builtin_amdgcn_readfirstlane(tid >> 6);
    const float* H = (const float*)(ws + WS_H); const float* RWG = (const float*)(ws + WS_RWG);
    float* RSTD = (float*)(lds + RT_RSTD); float* LOGS = (float*)(lds + RT_LOG); int* LCNT = (int*)(lds + RT_CNT);
    const int tok0 = grp * 64;
    if (tid < 32) LCNT[tid] = 0;
    if (w < 4) { const int tl = lane & 15, kq = lane >> 4; const float* hr = H + (size_t)(tok0 + w * 16 + tl) * 1024 + kq * 256; const float* br = RWG + (size_t)(kq * 256) * 32 + tl;
        f32x4 a0 = {0.f, 0.f, 0.f, 0.f}, a1 = {0.f, 0.f, 0.f, 0.f}; float ss = 0.f;
#pragma unroll 4
        for (int m4 = 0; m4 < 64; ++m4) { const f32x4 hv = *(const f32x4*)(hr + m4 * 4);
#pragma unroll
            for (int q = 0; q < 4; ++q) { const float b0 = br[(size_t)(m4 * 4 + q) * 32], b1 = br[(size_t)(m4 * 4 + q) * 32 + 16];
                a0 = __builtin_amdgcn_mfma_f32_16x16x4f32(hv[q], b0, a0, 0, 0, 0); a1 = __builtin_amdgcn_mfma_f32_16x16x4f32(hv[q], b1, a1, 0, 0, 0); ss += hv[q] * hv[q]; } }
        ss += __shfl_xor(ss, 16); ss += __shfl_xor(ss, 32);
        const float rs = rsqrtf(ss * (1.0f / 1024.0f) + EPS);
        if (kq == 0) RSTD[w * 16 + tl] = rs;
#pragma unroll
        for (int rg = 0; rg < 4; ++rg) { const int t = w * 16 + 4 * kq + rg; LOGS[t * 32 + tl] = a0[rg]; LOGS[t * 32 + 16 + tl] = a1[rg]; } }
    __syncthreads();
    if (tid < 64) { const int tok = tok0 + tid; const float rs = RSTD[tid]; float lg[32];
#pragma unroll
        for (int e = 0; e < 32; ++e) lg[e] = LOGS[tid * 32 + e] * rs + p.router_b[e];
        int be[4]; float bv[4];
#pragma unroll
        for (int k = 0; k < 4; ++k) { float best = -3.0e38f; int bi = 0;
#pragma unroll
            for (int e = 0; e < 32; ++e) { const bool tk = lg[e] > best; best = tk ? lg[e] : best; bi = tk ? e : bi; }
            be[k] = bi; bv[k] = best;
#pragma unroll
            for (int e = 0; e < 32; ++e) lg[e] = (e == bi) ? -3.0e38f : lg[e]; }
        const float e1 = __expf(bv[1] - bv[0]), e2 = __expf(bv[2] - bv[0]), e3 = __expf(bv[3] - bv[0]); const float inv = 1.0f / (1.0f + e1 + e2 + e3);
        const float gt[4] = {inv, e1 * inv, e2 * inv, e3 * inv};
#pragma unroll
        for (int k = 0; k < 4; ++k) { const int pos = atomicAdd(&LCNT[be[k]], 1);
            ((int*)(ws + WS_TOPE))[tok * 4 + k] = be[k]; ((float*)(ws + WS_TOPG))[tok * 4 + k] = gt[k]; ((int*)(ws + WS_TOPP))[tok * 4 + k] = pos; } }
    { bf16_t* HN = (bf16_t*)(ws + WS_HN);
#pragma unroll 4
      for (int i = 0; i < 16; ++i) { const int idx = tid + 512 * i, t = idx >> 7, c = idx & 127; const float rs = RSTD[t]; const size_t off = (size_t)(tok0 + t) * 1024 + c * 8;
          const f32x4 h0 = *(const f32x4*)(H + off), h1 = *(const f32x4*)(H + off + 4), g0 = *(const f32x4*)(p.norm_ffn_g + c * 8), g1 = *(const f32x4*)(p.norm_ffn_g + c * 8 + 4);
          u32x4 wv; wv.x = cvt_pk_bf16(h0[0] * rs * g0[0], h0[1] * rs * g0[1]); wv.y = cvt_pk_bf16(h0[2] * rs * g0[2], h0[3] * rs * g0[3]); wv.z = cvt_pk_bf16(h1[0] * rs * g1[0], h1[1] * rs * g1[1]); wv.w = cvt_pk_bf16(h1[2] * rs * g1[2], h1[3] * rs * g1[3]);
          *(u32x4*)(HN + off) = wv; } }
    __syncthreads();
    if (tid < 32) ((int*)(ws + WS_CNT))[grp * 32 + tid] = LCNT[tid];
    __syncthreads();
}

constexpr int DP_TOT = 0;
constexpr int DP_PART = 512;
__device__ __forceinline__ void dispatch_tables(const Params& p, int grp, char* lds) {
    unsigned char* ws = opaque(p.ws); const int tid = tid_(); const int* CNT = (const int*)(ws + WS_CNT); int* T = (int*)(lds + DP_TOT); int* PART = (int*)(lds + DP_PART);
    { const int e = tid & 31, part = tid >> 5; int tot = 0, pre = 0;
      for (int g2 = part * 16; g2 < part * 16 + 16; ++g2) { const int c = CNT[g2 * 32 + e]; tot += c; if (g2 < grp) pre += c; }
      PART[part * 32 + e] = tot; PART[512 + part * 32 + e] = pre; }
    __syncthreads();
    if (tid < 32) { int tot = 0, pre = 0; for (int q = 0; q < 16; ++q) { tot += PART[q * 32 + tid]; pre += PART[512 + q * 32 + tid]; } T[tid] = tot; T[64 + tid] = pre; }
    __syncthreads();
    if (tid == 0) { int base = 0; for (int e = 0; e < 32; ++e) { T[32 + e] = base; base += (T[e] + 255) >> 8; } T[96] = base; }
    __syncthreads();
}
__device__ __forceinline__ void dispatch_group(const Params& p, int grp, char* lds) {
    unsigned char* ws = opaque(p.ws); const int tid = tid_();
    dispatch_tables(p, grp, lds);
    const int* T = (const int*)(lds + DP_TOT); int* DEST = (int*)(lds + DP_PART + 4096);
    if (tid < 256) { const int tok = grp * 64 + (tid >> 2); const int e = ((const int*)(ws + WS_TOPE))[tok * 4 + (tid & 3)], lp = ((const int*)(ws + WS_TOPP))[tok * 4 + (tid & 3)];
        const int dest = T[32 + e] * 256 + T[64 + e] + lp; DEST[tid] = dest; ((int*)(ws + WS_SLOT))[tok * 4 + (tid & 3)] = dest; }
    __syncthreads();
    const bf16_t* HN = (const bf16_t*)(ws + WS_HN); bf16_t* XP = (bf16_t*)(ws + WS_XPAD);
#pragma unroll 4
    for (int i = 0; i < 64; ++i) { const int idx = tid + 512 * i, pr = idx >> 7, c = idx & 127; const int tok = grp * 64 + (pr >> 2);
        *(u32x4*)(XP + (size_t)DEST[pr] * 1024 + c * 8) = *(const u32x4*)(HN + (size_t)tok * 1024 + c * 8); }
    __syncthreads();
}

__device__ __forceinline__ void phase_combine(const Params& p) {
    unsigned char* ws = opaque(p.ws); const int tid = tid_(), lane = tid & 63, wid = tid >> 6, G = gridDim.x;
    const float* H = (const float*)(ws + WS_H); const bf16_t* YP = (const bf16_t*)(ws + WS_YPAD);
    for (int tok = blockIdx.x * 8 + wid; tok < NTOK; tok += G * 8) {
        int sl[4]; float gt[4];
#pragma unroll
        for (int k = 0; k < 4; ++k) { sl[k] = ((const int*)(ws + WS_SLOT))[tok * 4 + k]; gt[k] = ((const float*)(ws + WS_TOPG))[tok * 4 + k]; }
        f32x4 v[4]; float ss = 0.f;
#pragma unroll
        for (int i = 0; i < 4; ++i) { const int col = i * 256 + lane * 4; v[i] = *(const f32x4*)(H + (size_t)tok * 1024 + col);
#pragma unroll
            for (int k = 0; k < 4; ++k) { const u32x2 yw = *(const u32x2*)(YP + (size_t)sl[k] * 1024 + col); v[i][0] += gt[k] * bf_lo(yw.x); v[i][1] += gt[k] * bf_hi(yw.x); v[i][2] += gt[k] * bf_lo(yw.y); v[i][3] += gt[k] * bf_hi(yw.y); }
            ss += v[i][0] * v[i][0] + v[i][1] * v[i][1] + v[i][2] * v[i][2] + v[i][3] * v[i][3]; }
        ss = wave_sum(ss); const float rs = rsqrtf(ss * (1.0f / 1024.0f) + EPS);
#pragma unroll
        for (int i = 0; i < 4; ++i) { const int col = i * 256 + lane * 4; const f32x4 g = *(const f32x4*)(p.norm_final_g + col); f32x4 o; o[0] = v[i][0] * rs * g[0]; o[1] = v[i][1] * rs * g[1]; o[2] = v[i][2] * rs * g[2]; o[3] = v[i][3] * rs * g[3];
            *(f32x4*)(p.out + (size_t)tok * 1024 + col) = o; } }
}

extern __shared__ __attribute__((aligned(16))) char smem[];
__global__ void __launch_bounds__(512, 2) mega_fwd(Params p) {
    cg::grid_group grid = cg::this_grid();
    char* lds = smem; LDS3 unsigned char* lds3 = (LDS3 unsigned char*)smem;
    const int G = gridDim.x, bid = blockIdx.x;
    phase_prologue(p, lds);
    grid.sync();
    { unsigned char* ws = opaque(p.ws); pg8::DenseProb S; S.init(ws + WS_XN, ws + WS_W_IN, NTOK, INWP, 1024, G, bid);
      EpiProj E; E.ws = ws;
      pg8::gemm_phase(lds3, S, E); }
    grid.sync();
    for (int item = bid; item < 4 * 24 * 16; item += G) attn_item(p, item, lds);
    for (int item = bid; item < 1024; item += G) gla1_item(p, item, lds);
    grid.sync();
    phase_scan_combine(p);
    grid.sync();
    for (int item = bid; item < 1024; item += G) gla3_item(p, item, lds);
    grid.sync();
    { unsigned char* ws = opaque(p.ws); pg8::DenseProb S; S.init(ws + WS_YATT, ws + WS_W_A, NTOK, 1024, 512, G, bid);
      EpiGate<0> E; E.gate = (const bf16_t*)(ws + WS_SA); E.t1 = nullptr; E.out = (bf16_t*)(ws + WS_T1);
      pg8::gemm_phase(lds3, S, E); }
    { unsigned char* ws = opaque(p.ws); pg8::DenseProb S; S.init(ws + WS_YGLA, ws + WS_W_G, NTOK, 1024, 1024, G, bid);
      EpiGate<1> E; E.gate = (const bf16_t*)(ws + WS_SG); E.t1 = (const bf16_t*)(ws + WS_T1); E.out = (bf16_t*)(ws + WS_MERGED);
      pg8::gemm_phase(lds3, S, E); }
    grid.sync();
    { unsigned char* ws = opaque(p.ws); pg8::DenseProb S; S.init(ws + WS_MERGED, ws + WS_W_MIX, NTOK, 1024, 1024, G, bid);
      EpiResid E; E.x = p.x; E.h = (float*)(ws + WS_H);
      pg8::gemm_phase(lds3, S, E); }
    grid.sync();
    for (int grp = bid; grp < 256; grp += G) route_group(p, grp, lds);
    grid.sync();
    for (int grp = bid; grp < 256; grp += G) dispatch_group(p, grp, lds);
    if (bid == 0) { unsigned char* ws = opaque(p.ws); dispatch_tables(p, -1, lds); const int* T = (const int*)(lds + DP_TOT); int* TE = (int*)(ws + WS_TILEE);
        if (tid_() < 32) { const int e = tid_(); for (int t = T[32 + e]; t < T[32 + e] + ((T[e] + 255) >> 8); ++t) TE[16 + t] = e; }
        if (tid_() == 0) TE[0] = T[96]; }
    grid.sync();
    { unsigned char* ws = opaque(p.ws); const int* TE = (const int*)(ws + WS_TILEE);
      pg8::MoeProb S; S.A = (const char*)(ws + WS_XPAD); S.Bt = (const char*)(ws + WS_W_GU); S.K = 1024; S.nN = 8; S.T = TE[0]; S.G = G; S.c = bid; S.estride = (size_t)2048 * 1024 * 2; S.tile_e = TE + 16;
      EpiAct E; E.bgu = p.e_b_gu; E.tile_e = TE + 16; E.act = (bf16_t*)(ws + WS_ACT);
      pg8::gemm_phase(lds3, S, E); }
    grid.sync();
    { unsigned char* ws = opaque(p.ws); const int* TE = (const int*)(ws + WS_TILEE);
      pg8::MoeProb S; S.A = (const char*)(ws + WS_ACT); S.Bt = (const char*)(ws + WS_W_D); S.K = 1024; S.nN = 4; S.T = TE[0]; S.G = G; S.c = bid; S.estride = (size_t)1024 * 1024 * 2; S.tile_e = TE + 16;
      EpiDown E; E.bd = p.e_b_d; E.tile_e = TE + 16; E.y = (bf16_t*)(ws + WS_YPAD);
      pg8::gemm_phase(lds3, S, E); }
    grid.sync();
    phase_combine(p);
}

extern "C" void kernel_launch(void* const* d_in, const int* in_sizes, int n_in, void* d_out, int out_size, void* d_ws, size_t ws_size, hipStream_t stream) {
    static int grid = 0;
    if (grid == 0) {
        if (n_in != 17 || ws_size < WS_END) { fprintf(stderr, "kernel_launch: expected 17 inputs and >= %zu bytes of workspace (got %d, %zu); nothing launched\n", (size_t)WS_END, n_in, ws_size); grid = -1; return; }
        int dev = 0, cus = 0, per_cu = 0;
        if (hipGetDevice(&dev) != hipSuccess || hipDeviceGetAttribute(&cus, hipDeviceAttributeMultiprocessorCount, dev) != hipSuccess) { fprintf(stderr, "kernel_launch: device query failed\n"); grid = -1; return; }
        if (hipFuncSetAttribute((const void*)mega_fwd, hipFuncAttributeMaxDynamicSharedMemorySize, LDS_BYTES) != hipSuccess) { fprintf(stderr, "kernel_launch: hipFuncSetAttribute failed\n"); grid = -1; return; }
        if (hipOccupancyMaxActiveBlocksPerMultiprocessor(&per_cu, (const void*)mega_fwd, 512, LDS_BYTES) != hipSuccess || per_cu < 1) { fprintf(stderr, "kernel_launch: occupancy query failed (%d)\n", per_cu); grid = -1; return; }
        grid = cus;
    }
    if (grid < 0) return;
    Params p{};
    p.x = (const float*)d_in[0]; p.norm_mix_g = (const float*)d_in[1]; p.w_in = (const float*)d_in[2]; p.gla_gate_up = (const float*)d_in[3]; p.gla_gate_bias = (const float*)d_in[4]; p.gla_norm_g = (const float*)d_in[5];
    p.w_branch_gla = (const float*)d_in[6]; p.w_branch_att = (const float*)d_in[7]; p.w_mix_out = (const float*)d_in[8]; p.norm_ffn_g = (const float*)d_in[9]; p.router_w = (const float*)d_in[10]; p.router_b = (const float*)d_in[11];
    p.e_w_gu = (const float*)d_in[12]; p.e_b_gu = (const float*)d_in[13]; p.e_w_d = (const float*)d_in[14]; p.e_b_d = (const float*)d_in[15]; p.norm_final_g = (const float*)d_in[16];
    p.out = (float*)d_out; p.ws = (unsigned char*)d_ws;
    void* args[] = {&p};
    hipError_t e = hipLaunchCooperativeKernel((const void*)mega_fwd, dim3(grid), dim3(512), args, LDS_BYTES, stream);
    if (e != hipSuccess) fprintf(stderr, "kernel_launch: cooperative launch failed: %s (grid %d)\n", hipGetErrorString(e), grid);
}
```

```cpp
#include <hip/hip_runtime.h>
#include <hip/hip_cooperative_groups.h>
#include <cstdio>
#include <cstdint>
namespace cg = cooperative_groups;
#ifndef REP_P0
#define REP_P0 1
#define REP_P1 1
#define REP_ATT 1
#define REP_GLA1 1
#define REP_P3 1
#define REP_P4 1
#define REP_P5 1
#define REP_P6 1
#define REP_P7 1
#define REP_P8 1
#define REP_P9 1
#define REP_P10 1
#define REP_P11 1
#endif

#define LDS3 __attribute__((address_space(3)))
typedef unsigned short bf16_t;
typedef short bf16x8 __attribute__((ext_vector_type(8)));
typedef short s16x4 __attribute__((ext_vector_type(4)));
typedef short v4i16_t __attribute__((ext_vector_type(4)));
typedef float f32x4 __attribute__((ext_vector_type(4)));
typedef float f32x2 __attribute__((ext_vector_type(2)));
typedef float f32x16 __attribute__((ext_vector_type(16)));
typedef unsigned u32x4 __attribute__((ext_vector_type(4)));
typedef unsigned u32x2 __attribute__((ext_vector_type(2)));

constexpr int NTOK = 16384, DM = 1024, SEQ = 4096, NB = 4;
constexpr int INW = 9744, INWP = 9984;
constexpr int NEXP = 32, TOPK = 4, FF = 1024;
constexpr int MAXT = 288;
constexpr float EPS = 1e-5f;
constexpr float QSCALE = 0.125f * 1.4426950408889634f;
constexpr float LN2 = 0.6931471805599453f;

constexpr size_t al256(size_t x) { return (x + 255) & ~(size_t)255; }
constexpr size_t WS_W_IN = 0;
constexpr size_t WS_W_G = WS_W_IN + (size_t)INWP * 1024 * 2;
constexpr size_t WS_W_A = WS_W_G + (size_t)1024 * 1024 * 2;
constexpr size_t WS_W_MIX = WS_W_A + (size_t)1024 * 512 * 2;
constexpr size_t WS_W_GU = WS_W_MIX + (size_t)1024 * 1024 * 2;
constexpr size_t WS_W_D = WS_W_GU + (size_t)NEXP * 2048 * 1024 * 2;
constexpr size_t WS_ROPE_C = WS_W_D + (size_t)NEXP * 1024 * 1024 * 2;
constexpr size_t WS_ROPE_S = WS_ROPE_C + (size_t)SEQ * 8 * 4;
constexpr size_t WS_RWG = WS_ROPE_S + (size_t)SEQ * 8 * 4;
constexpr size_t WS_H = WS_RWG + (size_t)1024 * 32 * 4;
constexpr size_t WS_HN = WS_H + (size_t)NTOK * 1024 * 4;
constexpr size_t WS_TOPE = WS_HN + (size_t)NTOK * 1024 * 2;
constexpr size_t WS_TOPG = WS_TOPE + (size_t)NTOK * 4 * 4;
constexpr size_t WS_TOPP = WS_TOPG + (size_t)NTOK * 4 * 4;
constexpr size_t WS_SLOT = WS_TOPP + (size_t)NTOK * 4 * 4;
constexpr size_t WS_CNT = WS_SLOT + (size_t)NTOK * 4 * 4;
constexpr size_t WS_TILEE = WS_CNT + (size_t)256 * 32 * 4;
constexpr size_t WS_REGB = al256(WS_TILEE + (size_t)(MAXT + 32) * 4);
constexpr size_t WS_XN = WS_REGB;
constexpr size_t WS_GQ = WS_XN + (size_t)NTOK * 1024 * 2;
constexpr size_t WS_GK = WS_GQ + (size_t)NTOK * 512 * 2;
constexpr size_t WS_GV = WS_GK + (size_t)NTOK * 512 * 2;
constexpr size_t WS_GR = WS_GV + (size_t)NTOK * 1024 * 2;
constexpr size_t WS_SG = WS_GR + (size_t)NTOK * 1024 * 2;
constexpr size_t WS_SA = WS_SG + (size_t)NTOK * 1024 * 2;
constexpr size_t WS_AQ = WS_SA + (size_t)NTOK * 1024 * 2;
constexpr size_t WS_AK = WS_AQ + (size_t)NTOK * 1536 * 2;
constexpr size_t WS_AV = WS_AK + (size_t)NTOK * 1536 * 2;
constexpr size_t WS_GLR = WS_AV + (size_t)NTOK * 1536 * 2;
constexpr size_t WS_OATT = WS_GLR + (size_t)NTOK * 16 * 4;
constexpr size_t WS_LSE = WS_OATT + (size_t)3 * NTOK * 512 * 2;
constexpr size_t WS_QE = WS_LSE + (size_t)3 * NTOK * 8 * 4;
constexpr size_t WS_OINTRA = WS_QE + (size_t)NTOK * 512 * 2;
constexpr size_t WS_U = WS_OINTRA + (size_t)NTOK * 1024 * 4;
constexpr size_t WS_DEC = WS_U + (size_t)1024 * 128 * 256 * 2;
constexpr size_t WS_REGB_END = WS_DEC + (size_t)1024 * 128 * 4;
constexpr size_t WS_PREV = WS_AQ;
constexpr size_t WS_YGLA = WS_AV;
constexpr size_t WS_YATT = WS_XN;
constexpr size_t WS_T1 = WS_GQ;
constexpr size_t WS_MERGED = WS_GV;
constexpr size_t PADROWS = (size_t)MAXT * 256;
constexpr size_t WS_XPAD = WS_REGB;
constexpr size_t WS_ACT = WS_XPAD + PADROWS * 1024 * 2;
constexpr size_t WS_YPAD = WS_ACT + PADROWS * 1024 * 2;
constexpr size_t WS_PAD_END = WS_YPAD + PADROWS * 1024 * 2;
constexpr size_t WS_BAR = al256(WS_REGB_END > WS_PAD_END ? WS_REGB_END : WS_PAD_END);
constexpr size_t WS_END = WS_BAR + 3456 * 4;
static_assert(WS_PAD_END <= WS_REGB_END + (1u << 30), "map");

constexpr int LDS_XB = 147456;
constexpr int LDS_BYTES = 147456 + 16;

struct Params {
    const float *x, *norm_mix_g, *w_in, *gla_gate_up, *gla_gate_bias, *gla_norm_g, *w_branch_gla, *w_branch_att, *w_mix_out, *norm_ffn_g,
        *router_w, *router_b, *e_w_gu, *e_b_gu, *e_w_d, *e_b_d, *norm_final_g;
    float* out;
    unsigned char* ws;
};

__device__ __forceinline__ int tid_() { int t = threadIdx.x; asm volatile("" : "+v"(t)); return t; }
__device__ __forceinline__ unsigned char* opaque(unsigned char* q) { return q; }
__device__ __forceinline__ unsigned cvt_pk_bf16(float lo, float hi) { unsigned r; asm volatile("v_cvt_pk_bf16_f32 %0, %1, %2" : "=v"(r) : "v"(lo), "v"(hi)); return r; }
__device__ __forceinline__ float bf_lo(unsigned w) { return __uint_as_float(w << 16); }
__device__ __forceinline__ float bf_hi(unsigned w) { return __uint_as_float(w & 0xffff0000u); }
__device__ __forceinline__ float bf2f(bf16_t b) { return __uint_as_float(((unsigned)b) << 16); }
__device__ __forceinline__ u32x4 pack8(const float* v) { u32x4 w; w.x = cvt_pk_bf16(v[0], v[1]); w.y = cvt_pk_bf16(v[2], v[3]); w.z = cvt_pk_bf16(v[4], v[5]); w.w = cvt_pk_bf16(v[6], v[7]); return w; }
__device__ __forceinline__ void unpack8(u32x4 w, float* v) { v[0] = bf_lo(w.x); v[1] = bf_hi(w.x); v[2] = bf_lo(w.y); v[3] = bf_hi(w.y); v[4] = bf_lo(w.z); v[5] = bf_hi(w.z); v[6] = bf_lo(w.w); v[7] = bf_hi(w.w); }
__device__ __forceinline__ float sigmoidf_(float v) { return __builtin_amdgcn_rcpf(1.0f + __builtin_amdgcn_exp2f(v * -1.4426950408889634f)); }
__device__ __forceinline__ float wave_sum(float v) { v += __shfl_xor(v, 32); v += __shfl_xor(v, 16); v += __shfl_xor(v, 8); v += __shfl_xor(v, 4); v += __shfl_xor(v, 2); v += __shfl_xor(v, 1); return v; }
__device__ __forceinline__ s16x4 tr16(const LDS3 char* p) { return __builtin_bit_cast(s16x4, __builtin_amdgcn_ds_read_tr16_b64_v4i16((LDS3 v4i16_t*)p)); }
__device__ __forceinline__ bf16x8 cat8(s16x4 a, s16x4 b) { return (bf16x8){a[0], a[1], a[2], a[3], b[0], b[1], b[2], b[3]}; }
__device__ __forceinline__ int crow(int r, int hi) { return (r & 3) + 8 * (r >> 2) + 4 * hi; }
__device__ __forceinline__ void st_nt(void* p, u32x4 v) { __builtin_nontemporal_store(v, (u32x4*)p); }
#define MFMA32(a, b, c) __builtin_amdgcn_mfma_f32_32x32x16_bf16(a, b, c, 0, 0, 0)

namespace pg8 {
constexpr int BM = 256, BK = 64, HALF = 128, HTB = HALF * BK * 2, STAGE_BYTES = 8 * HTB, NXCD = 8, WGM = 8;
__host__ __device__ __forceinline__ int lds_byte(int r, int c) { const int st = (r >> 4) * 2 + (c >> 5), rr = r & 15, cc = c & 31, ob = rr * 64 + cc * 2; return st * 1024 + (ob ^ (((ob >> 9) & 1) << 5)); }
__host__ __device__ __forceinline__ void stage_rc(int b, int& R, int& C) { const int st = b / 1024, sb = b % 1024, swz = sb ^ (((sb >> 9) & 1) << 5); R = (st >> 1) * 16 + swz / 64; C = (st & 1) * 32 + (swz % 64) / 2; }
__host__ __device__ __forceinline__ int perm32(int rho) { const int n = rho >> 4, i = rho & 15; return 8 * (i >> 2) + 4 * n + (i & 3); }
struct Unit { int pm, pn; };

struct DenseProb {
    const char* A; const char* Bt; int K; int nM, nN, nwg, G, c;
    __device__ void init(const void* A_, const void* Bt_, int M, int N, int K_, int G_, int c_) { A = (const char*)A_; Bt = (const char*)Bt_; K = K_; nM = M / BM; nN = N / BM; nwg = nM * nN; G = G_; c = c_; }
    __device__ __forceinline__ bool next(int i, Unit& u) const {
        const long L = (long)i * G + c; if (L >= nwg) return false;
        int wgid = (int)L; { const int q = nwg / NXCD, r = nwg % NXCD, xcd = wgid % NXCD, off = wgid / NXCD; wgid = (xcd < r ? xcd * (q + 1) : r * (q + 1) + (xcd - r) * q) + off; }
        const int nig = WGM * nN, gid = wgid / nig, fm = gid * WGM, gsz = (nM - fm) < WGM ? (nM - fm) : WGM;
        u.pm = fm + ((wgid % nig) % gsz); u.pn = (wgid % nig) / gsz; return true;
    }
    __device__ __forceinline__ const char* a_ptr(const Unit& u) const { return A + (size_t)u.pm * BM * K * 2; }
    __device__ __forceinline__ const char* b_ptr(const Unit& u) const { return Bt + (size_t)u.pn * BM * K * 2; }
};
struct MoeProb {
    const char* A; const char* Bt; int K; int nN, T, G, c; size_t estride; const int* tile_e;
    __device__ __forceinline__ bool next(int i, Unit& u) const { const long L = (long)i * G + c; if (L >= (long)T * nN) return false; u.pm = (int)(L / nN); u.pn = (int)(L % nN); return true; }
    __device__ __forceinline__ const char* a_ptr(const Unit& u) const { return A + (size_t)u.pm * BM * K * 2; }
    __device__ __forceinline__ const char* b_ptr(const Unit& u) const { return Bt + (size_t)tile_e[u.pm] * estride + (size_t)u.pn * BM * K * 2; }
};

template <class Epi, class Prob>
__device__ __forceinline__ void gemm_phase(LDS3 unsigned char* lds, const Prob& S, const Epi& E) {
    const int tid = tid_(), wid = __builtin_amdgcn_readfirstlane(tid >> 6), lane = tid & 63, wr = wid >> 2, wc = wid & 3, fr = lane & 15, fq = lane >> 4;
    const int K = S.K, nt = K / BK;
    unsigned voffA[2], voffB[2];
#pragma unroll
    for (int i = 0; i < 2; ++i) { int R, C; stage_rc(tid * 16 + i * 8192, R, C); const int Rb = Epi::PERM ? (2 * (R & ~31) + perm32(R & 31)) : R;
        voffA[i] = (unsigned)(R * K + C) * 2u; voffB[i] = (unsigned)(Rb * K + C) * 2u; }
    const size_t kstep = (size_t)(BK * 2);
    const size_t hstep = (size_t)HALF * K * 2;
    const size_t hstepB = Epi::PERM ? (size_t)32 * K * 2 : hstep;
    const unsigned ldsw = (unsigned)wid * 1024u;
    const int aoff = lds_byte(wr * 64 + fr, fq * 8), boff = lds_byte(wc * 32 + fr, fq * 8);
#define PG8_SA(b, h) (((b) * 2 + (h)) * HTB)
#define PG8_SB(b, h) ((4 + (b) * 2 + (h)) * HTB)
#define PG8_STAGE(bufoff, gbase, voff) do { _Pragma("unroll") for (int _i = 0; _i < 2; ++_i) \
        __builtin_amdgcn_global_load_lds((const unsigned*)((const char*)(gbase) + (voff)[_i]), (LDS3 unsigned*)(lds + (bufoff) + ldsw + _i * 8192), 16, 0, 0); } while (0)
#define PG8_LDA(dst, b, h) do { _Pragma("unroll") for (int m = 0; m < 4; ++m) _Pragma("unroll") for (int k = 0; k < 2; ++k) dst[m][k] = *(const LDS3 bf16x8*)(lds + PG8_SA(b, h) + aoff + m * 2048 + k * 1024); } while (0)
#define PG8_LDB(dst, b, h) do { _Pragma("unroll") for (int n = 0; n < 2; ++n) _Pragma("unroll") for (int k = 0; k < 2; ++k) dst[n][k] = *(const LDS3 bf16x8*)(lds + PG8_SB(b, h) + boff + n * 2048 + k * 1024); } while (0)
#define PG8_MMA(ai, bj, At, Bt) do { __builtin_amdgcn_s_setprio(1); _Pragma("unroll") for (int m = 0; m < 4; ++m) _Pragma("unroll") for (int n = 0; n < 2; ++n) _Pragma("unroll") for (int k = 0; k < 2; ++k) \
        acc[ai][bj][m][n] = __builtin_amdgcn_mfma_f32_16x16x32_bf16(Bt[n][k], At[m][k], acc[ai][bj][m][n], 0, 0, 0); __builtin_amdgcn_s_setprio(0); } while (0)
#define PG8_WAIT_V(n) asm volatile("s_waitcnt vmcnt(" #n ")" ::: "memory")
#define PG8_WAIT_L(n) asm volatile("s_waitcnt lgkmcnt(" #n ")" ::: "memory")
#define PG8_BAR __builtin_amdgcn_s_barrier()
#define PG8_SCHED __builtin_amdgcn_sched_barrier(0)
    Unit cur, nxt; int ui = 0;
    if (!S.next(0, cur)) return;
    f32x4 acc[2][2][4][2];
#pragma unroll
    for (int a = 0; a < 2; ++a)
#pragma unroll
        for (int b = 0; b < 2; ++b)
#pragma unroll
            for (int m = 0; m < 4; ++m)
#pragma unroll
                for (int n = 0; n < 2; ++n) acc[a][b][m][n] = (f32x4){0.f, 0.f, 0.f, 0.f};
    bf16x8 At[4][2], B0[2][2], B1[2][2];
    const char* cA = S.a_ptr(cur); const char* cB = S.b_ptr(cur);
    PG8_STAGE(PG8_SB(0, 0), cB, voffB); PG8_STAGE(PG8_SA(0, 0), cA, voffA); PG8_STAGE(PG8_SB(0, 1), cB + hstepB, voffB); PG8_STAGE(PG8_SA(0, 1), cA + hstep, voffA);
    if (wr == 1) PG8_BAR;
    PG8_WAIT_V(4); PG8_BAR;
    PG8_STAGE(PG8_SB(1, 0), cB + kstep, voffB); PG8_STAGE(PG8_SA(1, 0), cA + kstep, voffA); PG8_STAGE(PG8_SB(1, 1), cB + hstepB + kstep, voffB);
    PG8_WAIT_V(6); PG8_BAR;
    for (;;) {
        const bool has_next = S.next(ui + 1, nxt);
        const char* nA = has_next ? S.a_ptr(nxt) : cA; const char* nB = has_next ? S.b_ptr(nxt) : cB;
        for (int t = 0; t < nt; t += 2) {
            const bool last = (t == nt - 2);
            const char* a1 = cA + (size_t)(t + 1) * kstep;
            const char* a2 = last ? nA : cA + (size_t)(t + 2) * kstep; const char* b2 = last ? nB : cB + (size_t)(t + 2) * kstep;
            const char* a3 = a2 + kstep; const char* b3 = b2 + kstep;
            PG8_LDB(B0, 0, 0); PG8_SCHED; PG8_LDA(At, 0, 0); PG8_STAGE(PG8_SA(1, 1), a1 + hstep, voffA);
            PG8_WAIT_L(8); PG8_BAR; PG8_WAIT_L(0); PG8_MMA(0, 0, At, B0); PG8_BAR; PG8_SCHED;
            PG8_LDB(B1, 0, 1); PG8_STAGE(PG8_SB(0, 0), b2, voffB);
            PG8_BAR; PG8_WAIT_L(0); PG8_MMA(0, 1, At, B1); PG8_BAR;
            PG8_LDA(At, 0, 1); PG8_STAGE(PG8_SA(0, 0), a2, voffA);
            PG8_BAR; PG8_WAIT_L(0); PG8_MMA(1, 0, At, B0); PG8_BAR; PG8_SCHED;
            PG8_STAGE(PG8_SB(0, 1), b2 + hstepB, voffB);
            PG8_WAIT_V(6); PG8_BAR; PG8_MMA(1, 1, At, B1); PG8_BAR;
            PG8_LDB(B0, 1, 0); PG8_SCHED; PG8_LDA(At, 1, 0); PG8_STAGE(PG8_SA(0, 1), a2 + hstep, voffA);
            PG8_WAIT_L(8); PG8_BAR; PG8_WAIT_L(0); PG8_MMA(0, 0, At, B0); PG8_BAR; PG8_SCHED;
            PG8_LDB(B1, 1, 1); PG8_STAGE(PG8_SB(1, 0), b3, voffB);
            PG8_BAR; PG8_WAIT_L(0); PG8_MMA(0, 1, At, B1); PG8_BAR;
            PG8_LDA(At, 1, 1); PG8_STAGE(PG8_SA(1, 0), a3, voffA);
            PG8_BAR; PG8_WAIT_L(0); PG8_MMA(1, 0, At, B0); PG8_BAR; PG8_SCHED;
            PG8_STAGE(PG8_SB(1, 1), b3 + hstepB, voffB);
            PG8_WAIT_V(6); PG8_BAR; PG8_MMA(1, 1, At, B1); PG8_BAR;
        }
        E(acc, cur, wr, wc, fr, fq);
        if (!has_next) break;
#pragma unroll
        for (int a = 0; a < 2; ++a)
#pragma unroll
            for (int b = 0; b < 2; ++b)
#pragma unroll
                for (int m = 0; m < 4; ++m)
#pragma unroll
                    for (int n = 0; n < 2; ++n) acc[a][b][m][n] = (f32x4){0.f, 0.f, 0.f, 0.f};
        cur = nxt; cA = nA; cB = nB; ++ui;
    }
    PG8_WAIT_V(0);
    if (wr == 0) PG8_BAR;
    PG8_BAR;
#undef PG8_SA
#undef PG8_SB
#undef PG8_STAGE
#undef PG8_LDA
#undef PG8_LDB
#undef PG8_MMA
#undef PG8_WAIT_V
#undef PG8_WAIT_L
#undef PG8_BAR
#undef PG8_SCHED
}
}
using pg8::Unit;

extern __shared__ __attribute__((aligned(16))) char smem[];
__device__ __forceinline__ char* smem_base() { return smem; }

constexpr int EPI_LDS = 131072;
__device__ __forceinline__ char* epi_slot(int wr, int wc) { return smem_base() + EPI_LDS + (wr * 4 + wc) * 2048; }
__device__ __forceinline__ void slot_put(char* slot, int fr, int fq, u32x4 w0, u32x4 w1) {
    *(u32x4*)(slot + fr * 128 + (((fq) ^ (fr & 7)) << 4)) = w0; *(u32x4*)(slot + fr * 128 + (((4 + fq) ^ (fr & 7)) << 4)) = w1; }
__device__ __forceinline__ u32x4 slot_get(const char* slot, int half, int lane) { const int row = half * 8 + (lane >> 3), ch = lane & 7; return *(const u32x4*)(slot + row * 128 + ((ch ^ (row & 7)) << 4)); }

#define EPI_ROWS(ai, m) for (int ai = 0; ai < 2; ++ai) _Pragma("unroll") for (int m = 0; m < 4; ++m)

struct EpiProj {
    static constexpr bool PERM = true;
    unsigned char* ws;
    __device__ __forceinline__ void operator()(const f32x4 (&acc)[2][2][4][2], const Unit& u, int wr, int wc, int fr, int fq) const {
        const int pn = u.pn; const int lane = fq * 16 + fr; char* slot = epi_slot(wr, wc);
        const int rowq = u.pm * 256 + wr * 64 + (lane >> 3);
        if (pn < 12 || (pn >= 30 && pn < 38)) {
            size_t boff; int ld, col0, act;
            if (pn < 2) { boff = WS_GQ; ld = 512; col0 = pn * 256; act = 0; }
            else if (pn < 4) { boff = WS_GK; ld = 512; col0 = (pn - 2) * 256; act = 0; }
            else if (pn < 8) { boff = WS_GV; ld = 1024; col0 = (pn - 4) * 256; act = 0; }
            else if (pn < 12) { boff = WS_GR; ld = 1024; col0 = (pn - 8) * 256; act = 1; }
            else if (pn < 34) { boff = WS_SG; ld = 1024; col0 = (pn - 30) * 256; act = 2; }
            else { boff = WS_SA; ld = 1024; col0 = (pn - 34) * 256; act = 2; }
            bf16_t* base = (bf16_t*)(ws + boff) + col0 + wc * 64 + (lane & 7) * 8;
#pragma unroll
            EPI_ROWS(ai, m) { u32x4 w[2];
#pragma unroll
                for (int bj = 0; bj < 2; ++bj) { float v[8];
#pragma unroll
                    for (int j = 0; j < 4; ++j) { v[j] = acc[ai][bj][m][0][j]; v[4 + j] = acc[ai][bj][m][1][j]; }
                    if (act == 1) {
#pragma unroll
                        for (int j = 0; j < 8; ++j) v[j] = v[j] * sigmoidf_(v[j]); }
                    if (act == 2) {
#pragma unroll
                        for (int j = 0; j < 8; ++j) v[j] = sigmoidf_(v[j]); }
                    w[bj] = pack8(v); }
                slot_put(slot, fr, fq, w[0], w[1]);
#pragma unroll
                for (int half = 0; half < 2; ++half) st_nt(base + (size_t)(rowq + ai * 128 + m * 16 + half * 8) * ld, slot_get(slot, half, lane)); }
        } else if (pn < 30) {
            const int which = (pn - 12) / 6, t6 = (pn - 12) % 6, sh = (t6 >> 1) * 2, dmask = (1 << sh) - 1, NL = SEQ >> sh;
            bf16_t* base = (bf16_t*)(ws + WS_AQ + (size_t)which * ((size_t)NTOK * 1536 * 2)) + (lane & 7) * 8;
            const bool rot = (which < 2) && (fq < 2);
            f32x4 frev;
#pragma unroll
            for (int q = 0; q < 4; ++q) frev[q] = rot ? __builtin_amdgcn_exp2f(-(float)(4 * fq + q) * (0.125f * 18.931568569324174f)) * 0.15915494309189535f : 0.f;
            const float sc = which == 0 ? QSCALE : 1.0f;
            const int head = t6 * 4 + wc;
#pragma unroll
            EPI_ROWS(ai, m) { const int s = (u.pm * 256 + wr * 64 + fr + ai * 128 + m * 16) & (SEQ - 1);
                f32x4 cs, sn;
#pragma unroll
                for (int q = 0; q < 4; ++q) { const float rev = __builtin_amdgcn_fractf((float)s * frev[q]); cs[q] = __builtin_amdgcn_cosf(rev); sn[q] = __builtin_amdgcn_sinf(rev); }
                u32x4 w[2];
#pragma unroll
                for (int bj = 0; bj < 2; ++bj) { float v[8];
#pragma unroll
                    for (int j = 0; j < 4; ++j) { v[j] = acc[ai][bj][m][0][j]; v[4 + j] = acc[ai][bj][m][1][j]; }
                    if (bj == 0) { const float a0 = v[0] * cs[0] - v[1] * sn[0], a1 = v[1] * cs[0] + v[0] * sn[0], a2 = v[2] * cs[1] - v[3] * sn[1], a3 = v[3] * cs[1] + v[2] * sn[1];
                      const float a4 = v[4] * cs[2] - v[5] * sn[2], a5 = v[5] * cs[2] + v[4] * sn[2], a6 = v[6] * cs[3] - v[7] * sn[3], a7 = v[7] * cs[3] + v[6] * sn[3];
                      v[0] = a0; v[1] = a1; v[2] = a2; v[3] = a3; v[4] = a4; v[5] = a5; v[6] = a6; v[7] = a7; }
#pragma unroll
                    for (int j = 0; j < 8; ++j) v[j] *= sc;
                    w[bj] = pack8(v); }
                slot_put(slot, fr, fq, w[0], w[1]);
#pragma unroll
                for (int half = 0; half < 2; ++half) { const int row = rowq + ai * 128 + m * 16 + half * 8, b = row >> 12, s2 = row & (SEQ - 1), r = s2 & dmask, n = s2 >> sh;
                    st_nt(base + ((size_t)(b * 24 + head) * SEQ + (size_t)r * NL + n) * 64, slot_get(slot, half, lane)); } }
        } else {
            const int row0 = u.pm * 256 + wr * 64 + fr;
            if (wc == 0 && fq < 2) { float* glr = (float*)(ws + WS_GLR);
#pragma unroll
                EPI_ROWS(ai, m) { float* rowp = glr + (size_t)(row0 + ai * 128 + m * 16) * 16 + 8 * fq; *(f32x4*)rowp = acc[ai][0][m][0]; *(f32x4*)(rowp + 4) = acc[ai][0][m][1]; } }
        }
    }
};

template <int MODE> struct EpiGate {
    static constexpr bool PERM = true;
    const bf16_t* gate; const bf16_t* t1; bf16_t* out;
    __device__ __forceinline__ void operator()(const f32x4 (&acc)[2][2][4][2], const Unit& u, int wr, int wc, int fr, int fq) const {
        const int lane = fq * 16 + fr; char* slot = epi_slot(wr, wc);
        const size_t off0 = (size_t)(u.pm * 256 + wr * 64 + (lane >> 3)) * 1024 + u.pn * 256 + wc * 64 + (lane & 7) * 8;
#pragma unroll
        for (int ai = 0; ai < 2; ++ai) { u32x4 gw[4][2], tw[4][2];
#pragma unroll
            for (int m = 0; m < 4; ++m)
#pragma unroll
                for (int half = 0; half < 2; ++half) { const size_t off = off0 + (size_t)(ai * 128 + m * 16 + half * 8) * 1024; gw[m][half] = *(const u32x4*)(gate + off); if (MODE == 1) tw[m][half] = *(const u32x4*)(t1 + off); }
#pragma unroll
            for (int m = 0; m < 4; ++m) { u32x4 w[2];
#pragma unroll
                for (int bj = 0; bj < 2; ++bj) { float v[8];
#pragma unroll
                    for (int j = 0; j < 4; ++j) { v[j] = acc[ai][bj][m][0][j]; v[4 + j] = acc[ai][bj][m][1][j]; }
                    w[bj] = pack8(v); }
                slot_put(slot, fr, fq, w[0], w[1]);
#pragma unroll
                for (int half = 0; half < 2; ++half) { float a[8], g[8]; unpack8(slot_get(slot, half, lane), a); unpack8(gw[m][half], g);
#pragma unroll
                    for (int j = 0; j < 8; ++j) a[j] *= g[j];
                    if (MODE == 1) { float t[8]; unpack8(tw[m][half], t);
#pragma unroll
                        for (int j = 0; j < 8; ++j) a[j] += t[j]; }
                    *(u32x4*)(out + off0 + (size_t)(ai * 128 + m * 16 + half * 8) * 1024) = pack8(a); } } }
    }
};

struct EpiResid {
    static constexpr bool PERM = false;
    const float* x; float* h;
    __device__ __forceinline__ void operator()(const f32x4 (&acc)[2][2][4][2], const Unit& u, int wr, int wc, int fr, int fq) const {
        const int lane = fq * 16 + fr; char* slot = epi_slot(wr, wc);
        const size_t off0 = (size_t)(u.pm * 256 + wr * 64 + (lane >> 3)) * 1024 + u.pn * 256 + wc * 32 + (lane & 7) * 4;
#pragma unroll
        for (int ai = 0; ai < 2; ++ai)
#pragma unroll
            for (int bj = 0; bj < 2; ++bj) { f32x4 xv[4][2];
#pragma unroll
                for (int m = 0; m < 4; ++m)
#pragma unroll
                    for (int half = 0; half < 2; ++half) xv[m][half] = *(const f32x4*)(x + off0 + (size_t)(ai * 128 + m * 16 + half * 8) * 1024 + bj * 128);
#pragma unroll
                for (int m = 0; m < 4; ++m) { slot_put(slot, fr, fq, __builtin_bit_cast(u32x4, acc[ai][bj][m][0]), __builtin_bit_cast(u32x4, acc[ai][bj][m][1]));
#pragma unroll
                    for (int half = 0; half < 2; ++half) { const f32x4 a = __builtin_bit_cast(f32x4, slot_get(slot, half, lane));
                        *(f32x4*)(h + off0 + (size_t)(ai * 128 + m * 16 + half * 8) * 1024 + bj * 128) = a + xv[m][half]; } } }
    }
};

struct EpiAct {
    static constexpr bool PERM = true;
    const float* bgu; const int* tile_e; bf16_t* act;
    __device__ __forceinline__ void operator()(const f32x4 (&acc)[2][2][4][2], const Unit& u, int wr, int wc, int fr, int fq) const {
        const int e = tile_e[u.pm]; const int row0 = u.pm * 256 + wr * 64 + fr; const int j0 = u.pn * 128 + wc * 32 + 8 * fq;
        float bg[8], bu[8];
        { const float* bp = bgu + (size_t)e * 2048 + 2 * j0;
#pragma unroll
          for (int q = 0; q < 4; ++q) { const f32x4 t = *(const f32x4*)(bp + 4 * q); bg[2 * q] = t[0]; bu[2 * q] = t[1]; bg[2 * q + 1] = t[2]; bu[2 * q + 1] = t[3]; } }
#pragma unroll
        EPI_ROWS(ai, m) { float v[8];
#pragma unroll
            for (int j = 0; j < 8; ++j) { const float gt = acc[ai][0][m][j >> 2][j & 3] + bg[j], up = acc[ai][1][m][j >> 2][j & 3] + bu[j];
                const float g = fminf(gt, 7.0f), uu = fminf(fmaxf(up, -7.0f), 7.0f); v[j] = (uu + 1.0f) * (g * sigmoidf_(1.702f * g)); }
            st_nt(act + (size_t)(row0 + ai * 128 + m * 16) * 1024 + j0, pack8(v)); }
    }
};

struct EpiDown {
    static constexpr bool PERM = true;
    const float* bd; const int* tile_e; bf16_t* y;
    __device__ __forceinline__ void operator()(const f32x4 (&acc)[2][2][4][2], const Unit& u, int wr, int wc, int fr, int fq) const {
        const int e = tile_e[u.pm]; const int lane = fq * 16 + fr; char* slot = epi_slot(wr, wc); const int col0 = u.pn * 256 + wc * 64 + 8 * fq;
        f32x4 b[2][2];
#pragma unroll
        for (int bj = 0; bj < 2; ++bj)
#pragma unroll
            for (int n = 0; n < 2; ++n) b[bj][n] = *(const f32x4*)(bd + (size_t)e * 1024 + col0 + bj * 32 + 4 * n);
        bf16_t* base = y + (size_t)(u.pm * 256 + wr * 64 + (lane >> 3)) * 1024 + u.pn * 256 + wc * 64 + (lane & 7) * 8;
#pragma unroll
        EPI_ROWS(ai, m) { u32x4 w[2];
#pragma unroll
            for (int bj = 0; bj < 2; ++bj) { const f32x4 v0 = acc[ai][bj][m][0] + b[bj][0], v1 = acc[ai][bj][m][1] + b[bj][1];
                w[bj].x = cvt_pk_bf16(v0[0], v0[1]); w[bj].y = cvt_pk_bf16(v0[2], v0[3]); w[bj].z = cvt_pk_bf16(v1[0], v1[1]); w[bj].w = cvt_pk_bf16(v1[2], v1[3]); }
            slot_put(slot, fr, fq, w[0], w[1]);
#pragma unroll
            for (int half = 0; half < 2; ++half) st_nt(base + (size_t)(ai * 128 + m * 16 + half * 8) * 1024, slot_get(slot, half, lane)); }
    }
};

__device__ __forceinline__ int win_colmap(int n) {
    if (n < 3072) return n;
    if (n < 7680) { const int off = n - 3072, which = off / 1536, hcol = off % 1536, head = hcol >> 6, p = hcol & 63;
        int dim = p; if (which < 2 && p < 16) dim = (p & 1) ? (p >> 1) + 8 : (p >> 1);
        return 3088 + which * 1536 + head * 64 + dim; }
    if (n < 9728) return 7696 + (n - 7680);
    if (n < 9744) return 3072 + (n - 9728);
    return -1;
}
__device__ __forceinline__ int gu_colmap(int n) { const int t = n >> 8, w = n & 255, wc = w >> 6, bj = (w >> 5) & 1, rho = w & 31; return 2 * (128 * t + 32 * wc + rho) + bj; }

__device__ __forceinline__ void transpose_tile(const float* src, int ld_src, bf16_t* dst, int K, int n0, int k0, int scol, char* lds) {
    const int t = tid_(), nl = t & 127, kq = t >> 7;
#pragma unroll
    for (int cc = 0; cc < 4; ++cc) { const int c = kq * 4 + cc; float v[8];
#pragma unroll
        for (int j = 0; j < 8; ++j) v[j] = scol >= 0 ? src[(size_t)(k0 + c * 8 + j) * ld_src + scol] : 0.f;
        *(u32x4*)(lds + nl * 256 + ((c ^ (nl & 15)) << 4)) = pack8(v); }
    __syncthreads();
#pragma unroll
    for (int pass = 0; pass < 4; ++pass) { const int idx = t + 512 * pass, n2 = idx >> 4, c2 = idx & 15;
        *(u32x4*)(dst + (size_t)(n0 + n2) * K + k0 + c2 * 8) = *(const u32x4*)(lds + n2 * 256 + ((c2 ^ (n2 & 15)) << 4)); }
    __syncthreads();
}

__device__ __forceinline__ void phase_prologue(const Params& p, char* lds) {
    unsigned char* ws = opaque(p.ws);
    const int tid = tid_(), lane = tid & 63, wid = tid >> 6, G = gridDim.x, bid = blockIdx.x;
    { bf16_t* xn = (bf16_t*)(ws + WS_XN);
      for (int row = bid * 8 + wid; row < NTOK; row += G * 8) { const float* xr = p.x + (size_t)row * 1024; f32x4 v[4]; float ss = 0.f;
#pragma unroll
          for (int i = 0; i < 4; ++i) { v[i] = *(const f32x4*)(xr + i * 256 + lane * 4); ss += v[i][0] * v[i][0] + v[i][1] * v[i][1] + v[i][2] * v[i][2] + v[i][3] * v[i][3]; }
          ss = wave_sum(ss); const float rs = rsqrtf(ss * (1.0f / 1024.0f) + EPS);
#pragma unroll
          for (int i = 0; i < 4; ++i) { const f32x4 g = *(const f32x4*)(p.norm_mix_g + i * 256 + lane * 4); u32x2 w; w.x = cvt_pk_bf16(v[i][0] * rs * g[0], v[i][1] * rs * g[1]); w.y = cvt_pk_bf16(v[i][2] * rs * g[2], v[i][3] * rs * g[3]);
              *(u32x2*)(xn + (size_t)row * 1024 + i * 256 + lane * 4) = w; } } }
    { float* rc = (float*)(ws + WS_ROPE_C); float* rsn = (float*)(ws + WS_ROPE_S); float* rwg = (float*)(ws + WS_RWG);
      for (int i = bid * 512 + tid; i < SEQ * 8; i += G * 512) { const int s = i >> 3, f = i & 7; const double inv = pow(500000.0, -(double)f * 0.125); const float ang = (float)s * (float)inv; rc[i] = (float)cos((double)ang); rsn[i] = (float)sin((double)ang); }
      for (int i = bid * 512 + tid; i < 1024 * 32; i += G * 512) rwg[i] = p.router_w[i] * p.norm_ffn_g[i >> 5]; }
    { constexpr int T0 = 78 * 8, T1 = T0 + 64, T2 = T1 + 32, T3 = T2 + 64, T4 = T3 + 32 * 128, T5 = T4 + 32 * 64;
      const int nl = tid & 127;
      for (int tile = bid; tile < T5; tile += G) {
          if (tile < T0) { const int nt_ = tile >> 3, kt = tile & 7; transpose_tile(p.w_in, INW, (bf16_t*)(ws + WS_W_IN), 1024, nt_ * 128, kt * 128, win_colmap(nt_ * 128 + nl), lds); }
          else if (tile < T1) { const int q = tile - T0, nt_ = q >> 3, kt = q & 7; transpose_tile(p.w_branch_gla, 1024, (bf16_t*)(ws + WS_W_G), 1024, nt_ * 128, kt * 128, nt_ * 128 + nl, lds); }
          else if (tile < T2) { const int q = tile - T1, nt_ = q >> 2, kt = q & 3; transpose_tile(p.w_branch_att, 1024, (bf16_t*)(ws + WS_W_A), 512, nt_ * 128, kt * 128, nt_ * 128 + nl, lds); }
          else if (tile < T3) { const int q = tile - T2, nt_ = q >> 3, kt = q & 7; transpose_tile(p.w_mix_out, 1024, (bf16_t*)(ws + WS_W_MIX), 1024, nt_ * 128, kt * 128, nt_ * 128 + nl, lds); }
          else if (tile < T4) { const int q = tile - T3, e = q >> 7, r = q & 127, nt_ = r >> 3, kt = r & 7;
              transpose_tile(p.e_w_gu + (size_t)e * 1024 * 2048, 2048, (bf16_t*)(ws + WS_W_GU) + (size_t)e * 2048 * 1024, 1024, nt_ * 128, kt * 128, gu_colmap(nt_ * 128 + nl), lds); }
          else { const int q = tile - T4, e = q >> 6, r = q & 63, nt_ = r >> 3, kt = r & 7;
              transpose_tile(p.e_w_d + (size_t)e * 1024 * 1024, 1024, (bf16_t*)(ws + WS_W_D) + (size_t)e * 1024 * 1024, 1024, nt_ * 128, kt * 128, nt_ * 128 + nl, lds); }
      } }
}

constexpr int AT_KCS = 385 * 16;
constexpr int AT_VH = 385 * 64;
constexpr int AT_K = 0, AT_V = 8 * AT_KCS, AT_WL = AT_V + 2 * AT_VH, AT_STG = AT_WL + 8 * 128, AT_END = AT_STG + 8 * 4096;
static_assert(AT_END <= LDS_BYTES, "attention LDS");
__device__ __forceinline__ void attn_item(const Params& p, int item, char* lds) {
    unsigned char* ws = opaque(p.ws);
    const int tid = tid_(), lane = tid & 63, r32 = lane & 31, hi = lane >> 5; const int w = __builtin_amdgcn_readfirstlane(tid >> 6);
    const int jj = item & 15, bh = item >> 4, head = bh % 24, b = bh / 24, g = head >> 3, sh = 2 * g, d = 1 << sh, NL = SEQ >> sh, ppr = 16 >> sh;
    const int r = jj / ppr, j = jj % ppr;
    const size_t hb = ((size_t)bh * SEQ + (size_t)r * NL) * 64;
    const bf16_t* Q = (const bf16_t*)(ws + WS_AQ) + hb; const bf16_t* Kg = (const bf16_t*)(ws + WS_AK) + hb; const bf16_t* Vg = (const bf16_t*)(ws + WS_AV) + hb;
    const int kn0 = 256 * j - 128;
#pragma unroll
    for (int i = 0; i < 6; ++i) { const int idx = tid + 512 * i, key = idx >> 3, c = idx & 7;
        if (kn0 + key >= 0) { const u32x4 kv = *(const u32x4*)(Kg + (ptrdiff_t)(kn0 + key) * 64 + c * 8); const u32x4 vv = *(const u32x4*)(Vg + (ptrdiff_t)(kn0 + key) * 64 + c * 8);
            *(u32x4*)(lds + AT_K + c * AT_KCS + key * 16) = kv; *(u32x4*)(lds + AT_V + (c >> 2) * AT_VH + key * 64 + (c & 3) * 16) = vv; } }
    bf16x8 qf[4];
#pragma unroll
    for (int d0 = 0; d0 < 4; ++d0) qf[d0] = *(const bf16x8*)(Q + (size_t)(256 * j + 32 * w + r32) * 64 + d0 * 16 + hi * 8);
    __syncthreads();
    const LDS3 char* l3 = (const LDS3 char*)lds;
    f32x16 s[5]; const int ktmin = (j == 0) ? 4 : 0;
#pragma unroll
    for (int t5 = 0; t5 < 5; ++t5) { const int kt = w + t5;
        if (kt >= ktmin) { f32x16 a = {};
#pragma unroll
            for (int d0 = 0; d0 < 4; ++d0) { const bf16x8 kf = *(const LDS3 bf16x8*)(l3 + AT_K + (2 * d0 + hi) * AT_KCS + (kt * 32 + r32) * 16); a = MFMA32(kf, qf[d0], a); }
            s[t5] = a; }
        else {
#pragma unroll
            for (int rr = 0; rr < 16; ++rr) s[t5][rr] = -1e30f; } }
#pragma unroll
    for (int rr = 0; rr < 16; ++rr) { const int c = crow(rr, hi); if (c < r32) s[0][rr] = -1e30f; if (c > r32) s[4][rr] = -1e30f; }
    float mx = -1e30f;
#pragma unroll
    for (int t5 = 0; t5 < 5; ++t5)
#pragma unroll
        for (int rr = 0; rr < 16; ++rr) mx = fmaxf(mx, s[t5][rr]);
    mx = fmaxf(mx, __shfl_xor(mx, 32));
    float l = 0.f;
#pragma unroll
    for (int t5 = 0; t5 < 5; ++t5)
#pragma unroll
        for (int rr = 0; rr < 16; ++rr) { const float e = __builtin_amdgcn_exp2f(s[t5][rr] - mx); s[t5][rr] = e; l += e; }
    l += __shfl_xor(l, 32);
    f32x16 o[2]; o[0] = f32x16{}; o[1] = f32x16{};
    const int blk = (lane >> 4) & 1, q4 = (lane & 15) >> 2, p4 = lane & 3;
#pragma unroll
    for (int t5 = 0; t5 < 5; ++t5) { const int kt = w + t5;
        if (kt >= ktmin) {
#pragma unroll
            for (int ss = 0; ss < 2; ++ss) { float pv[8];
#pragma unroll
                for (int q = 0; q < 8; ++q) pv[q] = s[t5][8 * ss + q];
                const bf16x8 pa = __builtin_bit_cast(bf16x8, pack8(pv));
#pragma unroll
                for (int dh = 0; dh < 2; ++dh) { const LDS3 char* vp = l3 + AT_V + dh * AT_VH + (kt * 32 + 16 * ss + 4 * hi + q4) * 64 + (16 * blk + 4 * p4) * 2;
                    const bf16x8 vf = cat8(tr16(vp), tr16(vp + 8 * 64)); o[dh] = MFMA32(pa, vf, o[dh]); } } } }
    const int n_q = 256 * j + 32 * w + r32; const int tok = b * SEQ + n_q * d + r;
    if (hi == 0) { ((float*)(ws + WS_LSE))[((size_t)g * NTOK + tok) * 8 + (head & 7)] = (mx + __builtin_amdgcn_logf(l)) * LN2;
        ((float*)(lds + AT_WL))[w * 32 + r32] = __builtin_amdgcn_rcpf(l); }
    bf16_t* stg = (bf16_t*)(lds + AT_STG) + w * 2048;
#pragma unroll
    for (int rr = 0; rr < 16; ++rr) { const int qr = crow(rr, hi); const float rl = ((const float*)(lds + AT_WL))[w * 32 + qr];
#pragma unroll
        for (int dh = 0; dh < 2; ++dh) stg[qr * 64 + dh * 32 + r32] = (bf16_t)(cvt_pk_bf16(o[dh][rr] * rl, 0.f) & 0xffffu); }
    bf16_t* og = (bf16_t*)(ws + WS_OATT) + (size_t)g * NTOK * 512;
#pragma unroll
    for (int i = 0; i < 4; ++i) { const int idx = i * 64 + lane, row = idx >> 3, ch = idx & 7; const int tk = b * SEQ + (256 * j + 32 * w + row) * d + r;
        *(u32x4*)(og + (size_t)tk * 512 + (head & 7) * 64 + ch * 8) = *(const u32x4*)(stg + row * 64 + ch * 8); }
    __syncthreads();
}

constexpr int G1_BB = 0;
constexpr int G1_QE = G1_BB + 64 * 128 * 4;
constexpr int G1_KE = G1_QE + 64 * 272;
constexpr int G1_KD = G1_KE + 64 * 272;
constexpr int G1_V = G1_KD + 64 * 320;
constexpr int G1_GLR = G1_V + 64 * 576;
constexpr int G1_GUP = G1_GLR + 64 * 16 * 4;
constexpr int G1_SEG = G1_GUP + 16 * 128 * 4;
constexpr int G1_BIAS = G1_SEG + 4 * 128 * 4;
constexpr int G1_END = G1_BIAS + 128 * 4;
static_assert(G1_END <= LDS_BYTES, "gla1 LDS");
__device__ __forceinline__ float logsigmoidf_(float z) { return fminf(z, 0.f) - log1pf(__expf(-fabsf(z))); }
__device__ __forceinline__ void gla1_item(const Params& p, int item, char* lds) {
    unsigned char* ws = opaque(p.ws);
    const int tid = tid_(), lane = tid & 63, r32 = lane & 31, hi = lane >> 5; const int w = __builtin_amdgcn_readfirstlane(tid >> 6);
    const int n = item & 63, bh = item >> 6, h = bh & 3, b = bh >> 2; const int tok0 = b * SEQ + n * 64;
    float* BB = (float*)(lds + G1_BB); float* GLRs = (float*)(lds + G1_GLR); float* GUP = (float*)(lds + G1_GUP); float* SEGs = (float*)(lds + G1_SEG); float* BIAS = (float*)(lds + G1_BIAS);
    for (int i = tid; i < 64 * 16; i += 512) GLRs[i] = ((const float*)(ws + WS_GLR))[(size_t)tok0 * 16 + i];
    for (int i = tid; i < 16 * 128; i += 512) GUP[i] = p.gla_gate_up[(i >> 7) * 512 + h * 128 + (i & 127)];
    if (tid < 128) BIAS[tid] = p.gla_gate_bias[h * 128 + tid];
    __syncthreads();
    { const int d = tid & 127, seg = tid >> 7; float gu[16];
#pragma unroll
      for (int r = 0; r < 16; ++r) gu[r] = GUP[r * 128 + d];
      const float bias = BIAS[d]; float run = 0.f;
#pragma unroll 4
      for (int ii = 0; ii < 16; ++ii) { const int i = seg * 16 + ii; float z = bias;
#pragma unroll
          for (int r4 = 0; r4 < 4; ++r4) { const f32x4 gl = *(const f32x4*)(GLRs + i * 16 + r4 * 4); z += gl[0] * gu[r4 * 4] + gl[1] * gu[r4 * 4 + 1] + gl[2] * gu[r4 * 4 + 2] + gl[3] * gu[r4 * 4 + 3]; }
          run += logsigmoidf_(z) * (1.0f / 16.0f); BB[i * 128 + d] = run; }
      SEGs[seg * 128 + d] = run;
      __syncthreads();
      float off = 0.f; for (int s2 = 0; s2 < seg; ++s2) off += SEGs[s2 * 128 + d];
      if (seg > 0) { for (int ii = 0; ii < 16; ++ii) BB[(seg * 16 + ii) * 128 + d] += off; }
      __syncthreads(); }
    { const bf16_t* gq = (const bf16_t*)(ws + WS_GQ); const bf16_t* gk = (const bf16_t*)(ws + WS_GK); const bf16_t* gv = (const bf16_t*)(ws + WS_GV); bf16_t* qeg = (bf16_t*)(ws + WS_QE);
#pragma unroll
      for (int pp = 0; pp < 2; ++pp) { const int idx = tid + 512 * pp, i = idx >> 4, c = idx & 15, d0 = c * 8; const size_t go = (size_t)(tok0 + i) * 512 + h * 128 + d0;
          float q[8], k[8], qe[8], ke[8], kd[8]; unpack8(*(const u32x4*)(gq + go), q); unpack8(*(const u32x4*)(gk + go), k);
#pragma unroll
          for (int j = 0; j < 8; ++j) { const float bb = BB[i * 128 + d0 + j], bl = BB[63 * 128 + d0 + j]; qe[j] = q[j] * __expf(bb) * 0.08838834764831845f; ke[j] = k[j] * __expf(-bb); kd[j] = k[j] * __expf(bl - bb); }
          const u32x4 qw = pack8(qe); *(u32x4*)(lds + G1_QE + i * 272 + c * 16) = qw; *(u32x4*)(qeg + go) = qw;
          *(u32x4*)(lds + G1_KE + i * 272 + c * 16) = pack8(ke); *(u32x4*)(lds + G1_KD + i * 320 + c * 16) = pack8(kd); }
#pragma unroll
      for (int pp = 0; pp < 4; ++pp) { const int idx = tid + 512 * pp, jv = idx >> 5, c = idx & 31; *(u32x4*)(lds + G1_V + jv * 576 + c * 16) = *(const u32x4*)(gv + (size_t)(tok0 + jv) * 1024 + h * 256 + c * 8); }
      if (tid < 128) ((float*)(ws + WS_DEC))[(size_t)item * 128 + tid] = __expf(BB[63 * 128 + tid]);
      __syncthreads(); }
    const LDS3 char* l3 = (const LDS3 char*)lds; const int blk = (lane >> 4) & 1, q4 = (lane & 15) >> 2, p4 = lane & 3;
    {
      const int it = w & 1, vq = w >> 1; f32x16 oi[2]; oi[0] = f32x16{}; oi[1] = f32x16{};
#pragma unroll
      for (int jt = 0; jt < 2; ++jt) { if (jt <= it) { f32x16 x = {};
#pragma unroll
          for (int s = 0; s < 8; ++s) { const bf16x8 a = *(const LDS3 bf16x8*)(l3 + G1_KE + (jt * 32 + r32) * 272 + (16 * s + 8 * hi) * 2), bq = *(const LDS3 bf16x8*)(l3 + G1_QE + (it * 32 + r32) * 272 + (16 * s + 8 * hi) * 2); x = MFMA32(a, bq, x); }
          if (jt == it) {
#pragma unroll
              for (int rr = 0; rr < 16; ++rr) if (crow(rr, hi) > r32) x[rr] = 0.f; }
#pragma unroll
          for (int ss = 0; ss < 2; ++ss) { float xv[8];
#pragma unroll
              for (int q = 0; q < 8; ++q) xv[q] = x[8 * ss + q];
              const bf16x8 xa = __builtin_bit_cast(bf16x8, pack8(xv));
#pragma unroll
              for (int vi = 0; vi < 2; ++vi) { const int vt = 2 * vq + vi; const LDS3 char* vp = l3 + G1_V + (jt * 32 + 16 * ss + 4 * hi + q4) * 576 + (vt * 32 + 16 * blk + 4 * p4) * 2;
                  const bf16x8 vf = cat8(tr16(vp), tr16(vp + 8 * 576)); oi[vi] = MFMA32(xa, vf, oi[vi]); } } } }
      float* og = (float*)(ws + WS_OINTRA);
#pragma unroll
      for (int vi = 0; vi < 2; ++vi)
#pragma unroll
          for (int rr = 0; rr < 16; ++rr) og[(size_t)(tok0 + it * 32 + crow(rr, hi)) * 1024 + h * 256 + (2 * vq + vi) * 32 + r32] = oi[vi][rr]; }
    {
      const int dt = w & 3, vg = w >> 2; f32x16 uu[4]; uu[0] = f32x16{}; uu[1] = f32x16{}; uu[2] = f32x16{}; uu[3] = f32x16{};
#pragma unroll
      for (int ks = 0; ks < 4; ++ks) { const LDS3 char* ap = l3 + G1_KD + (16 * ks + 8 * hi + q4) * 320 + (dt * 32 + 16 * blk + 4 * p4) * 2; const bf16x8 a = cat8(tr16(ap), tr16(ap + 4 * 320));
#pragma unroll
          for (int vi = 0; vi < 4; ++vi) { const int vt = 4 * vg + vi; const LDS3 char* vp = l3 + G1_V + (16 * ks + 8 * hi + q4) * 576 + (vt * 32 + 16 * blk + 4 * p4) * 2; const bf16x8 vf = cat8(tr16(vp), tr16(vp + 4 * 576)); uu[vi] = MFMA32(a, vf, uu[vi]); } }
      bf16_t* ug = (bf16_t*)(ws + WS_U) + (size_t)item * 128 * 256;
#pragma unroll
      for (int vi = 0; vi < 4; ++vi)
#pragma unroll
          for (int rr = 0; rr < 16; ++rr) ug[(size_t)(dt * 32 + crow(rr, hi)) * 256 + (4 * vg + vi) * 32 + r32] = (bf16_t)(cvt_pk_bf16(uu[vi][rr], 0.f) & 0xffffu); }
    __syncthreads();
}

__device__ __forceinline__ void phase_scan_combine(const Params& p) {
    unsigned char* ws = opaque(p.ws); const int G = gridDim.x;
    { const bf16_t* U = (const bf16_t*)(ws + WS_U); bf16_t* PV = (bf16_t*)(ws + WS_PREV); const float* DEC = (const float*)(ws + WS_DEC);
      for (int idx = blockIdx.x * 512 + tid_(); idx < 16 * 128 * 64; idx += G * 512) { const int bh = idx >> 13, rem = idx & 8191, d = rem >> 6, vq = rem & 63;
          float st[4] = {0.f, 0.f, 0.f, 0.f}; const size_t e0 = ((size_t)bh * 64 * 128 + d) * 256 + vq * 4;
#pragma unroll 8
          for (int n = 0; n < 64; ++n) { const size_t e = e0 + (size_t)n * 128 * 256; const u32x2 uw = *(const u32x2*)(U + e); const float dc = DEC[(size_t)(bh * 64 + n) * 128 + d];
              u32x2 pw; pw.x = cvt_pk_bf16(st[0], st[1]); pw.y = cvt_pk_bf16(st[2], st[3]); *(u32x2*)(PV + e) = pw;
              st[0] = dc * st[0] + bf_lo(uw.x); st[1] = dc * st[1] + bf_hi(uw.x); st[2] = dc * st[2] + bf_lo(uw.y); st[3] = dc * st[3] + bf_hi(uw.y); } } }
    { const bf16_t* OG = (const bf16_t*)(ws + WS_OATT); const float* LSE = (const float*)(ws + WS_LSE); bf16_t* YA = (bf16_t*)(ws + WS_YATT);
      for (int idx = blockIdx.x * 512 + tid_(); idx < NTOK * 64; idx += G * 512) { const int tok = idx >> 6, jc = idx & 63, jh = jc >> 3;
          const float l0 = LSE[(size_t)tok * 8 + jh], l1 = LSE[((size_t)NTOK + tok) * 8 + jh], l2 = LSE[((size_t)2 * NTOK + tok) * 8 + jh];
          const float m = fmaxf(l0, fmaxf(l1, l2)); float a0 = __expf(l0 - m), a1 = __expf(l1 - m), a2 = __expf(l2 - m); const float inv = __builtin_amdgcn_rcpf(a0 + a1 + a2); a0 *= inv; a1 *= inv; a2 *= inv;
          float o0[8], o1[8], o2[8], y[8]; const size_t off = (size_t)tok * 512 + jc * 8;
          unpack8(*(const u32x4*)(OG + off), o0); unpack8(*(const u32x4*)(OG + (size_t)NTOK * 512 + off), o1); unpack8(*(const u32x4*)(OG + (size_t)2 * NTOK * 512 + off), o2);
#pragma unroll
          for (int q = 0; q < 8; ++q) y[q] = a0 * o0[q] + a1 * o1[q] + a2 * o2[q];
          *(u32x4*)(YA + off) = pack8(y); } }
}

constexpr int G3_PREV = 0;
constexpr int G3_SS = G3_PREV + 128 * 576;
constexpr int G3_END = G3_SS + 8 * 32 * 4;
static_assert(G3_END <= LDS_BYTES, "gla3 LDS");
__device__ __forceinline__ void gla3_item(const Params& p, int item, char* lds) {
    unsigned char* ws = opaque(p.ws);
    const int tid = tid_(), lane = tid & 63, r32 = lane & 31, hi = lane >> 5; const int w = __builtin_amdgcn_readfirstlane(tid >> 6);
    const int n = item & 63, bh = item >> 6, h = bh & 3, b = bh >> 2; const int tok0 = b * SEQ + n * 64;
    const bf16_t* PV = (const bf16_t*)(ws + WS_PREV) + (size_t)item * 128 * 256;
#pragma unroll
    for (int pp = 0; pp < 8; ++pp) { const int idx = tid + 512 * pp, d = idx >> 5, c = idx & 31; *(u32x4*)(lds + G3_PREV + d * 576 + c * 16) = *(const u32x4*)(PV + (size_t)d * 256 + c * 8); }
    const int it = w & 1, vq = w >> 1; const bf16_t* qeg = (const bf16_t*)(ws + WS_QE) + (size_t)(tok0 + it * 32 + r32) * 512 + h * 128;
    bf16x8 qa[8];
#pragma unroll
    for (int s = 0; s < 8; ++s) qa[s] = *(const bf16x8*)(qeg + 16 * s + 8 * hi);
    __syncthreads();
    const LDS3 char* l3 = (const LDS3 char*)lds; const int blk = (lane >> 4) & 1, q4 = (lane & 15) >> 2, p4 = lane & 3;
    f32x16 o[2]; const float* oig = (const float*)(ws + WS_OINTRA);
#pragma unroll
    for (int vi = 0; vi < 2; ++vi)
#pragma unroll
        for (int rr = 0; rr < 16; ++rr) o[vi][rr] = oig[(size_t)(tok0 + it * 32 + crow(rr, hi)) * 1024 + h * 256 + (2 * vq + vi) * 32 + r32];
#pragma unroll
    for (int s = 0; s < 8; ++s)
#pragma unroll
        for (int vi = 0; vi < 2; ++vi) { const int vt = 2 * vq + vi; const LDS3 char* pp_ = l3 + G3_PREV + (16 * s + 8 * hi + q4) * 576 + (vt * 32 + 16 * blk + 4 * p4) * 2; const bf16x8 pf = cat8(tr16(pp_), tr16(pp_ + 4 * 576)); o[vi] = MFMA32(qa[s], pf, o[vi]); }
    float* SS = (float*)(lds + G3_SS);
#pragma unroll
    for (int rr = 0; rr < 16; ++rr) { float q = o[0][rr] * o[0][rr] + o[1][rr] * o[1][rr]; q += __shfl_xor(q, 16); q += __shfl_xor(q, 8); q += __shfl_xor(q, 4); q += __shfl_xor(q, 2); q += __shfl_xor(q, 1);
        if (r32 == 0) SS[w * 32 + crow(rr, hi)] = q; }
    __syncthreads();
    const bf16_t* grg = (const bf16_t*)(ws + WS_GR); bf16_t* yg = (bf16_t*)(ws + WS_YGLA);
    float ng[2]; ng[0] = p.gla_norm_g[(2 * vq) * 32 + r32]; ng[1] = p.gla_norm_g[(2 * vq + 1) * 32 + r32];
#pragma unroll
    for (int rr = 0; rr < 16; ++rr) { const int row = crow(rr, hi); const float tot = SS[(it + 0) * 32 + row] + SS[(it + 2) * 32 + row] + SS[(it + 4) * 32 + row] + SS[(it + 6) * 32 + row];
        const float rs = rsqrtf(tot * (1.0f / 256.0f) + EPS); const size_t ro = (size_t)(tok0 + it * 32 + row) * 1024 + h * 256;
#pragma unroll
        for (int vi = 0; vi < 2; ++vi) { const int col = (2 * vq + vi) * 32 + r32; const float y = o[vi][rr] * rs * ng[vi] * bf2f(grg[ro + col]); yg[ro + col] = (bf16_t)(cvt_pk_bf16(y, 0.f) & 0xffffu); } }
    __syncthreads();
}

constexpr int RT_RSTD = 0;
constexpr int RT_LOG = 256;
constexpr int RT_CNT = RT_LOG + 64 * 32 * 4;
__device__ __forceinline__ void route_group(const Params& p, int grp, char* lds) {
    unsigned char* ws = opaque(p.ws); const int tid = tid_(), lane = tid & 63; const int w = __builtin_amdgcn_readfirstlane(tid >> 6);
    const float* H = (const float*)(ws + WS_H); const float* RWG = (const float*)(ws + WS_RWG);
    float* RSTD = (float*)(lds + RT_RSTD); float* LOGS = (float*)(lds + RT_LOG); int* LCNT = (int*)(lds + RT_CNT);
    const int tok0 = grp * 64;
    if (tid < 32) LCNT[tid] = 0;
    if (w < 4) { const int tl = lane & 15, kq = lane >> 4; const float* hr = H + (size_t)(tok0 + w * 16 + tl) * 1024 + kq * 256; const float* br = RWG + (size_t)(kq * 256) * 32 + tl;
        f32x4 a0 = {0.f, 0.f, 0.f, 0.f}, a1 = {0.f, 0.f, 0.f, 0.f}; float ss = 0.f;
#pragma unroll 4
        for (int m4 = 0; m4 < 64; ++m4) { const f32x4 hv = *(const f32x4*)(hr + m4 * 4);
#pragma unroll
            for (int q = 0; q < 4; ++q) { const float b0 = br[(size_t)(m4 * 4 + q) * 32], b1 = br[(size_t)(m4 * 4 + q) * 32 + 16];
                a0 = __builtin_amdgcn_mfma_f32_16x16x4f32(hv[q], b0, a0, 0, 0, 0); a1 = __builtin_amdgcn_mfma_f32_16x16x4f32(hv[q], b1, a1, 0, 0, 0); ss += hv[q] * hv[q]; } }
        ss += __shfl_xor(ss, 16); ss += __shfl_xor(ss, 32);
        const float rs = rsqrtf(ss * (1.0f / 1024.0f) + EPS);
        if (kq == 0) RSTD[w * 16 + tl] = rs;
#pragma unroll
        for (int rg = 0; rg < 4; ++rg) { const int t = w * 16 + 4 * kq + rg; LOGS[t * 32 + tl] = a0[rg]; LOGS[t * 32 + 16 + tl] = a1[rg]; } }
    __syncthreads();
    if (tid < 64) { const int tok = tok0 + tid; const float rs = RSTD[tid]; float lg[32];
#pragma unroll
        for (int e = 0; e < 32; ++e) lg[e] = LOGS[tid * 32 + e] * rs + p.router_b[e];
        int be[4]; float bv[4];
#pragma unroll
        for (int k = 0; k < 4; ++k) { float best = -3.0e38f; int bi = 0;
#pragma unroll
            for (int e = 0; e < 32; ++e) { const bool tk = lg[e] > best; best = tk ? lg[e] : best; bi = tk ? e : bi; }
            be[k] = bi; bv[k] = best;
#pragma unroll
            for (int e = 0; e < 32; ++e) lg[e] = (e == bi) ? -3.0e38f : lg[e]; }
        const float e1 = __expf(bv[1] - bv[0]), e2 = __expf(bv[2] - bv[0]), e3 = __expf(bv[3] - bv[0]); const float inv = 1.0f / (1.0f + e1 + e2 + e3);
        const float gt[4] = {inv, e1 * inv, e2 * inv, e3 * inv};
#pragma unroll
        for (int k = 0; k < 4; ++k) { const int pos = atomicAdd(&LCNT[be[k]], 1);
            ((int*)(ws + WS_TOPE))[tok * 4 + k] = be[k]; ((float*)(ws + WS_TOPG))[tok * 4 + k] = gt[k]; ((int*)(ws + WS_TOPP))[tok * 4 + k] = pos; } }
    { bf16_t* HN = (bf16_t*)(ws + WS_HN);
#pragma unroll 4
      for (int i = 0; i < 16; ++i) { const int idx = tid + 512 * i, t = idx >> 7, c = idx & 127; const float rs = RSTD[t]; const size_t off = (size_t)(tok0 + t) * 1024 + c * 8;
          const f32x4 h0 = *(const f32x4*)(H + off), h1 = *(const f32x4*)(H + off + 4), g0 = *(const f32x4*)(p.norm_ffn_g + c * 8), g1 = *(const f32x4*)(p.norm_ffn_g + c * 8 + 4);
          u32x4 wv; wv.x = cvt_pk_bf16(h0[0] * rs * g0[0], h0[1] * rs * g0[1]); wv.y = cvt_pk_bf16(h0[2] * rs * g0[2], h0[3] * rs * g0[3]); wv.z = cvt_pk_bf16(h1[0] * rs * g1[0], h1[1] * rs * g1[1]); wv.w = cvt_pk_bf16(h1[2] * rs * g1[2], h1[3] * rs * g1[3]);
          *(u32x4*)(HN + off) = wv; } }
    __syncthreads();
    if (tid < 32) ((int*)(ws + WS_CNT))[grp * 32 + tid] = LCNT[tid];
    __syncthreads();
}

constexpr int DP_TOT = 0;
constexpr int DP_PART = 512;
__device__ __forceinline__ void dispatch_tables(const Params& p, int grp, char* lds) {
    unsigned char* ws = opaque(p.ws); const int tid = tid_(); const int* CNT = (const int*)(ws + WS_CNT); int* T = (int*)(lds + DP_TOT); int* PART = (int*)(lds + DP_PART);
    { const int e = tid & 31, part = tid >> 5; int tot = 0, pre = 0;
      for (int g2 = part * 16; g2 < part * 16 + 16; ++g2) { const int c = CNT[g2 * 32 + e]; tot += c; if (g2 < grp) pre += c; }
      PART[part * 32 + e] = tot; PART[512 + part * 32 + e] = pre; }
    __syncthreads();
    if (tid < 32) { int tot = 0, pre = 0; for (int q = 0; q < 16; ++q) { tot += PART[q * 32 + tid]; pre += PART[512 + q * 32 + tid]; } T[tid] = tot; T[64 + tid] = pre; }
    __syncthreads();
    if (tid == 0) { int base = 0; for (int e = 0; e < 32; ++e) { T[32 + e] = base; base += (T[e] + 255) >> 8; } T[96] = base; }
    __syncthreads();
}
__device__ __forceinline__ void dispatch_group(const Params& p, int grp, char* lds) {
    unsigned char* ws = opaque(p.ws); const int tid = tid_();
    dispatch_tables(p, grp, lds);
    const int* T = (const int*)(lds + DP_TOT); int* DEST = (int*)(lds + DP_PART + 4096);
    if (tid < 256) { const int tok = grp * 64 + (tid >> 2); const int e = ((const int*)(ws + WS_TOPE))[tok * 4 + (tid & 3)], lp = ((const int*)(ws + WS_TOPP))[tok * 4 + (tid & 3)];
        const int dest = T[32 + e] * 256 + T[64 + e] + lp; DEST[tid] = dest; ((int*)(ws + WS_SLOT))[tok * 4 + (tid & 3)] = dest; }
    __syncthreads();
    const bf16_t* HN = (const bf16_t*)(ws + WS_HN); bf16_t* XP = (bf16_t*)(ws + WS_XPAD);
#pragma unroll 4
    for (int i = 0; i < 64; ++i) { const int idx = tid + 512 * i, pr = idx >> 7, c = idx & 127; const int tok = grp * 64 + (pr >> 2);
        *(u32x4*)(XP + (size_t)DEST[pr] * 1024 + c * 8) = *(const u32x4*)(HN + (size_t)tok * 1024 + c * 8); }
    __syncthreads();
}

__device__ __forceinline__ void phase_combine(const Params& p) {
    unsigned char* ws = opaque(p.ws); const int tid = tid_(), lane = tid & 63, wid = tid >> 6, G = gridDim.x;
    const float* H = (const float*)(ws + WS_H); const bf16_t* YP = (const bf16_t*)(ws + WS_YPAD);
    for (int tok = blockIdx.x * 8 + wid; tok < NTOK; tok += G * 8) {
        int sl[4]; float gt[4];
#pragma unroll
        for (int k = 0; k < 4; ++k) { sl[k] = ((const int*)(ws + WS_SLOT))[tok * 4 + k]; gt[k] = ((const float*)(ws + WS_TOPG))[tok * 4 + k]; }
        f32x4 v[4]; float ss = 0.f;
#pragma unroll
        for (int i = 0; i < 4; ++i) { const int col = i * 256 + lane * 4; v[i] = *(const f32x4*)(H + (size_t)tok * 1024 + col);
#pragma unroll
            for (int k = 0; k < 4; ++k) { const u32x2 yw = *(const u32x2*)(YP + (size_t)sl[k] * 1024 + col); v[i][0] += gt[k] * bf_lo(yw.x); v[i][1] += gt[k] * bf_hi(yw.x); v[i][2] += gt[k] * bf_lo(yw.y); v[i][3] += gt[k] * bf_hi(yw.y); }
            ss += v[i][0] * v[i][0] + v[i][1] * v[i][1] + v[i][2] * v[i][2] + v[i][3] * v[i][3]; }
        ss = wave_sum(ss); const float rs = rsqrtf(ss * (1.0f / 1024.0f) + EPS);
#pragma unroll
        for (int i = 0; i < 4; ++i) { const int col = i * 256 + lane * 4; const f32x4 g = *(const f32x4*)(p.norm_final_g + col); f32x4 o; o[0] = v[i][0] * rs * g[0]; o[1] = v[i][1] * rs * g[1]; o[2] = v[i][2] * rs * g[2]; o[3] = v[i][3] * rs * g[3];
            *(f32x4*)(p.out + (size_t)tok * 1024 + col) = o; } }
}


#define XB_TMO      128
#define XB_XCNT(j)  (256  + 64 * (j))
#define XB_XSUB(j)  (1280 + 64 * (j))
#define XB_XGEN(j)  (2304 + 64 * (j))
#define XB_TOP      3328
#define XB_TOPGEN   3392
#define XCD_BAR_WORDS 3456
#define XB_SPIN_CAP (1u << 18)
__device__ __forceinline__ unsigned xb_ld(unsigned* p)              { return __hip_atomic_load(p, __ATOMIC_RELAXED, __HIP_MEMORY_SCOPE_AGENT); }
__device__ __forceinline__ unsigned xb_add(unsigned* p, unsigned v) { return __hip_atomic_fetch_add(p, v, __ATOMIC_RELAXED, __HIP_MEMORY_SCOPE_AGENT); }
__device__ __forceinline__ unsigned xb_xcc_id() { return (unsigned)__builtin_amdgcn_s_getreg((3 << 11) | 20) & 0xFu; }
#define XB_SPIN(cond, bar) do { unsigned _sp = 0; while (cond) { __builtin_amdgcn_s_sleep(1); \
    if ((++_sp & 255u) == 0u) { if (xb_ld(&(bar)[XB_TMO])) break; if (_sp > XB_SPIN_CAP) { atomicAdd(&(bar)[XB_TMO], 1u); break; } } } } while (0)
struct XcdBarrier { unsigned* bar; unsigned x; volatile LDS3 unsigned* st; };
__device__ __forceinline__ XcdBarrier xcd_barrier_post(unsigned* bar, volatile LDS3 unsigned* st) {
    XcdBarrier b; b.bar = bar; b.x = xb_xcc_id(); b.st = st;
    if (tid_() == 0) (void)xb_add(&bar[XB_XCNT(b.x)], 1u);
    return b;
}
__device__ __forceinline__ void xcd_barrier_complete(unsigned* bar, unsigned x, unsigned& nloc, unsigned& nx) {
    const unsigned G = gridDim.x * gridDim.y * gridDim.z;
    unsigned sum, cnt, mine, sp = 0u;
    for (;;) {
        sum = 0u; cnt = 0u; mine = 0u;
#pragma unroll
        for (unsigned j = 0; j < 16; ++j) { const unsigned c = xb_ld(&bar[XB_XCNT(j)]); sum += c; cnt += (c > 0u) ? 1u : 0u; mine = (j == x) ? c : mine; }
        if (sum == G) break;
        __builtin_amdgcn_s_sleep(1);
        if ((++sp & 255u) == 0u) { if (xb_ld(&bar[XB_TMO])) break; if (sp > XB_SPIN_CAP) { atomicAdd(&bar[XB_TMO], 1u); break; } }
    }
    nloc = mine > 0u ? mine : 1u; nx = cnt > 0u ? cnt : 1u;
}
__device__ __forceinline__ void xcd_barrier(const XcdBarrier& b) {
    asm volatile("s_waitcnt vmcnt(0)" ::: "memory");
    __syncthreads();
    if (tid_() == 0) {
        unsigned* bar = b.bar;
        __builtin_amdgcn_s_waitcnt(0);
        unsigned nloc = b.st[0], nx = b.st[1];
        if (nloc == 0u) { xcd_barrier_complete(bar, b.x, nloc, nx); b.st[0] = nloc; b.st[1] = nx; }
        const unsigned old = xb_add(&bar[XB_XSUB(b.x)], 1u);
        const unsigned gen = old / nloc;
        if (old + 1u == (gen + 1u) * nloc) {
            __builtin_amdgcn_fence(__ATOMIC_RELEASE, "agent");
            asm volatile("s_waitcnt vmcnt(0)" ::: "memory");
            const unsigned og = xb_add(&bar[XB_TOP], 1u);
            const unsigned tg = og / nx;
            if (og + 1u == (tg + 1u) * nx) xb_add(&bar[XB_TOPGEN], 1u);
            else XB_SPIN(xb_ld(&bar[XB_TOPGEN]) == tg, bar);
            __builtin_amdgcn_fence(__ATOMIC_ACQUIRE, "agent");
            xb_add(&bar[XB_XGEN(b.x)], 1u);
            asm volatile("s_waitcnt vmcnt(0)" ::: "memory");
        } else {
            XB_SPIN(xb_ld(&bar[XB_XGEN(b.x)]) == gen, bar);
            __builtin_amdgcn_fence(__ATOMIC_ACQUIRE, "agent");
            asm volatile("s_waitcnt vmcnt(0)" ::: "memory");
        }
    }
    __syncthreads();
}

__global__ void __launch_bounds__(512, 2) mega_fwd(Params p) {
    cg::grid_group grid = cg::this_grid();
    char* lds = smem; LDS3 unsigned char* lds3 = (LDS3 unsigned char*)smem;
    const int G = gridDim.x, bid = blockIdx.x;
    if (tid_() < 4) ((volatile LDS3 unsigned*)(lds3 + LDS_XB))[tid_()] = 0u;
    __syncthreads();
    const XcdBarrier xb = xcd_barrier_post((unsigned*)(p.ws + WS_BAR), (volatile LDS3 unsigned*)(lds3 + LDS_XB));
    for (int rep = 0; rep < REP_P0; ++rep) phase_prologue(p, lds);
    grid.sync();
    for (int rep = 0; rep < REP_P1; ++rep) { unsigned char* ws = opaque(p.ws); pg8::DenseProb S; S.init(ws + WS_XN, ws + WS_W_IN, NTOK, INWP, 1024, G, bid);
      EpiProj E; E.ws = ws;
      pg8::gemm_phase(lds3, S, E); }
    xcd_barrier(xb);
    for (int rep = 0; rep < REP_ATT; ++rep) for (int item = bid; item < 4 * 24 * 16; item += G) attn_item(p, item, lds);
    for (int rep = 0; rep < REP_GLA1; ++rep) for (int item = bid; item < 1024; item += G) gla1_item(p, item, lds);
    xcd_barrier(xb);
    for (int rep = 0; rep < REP_P3; ++rep) phase_scan_combine(p);
    xcd_barrier(xb);
    for (int rep = 0; rep < REP_P4; ++rep) for (int item = bid; item < 1024; item += G) gla3_item(p, item, lds);
    xcd_barrier(xb);
    for (int rep = 0; rep < REP_P5; ++rep) {
    { unsigned char* ws = opaque(p.ws); pg8::DenseProb S; S.init(ws + WS_YATT, ws + WS_W_A, NTOK, 1024, 512, G, bid);
      EpiGate<0> E; E.gate = (const bf16_t*)(ws + WS_SA); E.t1 = nullptr; E.out = (bf16_t*)(ws + WS_T1);
      pg8::gemm_phase(lds3, S, E); }
    { unsigned char* ws = opaque(p.ws); pg8::DenseProb S; S.init(ws + WS_YGLA, ws + WS_W_G, NTOK, 1024, 1024, G, bid);
      EpiGate<1> E; E.gate = (const bf16_t*)(ws + WS_SG); E.t1 = (const bf16_t*)(ws + WS_T1); E.out = (bf16_t*)(ws + WS_MERGED);
      pg8::gemm_phase(lds3, S, E); }
    }
    xcd_barrier(xb);
    for (int rep = 0; rep < REP_P6; ++rep) { unsigned char* ws = opaque(p.ws); pg8::DenseProb S; S.init(ws + WS_MERGED, ws + WS_W_MIX, NTOK, 1024, 1024, G, bid);
      EpiResid E; E.x = p.x; E.h = (float*)(ws + WS_H);
      pg8::gemm_phase(lds3, S, E); }
    xcd_barrier(xb);
    for (int rep = 0; rep < REP_P7; ++rep) for (int grp = bid; grp < 256; grp += G) route_group(p, grp, lds);
    xcd_barrier(xb);
    for (int rep = 0; rep < REP_P8; ++rep) for (int grp = bid; grp < 256; grp += G) dispatch_group(p, grp, lds);
    if (bid == 0) { unsigned char* ws = opaque(p.ws); dispatch_tables(p, -1, lds); const int* T = (const int*)(lds + DP_TOT); int* TE = (int*)(ws + WS_TILEE);
        if (tid_() < 32) { const int e = tid_(); for (int t = T[32 + e]; t < T[32 + e] + ((T[e] + 255) >> 8); ++t) TE[16 + t] = e; }
        if (tid_() == 0) TE[0] = T[96]; }
    xcd_barrier(xb);
    for (int rep = 0; rep < REP_P9; ++rep) { unsigned char* ws = opaque(p.ws); const int* TE = (const int*)(ws + WS_TILEE);
      pg8::MoeProb S; S.A = (const char*)(ws + WS_XPAD); S.Bt = (const char*)(ws + WS_W_GU); S.K = 1024; S.nN = 8; S.T = TE[0]; S.G = G; S.c = bid; S.estride = (size_t)2048 * 1024 * 2; S.tile_e = TE + 16;
      EpiAct E; E.bgu = p.e_b_gu; E.tile_e = TE + 16; E.act = (bf16_t*)(ws + WS_ACT);
      pg8::gemm_phase(lds3, S, E); }
    xcd_barrier(xb);
    for (int rep = 0; rep < REP_P10; ++rep) { unsigned char* ws = opaque(p.ws); const int* TE = (const int*)(ws + WS_TILEE);
      pg8::MoeProb S; S.A = (const char*)(ws + WS_ACT); S.Bt = (const char*)(ws + WS_W_D); S.K = 1024; S.nN = 4; S.T = TE[0]; S.G = G; S.c = bid; S.estride = (size_t)1024 * 1024 * 2; S.tile_e = TE + 16;
      EpiDown E; E.bd = p.e_b_d; E.tile_e = TE + 16; E.y = (bf16_t*)(ws + WS_YPAD);
      pg8::gemm_phase(lds3, S, E); }
    xcd_barrier(xb);
    for (int rep = 0; rep < REP_P11; ++rep) phase_combine(p);
}

extern "C" void kernel_launch(void* const* d_in, const int* in_sizes, int n_in, void* d_out, int out_size, void* d_ws, size_t ws_size, hipStream_t stream) {
    static int grid = 0;
    if (grid == 0) {
        if (n_in != 17 || ws_size < WS_END) { fprintf(stderr, "kernel_launch: expected 17 inputs and >= %zu bytes of workspace (got %d, %zu); nothing launched\n", (size_t)WS_END, n_in, ws_size); grid = -1; return; }
        int dev = 0, cus = 0, per_cu = 0;
        if (hipGetDevice(&dev) != hipSuccess || hipDeviceGetAttribute(&cus, hipDeviceAttributeMultiprocessorCount, dev) != hipSuccess) { fprintf(stderr, "kernel_launch: device query failed\n"); grid = -1; return; }
        if (hipFuncSetAttribute((const void*)mega_fwd, hipFuncAttributeMaxDynamicSharedMemorySize, LDS_BYTES) != hipSuccess) { fprintf(stderr, "kernel_launch: hipFuncSetAttribute failed\n"); grid = -1; return; }
        if (hipOccupancyMaxActiveBlocksPerMultiprocessor(&per_cu, (const void*)mega_fwd, 512, LDS_BYTES) != hipSuccess || per_cu < 1) { fprintf(stderr, "kernel_launch: occupancy query failed (%d)\n", per_cu); grid = -1; return; }
        grid = cus;
    }
    if (grid < 0) return;
    Params p{};
    p.x = (const float*)d_in[0]; p.norm_mix_g = (const float*)d_in[1]; p.w_in = (const float*)d_in[2]; p.gla_gate_up = (const float*)d_in[3]; p.gla_gate_bias = (const float*)d_in[4]; p.gla_norm_g = (const float*)d_in[5];
    p.w_branch_gla = (const float*)d_in[6]; p.w_branch_att = (const float*)d_in[7]; p.w_mix_out = (const float*)d_in[8]; p.norm_ffn_g = (const float*)d_in[9]; p.router_w = (const float*)d_in[10]; p.router_b = (const float*)d_in[11];
    p.e_w_gu = (const float*)d_in[12]; p.e_b_gu = (const float*)d_in[13]; p.e_w_d = (const float*)d_in[14]; p.e_b_d = (const float*)d_in[15]; p.norm_final_g = (const float*)d_in[16];
    p.out = (float*)d_out; p.ws = (unsigned char*)d_ws;
    if (hipMemsetAsync((char*)d_ws + WS_BAR, 0, 3456 * 4, stream) != hipSuccess) { fprintf(stderr, "kernel_launch: memset of the barrier words failed\n"); return; }
    void* args[] = {&p};
    hipError_t e = hipLaunchCooperativeKernel((const void*)mega_fwd, dim3(grid), dim3(512), args, LDS_BYTES, stream);
    if (e != hipSuccess) fprintf(stderr, "kernel_launch: cooperative launch failed: %s (grid %d)\n", hipGetErrorString(e), grid);
}
```

```cpp
#include <hip/hip_runtime.h>
#include <hip/hip_cooperative_groups.h>
#include <cstdio>
#include <cstdint>
namespace cg = cooperative_groups;
#ifndef REP_P0
#define REP_P0 1
#define REP_P1 1
#define REP_ATT 1
#define REP_GLA1 1
#define REP_P3 1
#define REP_P4 1
#define REP_P5 1
#define REP_P6 1
#define REP_P7 1
#define REP_P8 1
#define REP_P9 1
#define REP_P10 1
#define REP_P11 1
#endif

#define LDS3 __attribute__((address_space(3)))
typedef unsigned short bf16_t;
typedef short bf16x8 __attribute__((ext_vector_type(8)));
typedef short s16x4 __attribute__((ext_vector_type(4)));
typedef short v4i16_t __attribute__((ext_vector_type(4)));
typedef float f32x4 __attribute__((ext_vector_type(4)));
typedef float f32x2 __attribute__((ext_vector_type(2)));
typedef float f32x16 __attribute__((ext_vector_type(16)));
typedef unsigned u32x4 __attribute__((ext_vector_type(4)));
typedef unsigned u32x2 __attribute__((ext_vector_type(2)));
typedef int i32x8 __attribute__((ext_vector_type(8)));
typedef int i32x4 __attribute__((ext_vector_type(4)));

constexpr int NTOK = 16384, DM = 1024, SEQ = 4096, NB = 4;
constexpr int INW = 9744, INWP = 9984;
constexpr int NEXP = 32, TOPK = 4, FF = 1024;
constexpr int MAXT = 288;
constexpr float EPS = 1e-5f;
constexpr float QSCALE = 0.125f * 1.4426950408889634f;
constexpr float LN2 = 0.6931471805599453f;

constexpr size_t al256(size_t x) { return (x + 255) & ~(size_t)255; }
constexpr size_t WS_W_IN = 0;
constexpr size_t WS_W_G = WS_W_IN + (size_t)INWP * 1024 * 2;
constexpr size_t WS_W_A = WS_W_G + (size_t)1024 * 1024 * 2;
constexpr size_t WS_W_MIX = WS_W_A + (size_t)1024 * 512 * 2;
constexpr size_t WS_W_GU = WS_W_MIX + (size_t)1024 * 1024 * 2;
constexpr size_t WS_W_D = WS_W_GU + (size_t)NEXP * 2048 * 1024;
constexpr size_t WS_ROPE_C = WS_W_D + (size_t)NEXP * 1024 * 1024;
constexpr size_t WS_ROPE_S = WS_ROPE_C + (size_t)SEQ * 8 * 4;
constexpr size_t WS_RWG = WS_ROPE_S + (size_t)SEQ * 8 * 4;
constexpr size_t WS_H = WS_RWG + (size_t)1024 * 32 * 4;
constexpr size_t WS_HN = WS_H + (size_t)NTOK * 1024 * 4;
constexpr size_t WS_TOPE = WS_HN + (size_t)NTOK * 1024;
constexpr size_t WS_TOPG = WS_TOPE + (size_t)NTOK * 4 * 4;
constexpr size_t WS_TOPP = WS_TOPG + (size_t)NTOK * 4 * 4;
constexpr size_t WS_SLOT = WS_TOPP + (size_t)NTOK * 4 * 4;
constexpr size_t WS_CNT = WS_SLOT + (size_t)NTOK * 4 * 4;
constexpr size_t WS_TILEE = WS_CNT + (size_t)256 * 32 * 4;
constexpr size_t WS_REGB = al256(WS_TILEE + (size_t)(MAXT + 32) * 4);
constexpr size_t WS_XN = WS_REGB;
constexpr size_t WS_GQ = WS_XN + (size_t)NTOK * 1024 * 2;
constexpr size_t WS_GK = WS_GQ + (size_t)NTOK * 512 * 2;
constexpr size_t WS_GV = WS_GK + (size_t)NTOK * 512 * 2;
constexpr size_t WS_GR = WS_GV + (size_t)NTOK * 1024 * 2;
constexpr size_t WS_SG = WS_GR + (size_t)NTOK * 1024 * 2;
constexpr size_t WS_SA = WS_SG + (size_t)NTOK * 1024 * 2;
constexpr size_t WS_AQ = WS_SA + (size_t)NTOK * 1024 * 2;
constexpr size_t WS_AK = WS_AQ + (size_t)NTOK * 1536 * 2;
constexpr size_t WS_AV = WS_AK + (size_t)NTOK * 1536 * 2;
constexpr size_t WS_GLR = WS_AV + (size_t)NTOK * 1536 * 2;
constexpr size_t WS_OATT = WS_GLR + (size_t)NTOK * 16 * 4;
constexpr size_t WS_LSE = WS_OATT + (size_t)3 * NTOK * 512 * 2;
constexpr size_t WS_QE = WS_LSE + (size_t)3 * NTOK * 8 * 4;
constexpr size_t WS_OINTRA = WS_QE + (size_t)NTOK * 512 * 2;
constexpr size_t WS_U = WS_OINTRA + (size_t)NTOK * 1024 * 4;
constexpr size_t WS_DEC = WS_U + (size_t)1024 * 128 * 256 * 2;
constexpr size_t WS_REGB_END = WS_DEC + (size_t)1024 * 128 * 4;
constexpr size_t WS_PREV = WS_AQ;
constexpr size_t WS_YGLA = WS_AV;
constexpr size_t WS_YATT = WS_XN;
constexpr size_t WS_T1 = WS_GQ;
constexpr size_t WS_MERGED = WS_GV;
constexpr size_t PADROWS = (size_t)MAXT * 256;
constexpr size_t WS_XPAD = WS_REGB;
constexpr size_t WS_ACT = WS_XPAD + PADROWS * 1024;
constexpr size_t WS_YPAD = WS_ACT + PADROWS * 1024;
constexpr size_t WS_PAD_END = WS_YPAD + PADROWS * 1024 * 2;
constexpr size_t WS_BAR = al256(WS_REGB_END > WS_PAD_END ? WS_REGB_END : WS_PAD_END);
constexpr size_t WS_END = WS_BAR + 3456 * 4;
static_assert(WS_PAD_END <= WS_REGB_END + (1u << 30), "map");

constexpr int LDS_XB = 147456;
constexpr int LDS_BYTES = 147456 + 16;

struct Params {
    const float *x, *norm_mix_g, *w_in, *gla_gate_up, *gla_gate_bias, *gla_norm_g, *w_branch_gla, *w_branch_att, *w_mix_out, *norm_ffn_g,
        *router_w, *router_b, *e_w_gu, *e_b_gu, *e_w_d, *e_b_d, *norm_final_g;
    float* out;
    unsigned char* ws;
};

__device__ __forceinline__ int tid_() { int t = threadIdx.x; asm volatile("" : "+v"(t)); return t; }
__device__ __forceinline__ unsigned char* opaque(unsigned char* q) { return q; }
__device__ __forceinline__ unsigned cvt_pk_bf16(float lo, float hi) { unsigned r; asm volatile("v_cvt_pk_bf16_f32 %0, %1, %2" : "=v"(r) : "v"(lo), "v"(hi)); return r; }
__device__ __forceinline__ float bf_lo(unsigned w) { return __uint_as_float(w << 16); }
__device__ __forceinline__ float bf_hi(unsigned w) { return __uint_as_float(w & 0xffff0000u); }
__device__ __forceinline__ float bf2f(bf16_t b) { return __uint_as_float(((unsigned)b) << 16); }
__device__ __forceinline__ u32x4 pack8(const float* v) { u32x4 w; w.x = cvt_pk_bf16(v[0], v[1]); w.y = cvt_pk_bf16(v[2], v[3]); w.z = cvt_pk_bf16(v[4], v[5]); w.w = cvt_pk_bf16(v[6], v[7]); return w; }
__device__ __forceinline__ void unpack8(u32x4 w, float* v) { v[0] = bf_lo(w.x); v[1] = bf_hi(w.x); v[2] = bf_lo(w.y); v[3] = bf_hi(w.y); v[4] = bf_lo(w.z); v[5] = bf_hi(w.z); v[6] = bf_lo(w.w); v[7] = bf_hi(w.w); }
__device__ __forceinline__ float sigmoidf_(float v) { return __builtin_amdgcn_rcpf(1.0f + __builtin_amdgcn_exp2f(v * -1.4426950408889634f)); }
__device__ __forceinline__ float wave_sum(float v) { v += __shfl_xor(v, 32); v += __shfl_xor(v, 16); v += __shfl_xor(v, 8); v += __shfl_xor(v, 4); v += __shfl_xor(v, 2); v += __shfl_xor(v, 1); return v; }
__device__ __forceinline__ s16x4 tr16(const LDS3 char* p) { return __builtin_bit_cast(s16x4, __builtin_amdgcn_ds_read_tr16_b64_v4i16((LDS3 v4i16_t*)p)); }
__device__ __forceinline__ bf16x8 cat8(s16x4 a, s16x4 b) { return (bf16x8){a[0], a[1], a[2], a[3], b[0], b[1], b[2], b[3]}; }
__device__ __forceinline__ int crow(int r, int hi) { return (r & 3) + 8 * (r >> 2) + 4 * hi; }
__device__ __forceinline__ void st_nt(void* p, u32x4 v) { __builtin_nontemporal_store(v, (u32x4*)p); }
__device__ __forceinline__ int pk4_fp8(float a, float b, float c, float d) { int w = __builtin_amdgcn_cvt_pk_fp8_f32(a, b, 0, false); return __builtin_amdgcn_cvt_pk_fp8_f32(c, d, w, true); }
#define MFMA32(a, b, c) __builtin_amdgcn_mfma_f32_32x32x16_bf16(a, b, c, 0, 0, 0)

namespace pg8 {
constexpr int BM = 256, BK = 64, HALF = 128, HTB = HALF * BK * 2, STAGE_BYTES = 8 * HTB, NXCD = 8, WGM = 8;
__host__ __device__ __forceinline__ int lds_byte(int r, int c) { const int st = (r >> 4) * 2 + (c >> 5), rr = r & 15, cc = c & 31, ob = rr * 64 + cc * 2; return st * 1024 + (ob ^ (((ob >> 9) & 1) << 5)); }
__host__ __device__ __forceinline__ void stage_rc(int b, int& R, int& C) { const int st = b / 1024, sb = b % 1024, swz = sb ^ (((sb >> 9) & 1) << 5); R = (st >> 1) * 16 + swz / 64; C = (st & 1) * 32 + (swz % 64) / 2; }
__host__ __device__ __forceinline__ int perm32(int rho) { const int n = rho >> 4, i = rho & 15; return 8 * (i >> 2) + 4 * n + (i & 3); }
struct Unit { int pm, pn; };

struct DenseProb {
    const char* A; const char* Bt; int K; int nM, nN, nwg, G, c;
    __device__ void init(const void* A_, const void* Bt_, int M, int N, int K_, int G_, int c_) { A = (const char*)A_; Bt = (const char*)Bt_; K = K_; nM = M / BM; nN = N / BM; nwg = nM * nN; G = G_; c = c_; }
    __device__ __forceinline__ bool next(int i, Unit& u) const {
        const long L = (long)i * G + c; if (L >= nwg) return false;
        int wgid = (int)L; { const int q = nwg / NXCD, r = nwg % NXCD, xcd = wgid % NXCD, off = wgid / NXCD; wgid = (xcd < r ? xcd * (q + 1) : r * (q + 1) + (xcd - r) * q) + off; }
        const int nig = WGM * nN, gid = wgid / nig, fm = gid * WGM, gsz = (nM - fm) < WGM ? (nM - fm) : WGM;
        u.pm = fm + ((wgid % nig) % gsz); u.pn = (wgid % nig) / gsz; return true;
    }
    __device__ __forceinline__ const char* a_ptr(const Unit& u) const { return A + (size_t)u.pm * BM * K * 2; }
    __device__ __forceinline__ const char* b_ptr(const Unit& u) const { return Bt + (size_t)u.pn * BM * K * 2; }
};
struct MoeProb {
    const char* A; const char* Bt; int K; int nN, T, G, c; size_t estride; const int* tile_e;
    __device__ __forceinline__ bool next(int i, Unit& u) const { const long L = (long)i * G + c; if (L >= (long)T * nN) return false; u.pm = (int)(L / nN); u.pn = (int)(L % nN); return true; }
    __device__ __forceinline__ const char* a_ptr(const Unit& u) const { return A + (size_t)u.pm * BM * K * 2; }
    __device__ __forceinline__ const char* b_ptr(const Unit& u) const { return Bt + (size_t)tile_e[u.pm] * estride + (size_t)u.pn * BM * K * 2; }
};

template <class Epi, class Prob>
__device__ __forceinline__ void gemm_phase(LDS3 unsigned char* lds, const Prob& S, const Epi& E) {
    const int tid = tid_(), wid = __builtin_amdgcn_readfirstlane(tid >> 6), lane = tid & 63, wr = wid >> 2, wc = wid & 3, fr = lane & 15, fq = lane >> 4;
    const int K = S.K, nt = K / BK;
    unsigned voffA[2], voffB[2];
#pragma unroll
    for (int i = 0; i < 2; ++i) { int R, C; stage_rc(tid * 16 + i * 8192, R, C); const int Rb = Epi::PERM ? (2 * (R & ~31) + perm32(R & 31)) : R;
        voffA[i] = (unsigned)(R * K + C) * 2u; voffB[i] = (unsigned)(Rb * K + C) * 2u; }
    const size_t kstep = (size_t)(BK * 2);
    const size_t hstep = (size_t)HALF * K * 2;
    const size_t hstepB = Epi::PERM ? (size_t)32 * K * 2 : hstep;
    const unsigned ldsw = (unsigned)wid * 1024u;
    const int aoff = lds_byte(wr * 64 + fr, fq * 8), boff = lds_byte(wc * 32 + fr, fq * 8);
#define PG8_SA(b, h) (((b) * 2 + (h)) * HTB)
#define PG8_SB(b, h) ((4 + (b) * 2 + (h)) * HTB)
#define PG8_STAGE(bufoff, gbase, voff) do { _Pragma("unroll") for (int _i = 0; _i < 2; ++_i) \
        __builtin_amdgcn_global_load_lds((const unsigned*)((const char*)(gbase) + (voff)[_i]), (LDS3 unsigned*)(lds + (bufoff) + ldsw + _i * 8192), 16, 0, 0); } while (0)
#define PG8_LD8(ptr) __builtin_shufflevector(*(const LDS3 i32x4*)(ptr), *(const LDS3 i32x4*)((ptr) + 1024), 0, 1, 2, 3, 4, 5, 6, 7)
#define PG8_LO(x) __builtin_bit_cast(bf16x8, __builtin_shufflevector(x, x, 0, 1, 2, 3))
#define PG8_HI(x) __builtin_bit_cast(bf16x8, __builtin_shufflevector(x, x, 4, 5, 6, 7))
#define PG8_LDA(dst, b, h) do { _Pragma("unroll") for (int m = 0; m < 4; ++m) dst[m] = PG8_LD8(lds + PG8_SA(b, h) + aoff + m * 2048); } while (0)
#define PG8_LDB(dst, b, h) do { _Pragma("unroll") for (int n = 0; n < 2; ++n) dst[n] = PG8_LD8(lds + PG8_SB(b, h) + boff + n * 2048); } while (0)
#define PG8_MMA(ai, bj, At, Bt) do { __builtin_amdgcn_s_setprio(1); _Pragma("unroll") for (int m = 0; m < 4; ++m) _Pragma("unroll") for (int n = 0; n < 2; ++n) { \
        if constexpr (Epi::FP8) asm volatile("v_mfma_scale_f32_16x16x128_f8f6f4 %0, %1, %2, %0, %3, %4 op_sel_hi:[0,0,0]" : "+v"(acc[ai][bj][m][n]) : "v"(Bt[n]), "v"(At[m]), "v"(sc_w), "v"(sc_1)); \
        else { acc[ai][bj][m][n] = __builtin_amdgcn_mfma_f32_16x16x32_bf16(PG8_LO(Bt[n]), PG8_LO(At[m]), acc[ai][bj][m][n], 0, 0, 0); acc[ai][bj][m][n] = __builtin_amdgcn_mfma_f32_16x16x32_bf16(PG8_HI(Bt[n]), PG8_HI(At[m]), acc[ai][bj][m][n], 0, 0, 0); } } __builtin_amdgcn_s_setprio(0); } while (0)
#define PG8_WAIT_V(n) asm volatile("s_waitcnt vmcnt(" #n ")" ::: "memory")
#define PG8_WAIT_L(n) asm volatile("s_waitcnt lgkmcnt(" #n ")" ::: "memory")
#define PG8_BAR __builtin_amdgcn_s_barrier()
#define PG8_SCHED __builtin_amdgcn_sched_barrier(0)
    Unit cur, nxt; int ui = 0;
    if (!S.next(0, cur)) return;
    f32x4 acc[2][2][4][2];
#pragma unroll
    for (int a = 0; a < 2; ++a)
#pragma unroll
        for (int b = 0; b < 2; ++b)
#pragma unroll
            for (int m = 0; m < 4; ++m)
#pragma unroll
                for (int n = 0; n < 2; ++n) acc[a][b][m][n] = (f32x4){0.f, 0.f, 0.f, 0.f};
    i32x8 At[4], B0[2], B1[2];
    int sc_w = 0x7A7A7A7A  , sc_1 = 0x7F7F7F7F; asm volatile("" : "+v"(sc_w), "+v"(sc_1));
    const char* cA = S.a_ptr(cur); const char* cB = S.b_ptr(cur);
    PG8_STAGE(PG8_SB(0, 0), cB, voffB); PG8_STAGE(PG8_SA(0, 0), cA, voffA); PG8_STAGE(PG8_SB(0, 1), cB + hstepB, voffB); PG8_STAGE(PG8_SA(0, 1), cA + hstep, voffA);
    if (wr == 1) PG8_BAR;
    PG8_WAIT_V(4); PG8_BAR;
    PG8_STAGE(PG8_SB(1, 0), cB + kstep, voffB); PG8_STAGE(PG8_SA(1, 0), cA + kstep, voffA); PG8_STAGE(PG8_SB(1, 1), cB + hstepB + kstep, voffB);
    PG8_WAIT_V(6); PG8_BAR;
    for (;;) {
        const bool has_next = S.next(ui + 1, nxt);
        const char* nA = has_next ? S.a_ptr(nxt) : cA; const char* nB = has_next ? S.b_ptr(nxt) : cB;
        for (int t = 0; t < nt; t += 2) {
            const bool last = (t == nt - 2);
            const char* a1 = cA + (size_t)(t + 1) * kstep;
            const char* a2 = last ? nA : cA + (size_t)(t + 2) * kstep; const char* b2 = last ? nB : cB + (size_t)(t + 2) * kstep;
            const char* a3 = a2 + kstep; const char* b3 = b2 + kstep;
            PG8_LDB(B0, 0, 0); PG8_SCHED; PG8_LDA(At, 0, 0); PG8_STAGE(PG8_SA(1, 1), a1 + hstep, voffA);
            PG8_WAIT_L(8); PG8_BAR; PG8_WAIT_L(0); PG8_MMA(0, 0, At, B0); PG8_BAR; PG8_SCHED;
            PG8_LDB(B1, 0, 1); PG8_STAGE(PG8_SB(0, 0), b2, voffB);
            PG8_BAR; PG8_WAIT_L(0); PG8_MMA(0, 1, At, B1); PG8_BAR;
            PG8_LDA(At, 0, 1); PG8_STAGE(PG8_SA(0, 0), a2, voffA);
            PG8_BAR; PG8_WAIT_L(0); PG8_MMA(1, 0, At, B0); PG8_BAR; PG8_SCHED;
            PG8_STAGE(PG8_SB(0, 1), b2 + hstepB, voffB);
            PG8_WAIT_V(6); PG8_BAR; PG8_MMA(1, 1, At, B1); PG8_BAR;
            PG8_LDB(B0, 1, 0); PG8_SCHED; PG8_LDA(At, 1, 0); PG8_STAGE(PG8_SA(0, 1), a2 + hstep, voffA);
            PG8_WAIT_L(8); PG8_BAR; PG8_WAIT_L(0); PG8_MMA(0, 0, At, B0); PG8_BAR; PG8_SCHED;
            PG8_LDB(B1, 1, 1); PG8_STAGE(PG8_SB(1, 0), b3, voffB);
            PG8_BAR; PG8_WAIT_L(0); PG8_MMA(0, 1, At, B1); PG8_BAR;
            PG8_LDA(At, 1, 1); PG8_STAGE(PG8_SA(1, 0), a3, voffA);
            PG8_BAR; PG8_WAIT_L(0); PG8_MMA(1, 0, At, B0); PG8_BAR; PG8_SCHED;
            PG8_STAGE(PG8_SB(1, 1), b3 + hstepB, voffB);
            PG8_WAIT_V(6); PG8_BAR; PG8_MMA(1, 1, At, B1); PG8_BAR;
        }
        if constexpr (Epi::FP8) asm volatile("s_nop 15\n\ts_nop 15" ::: "memory");
        E(acc, cur, wr, wc, fr, fq);
        if (!has_next) break;
#pragma unroll
        for (int a = 0; a < 2; ++a)
#pragma unroll
            for (int b = 0; b < 2; ++b)
#pragma unroll
                for (int m = 0; m < 4; ++m)
#pragma unroll
                    for (int n = 0; n < 2; ++n) acc[a][b][m][n] = (f32x4){0.f, 0.f, 0.f, 0.f};
        if constexpr (Epi::FP8) asm volatile("s_nop 7" ::: "memory");
        cur = nxt; cA = nA; cB = nB; ++ui;
    }
    PG8_WAIT_V(0);
    if (wr == 0) PG8_BAR;
    PG8_BAR;
#undef PG8_SA
#undef PG8_SB
#undef PG8_STAGE
#undef PG8_LDA
#undef PG8_LDB
#undef PG8_MMA
#undef PG8_LD8
#undef PG8_LO
#undef PG8_HI
#undef PG8_WAIT_V
#undef PG8_WAIT_L
#undef PG8_BAR
#undef PG8_SCHED
}
}
using pg8::Unit;

extern __shared__ __attribute__((aligned(16))) char smem[];
__device__ __forceinline__ char* smem_base() { return smem; }

constexpr int EPI_LDS = 131072;
__device__ __forceinline__ char* epi_slot(int wr, int wc) { return smem_base() + EPI_LDS + (wr * 4 + wc) * 2048; }
__device__ __forceinline__ void slot_put(char* slot, int fr, int fq, u32x4 w0, u32x4 w1) {
    *(u32x4*)(slot + fr * 128 + (((fq) ^ (fr & 7)) << 4)) = w0; *(u32x4*)(slot + fr * 128 + (((4 + fq) ^ (fr & 7)) << 4)) = w1; }
__device__ __forceinline__ u32x4 slot_get(const char* slot, int half, int lane) { const int row = half * 8 + (lane >> 3), ch = lane & 7; return *(const u32x4*)(slot + row * 128 + ((ch ^ (row & 7)) << 4)); }

#define EPI_ROWS(ai, m) for (int ai = 0; ai < 2; ++ai) _Pragma("unroll") for (int m = 0; m < 4; ++m)

struct EpiProj {
    static constexpr bool PERM = true, FP8 = false;
    unsigned char* ws;
    __device__ __forceinline__ void operator()(const f32x4 (&acc)[2][2][4][2], const Unit& u, int wr, int wc, int fr, int fq) const {
        const int pn = u.pn; const int lane = fq * 16 + fr; char* slot = epi_slot(wr, wc);
        const int rowq = u.pm * 256 + wr * 64 + (lane >> 3);
        if (pn < 12 || (pn >= 30 && pn < 38)) {
            size_t boff; int ld, col0, act;
            if (pn < 2) { boff = WS_GQ; ld = 512; col0 = pn * 256; act = 0; }
            else if (pn < 4) { boff = WS_GK; ld = 512; col0 = (pn - 2) * 256; act = 0; }
            else if (pn < 8) { boff = WS_GV; ld = 1024; col0 = (pn - 4) * 256; act = 0; }
            else if (pn < 12) { boff = WS_GR; ld = 1024; col0 = (pn - 8) * 256; act = 1; }
            else if (pn < 34) { boff = WS_SG; ld = 1024; col0 = (pn - 30) * 256; act = 2; }
            else { boff = WS_SA; ld = 1024; col0 = (pn - 34) * 256; act = 2; }
            bf16_t* base = (bf16_t*)(ws + boff) + col0 + wc * 64 + (lane & 7) * 8;
#pragma unroll
            EPI_ROWS(ai, m) { u32x4 w[2];
#pragma unroll
                for (int bj = 0; bj < 2; ++bj) { float v[8];
#pragma unroll
                    for (int j = 0; j < 4; ++j) { v[j] = acc[ai][bj][m][0][j]; v[4 + j] = acc[ai][bj][m][1][j]; }
                    if (act == 1) {
#pragma unroll
                        for (int j = 0; j < 8; ++j) v[j] = v[j] * sigmoidf_(v[j]); }
                    if (act == 2) {
#pragma unroll
                        for (int j = 0; j < 8; ++j) v[j] = sigmoidf_(v[j]); }
                    w[bj] = pack8(v); }
                slot_put(slot, fr, fq, w[0], w[1]);
#pragma unroll
                for (int half = 0; half < 2; ++half) st_nt(base + (size_t)(rowq + ai * 128 + m * 16 + half * 8) * ld, slot_get(slot, half, lane)); }
        } else if (pn < 30) {
            const int which = (pn - 12) / 6, t6 = (pn - 12) % 6, sh = (t6 >> 1) * 2, dmask = (1 << sh) - 1, NL = SEQ >> sh;
            bf16_t* base = (bf16_t*)(ws + WS_AQ + (size_t)which * ((size_t)NTOK * 1536 * 2)) + (lane & 7) * 8;
            const bool rot = (which < 2) && (fq < 2);
            f32x4 frev;
#pragma unroll
            for (int q = 0; q < 4; ++q) frev[q] = rot ? __builtin_amdgcn_exp2f(-(float)(4 * fq + q) * (0.125f * 18.931568569324174f)) * 0.15915494309189535f : 0.f;
            const float sc = which == 0 ? QSCALE : 1.0f;
            const int head = t6 * 4 + wc;
#pragma unroll
            EPI_ROWS(ai, m) { const int s = (u.pm * 256 + wr * 64 + fr + ai * 128 + m * 16) & (SEQ - 1);
                f32x4 cs, sn;
#pragma unroll
                for (int q = 0; q < 4; ++q) { const float rev = __builtin_amdgcn_fractf((float)s * frev[q]); cs[q] = __builtin_amdgcn_cosf(rev); sn[q] = __builtin_amdgcn_sinf(rev); }
                u32x4 w[2];
#pragma unroll
                for (int bj = 0; bj < 2; ++bj) { float v[8];
#pragma unroll
                    for (int j = 0; j < 4; ++j) { v[j] = acc[ai][bj][m][0][j]; v[4 + j] = acc[ai][bj][m][1][j]; }
                    if (bj == 0) { const float a0 = v[0] * cs[0] - v[1] * sn[0], a1 = v[1] * cs[0] + v[0] * sn[0], a2 = v[2] * cs[1] - v[3] * sn[1], a3 = v[3] * cs[1] + v[2] * sn[1];
                      const float a4 = v[4] * cs[2] - v[5] * sn[2], a5 = v[5] * cs[2] + v[4] * sn[2], a6 = v[6] * cs[3] - v[7] * sn[3], a7 = v[7] * cs[3] + v[6] * sn[3];
                      v[0] = a0; v[1] = a1; v[2] = a2; v[3] = a3; v[4] = a4; v[5] = a5; v[6] = a6; v[7] = a7; }
#pragma unroll
                    for (int j = 0; j < 8; ++j) v[j] *= sc;
                    w[bj] = pack8(v); }
                slot_put(slot, fr, fq, w[0], w[1]);
#pragma unroll
                for (int half = 0; half < 2; ++half) { const int row = rowq + ai * 128 + m * 16 + half * 8, b = row >> 12, s2 = row & (SEQ - 1), r = s2 & dmask, n = s2 >> sh;
                    st_nt(base + ((size_t)(b * 24 + head) * SEQ + (size_t)r * NL + n) * 64, slot_get(slot, half, lane)); } }
        } else {
            const int row0 = u.pm * 256 + wr * 64 + fr;
            if (wc == 0 && fq < 2) { float* glr = (float*)(ws + WS_GLR);
#pragma unroll
                EPI_ROWS(ai, m) { float* rowp = glr + (size_t)(row0 + ai * 128 + m * 16) * 16 + 8 * fq; *(f32x4*)rowp = acc[ai][0][m][0]; *(f32x4*)(rowp + 4) = acc[ai][0][m][1]; } }
        }
    }
};

template <int MODE> struct EpiGate {
    static constexpr bool PERM = true, FP8 = false;
    const bf16_t* gate; const bf16_t* t1; bf16_t* out;
    __device__ __forceinline__ void operator()(const f32x4 (&acc)[2][2][4][2], const Unit& u, int wr, int wc, int fr, int fq) const {
        const int lane = fq * 16 + fr; char* slot = epi_slot(wr, wc);
        const size_t off0 = (size_t)(u.pm * 256 + wr * 64 + (lane >> 3)) * 1024 + u.pn * 256 + wc * 64 + (lane & 7) * 8;
#pragma unroll
        for (int ai = 0; ai < 2; ++ai) { u32x4 gw[4][2], tw[4][2];
#pragma unroll
            for (int m = 0; m < 4; ++m)
#pragma unroll
                for (int half = 0; half < 2; ++half) { const size_t off = off0 + (size_t)(ai * 128 + m * 16 + half * 8) * 1024; gw[m][half] = *(const u32x4*)(gate + off); if (MODE == 1) tw[m][half] = *(const u32x4*)(t1 + off); }
#pragma unroll
            for (int m = 0; m < 4; ++m) { u32x4 w[2];
#pragma unroll
                for (int bj = 0; bj < 2; ++bj) { float v[8];
#pragma unroll
                    for (int j = 0; j < 4; ++j) { v[j] = acc[ai][bj][m][0][j]; v[4 + j] = acc[ai][bj][m][1][j]; }
                    w[bj] = pack8(v); }
                slot_put(slot, fr, fq, w[0], w[1]);
#pragma unroll
                for (int half = 0; half < 2; ++half) { float a[8], g[8]; unpack8(slot_get(slot, half, lane), a); unpack8(gw[m][half], g);
#pragma unroll
                    for (int j = 0; j < 8; ++j) a[j] *= g[j];
                    if (MODE == 1) { float t[8]; unpack8(tw[m][half], t);
#pragma unroll
                        for (int j = 0; j < 8; ++j) a[j] += t[j]; }
                    *(u32x4*)(out + off0 + (size_t)(ai * 128 + m * 16 + half * 8) * 1024) = pack8(a); } } }
    }
};

struct EpiResid {
    static constexpr bool PERM = false, FP8 = false;
    const float* x; float* h;
    __device__ __forceinline__ void operator()(const f32x4 (&acc)[2][2][4][2], const Unit& u, int wr, int wc, int fr, int fq) const {
        const int lane = fq * 16 + fr; char* slot = epi_slot(wr, wc);
        const size_t off0 = (size_t)(u.pm * 256 + wr * 64 + (lane >> 3)) * 1024 + u.pn * 256 + wc * 32 + (lane & 7) * 4;
#pragma unroll
        for (int ai = 0; ai < 2; ++ai)
#pragma unroll
            for (int bj = 0; bj < 2; ++bj) { f32x4 xv[4][2];
#pragma unroll
                for (int m = 0; m < 4; ++m)
#pragma unroll
                    for (int half = 0; half < 2; ++half) xv[m][half] = *(const f32x4*)(x + off0 + (size_t)(ai * 128 + m * 16 + half * 8) * 1024 + bj * 128);
#pragma unroll
                for (int m = 0; m < 4; ++m) { slot_put(slot, fr, fq, __builtin_bit_cast(u32x4, acc[ai][bj][m][0]), __builtin_bit_cast(u32x4, acc[ai][bj][m][1]));
#pragma unroll
                    for (int half = 0; half < 2; ++half) { const f32x4 a = __builtin_bit_cast(f32x4, slot_get(slot, half, lane));
                        *(f32x4*)(h + off0 + (size_t)(ai * 128 + m * 16 + half * 8) * 1024 + bj * 128) = a + xv[m][half]; } } }
    }
};

struct EpiAct {
    static constexpr bool PERM = true, FP8 = true;
    const float* bgu; const int* tile_e; unsigned char* act;
    __device__ __forceinline__ void operator()(const f32x4 (&acc)[2][2][4][2], const Unit& u, int wr, int wc, int fr, int fq) const {
        const int e = tile_e[u.pm]; const int row0 = u.pm * 256 + wr * 64 + fr; const int j0 = u.pn * 128 + wc * 32 + 8 * fq;
        float bg[8], bu[8];
        { const float* bp = bgu + (size_t)e * 2048 + 2 * j0;
#pragma unroll
          for (int q = 0; q < 4; ++q) { const f32x4 t = *(const f32x4*)(bp + 4 * q); bg[2 * q] = t[0]; bu[2 * q] = t[1]; bg[2 * q + 1] = t[2]; bu[2 * q + 1] = t[3]; } }
#pragma unroll
        EPI_ROWS(ai, m) { float v[8];
#pragma unroll
            for (int j = 0; j < 8; ++j) { const float gt = acc[ai][0][m][j >> 2][j & 3] + bg[j], up = acc[ai][1][m][j >> 2][j & 3] + bu[j];
                const float g = fminf(gt, 7.0f), uu = fminf(fmaxf(up, -7.0f), 7.0f); v[j] = (uu + 1.0f) * (g * sigmoidf_(1.702f * g)); }
            u32x2 w8; w8.x = (unsigned)pk4_fp8(v[0], v[1], v[2], v[3]); w8.y = (unsigned)pk4_fp8(v[4], v[5], v[6], v[7]);
            __builtin_nontemporal_store(w8, (u32x2*)(act + (size_t)(row0 + ai * 128 + m * 16) * 1024 + j0)); }
    }
};

struct EpiDown {
    static constexpr bool PERM = true, FP8 = true;
    const float* bd; const int* tile_e; bf16_t* y;
    __device__ __forceinline__ void operator()(const f32x4 (&acc)[2][2][4][2], const Unit& u, int wr, int wc, int fr, int fq) const {
        const int e = tile_e[u.pm]; const int lane = fq * 16 + fr; char* slot = epi_slot(wr, wc); const int col0 = u.pn * 256 + wc * 64 + 8 * fq;
        f32x4 b[2][2];
#pragma unroll
        for (int bj = 0; bj < 2; ++bj)
#pragma unroll
            for (int n = 0; n < 2; ++n) b[bj][n] = *(const f32x4*)(bd + (size_t)e * 1024 + col0 + bj * 32 + 4 * n);
        bf16_t* base = y + (size_t)(u.pm * 256 + wr * 64 + (lane >> 3)) * 1024 + u.pn * 256 + wc * 64 + (lane & 7) * 8;
#pragma unroll
        EPI_ROWS(ai, m) { u32x4 w[2];
#pragma unroll
            for (int bj = 0; bj < 2; ++bj) { const f32x4 v0 = acc[ai][bj][m][0] + b[bj][0], v1 = acc[ai][bj][m][1] + b[bj][1];
                w[bj].x = cvt_pk_bf16(v0[0], v0[1]); w[bj].y = cvt_pk_bf16(v0[2], v0[3]); w[bj].z = cvt_pk_bf16(v1[0], v1[1]); w[bj].w = cvt_pk_bf16(v1[2], v1[3]); }
            slot_put(slot, fr, fq, w[0], w[1]);
#pragma unroll
            for (int half = 0; half < 2; ++half) st_nt(base + (size_t)(ai * 128 + m * 16 + half * 8) * 1024, slot_get(slot, half, lane)); }
    }
};

__device__ __forceinline__ int win_colmap(int n) {
    if (n < 3072) return n;
    if (n < 7680) { const int off = n - 3072, which = off / 1536, hcol = off % 1536, head = hcol >> 6, p = hcol & 63;
        int dim = p; if (which < 2 && p < 16) dim = (p & 1) ? (p >> 1) + 8 : (p >> 1);
        return 3088 + which * 1536 + head * 64 + dim; }
    if (n < 9728) return 7696 + (n - 7680);
    if (n < 9744) return 3072 + (n - 9728);
    return -1;
}
__device__ __forceinline__ int gu_colmap(int n) { const int t = n >> 8, w = n & 255, wc = w >> 6, bj = (w >> 5) & 1, rho = w & 31; return 2 * (128 * t + 32 * wc + rho) + bj; }

__device__ __forceinline__ void transpose_tile(const float* src, int ld_src, bf16_t* dst, int K, int n0, int k0, int scol, char* lds) {
    const int t = tid_(), nl = t & 127, kq = t >> 7;
#pragma unroll
    for (int cc = 0; cc < 4; ++cc) { const int c = kq * 4 + cc; float v[8];
#pragma unroll
        for (int j = 0; j < 8; ++j) v[j] = scol >= 0 ? src[(size_t)(k0 + c * 8 + j) * ld_src + scol] : 0.f;
        *(u32x4*)(lds + nl * 256 + ((c ^ (nl & 15)) << 4)) = pack8(v); }
    __syncthreads();
#pragma unroll
    for (int pass = 0; pass < 4; ++pass) { const int idx = t + 512 * pass, n2 = idx >> 4, c2 = idx & 15;
        *(u32x4*)(dst + (size_t)(n0 + n2) * K + k0 + c2 * 8) = *(const u32x4*)(lds + n2 * 256 + ((c2 ^ (n2 & 15)) << 4)); }
    __syncthreads();
}

__device__ __forceinline__ void transpose_tile8(const float* src, int ld_src, unsigned char* dst, int K, int n0, int k0, int scol, float scale, char* lds) {
    const int t = tid_(), nl = t & 127, kq = t >> 7;
#pragma unroll
    for (int cc = 0; cc < 4; ++cc) { const int c = kq * 4 + cc; float v[16];
#pragma unroll
        for (int j = 0; j < 16; ++j) v[j] = src[(size_t)(k0 + c * 16 + j) * ld_src + scol] * scale;
        u32x4 w; w.x = (unsigned)pk4_fp8(v[0], v[1], v[2], v[3]); w.y = (unsigned)pk4_fp8(v[4], v[5], v[6], v[7]); w.z = (unsigned)pk4_fp8(v[8], v[9], v[10], v[11]); w.w = (unsigned)pk4_fp8(v[12], v[13], v[14], v[15]);
        *(u32x4*)(lds + nl * 256 + ((c ^ (nl & 15)) << 4)) = w; }
    __syncthreads();
#pragma unroll
    for (int pass = 0; pass < 4; ++pass) { const int idx = t + 512 * pass, n2 = idx >> 4, c2 = idx & 15;
        *(u32x4*)(dst + (size_t)(n0 + n2) * K + k0 + c2 * 16) = *(const u32x4*)(lds + n2 * 256 + ((c2 ^ (n2 & 15)) << 4)); }
    __syncthreads();
}

__device__ __forceinline__ void phase_prologue(const Params& p, char* lds) {
    unsigned char* ws = opaque(p.ws);
    const int tid = tid_(), lane = tid & 63, wid = tid >> 6, G = gridDim.x, bid = blockIdx.x;
    { bf16_t* xn = (bf16_t*)(ws + WS_XN);
      for (int row = bid * 8 + wid; row < NTOK; row += G * 8) { const float* xr = p.x + (size_t)row * 1024; f32x4 v[4]; float ss = 0.f;
#pragma unroll
          for (int i = 0; i < 4; ++i) { v[i] = *(const f32x4*)(xr + i * 256 + lane * 4); ss += v[i][0] * v[i][0] + v[i][1] * v[i][1] + v[i][2] * v[i][2] + v[i][3] * v[i][3]; }
          ss = wave_sum(ss); const float rs = rsqrtf(ss * (1.0f / 1024.0f) + EPS);
#pragma unroll
          for (int i = 0; i < 4; ++i) { const f32x4 g = *(const f32x4*)(p.norm_mix_g + i * 256 + lane * 4); u32x2 w; w.x = cvt_pk_bf16(v[i][0] * rs * g[0], v[i][1] * rs * g[1]); w.y = cvt_pk_bf16(v[i][2] * rs * g[2], v[i][3] * rs * g[3]);
              *(u32x2*)(xn + (size_t)row * 1024 + i * 256 + lane * 4) = w; } } }
    { float* rc = (float*)(ws + WS_ROPE_C); float* rsn = (float*)(ws + WS_ROPE_S); float* rwg = (float*)(ws + WS_RWG);
      for (int i = bid * 512 + tid; i < SEQ * 8; i += G * 512) { const int s = i >> 3, f = i & 7; const double inv = pow(500000.0, -(double)f * 0.125); const float ang = (float)s * (float)inv; rc[i] = (float)cos((double)ang); rsn[i] = (float)sin((double)ang); }
      for (int i = bid * 512 + tid; i < 1024 * 32; i += G * 512) rwg[i] = p.router_w[i] * p.norm_ffn_g[i >> 5]; }
    { constexpr int T0 = 78 * 8, T1 = T0 + 64, T2 = T1 + 32, T3 = T2 + 64, T4 = T3 + 32 * 64, T5 = T4 + 32 * 32;
      const int nl = tid & 127;
      for (int tile = bid; tile < T5; tile += G) {
          if (tile < T0) { const int nt_ = tile >> 3, kt = tile & 7; transpose_tile(p.w_in, INW, (bf16_t*)(ws + WS_W_IN), 1024, nt_ * 128, kt * 128, win_colmap(nt_ * 128 + nl), lds); }
          else if (tile < T1) { const int q = tile - T0, nt_ = q >> 3, kt = q & 7; transpose_tile(p.w_branch_gla, 1024, (bf16_t*)(ws + WS_W_G), 1024, nt_ * 128, kt * 128, nt_ * 128 + nl, lds); }
          else if (tile < T2) { const int q = tile - T1, nt_ = q >> 2, kt = q & 3; transpose_tile(p.w_branch_att, 1024, (bf16_t*)(ws + WS_W_A), 512, nt_ * 128, kt * 128, nt_ * 128 + nl, lds); }
          else if (tile < T3) { const int q = tile - T2, nt_ = q >> 3, kt = q & 7; transpose_tile(p.w_mix_out, 1024, (bf16_t*)(ws + WS_W_MIX), 1024, nt_ * 128, kt * 128, nt_ * 128 + nl, lds); }
          else if (tile < T4) { const int q = tile - T3, e = q >> 6, r = q & 63, nt_ = r >> 2, kt = r & 3;
              transpose_tile8(p.e_w_gu + (size_t)e * 1024 * 2048, 2048, ws + WS_W_GU + (size_t)e * 2048 * 1024, 1024, nt_ * 128, kt * 256, gu_colmap(nt_ * 128 + nl), 32.0f, lds); }
          else { const int q = tile - T4, e = q >> 5, r = q & 31, nt_ = r >> 2, kt = r & 3;
              transpose_tile8(p.e_w_d + (size_t)e * 1024 * 1024, 1024, ws + WS_W_D + (size_t)e * 1024 * 1024, 1024, nt_ * 128, kt * 256, nt_ * 128 + nl, 32.0f, lds); }
      } }
}

constexpr int AT_KCS = 385 * 16;
constexpr int AT_VH = 385 * 64;
constexpr int AT_K = 0, AT_V = 8 * AT_KCS, AT_WL = AT_V + 2 * AT_VH, AT_STG = AT_WL + 8 * 128, AT_END = AT_STG + 8 * 4096;
static_assert(AT_END <= LDS_BYTES, "attention LDS");
__device__ __forceinline__ void attn_item(const Params& p, int item, char* lds) {
    unsigned char* ws = opaque(p.ws);
    const int tid = tid_(), lane = tid & 63, r32 = lane & 31, hi = lane >> 5; const int w = __builtin_amdgcn_readfirstlane(tid >> 6);
    const int jj = item & 15, bh = item >> 4, head = bh % 24, b = bh / 24, g = head >> 3, sh = 2 * g, d = 1 << sh, NL = SEQ >> sh, ppr = 16 >> sh;
    const int r = jj / ppr, j = jj % ppr;
    const size_t hb = ((size_t)bh * SEQ + (size_t)r * NL) * 64;
    const bf16_t* Q = (const bf16_t*)(ws + WS_AQ) + hb; const bf16_t* Kg = (const bf16_t*)(ws + WS_AK) + hb; const bf16_t* Vg = (const bf16_t*)(ws + WS_AV) + hb;
    const int kn0 = 256 * j - 128;
#pragma unroll
    for (int i = 0; i < 6; ++i) { const int idx = tid + 512 * i, key = idx >> 3, c = idx & 7;
        if (kn0 + key >= 0) { const u32x4 kv = *(const u32x4*)(Kg + (ptrdiff_t)(kn0 + key) * 64 + c * 8); const u32x4 vv = *(const u32x4*)(Vg + (ptrdiff_t)(kn0 + key) * 64 + c * 8);
            *(u32x4*)(lds + AT_K + c * AT_KCS + key * 16) = kv; *(u32x4*)(lds + AT_V + (c >> 2) * AT_VH + key * 64 + (c & 3) * 16) = vv; } }
    bf16x8 qf[4];
#pragma unroll
    for (int d0 = 0; d0 < 4; ++d0) qf[d0] = *(const bf16x8*)(Q + (size_t)(256 * j + 32 * w + r32) * 64 + d0 * 16 + hi * 8);
    __syncthreads();
    const LDS3 char* l3 = (const LDS3 char*)lds;
    f32x16 s[5]; const int ktmin = (j == 0) ? 4 : 0;
#pragma unroll
    for (int t5 = 0; t5 < 5; ++t5) { const int kt = w + t5;
        if (kt >= ktmin) { f32x16 a = {};
#pragma unroll
            for (int d0 = 0; d0 < 4; ++d0) { const bf16x8 kf = *(const LDS3 bf16x8*)(l3 + AT_K + (2 * d0 + hi) * AT_KCS + (kt * 32 + r32) * 16); a = MFMA32(kf, qf[d0], a); }
            s[t5] = a; }
        else {
#pragma unroll
            for (int rr = 0; rr < 16; ++rr) s[t5][rr] = -1e30f; } }
#pragma unroll
    for (int rr = 0; rr < 16; ++rr) { const int c = crow(rr, hi); if (c < r32) s[0][rr] = -1e30f; if (c > r32) s[4][rr] = -1e30f; }
    float mx = -1e30f;
#pragma unroll
    for (int t5 = 0; t5 < 5; ++t5)
#pragma unroll
        for (int rr = 0; rr < 16; ++rr) mx = fmaxf(mx, s[t5][rr]);
    mx = fmaxf(mx, __shfl_xor(mx, 32));
    float l = 0.f;
#pragma unroll
    for (int t5 = 0; t5 < 5; ++t5)
#pragma unroll
        for (int rr = 0; rr < 16; ++rr) { const float e = __builtin_amdgcn_exp2f(s[t5][rr] - mx); s[t5][rr] = e; l += e; }
    l += __shfl_xor(l, 32);
    f32x16 o[2]; o[0] = f32x16{}; o[1] = f32x16{};
    const int blk = (lane >> 4) & 1, q4 = (lane & 15) >> 2, p4 = lane & 3;
#pragma unroll
    for (int t5 = 0; t5 < 5; ++t5) { const int kt = w + t5;
        if (kt >= ktmin) {
#pragma unroll
            for (int ss = 0; ss < 2; ++ss) { float pv[8];
#pragma unroll
                for (int q = 0; q < 8; ++q) pv[q] = s[t5][8 * ss + q];
                const bf16x8 pa = __builtin_bit_cast(bf16x8, pack8(pv));
#pragma unroll
                for (int dh = 0; dh < 2; ++dh) { const LDS3 char* vp = l3 + AT_V + dh * AT_VH + (kt * 32 + 16 * ss + 4 * hi + q4) * 64 + (16 * blk + 4 * p4) * 2;
                    const bf16x8 vf = cat8(tr16(vp), tr16(vp + 8 * 64)); o[dh] = MFMA32(pa, vf, o[dh]); } } } }
    const int n_q = 256 * j + 32 * w + r32; const int tok = b * SEQ + n_q * d + r;
    if (hi == 0) { ((float*)(ws + WS_LSE))[((size_t)g * NTOK + tok) * 8 + (head & 7)] = (mx + __builtin_amdgcn_logf(l)) * LN2;
        ((float*)(lds + AT_WL))[w * 32 + r32] = __builtin_amdgcn_rcpf(l); }
    bf16_t* stg = (bf16_t*)(lds + AT_STG) + w * 2048;
#pragma unroll
    for (int rr = 0; rr < 16; ++rr) { const int qr = crow(rr, hi); const float rl = ((const float*)(lds + AT_WL))[w * 32 + qr];
#pragma unroll
        for (int dh = 0; dh < 2; ++dh) stg[qr * 64 + dh * 32 + r32] = (bf16_t)(cvt_pk_bf16(o[dh][rr] * rl, 0.f) & 0xffffu); }
    bf16_t* og = (bf16_t*)(ws + WS_OATT) + (size_t)g * NTOK * 512;
#pragma unroll
    for (int i = 0; i < 4; ++i) { const int idx = i * 64 + lane, row = idx >> 3, ch = idx & 7; const int tk = b * SEQ + (256 * j + 32 * w + row) * d + r;
        *(u32x4*)(og + (size_t)tk * 512 + (head & 7) * 64 + ch * 8) = *(const u32x4*)(stg + row * 64 + ch * 8); }
    __syncthreads();
}

constexpr int G1_BB = 0;
constexpr int G1_QE = G1_BB + 64 * 128 * 4;
constexpr int G1_KE = G1_QE + 64 * 272;
constexpr int G1_KD = G1_KE + 64 * 272;
constexpr int G1_V = G1_KD + 64 * 320;
constexpr int G1_GLR = G1_V + 64 * 576;
constexpr int G1_GUP = G1_GLR + 64 * 16 * 4;
constexpr int G1_SEG = G1_GUP + 16 * 128 * 4;
constexpr int G1_BIAS = G1_SEG + 4 * 128 * 4;
constexpr int G1_END = G1_BIAS + 128 * 4;
static_assert(G1_END <= LDS_BYTES, "gla1 LDS");
__device__ __forceinline__ float logsigmoidf_(float z) { return fminf(z, 0.f) - log1pf(__expf(-fabsf(z))); }
__device__ __forceinline__ void gla1_item(const Params& p, int item, char* lds) {
    unsigned char* ws = opaque(p.ws);
    const int tid = tid_(), lane = tid & 63, r32 = lane & 31, hi = lane >> 5; const int w = __builtin_amdgcn_readfirstlane(tid >> 6);
    const int n = item & 63, bh = item >> 6, h = bh & 3, b = bh >> 2; const int tok0 = b * SEQ + n * 64;
    float* BB = (float*)(lds + G1_BB); float* GLRs = (float*)(lds + G1_GLR); float* GUP = (float*)(lds + G1_GUP); float* SEGs = (float*)(lds + G1_SEG); float* BIAS = (float*)(lds + G1_BIAS);
    for (int i = tid; i < 64 * 16; i += 512) GLRs[i] = ((const float*)(ws + WS_GLR))[(size_t)tok0 * 16 + i];
    for (int i = tid; i < 16 * 128; i += 512) GUP[i] = p.gla_gate_up[(i >> 7) * 512 + h * 128 + (i & 127)];
    if (tid < 128) BIAS[tid] = p.gla_gate_bias[h * 128 + tid];
    __syncthreads();
    { const int d = tid & 127, seg = tid >> 7; float gu[16];
#pragma unroll
      for (int r = 0; r < 16; ++r) gu[r] = GUP[r * 128 + d];
      const float bias = BIAS[d]; float run = 0.f;
#pragma unroll 4
      for (int ii = 0; ii < 16; ++ii) { const int i = seg * 16 + ii; float z = bias;
#pragma unroll
          for (int r4 = 0; r4 < 4; ++r4) { const f32x4 gl = *(const f32x4*)(GLRs + i * 16 + r4 * 4); z += gl[0] * gu[r4 * 4] + gl[1] * gu[r4 * 4 + 1] + gl[2] * gu[r4 * 4 + 2] + gl[3] * gu[r4 * 4 + 3]; }
          run += logsigmoidf_(z) * (1.0f / 16.0f); BB[i * 128 + d] = run; }
      SEGs[seg * 128 + d] = run;
      __syncthreads();
      float off = 0.f; for (int s2 = 0; s2 < seg; ++s2) off += SEGs[s2 * 128 + d];
      if (seg > 0) { for (int ii = 0; ii < 16; ++ii) BB[(seg * 16 + ii) * 128 + d] += off; }
      __syncthreads(); }
    { const bf16_t* gq = (const bf16_t*)(ws + WS_GQ); const bf16_t* gk = (const bf16_t*)(ws + WS_GK); const bf16_t* gv = (const bf16_t*)(ws + WS_GV); bf16_t* qeg = (bf16_t*)(ws + WS_QE);
#pragma unroll
      for (int pp = 0; pp < 2; ++pp) { const int idx = tid + 512 * pp, i = idx >> 4, c = idx & 15, d0 = c * 8; const size_t go = (size_t)(tok0 + i) * 512 + h * 128 + d0;
          float q[8], k[8], qe[8], ke[8], kd[8]; unpack8(*(const u32x4*)(gq + go), q); unpack8(*(const u32x4*)(gk + go), k);
#pragma unroll
          for (int j = 0; j < 8; ++j) { const float bb = BB[i * 128 + d0 + j], bl = BB[63 * 128 + d0 + j]; qe[j] = q[j] * __expf(bb) * 0.08838834764831845f; ke[j] = k[j] * __expf(-bb); kd[j] = k[j] * __expf(bl - bb); }
          const u32x4 qw = pack8(qe); *(u32x4*)(lds + G1_QE + i * 272 + c * 16) = qw; *(u32x4*)(qeg + go) = qw;
          *(u32x4*)(lds + G1_KE + i * 272 + c * 16) = pack8(ke); *(u32x4*)(lds + G1_KD + i * 320 + c * 16) = pack8(kd); }
#pragma unroll
      for (int pp = 0; pp < 4; ++pp) { const int idx = tid + 512 * pp, jv = idx >> 5, c = idx & 31; *(u32x4*)(lds + G1_V + jv * 576 + c * 16) = *(const u32x4*)(gv + (size_t)(tok0 + jv) * 1024 + h * 256 + c * 8); }
      if (tid < 128) ((float*)(ws + WS_DEC))[(size_t)item * 128 + tid] = __expf(BB[63 * 128 + tid]);
      __syncthreads(); }
    const LDS3 char* l3 = (const LDS3 char*)lds; const int blk = (lane >> 4) & 1, q4 = (lane & 15) >> 2, p4 = lane & 3;
    {
      const int it = w & 1, vq = w >> 1; f32x16 oi[2]; oi[0] = f32x16{}; oi[1] = f32x16{};
#pragma unroll
      for (int jt = 0; jt < 2; ++jt) { if (jt <= it) { f32x16 x = {};
#pragma unroll
          for (int s = 0; s < 8; ++s) { const bf16x8 a = *(const LDS3 bf16x8*)(l3 + G1_KE + (jt * 32 + r32) * 272 + (16 * s + 8 * hi) * 2), bq = *(const LDS3 bf16x8*)(l3 + G1_QE + (it * 32 + r32) * 272 + (16 * s + 8 * hi) * 2); x = MFMA32(a, bq, x); }
          if (jt == it) {
#pragma unroll
              for (int rr = 0; rr < 16; ++rr) if (crow(rr, hi) > r32) x[rr] = 0.f; }
#pragma unroll
          for (int ss = 0; ss < 2; ++ss) { float xv[8];
#pragma unroll
              for (int q = 0; q < 8; ++q) xv[q] = x[8 * ss + q];
              const bf16x8 xa = __builtin_bit_cast(bf16x8, pack8(xv));
#pragma unroll
              for (int vi = 0; vi < 2; ++vi) { const int vt = 2 * vq + vi; const LDS3 char* vp = l3 + G1_V + (jt * 32 + 16 * ss + 4 * hi + q4) * 576 + (vt * 32 + 16 * blk + 4 * p4) * 2;
                  const bf16x8 vf = cat8(tr16(vp), tr16(vp + 8 * 576)); oi[vi] = MFMA32(xa, vf, oi[vi]); } } } }
      float* og = (float*)(ws + WS_OINTRA);
#pragma unroll
      for (int vi = 0; vi < 2; ++vi)
#pragma unroll
          for (int rr = 0; rr < 16; ++rr) og[(size_t)(tok0 + it * 32 + crow(rr, hi)) * 1024 + h * 256 + (2 * vq + vi) * 32 + r32] = oi[vi][rr]; }
    {
      const int dt = w & 3, vg = w >> 2; f32x16 uu[4]; uu[0] = f32x16{}; uu[1] = f32x16{}; uu[2] = f32x16{}; uu[3] = f32x16{};
#pragma unroll
      for (int ks = 0; ks < 4; ++ks) { const LDS3 char* ap = l3 + G1_KD + (16 * ks + 8 * hi + q4) * 320 + (dt * 32 + 16 * blk + 4 * p4) * 2; const bf16x8 a = cat8(tr16(ap), tr16(ap + 4 * 320));
#pragma unroll
          for (int vi = 0; vi < 4; ++vi) { const int vt = 4 * vg + vi; const LDS3 char* vp = l3 + G1_V + (16 * ks + 8 * hi + q4) * 576 + (vt * 32 + 16 * blk + 4 * p4) * 2; const bf16x8 vf = cat8(tr16(vp), tr16(vp + 4 * 576)); uu[vi] = MFMA32(a, vf, uu[vi]); } }
      bf16_t* ug = (bf16_t*)(ws + WS_U) + (size_t)item * 128 * 256;
#pragma unroll
      for (int vi = 0; vi < 4; ++vi)
#pragma unroll
          for (int rr = 0; rr < 16; ++rr) ug[(size_t)(dt * 32 + crow(rr, hi)) * 256 + (4 * vg + vi) * 32 + r32] = (bf16_t)(cvt_pk_bf16(uu[vi][rr], 0.f) & 0xffffu); }
    __syncthreads();
}

__device__ __forceinline__ void phase_scan_combine(const Params& p) {
    unsigned char* ws = opaque(p.ws); const int G = gridDim.x;
    { const bf16_t* U = (const bf16_t*)(ws + WS_U); bf16_t* PV = (bf16_t*)(ws + WS_PREV); const float* DEC = (const float*)(ws + WS_DEC);
      for (int idx = blockIdx.x * 512 + tid_(); idx < 16 * 128 * 64; idx += G * 512) { const int bh = idx >> 13, rem = idx & 8191, d = rem >> 6, vq = rem & 63;
          float st[4] = {0.f, 0.f, 0.f, 0.f}; const size_t e0 = ((size_t)bh * 64 * 128 + d) * 256 + vq * 4;
#pragma unroll 8
          for (int n = 0; n < 64; ++n) { const size_t e = e0 + (size_t)n * 128 * 256; const u32x2 uw = *(const u32x2*)(U + e); const float dc = DEC[(size_t)(bh * 64 + n) * 128 + d];
              u32x2 pw; pw.x = cvt_pk_bf16(st[0], st[1]); pw.y = cvt_pk_bf16(st[2], st[3]); *(u32x2*)(PV + e) = pw;
              st[0] = dc * st[0] + bf_lo(uw.x); st[1] = dc * st[1] + bf_hi(uw.x); st[2] = dc * st[2] + bf_lo(uw.y); st[3] = dc * st[3] + bf_hi(uw.y); } } }
    { const bf16_t* OG = (const bf16_t*)(ws + WS_OATT); const float* LSE = (const float*)(ws + WS_LSE); bf16_t* YA = (bf16_t*)(ws + WS_YATT);
      for (int idx = blockIdx.x * 512 + tid_(); idx < NTOK * 64; idx += G * 512) { const int tok = idx >> 6, jc = idx & 63, jh = jc >> 3;
          const float l0 = LSE[(size_t)tok * 8 + jh], l1 = LSE[((size_t)NTOK + tok) * 8 + jh], l2 = LSE[((size_t)2 * NTOK + tok) * 8 + jh];
          const float m = fmaxf(l0, fmaxf(l1, l2)); float a0 = __expf(l0 - m), a1 = __expf(l1 - m), a2 = __expf(l2 - m); const float inv = __builtin_amdgcn_rcpf(a0 + a1 + a2); a0 *= inv; a1 *= inv; a2 *= inv;
          float o0[8], o1[8], o2[8], y[8]; const size_t off = (size_t)tok * 512 + jc * 8;
          unpack8(*(const u32x4*)(OG + off), o0); unpack8(*(const u32x4*)(OG + (size_t)NTOK * 512 + off), o1); unpack8(*(const u32x4*)(OG + (size_t)2 * NTOK * 512 + off), o2);
#pragma unroll
          for (int q = 0; q < 8; ++q) y[q] = a0 * o0[q] + a1 * o1[q] + a2 * o2[q];
          *(u32x4*)(YA + off) = pack8(y); } }
}

constexpr int G3_PREV = 0;
constexpr int G3_SS = G3_PREV + 128 * 576;
constexpr int G3_END = G3_SS + 8 * 32 * 4;
static_assert(G3_END <= LDS_BYTES, "gla3 LDS");
__device__ __forceinline__ void gla3_item(const Params& p, int item, char* lds) {
    unsigned char* ws = opaque(p.ws);
    const int tid = tid_(), lane = tid & 63, r32 = lane & 31, hi = lane >> 5; const int w = __builtin_amdgcn_readfirstlane(tid >> 6);
    const int n = item & 63, bh = item >> 6, h = bh & 3, b = bh >> 2; const int tok0 = b * SEQ + n * 64;
    const bf16_t* PV = (const bf16_t*)(ws + WS_PREV) + (size_t)item * 128 * 256;
#pragma unroll
    for (int pp = 0; pp < 8; ++pp) { const int idx = tid + 512 * pp, d = idx >> 5, c = idx & 31; *(u32x4*)(lds + G3_PREV + d * 576 + c * 16) = *(const u32x4*)(PV + (size_t)d * 256 + c * 8); }
    const int it = w & 1, vq = w >> 1; const bf16_t* qeg = (const bf16_t*)(ws + WS_QE) + (size_t)(tok0 + it * 32 + r32) * 512 + h * 128;
    bf16x8 qa[8];
#pragma unroll
    for (int s = 0; s < 8; ++s) qa[s] = *(const bf16x8*)(qeg + 16 * s + 8 * hi);
    __syncthreads();
    const LDS3 char* l3 = (const LDS3 char*)lds; const int blk = (lane >> 4) & 1, q4 = (lane & 15) >> 2, p4 = lane & 3;
    f32x16 o[2]; const float* oig = (const float*)(ws + WS_OINTRA);
#pragma unroll
    for (int vi = 0; vi < 2; ++vi)
#pragma unroll
        for (int rr = 0; rr < 16; ++rr) o[vi][rr] = oig[(size_t)(tok0 + it * 32 + crow(rr, hi)) * 1024 + h * 256 + (2 * vq + vi) * 32 + r32];
#pragma unroll
    for (int s = 0; s < 8; ++s)
#pragma unroll
        for (int vi = 0; vi < 2; ++vi) { const int vt = 2 * vq + vi; const LDS3 char* pp_ = l3 + G3_PREV + (16 * s + 8 * hi + q4) * 576 + (vt * 32 + 16 * blk + 4 * p4) * 2; const bf16x8 pf = cat8(tr16(pp_), tr16(pp_ + 4 * 576)); o[vi] = MFMA32(qa[s], pf, o[vi]); }
    float* SS = (float*)(lds + G3_SS);
#pragma unroll
    for (int rr = 0; rr < 16; ++rr) { float q = o[0][rr] * o[0][rr] + o[1][rr] * o[1][rr]; q += __shfl_xor(q, 16); q += __shfl_xor(q, 8); q += __shfl_xor(q, 4); q += __shfl_xor(q, 2); q += __shfl_xor(q, 1);
        if (r32 == 0) SS[w * 32 + crow(rr, hi)] = q; }
    __syncthreads();
    const bf16_t* grg = (const bf16_t*)(ws + WS_GR); bf16_t* yg = (bf16_t*)(ws + WS_YGLA);
    float ng[2]; ng[0] = p.gla_norm_g[(2 * vq) * 32 + r32]; ng[1] = p.gla_norm_g[(2 * vq + 1) * 32 + r32];
#pragma unroll
    for (int rr = 0; rr < 16; ++rr) { const int row = crow(rr, hi); const float tot = SS[(it + 0) * 32 + row] + SS[(it + 2) * 32 + row] + SS[(it + 4) * 32 + row] + SS[(it + 6) * 32 + row];
        const float rs = rsqrtf(tot * (1.0f / 256.0f) + EPS); const size_t ro = (size_t)(tok0 + it * 32 + row) * 1024 + h * 256;
#pragma unroll
        for (int vi = 0; vi < 2; ++vi) { const int col = (2 * vq + vi) * 32 + r32; const float y = o[vi][rr] * rs * ng[vi] * bf2f(grg[ro + col]); yg[ro + col] = (bf16_t)(cvt_pk_bf16(y, 0.f) & 0xffffu); } }
    __syncthreads();
}

constexpr int RT_RSTD = 0;
constexpr int RT_LOG = 256;
constexpr int RT_CNT = RT_LOG + 64 * 32 * 4;
__device__ __forceinline__ void route_group(const Params& p, int grp, char* lds) {
    unsigned char* ws = opaque(p.ws); const int tid = tid_(), lane = tid & 63; const int w = __builtin_amdgcn_readfirstlane(tid >> 6);
    const float* H = (const float*)(ws + WS_H); const float* RWG = (const float*)(ws + WS_RWG);
    float* RSTD = (float*)(lds + RT_RSTD); float* LOGS = (float*)(lds + RT_LOG); int* LCNT = (int*)(lds + RT_CNT);
    const int tok0 = grp * 64;
    if (tid < 32) LCNT[tid] = 0;
    if (w < 4) { const int tl = lane & 15, kq = lane >> 4; const float* hr = H + (size_t)(tok0 + w * 16 + tl) * 1024 + kq * 256; const float* br = RWG + (size_t)(kq * 256) * 32 + tl;
        f32x4 a0 = {0.f, 0.f, 0.f, 0.f}, a1 = {0.f, 0.f, 0.f, 0.f}; float ss = 0.f;
#pragma unroll 4
        for (int m4 = 0; m4 < 64; ++m4) { const f32x4 hv = *(const f32x4*)(hr + m4 * 4);
#pragma unroll
            for (int q = 0; q < 4; ++q) { const float b0 = br[(size_t)(m4 * 4 + q) * 32], b1 = br[(size_t)(m4 * 4 + q) * 32 + 16];
                a0 = __builtin_amdgcn_mfma_f32_16x16x4f32(hv[q], b0, a0, 0, 0, 0); a1 = __builtin_amdgcn_mfma_f32_16x16x4f32(hv[q], b1, a1, 0, 0, 0); ss += hv[q] * hv[q]; } }
        ss += __shfl_xor(ss, 16); ss += __shfl_xor(ss, 32);
        const float rs = rsqrtf(ss * (1.0f / 1024.0f) + EPS);
        if (kq == 0) RSTD[w * 16 + tl] = rs;
#pragma unroll
        for (int rg = 0; rg < 4; ++rg) { const int t = w * 16 + 4 * kq + rg; LOGS[t * 32 + tl] = a0[rg]; LOGS[t * 32 + 16 + tl] = a1[rg]; } }
    __syncthreads();
    if (tid < 64) { const int tok = tok0 + tid; const float rs = RSTD[tid]; float lg[32];
#pragma unroll
        for (int e = 0; e < 32; ++e) lg[e] = LOGS[tid * 32 + e] * rs + p.router_b[e];
        int be[4]; float bv[4];
#pragma unroll
        for (int k = 0; k < 4; ++k) { float best = -3.0e38f; int bi = 0;
#pragma unroll
            for (int e = 0; e < 32; ++e) { const bool tk = lg[e] > best; best = tk ? lg[e] : best; bi = tk ? e : bi; }
            be[k] = bi; bv[k] = best;
#pragma unroll
            for (int e = 0; e < 32; ++e) lg[e] = (e == bi) ? -3.0e38f : lg[e]; }
        const float e1 = __expf(bv[1] - bv[0]), e2 = __expf(bv[2] - bv[0]), e3 = __expf(bv[3] - bv[0]); const float inv = 1.0f / (1.0f + e1 + e2 + e3);
        const float gt[4] = {inv, e1 * inv, e2 * inv, e3 * inv};
#pragma unroll
        for (int k = 0; k < 4; ++k) { const int pos = atomicAdd(&LCNT[be[k]], 1);
            ((int*)(ws + WS_TOPE))[tok * 4 + k] = be[k]; ((float*)(ws + WS_TOPG))[tok * 4 + k] = gt[k]; ((int*)(ws + WS_TOPP))[tok * 4 + k] = pos; } }
    { unsigned char* HN = ws + WS_HN;
#pragma unroll 2
      for (int i = 0; i < 8; ++i) { const int idx = tid + 512 * i, t = idx >> 6, c = idx & 63; const float rs = RSTD[t]; const size_t off = (size_t)(tok0 + t) * 1024 + c * 16; u32x4 wv;
#pragma unroll
          for (int q = 0; q < 4; ++q) { const f32x4 h0 = *(const f32x4*)(H + off + 4 * q), g0 = *(const f32x4*)(p.norm_ffn_g + c * 16 + 4 * q); wv[q] = (unsigned)pk4_fp8(h0[0] * rs * g0[0], h0[1] * rs * g0[1], h0[2] * rs * g0[2], h0[3] * rs * g0[3]); }
          *(u32x4*)(HN + off) = wv; } }
    __syncthreads();
    if (tid < 32) ((int*)(ws + WS_CNT))[grp * 32 + tid] = LCNT[tid];
    __syncthreads();
}

constexpr int DP_TOT = 0;
constexpr int DP_PART = 512;
__device__ __forceinline__ void dispatch_tables(const Params& p, int grp, char* lds) {
    unsigned char* ws = opaque(p.ws); const int tid = tid_(); const int* CNT = (const int*)(ws + WS_CNT); int* T = (int*)(lds + DP_TOT); int* PART = (int*)(lds + DP_PART);
    { const int e = tid & 31, part = tid >> 5; int tot = 0, pre = 0;
      for (int g2 = part * 16; g2 < part * 16 + 16; ++g2) { const int c = CNT[g2 * 32 + e]; tot += c; if (g2 < grp) pre += c; }
      PART[part * 32 + e] = tot; PART[512 + part * 32 + e] = pre; }
    __syncthreads();
    if (tid < 32) { int tot = 0, pre = 0; for (int q = 0; q < 16; ++q) { tot += PART[q * 32 + tid]; pre += PART[512 + q * 32 + tid]; } T[tid] = tot; T[64 + tid] = pre; }
    __syncthreads();
    if (tid == 0) { int base = 0; for (int e = 0; e < 32; ++e) { T[32 + e] = base; base += (T[e] + 255) >> 8; } T[96] = base; }
    __syncthreads();
}
__device__ __forceinline__ void dispatch_group(const Params& p, int grp, char* lds) {
    unsigned char* ws = opaque(p.ws); const int tid = tid_();
    dispatch_tables(p, grp, lds);
    const int* T = (const int*)(lds + DP_TOT); int* DEST = (int*)(lds + DP_PART + 4096);
    if (tid < 256) { const int tok = grp * 64 + (tid >> 2); const int e = ((const int*)(ws + WS_TOPE))[tok * 4 + (tid & 3)], lp = ((const int*)(ws + WS_TOPP))[tok * 4 + (tid & 3)];
        const int dest = T[32 + e] * 256 + T[64 + e] + lp; DEST[tid] = dest; ((int*)(ws + WS_SLOT))[tok * 4 + (tid & 3)] = dest; }
    __syncthreads();
    const unsigned char* HN = ws + WS_HN; unsigned char* XP = ws + WS_XPAD;
#pragma unroll 4
    for (int i = 0; i < 32; ++i) { const int idx = tid + 512 * i, pr = idx >> 6, c = idx & 63; const int tok = grp * 64 + (pr >> 2);
        *(u32x4*)(XP + (size_t)DEST[pr] * 1024 + c * 16) = *(const u32x4*)(HN + (size_t)tok * 1024 + c * 16); }
    __syncthreads();
}

__device__ __forceinline__ void phase_combine(const Params& p) {
    unsigned char* ws = opaque(p.ws); const int tid = tid_(), lane = tid & 63, wid = tid >> 6, G = gridDim.x;
    const float* H = (const float*)(ws + WS_H); const bf16_t* YP = (const bf16_t*)(ws + WS_YPAD);
    for (int tok = blockIdx.x * 8 + wid; tok < NTOK; tok += G * 8) {
        int sl[4]; float gt[4];
#pragma unroll
        for (int k = 0; k < 4; ++k) { sl[k] = ((const int*)(ws + WS_SLOT))[tok * 4 + k]; gt[k] = ((const float*)(ws + WS_TOPG))[tok * 4 + k]; }
        f32x4 v[4]; float ss = 0.f;
#pragma unroll
        for (int i = 0; i < 4; ++i) { const int col = i * 256 + lane * 4; v[i] = *(const f32x4*)(H + (size_t)tok * 1024 + col);
#pragma unroll
            for (int k = 0; k < 4; ++k) { const u32x2 yw = *(const u32x2*)(YP + (size_t)sl[k] * 1024 + col); v[i][0] += gt[k] * bf_lo(yw.x); v[i][1] += gt[k] * bf_hi(yw.x); v[i][2] += gt[k] * bf_lo(yw.y); v[i][3] += gt[k] * bf_hi(yw.y); }
            ss += v[i][0] * v[i][0] + v[i][1] * v[i][1] + v[i][2] * v[i][2] + v[i][3] * v[i][3]; }
        ss = wave_sum(ss); const float rs = rsqrtf(ss * (1.0f / 1024.0f) + EPS);
#pragma unroll
        for (int i = 0; i < 4; ++i) { const int col = i * 256 + lane * 4; const f32x4 g = *(const f32x4*)(p.norm_final_g + col); f32x4 o; o[0] = v[i][0] * rs * g[0]; o[1] = v[i][1] * rs * g[1]; o[2] = v[i][2] * rs * g[2]; o[3] = v[i][3] * rs * g[3];
            *(f32x4*)(p.out + (size_t)tok * 1024 + col) = o; } }
}


#define XB_TMO      128
#define XB_XCNT(j)  (256  + 64 * (j))
#define XB_XSUB(j)  (1280 + 64 * (j))
#define XB_XGEN(j)  (2304 + 64 * (j))
#define XB_TOP      3328
#define XB_TOPGEN   3392
#define XCD_BAR_WORDS 3456
#define XB_SPIN_CAP (1u << 18)
__device__ __forceinline__ unsigned xb_ld(unsigned* p)              { return __hip_atomic_load(p, __ATOMIC_RELAXED, __HIP_MEMORY_SCOPE_AGENT); }
__device__ __forceinline__ unsigned xb_add(unsigned* p, unsigned v) { return __hip_atomic_fetch_add(p, v, __ATOMIC_RELAXED, __HIP_MEMORY_SCOPE_AGENT); }
__device__ __forceinline__ unsigned xb_xcc_id() { return (unsigned)__builtin_amdgcn_s_getreg((3 << 11) | 20) & 0xFu; }
#define XB_SPIN(cond, bar) do { unsigned _sp = 0; while (cond) { __builtin_amdgcn_s_sleep(1); \
    if ((++_sp & 255u) == 0u) { if (xb_ld(&(bar)[XB_TMO])) break; if (_sp > XB_SPIN_CAP) { atomicAdd(&(bar)[XB_TMO], 1u); break; } } } } while (0)
struct XcdBarrier { unsigned* bar; unsigned x; volatile LDS3 unsigned* st; };
__device__ __forceinline__ XcdBarrier xcd_barrier_post(unsigned* bar, volatile LDS3 unsigned* st) {
    XcdBarrier b; b.bar = bar; b.x = xb_xcc_id(); b.st = st;
    if (tid_() == 0) (void)xb_add(&bar[XB_XCNT(b.x)], 1u);
    return b;
}
__device__ __forceinline__ void xcd_barrier_complete(unsigned* bar, unsigned x, unsigned& nloc, unsigned& nx) {
    const unsigned G = gridDim.x * gridDim.y * gridDim.z;
    unsigned sum, cnt, mine, sp = 0u;
    for (;;) {
        sum = 0u; cnt = 0u; mine = 0u;
#pragma unroll
        for (unsigned j = 0; j < 16; ++j) { const unsigned c = xb_ld(&bar[XB_XCNT(j)]); sum += c; cnt += (c > 0u) ? 1u : 0u; mine = (j == x) ? c : mine; }
        if (sum == G) break;
        __builtin_amdgcn_s_sleep(1);
        if ((++sp & 255u) == 0u) { if (xb_ld(&bar[XB_TMO])) break; if (sp > XB_SPIN_CAP) { atomicAdd(&bar[XB_TMO], 1u); break; } }
    }
    nloc = mine > 0u ? mine : 1u; nx = cnt > 0u ? cnt : 1u;
}
__device__ __forceinline__ void xcd_barrier(const XcdBarrier& b) {
    asm volatile("s_waitcnt vmcnt(0)" ::: "memory");
    __syncthreads();
    if (tid_() == 0) {
        unsigned* bar = b.bar;
        __builtin_amdgcn_s_waitcnt(0);
        unsigned nloc = b.st[0], nx = b.st[1];
        if (nloc == 0u) { xcd_barrier_complete(bar, b.x, nloc, nx); b.st[0] = nloc; b.st[1] = nx; }
        const unsigned old = xb_add(&bar[XB_XSUB(b.x)], 1u);
        const unsigned gen = old / nloc;
        if (old + 1u == (gen + 1u) * nloc) {
            __builtin_amdgcn_fence(__ATOMIC_RELEASE, "agent");
            asm volatile("s_waitcnt vmcnt(0)" ::: "memory");
            const unsigned og = xb_add(&bar[XB_TOP], 1u);
            const unsigned tg = og / nx;
            if (og + 1u == (tg + 1u) * nx) xb_add(&bar[XB_TOPGEN], 1u);
            else XB_SPIN(xb_ld(&bar[XB_TOPGEN]) == tg, bar);
            __builtin_amdgcn_fence(__ATOMIC_ACQUIRE, "agent");
            xb_add(&bar[XB_XGEN(b.x)], 1u);
            asm volatile("s_waitcnt vmcnt(0)" ::: "memory");
        } else {
            XB_SPIN(xb_ld(&bar[XB_XGEN(b.x)]) == gen, bar);
            __builtin_amdgcn_fence(__ATOMIC_ACQUIRE, "agent");
            asm volatile("s_waitcnt vmcnt(0)" ::: "memory");
        }
    }
    __syncthreads();
}

__global__ void __launch_bounds__(512, 2) mega_fwd(Params p) {
    cg::grid_group grid = cg::this_grid();
    char* lds = smem; LDS3 unsigned char* lds3 = (LDS3 unsigned char*)smem;
    const int G = gridDim.x, bid = blockIdx.x;
    if (tid_() < 4) ((volatile LDS3 unsigned*)(lds3 + LDS_XB))[tid_()] = 0u;
    __syncthreads();
    const XcdBarrier xb = xcd_barrier_post((unsigned*)(p.ws + WS_BAR), (volatile LDS3 unsigned*)(lds3 + LDS_XB));
    for (int rep = 0; rep < REP_P0; ++rep) phase_prologue(p, lds);
    if (p.ws == nullptr) grid.sync();
    xcd_barrier(xb);
    for (int rep = 0; rep < REP_P1; ++rep) { unsigned char* ws = opaque(p.ws); pg8::DenseProb S; S.init(ws + WS_XN, ws + WS_W_IN, NTOK, INWP, 1024, G, bid);
      EpiProj E; E.ws = ws;
      pg8::gemm_phase(lds3, S, E); }
    xcd_barrier(xb);
    for (int rep = 0; rep < REP_ATT; ++rep) for (int item = bid; item < 4 * 24 * 16; item += G) attn_item(p, item, lds);
    for (int rep = 0; rep < REP_GLA1; ++rep) for (int item = bid; item < 1024; item += G) gla1_item(p, item, lds);
    xcd_barrier(xb);
    for (int rep = 0; rep < REP_P3; ++rep) phase_scan_combine(p);
    xcd_barrier(xb);
    for (int rep = 0; rep < REP_P4; ++rep) for (int item = bid; item < 1024; item += G) gla3_item(p, item, lds);
    xcd_barrier(xb);
    for (int rep = 0; rep < REP_P5; ++rep) {
    { unsigned char* ws = opaque(p.ws); pg8::DenseProb S; S.init(ws + WS_YATT, ws + WS_W_A, NTOK, 1024, 512, G, bid);
      EpiGate<0> E; E.gate = (const bf16_t*)(ws + WS_SA); E.t1 = nullptr; E.out = (bf16_t*)(ws + WS_T1);
      pg8::gemm_phase(lds3, S, E); }
    { unsigned char* ws = opaque(p.ws); pg8::DenseProb S; S.init(ws + WS_YGLA, ws + WS_W_G, NTOK, 1024, 1024, G, bid);
      EpiGate<1> E; E.gate = (const bf16_t*)(ws + WS_SG); E.t1 = (const bf16_t*)(ws + WS_T1); E.out = (bf16_t*)(ws + WS_MERGED);
      pg8::gemm_phase(lds3, S, E); }
    }
    xcd_barrier(xb);
    for (int rep = 0; rep < REP_P6; ++rep) { unsigned char* ws = opaque(p.ws); pg8::DenseProb S; S.init(ws + WS_MERGED, ws + WS_W_MIX, NTOK, 1024, 1024, G, bid);
      EpiResid E; E.x = p.x; E.h = (float*)(ws + WS_H);
      pg8::gemm_phase(lds3, S, E); }
    xcd_barrier(xb);
    for (int rep = 0; rep < REP_P7; ++rep) for (int grp = bid; grp < 256; grp += G) route_group(p, grp, lds);
    xcd_barrier(xb);
    for (int rep = 0; rep < REP_P8; ++rep) for (int grp = bid; grp < 256; grp += G) dispatch_group(p, grp, lds);
    if (bid == 0) { unsigned char* ws = opaque(p.ws); dispatch_tables(p, -1, lds); const int* T = (const int*)(lds + DP_TOT); int* TE = (int*)(ws + WS_TILEE);
        if (tid_() < 32) { const int e = tid_(); for (int t = T[32 + e]; t < T[32 + e] + ((T[e] + 255) >> 8); ++t) TE[16 + t] = e; }
        if (tid_() == 0) TE[0] = T[96]; }
    xcd_barrier(xb);
    for (int rep = 0; rep < REP_P9; ++rep) { unsigned char* ws = opaque(p.ws); const int* TE = (const int*)(ws + WS_TILEE);
      pg8::MoeProb S; S.A = (const char*)(ws + WS_XPAD); S.Bt = (const char*)(ws + WS_W_GU); S.K = 512  ; S.nN = 8; S.T = TE[0]; S.G = G; S.c = bid; S.estride = (size_t)2048 * 1024; S.tile_e = TE + 16;
      EpiAct E; E.bgu = p.e_b_gu; E.tile_e = TE + 16; E.act = ws + WS_ACT;
      pg8::gemm_phase(lds3, S, E); }
    xcd_barrier(xb);
    for (int rep = 0; rep < REP_P10; ++rep) { unsigned char* ws = opaque(p.ws); const int* TE = (const int*)(ws + WS_TILEE);
      pg8::MoeProb S; S.A = (const char*)(ws + WS_ACT); S.Bt = (const char*)(ws + WS_W_D); S.K = 512  ; S.nN = 4; S.T = TE[0]; S.G = G; S.c = bid; S.estride = (size_t)1024 * 1024; S.tile_e = TE + 16;
      EpiDown E; E.bd = p.e_b_d; E.tile_e = TE + 16; E.y = (bf16_t*)(ws + WS_YPAD);
      pg8::gemm_phase(lds3, S, E); }
    xcd_barrier(xb);
    for (int rep = 0; rep < REP_P11; ++rep) phase_combine(p);
}

extern "C" void kernel_launch(void* const* d_in, const int* in_sizes, int n_in, void* d_out, int out_size, void* d_ws, size_t ws_size, hipStream_t stream) {
    static int grid = 0;
    if (grid == 0) {
        if (n_in != 17 || ws_size < WS_END) { fprintf(stderr, "kernel_launch: expected 17 inputs and >= %zu bytes of workspace (got %d, %zu); nothing launched\n", (size_t)WS_END, n_in, ws_size); grid = -1; return; }
        int dev = 0, cus = 0, per_cu = 0;
        if (hipGetDevice(&dev) != hipSuccess || hipDeviceGetAttribute(&cus, hipDeviceAttributeMultiprocessorCount, dev) != hipSuccess) { fprintf(stderr, "kernel_launch: device query failed\n"); grid = -1; return; }
        if (hipFuncSetAttribute((const void*)mega_fwd, hipFuncAttributeMaxDynamicSharedMemorySize, LDS_BYTES) != hipSuccess) { fprintf(stderr, "kernel_launch: hipFuncSetAttribute failed\n"); grid = -1; return; }
        if (hipOccupancyMaxActiveBlocksPerMultiprocessor(&per_cu, (const void*)mega_fwd, 512, LDS_BYTES) != hipSuccess || per_cu < 1) { fprintf(stderr, "kernel_launch: occupancy query failed (%d)\n", per_cu); grid = -1; return; }
        grid = cus;
    }
    if (grid < 0) return;
    Params p{};
    p.x = (const float*)d_in[0]; p.norm_mix_g = (const float*)d_in[1]; p.w_in = (const float*)d_in[2]; p.gla_gate_up = (const float*)d_in[3]; p.gla_gate_bias = (const float*)d_in[4]; p.gla_norm_g = (const float*)d_in[5];
    p.w_branch_gla = (const float*)d_in[6]; p.w_branch_att = (const float*)d_in[7]; p.w_mix_out = (const float*)d_in[8]; p.norm_ffn_g = (const float*)d_in[9]; p.router_w = (const float*)d_in[10]; p.router_b = (const float*)d_in[11];
    p.e_w_gu = (const float*)d_in[12]; p.e_b_gu = (const float*)d_in[13]; p.e_w_d = (const float*)d_in[14]; p.e_b_d = (const float*)d_in[15]; p.norm_final_g = (const float*)d_in[16];
    p.out = (float*)d_out; p.ws = (unsigned char*)d_ws;
    if (hipMemsetAsync((char*)d_ws + WS_BAR, 0, 3456 * 4, stream) != hipSuccess) { fprintf(stderr, "kernel_launch: memset of the barrier words failed\n"); return; }
    void* args[] = {&p};
    hipError_t e = hipLaunchCooperativeKernel((const void*)mega_fwd, dim3(grid), dim3(512), args, LDS_BYTES, stream);
    if (e != hipSuccess) fprintf(stderr, "kernel_launch: cooperative launch failed: %s (grid %d)\n", hipGetErrorString(e), grid);
}
```

```cpp
#include <hip/hip_runtime.h>
#include <hip/hip_cooperative_groups.h>
#include <cstdio>
#include <cstdint>
namespace cg = cooperative_groups;
#ifndef REP_P0
#define REP_P0 1
#define REP_P1 1
#define REP_ATT 1
#define REP_GLA1 1
#define REP_P3 1
#define REP_P4 1
#define REP_P5 1
#define REP_P6 1
#define REP_P7 1
#define REP_P8 1
#define REP_P9 1
#define REP_P10 1
#define REP_P11 1
#endif

#define LDS3 __attribute__((address_space(3)))
typedef unsigned short bf16_t;
typedef short bf16x8 __attribute__((ext_vector_type(8)));
typedef short s16x4 __attribute__((ext_vector_type(4)));
typedef short v4i16_t __attribute__((ext_vector_type(4)));
typedef float f32x4 __attribute__((ext_vector_type(4)));
typedef float f32x2 __attribute__((ext_vector_type(2)));
typedef float f32x16 __attribute__((ext_vector_type(16)));
typedef unsigned u32x4 __attribute__((ext_vector_type(4)));
typedef unsigned u32x2 __attribute__((ext_vector_type(2)));
typedef int i32x8 __attribute__((ext_vector_type(8)));
typedef int i32x4 __attribute__((ext_vector_type(4)));

constexpr int NTOK = 16384, DM = 1024, SEQ = 4096, NB = 4;
constexpr int INW = 9744, INWP = 9984;
constexpr int NEXP = 32, TOPK = 4, FF = 1024;
constexpr int MAXT = 288;
constexpr float EPS = 1e-5f;
constexpr float QSCALE = 0.125f * 1.4426950408889634f;
constexpr float LN2 = 0.6931471805599453f;

constexpr size_t al256(size_t x) { return (x + 255) & ~(size_t)255; }
constexpr size_t WS_W_IN = 0;
constexpr size_t WS_W_G = WS_W_IN + (size_t)INWP * 1024 * 2;
constexpr size_t WS_W_A = WS_W_G + (size_t)1024 * 1024 * 2;
constexpr size_t WS_W_MIX = WS_W_A + (size_t)1024 * 512 * 2;
constexpr size_t WS_W_GU = WS_W_MIX + (size_t)1024 * 1024 * 2;
constexpr size_t WS_W_D = WS_W_GU + (size_t)NEXP * 2048 * 1024;
constexpr size_t WS_ROPE_C = WS_W_D + (size_t)NEXP * 1024 * 1024;
constexpr size_t WS_ROPE_S = WS_ROPE_C + (size_t)SEQ * 8 * 4;
constexpr size_t WS_RWG = WS_ROPE_S + (size_t)SEQ * 8 * 4;
constexpr size_t WS_H = WS_RWG + (size_t)1024 * 32 * 4;
constexpr size_t WS_HN = WS_H + (size_t)NTOK * 1024 * 4;
constexpr size_t WS_TOPE = WS_HN + (size_t)NTOK * 1024;
constexpr size_t WS_TOPG = WS_TOPE + (size_t)NTOK * 4 * 4;
constexpr size_t WS_TOPP = WS_TOPG + (size_t)NTOK * 4 * 4;
constexpr size_t WS_SLOT = WS_TOPP + (size_t)NTOK * 4 * 4;
constexpr size_t WS_CNT = WS_SLOT + (size_t)NTOK * 4 * 4;
constexpr size_t WS_TILEE = WS_CNT + (size_t)256 * 32 * 4;
constexpr size_t WS_REGB = al256(WS_TILEE + (size_t)(MAXT + 32) * 4);
constexpr size_t WS_XN = WS_REGB;
constexpr size_t WS_GQ = WS_XN + (size_t)NTOK * 1024 * 2;
constexpr size_t WS_GK = WS_GQ + (size_t)NTOK * 512 * 2;
constexpr size_t WS_GV = WS_GK + (size_t)NTOK * 512 * 2;
constexpr size_t WS_GR = WS_GV + (size_t)NTOK * 1024 * 2;
constexpr size_t WS_SG = WS_GR + (size_t)NTOK * 1024 * 2;
constexpr size_t WS_SA = WS_SG + (size_t)NTOK * 1024 * 2;
constexpr size_t WS_AQ = WS_SA + (size_t)NTOK * 1024 * 2;
constexpr size_t WS_AK = WS_AQ + (size_t)NTOK * 1536 * 2;
constexpr size_t WS_AV = WS_AK + (size_t)NTOK * 1536 * 2;
constexpr size_t WS_GLR = WS_AV + (size_t)NTOK * 1536 * 2;
constexpr size_t WS_OATT = WS_GLR + (size_t)NTOK * 16 * 4;
constexpr size_t WS_LSE = WS_OATT + (size_t)3 * NTOK * 512 * 2;
constexpr size_t WS_QE = WS_LSE + (size_t)3 * NTOK * 8 * 4;
constexpr size_t WS_OINTRA = WS_QE + (size_t)NTOK * 512 * 2;
constexpr size_t WS_U = WS_OINTRA + (size_t)NTOK * 1024 * 2;
constexpr size_t WS_DEC = WS_U + (size_t)1024 * 128 * 256 * 2;
constexpr size_t WS_REGB_END = WS_DEC + (size_t)1024 * 128 * 4;
constexpr size_t WS_PREV = WS_AQ;
constexpr size_t WS_YGLA = WS_AV;
constexpr size_t WS_YATT = WS_XN;
constexpr size_t WS_T1 = WS_GQ;
constexpr size_t WS_MERGED = WS_GV;
constexpr size_t PADROWS = (size_t)MAXT * 256;
constexpr size_t WS_XPAD = WS_REGB;
constexpr size_t WS_ACT = WS_XPAD + PADROWS * 1024;
constexpr size_t WS_YPAD = WS_ACT + PADROWS * 1024;
constexpr size_t WS_PAD_END = WS_YPAD + PADROWS * 1024 * 2;
constexpr size_t WS_BAR = al256(WS_REGB_END > WS_PAD_END ? WS_REGB_END : WS_PAD_END);
constexpr size_t WS_END = WS_BAR + 3456 * 4;
static_assert(WS_PAD_END <= WS_REGB_END + (1u << 30), "map");

constexpr int LDS_XB = 147456;
constexpr int LDS_BYTES = 147456 + 16;

struct Params {
    const float *x, *norm_mix_g, *w_in, *gla_gate_up, *gla_gate_bias, *gla_norm_g, *w_branch_gla, *w_branch_att, *w_mix_out, *norm_ffn_g,
        *router_w, *router_b, *e_w_gu, *e_b_gu, *e_w_d, *e_b_d, *norm_final_g;
    float* out;
    unsigned char* ws;
};

__device__ __forceinline__ int tid_() { int t = threadIdx.x; asm volatile("" : "+v"(t)); return t; }
__device__ __forceinline__ unsigned char* opaque(unsigned char* q) { return q; }
__device__ __forceinline__ unsigned cvt_pk_bf16(float lo, float hi) { unsigned r; asm volatile("v_cvt_pk_bf16_f32 %0, %1, %2" : "=v"(r) : "v"(lo), "v"(hi)); return r; }
__device__ __forceinline__ float bf_lo(unsigned w) { return __uint_as_float(w << 16); }
__device__ __forceinline__ float bf_hi(unsigned w) { return __uint_as_float(w & 0xffff0000u); }
__device__ __forceinline__ float bf2f(bf16_t b) { return __uint_as_float(((unsigned)b) << 16); }
__device__ __forceinline__ u32x4 pack8(const float* v) { u32x4 w; w.x = cvt_pk_bf16(v[0], v[1]); w.y = cvt_pk_bf16(v[2], v[3]); w.z = cvt_pk_bf16(v[4], v[5]); w.w = cvt_pk_bf16(v[6], v[7]); return w; }
__device__ __forceinline__ void unpack8(u32x4 w, float* v) { v[0] = bf_lo(w.x); v[1] = bf_hi(w.x); v[2] = bf_lo(w.y); v[3] = bf_hi(w.y); v[4] = bf_lo(w.z); v[5] = bf_hi(w.z); v[6] = bf_lo(w.w); v[7] = bf_hi(w.w); }
__device__ __forceinline__ float sigmoidf_(float v) { return __builtin_amdgcn_rcpf(1.0f + __builtin_amdgcn_exp2f(v * -1.4426950408889634f)); }
__device__ __forceinline__ float wave_sum(float v) { v += __shfl_xor(v, 32); v += __shfl_xor(v, 16); v += __shfl_xor(v, 8); v += __shfl_xor(v, 4); v += __shfl_xor(v, 2); v += __shfl_xor(v, 1); return v; }
__device__ __forceinline__ s16x4 tr16(const LDS3 char* p) { return __builtin_bit_cast(s16x4, __builtin_amdgcn_ds_read_tr16_b64_v4i16((LDS3 v4i16_t*)p)); }
__device__ __forceinline__ bf16x8 cat8(s16x4 a, s16x4 b) { return (bf16x8){a[0], a[1], a[2], a[3], b[0], b[1], b[2], b[3]}; }
__device__ __forceinline__ int crow(int r, int hi) { return (r & 3) + 8 * (r >> 2) + 4 * hi; }
__device__ __forceinline__ void st_nt(void* p, u32x4 v) { __builtin_nontemporal_store(v, (u32x4*)p); }
__device__ __forceinline__ int pk4_fp8(float a, float b, float c, float d) { int w = __builtin_amdgcn_cvt_pk_fp8_f32(a, b, 0, false); return __builtin_amdgcn_cvt_pk_fp8_f32(c, d, w, true); }
#define MFMA32(a, b, c) __builtin_amdgcn_mfma_f32_32x32x16_bf16(a, b, c, 0, 0, 0)

namespace pg8 {
constexpr int BM = 256, BK = 64, HALF = 128, HTB = HALF * BK * 2, STAGE_BYTES = 8 * HTB, NXCD = 8, WGM = 8;
constexpr bool GEMM_ALIGN_EPI = true;
constexpr bool GEMM_SP2 = true;
__host__ __device__ __forceinline__ int lds_byte(int r, int c) { const int st = (r >> 4) * 2 + (c >> 5), rr = r & 15, cc = c & 31, ob = rr * 64 + cc * 2; return st * 1024 + (ob ^ (((ob >> 9) & 1) << 5)); }
__host__ __device__ __forceinline__ void stage_rc(int b, int& R, int& C) { const int st = b / 1024, sb = b % 1024, swz = sb ^ (((sb >> 9) & 1) << 5); R = (st >> 1) * 16 + swz / 64; C = (st & 1) * 32 + (swz % 64) / 2; }
__host__ __device__ __forceinline__ int perm32(int rho) { const int n = rho >> 4, i = rho & 15; return 8 * (i >> 2) + 4 * n + (i & 3); }
struct Unit { int pm, pn; };

struct DenseProb {
    const char* A; const char* Bt; int K; int nM, nN, nwg, G, c;
    __device__ void init(const void* A_, const void* Bt_, int M, int N, int K_, int G_, int c_) { A = (const char*)A_; Bt = (const char*)Bt_; K = K_; nM = M / BM; nN = N / BM; nwg = nM * nN; G = G_; c = c_; }
    __device__ __forceinline__ bool next(int i, Unit& u) const {
        const long L = (long)i * G + c; if (L >= nwg) return false;
        int wgid = (int)L; { const int q = nwg / NXCD, r = nwg % NXCD, xcd = wgid % NXCD, off = wgid / NXCD; wgid = (xcd < r ? xcd * (q + 1) : r * (q + 1) + (xcd - r) * q) + off; }
        const int nig = WGM * nN, gid = wgid / nig, fm = gid * WGM, gsz = (nM - fm) < WGM ? (nM - fm) : WGM;
        u.pm = fm + ((wgid % nig) % gsz); u.pn = (wgid % nig) / gsz; return true;
    }
    __device__ __forceinline__ const char* a_ptr(const Unit& u) const { return A + (size_t)u.pm * BM * K * 2; }
    __device__ __forceinline__ const char* b_ptr(const Unit& u) const { return Bt + (size_t)u.pn * BM * K * 2; }
};
struct MoeProb {
    const char* A; const char* Bt; int K; int nN, T, G, c; size_t estride; const int* tile_e;
    __device__ __forceinline__ bool next(int i, Unit& u) const { const long L = (long)i * G + c; if (L >= (long)T * nN) return false; u.pm = (int)(L / nN); u.pn = (int)(L % nN); return true; }
    __device__ __forceinline__ const char* a_ptr(const Unit& u) const { return A + (size_t)u.pm * BM * K * 2; }
    __device__ __forceinline__ const char* b_ptr(const Unit& u) const { return Bt + (size_t)tile_e[u.pm] * estride + (size_t)u.pn * BM * K * 2; }
};

template <class Epi, class Prob>
__device__ __forceinline__ void gemm_phase(LDS3 unsigned char* lds, const Prob& S, const Epi& E) {
    const int tid = tid_(), wid = __builtin_amdgcn_readfirstlane(tid >> 6), lane = tid & 63, wr = wid >> 2, wc = wid & 3, fr = lane & 15, fq = lane >> 4;
    const int K = S.K, nt = K / BK;
    unsigned voffA[2], voffB[2];
#pragma unroll
    for (int i = 0; i < 2; ++i) { int R, C; stage_rc(tid * 16 + i * 8192, R, C); const int Rb = Epi::PERM ? (2 * (R & ~31) + perm32(R & 31)) : R;
        voffA[i] = (unsigned)(R * K + C) * 2u; voffB[i] = (unsigned)(Rb * K + C) * 2u; }
    const size_t kstep = (size_t)(BK * 2);
    const size_t hstep = (size_t)HALF * K * 2;
    const size_t hstepB = Epi::PERM ? (size_t)32 * K * 2 : hstep;
    const unsigned ldsw = (unsigned)wid * 1024u;
    const int aoff = lds_byte(wr * 64 + fr, fq * 8), boff = lds_byte(wc * 32 + fr, fq * 8);
#define PG8_SA(b, h) (((b) * 2 + (h)) * HTB)
#define PG8_SB(b, h) ((4 + (b) * 2 + (h)) * HTB)
#define PG8_STAGE(bufoff, gbase, voff) do { _Pragma("unroll") for (int _i = 0; _i < 2; ++_i) \
        __builtin_amdgcn_global_load_lds((const unsigned*)((const char*)(gbase) + (voff)[_i]), (LDS3 unsigned*)(lds + (bufoff) + ldsw + _i * 8192), 16, 0, 0); } while (0)
#define PG8_LD8(ptr) __builtin_shufflevector(*(const LDS3 i32x4*)(ptr), *(const LDS3 i32x4*)((ptr) + 1024), 0, 1, 2, 3, 4, 5, 6, 7)
#define PG8_LO(x) __builtin_bit_cast(bf16x8, __builtin_shufflevector(x, x, 0, 1, 2, 3))
#define PG8_HI(x) __builtin_bit_cast(bf16x8, __builtin_shufflevector(x, x, 4, 5, 6, 7))
#define PG8_LDA(dst, b, h) do { _Pragma("unroll") for (int m = 0; m < 4; ++m) dst[m] = PG8_LD8(lds + PG8_SA(b, h) + aoff + m * 2048); } while (0)
#define PG8_LDB(dst, b, h) do { _Pragma("unroll") for (int n = 0; n < 2; ++n) dst[n] = PG8_LD8(lds + PG8_SB(b, h) + boff + n * 2048); } while (0)
#define PG8_MMA(ai, bj, At, Bt) do { __builtin_amdgcn_s_setprio(1); _Pragma("unroll") for (int m = 0; m < 4; ++m) _Pragma("unroll") for (int n = 0; n < 2; ++n) { \
        if constexpr (Epi::FP8) asm volatile("v_mfma_scale_f32_16x16x128_f8f6f4 %0, %1, %2, %0, %3, %4 op_sel_hi:[0,0,0]" : "+v"(acc[ai][bj][m][n]) : "v"(Bt[n]), "v"(At[m]), "v"(sc_w), "v"(sc_1)); \
        else { acc[ai][bj][m][n] = __builtin_amdgcn_mfma_f32_16x16x32_bf16(PG8_LO(Bt[n]), PG8_LO(At[m]), acc[ai][bj][m][n], 0, 0, 0); acc[ai][bj][m][n] = __builtin_amdgcn_mfma_f32_16x16x32_bf16(PG8_HI(Bt[n]), PG8_HI(At[m]), acc[ai][bj][m][n], 0, 0, 0); } } __builtin_amdgcn_s_setprio(0); } while (0)
#define PG8_WAIT_V(n) asm volatile("s_waitcnt vmcnt(" #n ")" ::: "memory")
#define PG8_WAIT_L(n) asm volatile("s_waitcnt lgkmcnt(" #n ")" ::: "memory")
#define PG8_BAR __builtin_amdgcn_s_barrier()
#define PG8_SCHED __builtin_amdgcn_sched_barrier(0)
    Unit cur, nxt; int ui = 0;
    if (!S.next(0, cur)) return;
    f32x4 acc[2][2][4][2];
#pragma unroll
    for (int a = 0; a < 2; ++a)
#pragma unroll
        for (int b = 0; b < 2; ++b)
#pragma unroll
            for (int m = 0; m < 4; ++m)
#pragma unroll
                for (int n = 0; n < 2; ++n) acc[a][b][m][n] = (f32x4){0.f, 0.f, 0.f, 0.f};
    i32x8 At[4], B0[2], B1[2];
    int sc_w = 0x7A7A7A7A  , sc_1 = 0x7F7F7F7F; asm volatile("" : "+v"(sc_w), "+v"(sc_1));
    const char* cA = S.a_ptr(cur); const char* cB = S.b_ptr(cur);
    if constexpr (GEMM_SP2) {
        PG8_STAGE(PG8_SB(0, 0), cB, voffB); PG8_STAGE(PG8_SB(0, 1), cB + hstepB, voffB); PG8_STAGE(PG8_SA(0, 0), cA, voffA); PG8_STAGE(PG8_SA(0, 1), cA + hstep, voffA);
        if (wr == 1) PG8_BAR;
        PG8_WAIT_V(2); PG8_BAR;
        PG8_STAGE(PG8_SB(1, 0), cB + kstep, voffB); PG8_STAGE(PG8_SA(1, 0), cA + kstep, voffA); PG8_STAGE(PG8_SB(1, 1), cB + hstepB + kstep, voffB);
        PG8_WAIT_V(6); PG8_BAR;
    } else {
    PG8_STAGE(PG8_SB(0, 0), cB, voffB); PG8_STAGE(PG8_SA(0, 0), cA, voffA); PG8_STAGE(PG8_SB(0, 1), cB + hstepB, voffB); PG8_STAGE(PG8_SA(0, 1), cA + hstep, voffA);
    if (wr == 1) PG8_BAR;
    PG8_WAIT_V(4); PG8_BAR;
    PG8_STAGE(PG8_SB(1, 0), cB + kstep, voffB); PG8_STAGE(PG8_SA(1, 0), cA + kstep, voffA); PG8_STAGE(PG8_SB(1, 1), cB + hstepB + kstep, voffB);
    PG8_WAIT_V(6); PG8_BAR;
    }
    for (;;) {
        const bool has_next = S.next(ui + 1, nxt);
        const char* nA = has_next ? S.a_ptr(nxt) : cA; const char* nB = has_next ? S.b_ptr(nxt) : cB;
        for (int t = 0; t < nt; t += 2) {
            const bool last = (t == nt - 2);
            const char* a1 = cA + (size_t)(t + 1) * kstep;
            const char* a2 = last ? nA : cA + (size_t)(t + 2) * kstep; const char* b2 = last ? nB : cB + (size_t)(t + 2) * kstep;
            const char* a3 = a2 + kstep; const char* b3 = b2 + kstep;
            if constexpr (GEMM_SP2) {
            PG8_LDB(B0, 0, 0); PG8_LDB(B1, 0, 1); PG8_SCHED; PG8_LDA(At, 0, 0); PG8_STAGE(PG8_SA(1, 1), a1 + hstep, voffA);
            PG8_WAIT_V(8); PG8_WAIT_L(0); PG8_BAR; PG8_MMA(0, 0, At, B0); PG8_MMA(0, 1, At, B1); PG8_BAR; PG8_SCHED;
            PG8_LDA(At, 0, 1); PG8_STAGE(PG8_SB(0, 0), b2, voffB); PG8_STAGE(PG8_SB(0, 1), b2 + hstepB, voffB); PG8_STAGE(PG8_SA(0, 0), a2, voffA);
            PG8_WAIT_V(8); PG8_WAIT_L(0); PG8_BAR; PG8_MMA(1, 0, At, B0); PG8_MMA(1, 1, At, B1); PG8_BAR; PG8_SCHED;
            PG8_LDB(B0, 1, 0); PG8_LDB(B1, 1, 1); PG8_SCHED; PG8_LDA(At, 1, 0); PG8_STAGE(PG8_SA(0, 1), a2 + hstep, voffA);
            PG8_WAIT_V(8); PG8_WAIT_L(0); PG8_BAR; PG8_MMA(0, 0, At, B0); PG8_MMA(0, 1, At, B1); PG8_BAR; PG8_SCHED;
            PG8_LDA(At, 1, 1); PG8_STAGE(PG8_SB(1, 0), b3, voffB); PG8_STAGE(PG8_SB(1, 1), b3 + hstepB, voffB); PG8_STAGE(PG8_SA(1, 0), a3, voffA);
            PG8_WAIT_V(8); PG8_WAIT_L(0); PG8_BAR; PG8_MMA(1, 0, At, B0); PG8_MMA(1, 1, At, B1); PG8_BAR; PG8_SCHED;
            } else {
            PG8_LDB(B0, 0, 0); PG8_SCHED; PG8_LDA(At, 0, 0); PG8_STAGE(PG8_SA(1, 1), a1 + hstep, voffA);
            PG8_WAIT_L(8); PG8_BAR; PG8_WAIT_L(0); PG8_MMA(0, 0, At, B0); PG8_BAR; PG8_SCHED;
            PG8_LDB(B1, 0, 1); PG8_STAGE(PG8_SB(0, 0), b2, voffB);
            PG8_BAR; PG8_WAIT_L(0); PG8_MMA(0, 1, At, B1); PG8_BAR;
            PG8_LDA(At, 0, 1); PG8_STAGE(PG8_SA(0, 0), a2, voffA);
            PG8_BAR; PG8_WAIT_L(0); PG8_MMA(1, 0, At, B0); PG8_BAR; PG8_SCHED;
            PG8_STAGE(PG8_SB(0, 1), b2 + hstepB, voffB);
            PG8_WAIT_V(6); PG8_BAR; PG8_MMA(1, 1, At, B1); PG8_BAR;
            PG8_LDB(B0, 1, 0); PG8_SCHED; PG8_LDA(At, 1, 0); PG8_STAGE(PG8_SA(0, 1), a2 + hstep, voffA);
            PG8_WAIT_L(8); PG8_BAR; PG8_WAIT_L(0); PG8_MMA(0, 0, At, B0); PG8_BAR; PG8_SCHED;
            PG8_LDB(B1, 1, 1); PG8_STAGE(PG8_SB(1, 0), b3, voffB);
            PG8_BAR; PG8_WAIT_L(0); PG8_MMA(0, 1, At, B1); PG8_BAR;
            PG8_LDA(At, 1, 1); PG8_STAGE(PG8_SA(1, 0), a3, voffA);
            PG8_BAR; PG8_WAIT_L(0); PG8_MMA(1, 0, At, B0); PG8_BAR; PG8_SCHED;
            PG8_STAGE(PG8_SB(1, 1), b3 + hstepB, voffB);
            PG8_WAIT_V(6); PG8_BAR; PG8_MMA(1, 1, At, B1); PG8_BAR;
            }
        }
        if constexpr (GEMM_ALIGN_EPI) { if (wr == 0) PG8_BAR; }
        if constexpr (Epi::FP8) asm volatile("s_nop 15\n\ts_nop 15" ::: "memory");
        E(acc, cur, wr, wc, fr, fq);
        if (!has_next) break;
#pragma unroll
        for (int a = 0; a < 2; ++a)
#pragma unroll
            for (int b = 0; b < 2; ++b)
#pragma unroll
                for (int m = 0; m < 4; ++m)
#pragma unroll
                    for (int n = 0; n < 2; ++n) acc[a][b][m][n] = (f32x4){0.f, 0.f, 0.f, 0.f};
        if constexpr (Epi::FP8) asm volatile("s_nop 7" ::: "memory");
        cur = nxt; cA = nA; cB = nB; ++ui;
        if constexpr (GEMM_ALIGN_EPI) { if (wr == 1) PG8_BAR; }
    }
    PG8_WAIT_V(0);
    if constexpr (!GEMM_ALIGN_EPI) { if (wr == 0) PG8_BAR; }
    PG8_BAR;
#undef PG8_SA
#undef PG8_SB
#undef PG8_STAGE
#undef PG8_LDA
#undef PG8_LDB
#undef PG8_MMA
#undef PG8_LD8
#undef PG8_LO
#undef PG8_HI
#undef PG8_WAIT_V
#undef PG8_WAIT_L
#undef PG8_BAR
#undef PG8_SCHED
}
}
using pg8::Unit;

extern __shared__ __attribute__((aligned(16))) char smem[];
__device__ __forceinline__ char* smem_base() { return smem; }

constexpr int EPI_LDS = 131072;
__device__ __forceinline__ char* epi_slot(int wr, int wc) { return smem_base() + EPI_LDS + (wr * 4 + wc) * 2048; }
__device__ __forceinline__ void slot_put(char* slot, int fr, int fq, u32x4 w0, u32x4 w1) {
    *(u32x4*)(slot + fr * 128 + (((fq) ^ (fr & 7)) << 4)) = w0; *(u32x4*)(slot + fr * 128 + (((4 + fq) ^ (fr & 7)) << 4)) = w1; }
__device__ __forceinline__ u32x4 slot_get(const char* slot, int half, int lane) { const int row = half * 8 + (lane >> 3), ch = lane & 7; return *(const u32x4*)(slot + row * 128 + ((ch ^ (row & 7)) << 4)); }

#define EPI_ROWS(ai, m) for (int ai = 0; ai < 2; ++ai) _Pragma("unroll") for (int m = 0; m < 4; ++m)

struct EpiProj {
    static constexpr bool PERM = true, FP8 = false;
    unsigned char* ws;
    __device__ __forceinline__ void operator()(const f32x4 (&acc)[2][2][4][2], const Unit& u, int wr, int wc, int fr, int fq) const {
        const int pn = u.pn; const int lane = fq * 16 + fr; char* slot = epi_slot(wr, wc);
        const int rowq = u.pm * 256 + wr * 64 + (lane >> 3);
        if (pn < 12 || (pn >= 30 && pn < 38)) {
            size_t boff; int ld, col0, act;
            if (pn < 2) { boff = WS_GQ; ld = 512; col0 = pn * 256; act = 0; }
            else if (pn < 4) { boff = WS_GK; ld = 512; col0 = (pn - 2) * 256; act = 0; }
            else if (pn < 8) { boff = WS_GV; ld = 1024; col0 = (pn - 4) * 256; act = 0; }
            else if (pn < 12) { boff = WS_GR; ld = 1024; col0 = (pn - 8) * 256; act = 1; }
            else if (pn < 34) { boff = WS_SG; ld = 1024; col0 = (pn - 30) * 256; act = 2; }
            else { boff = WS_SA; ld = 1024; col0 = (pn - 34) * 256; act = 2; }
            bf16_t* base = (bf16_t*)(ws + boff) + col0 + wc * 64 + (lane & 7) * 8;
#pragma unroll
            EPI_ROWS(ai, m) { u32x4 w[2];
#pragma unroll
                for (int bj = 0; bj < 2; ++bj) { float v[8];
#pragma unroll
                    for (int j = 0; j < 4; ++j) { v[j] = acc[ai][bj][m][0][j]; v[4 + j] = acc[ai][bj][m][1][j]; }
                    if (act == 1) {
#pragma unroll
                        for (int j = 0; j < 8; ++j) v[j] = v[j] * sigmoidf_(v[j]); }
                    if (act == 2) {
#pragma unroll
                        for (int j = 0; j < 8; ++j) v[j] = sigmoidf_(v[j]); }
                    w[bj] = pack8(v); }
                slot_put(slot, fr, fq, w[0], w[1]);
#pragma unroll
                for (int half = 0; half < 2; ++half) st_nt(base + (size_t)(rowq + ai * 128 + m * 16 + half * 8) * ld, slot_get(slot, half, lane)); }
        } else if (pn < 30) {
            const int which = (pn - 12) / 6, t6 = (pn - 12) % 6, sh = (t6 >> 1) * 2, dmask = (1 << sh) - 1, NL = SEQ >> sh;
            bf16_t* base = (bf16_t*)(ws + WS_AQ + (size_t)which * ((size_t)NTOK * 1536 * 2)) + (lane & 7) * 8;
            const bool rot = (which < 2) && (fq < 2);
            f32x4 frev;
#pragma unroll
            for (int q = 0; q < 4; ++q) frev[q] = rot ? __builtin_amdgcn_exp2f(-(float)(4 * fq + q) * (0.125f * 18.931568569324174f)) * 0.15915494309189535f : 0.f;
            const float sc = which == 0 ? QSCALE : 1.0f;
            const int head = t6 * 4 + wc;
#pragma unroll
            EPI_ROWS(ai, m) { const int s = (u.pm * 256 + wr * 64 + fr + ai * 128 + m * 16) & (SEQ - 1);
                f32x4 cs, sn;
#pragma unroll
                for (int q = 0; q < 4; ++q) { const float rev = __builtin_amdgcn_fractf((float)s * frev[q]); cs[q] = __builtin_amdgcn_cosf(rev); sn[q] = __builtin_amdgcn_sinf(rev); }
                u32x4 w[2];
#pragma unroll
                for (int bj = 0; bj < 2; ++bj) { float v[8];
#pragma unroll
                    for (int j = 0; j < 4; ++j) { v[j] = acc[ai][bj][m][0][j]; v[4 + j] = acc[ai][bj][m][1][j]; }
                    if (bj == 0) { const float a0 = v[0] * cs[0] - v[1] * sn[0], a1 = v[1] * cs[0] + v[0] * sn[0], a2 = v[2] * cs[1] - v[3] * sn[1], a3 = v[3] * cs[1] + v[2] * sn[1];
                      const float a4 = v[4] * cs[2] - v[5] * sn[2], a5 = v[5] * cs[2] + v[4] * sn[2], a6 = v[6] * cs[3] - v[7] * sn[3], a7 = v[7] * cs[3] + v[6] * sn[3];
                      v[0] = a0; v[1] = a1; v[2] = a2; v[3] = a3; v[4] = a4; v[5] = a5; v[6] = a6; v[7] = a7; }
#pragma unroll
                    for (int j = 0; j < 8; ++j) v[j] *= sc;
                    w[bj] = pack8(v); }
                slot_put(slot, fr, fq, w[0], w[1]);
#pragma unroll
                for (int half = 0; half < 2; ++half) { const int row = rowq + ai * 128 + m * 16 + half * 8, b = row >> 12, s2 = row & (SEQ - 1), r = s2 & dmask, n = s2 >> sh;
                    st_nt(base + ((size_t)(b * 24 + head) * SEQ + (size_t)r * NL + n) * 64, slot_get(slot, half, lane)); } }
        } else {
            const int row0 = u.pm * 256 + wr * 64 + fr;
            if (wc == 0 && fq < 2) { float* glr = (float*)(ws + WS_GLR);
#pragma unroll
                EPI_ROWS(ai, m) { float* rowp = glr + (size_t)(row0 + ai * 128 + m * 16) * 16 + 8 * fq; *(f32x4*)rowp = acc[ai][0][m][0]; *(f32x4*)(rowp + 4) = acc[ai][0][m][1]; } }
        }
    }
};

template <int MODE> struct EpiGate {
    static constexpr bool PERM = true, FP8 = false;
    const bf16_t* gate; const bf16_t* t1; bf16_t* out;
    __device__ __forceinline__ void operator()(const f32x4 (&acc)[2][2][4][2], const Unit& u, int wr, int wc, int fr, int fq) const {
        const int lane = fq * 16 + fr; char* slot = epi_slot(wr, wc);
        const size_t off0 = (size_t)(u.pm * 256 + wr * 64 + (lane >> 3)) * 1024 + u.pn * 256 + wc * 64 + (lane & 7) * 8;
#pragma unroll
        for (int ai = 0; ai < 2; ++ai) { u32x4 gw[4][2], tw[4][2];
#pragma unroll
            for (int m = 0; m < 4; ++m)
#pragma unroll
                for (int half = 0; half < 2; ++half) { const size_t off = off0 + (size_t)(ai * 128 + m * 16 + half * 8) * 1024; gw[m][half] = *(const u32x4*)(gate + off); if (MODE == 1) tw[m][half] = *(const u32x4*)(t1 + off); }
#pragma unroll
            for (int m = 0; m < 4; ++m) { u32x4 w[2];
#pragma unroll
                for (int bj = 0; bj < 2; ++bj) { float v[8];
#pragma unroll
                    for (int j = 0; j < 4; ++j) { v[j] = acc[ai][bj][m][0][j]; v[4 + j] = acc[ai][bj][m][1][j]; }
                    w[bj] = pack8(v); }
                slot_put(slot, fr, fq, w[0], w[1]);
#pragma unroll
                for (int half = 0; half < 2; ++half) { float a[8], g[8]; unpack8(slot_get(slot, half, lane), a); unpack8(gw[m][half], g);
#pragma unroll
                    for (int j = 0; j < 8; ++j) a[j] *= g[j];
                    if (MODE == 1) { float t[8]; unpack8(tw[m][half], t);
#pragma unroll
                        for (int j = 0; j < 8; ++j) a[j] += t[j]; }
                    *(u32x4*)(out + off0 + (size_t)(ai * 128 + m * 16 + half * 8) * 1024) = pack8(a); } } }
    }
};

struct EpiResid {
    static constexpr bool PERM = false, FP8 = false;
    const float* x; float* h;
    __device__ __forceinline__ void operator()(const f32x4 (&acc)[2][2][4][2], const Unit& u, int wr, int wc, int fr, int fq) const {
        const int lane = fq * 16 + fr; char* slot = epi_slot(wr, wc);
        const size_t off0 = (size_t)(u.pm * 256 + wr * 64 + (lane >> 3)) * 1024 + u.pn * 256 + wc * 32 + (lane & 7) * 4;
#pragma unroll
        for (int ai = 0; ai < 2; ++ai)
#pragma unroll
            for (int bj = 0; bj < 2; ++bj) { f32x4 xv[4][2];
#pragma unroll
                for (int m = 0; m < 4; ++m)
#pragma unroll
                    for (int half = 0; half < 2; ++half) xv[m][half] = *(const f32x4*)(x + off0 + (size_t)(ai * 128 + m * 16 + half * 8) * 1024 + bj * 128);
#pragma unroll
                for (int m = 0; m < 4; ++m) { slot_put(slot, fr, fq, __builtin_bit_cast(u32x4, acc[ai][bj][m][0]), __builtin_bit_cast(u32x4, acc[ai][bj][m][1]));
#pragma unroll
                    for (int half = 0; half < 2; ++half) { const f32x4 a = __builtin_bit_cast(f32x4, slot_get(slot, half, lane));
                        *(f32x4*)(h + off0 + (size_t)(ai * 128 + m * 16 + half * 8) * 1024 + bj * 128) = a + xv[m][half]; } } }
    }
};

struct EpiAct {
    static constexpr bool PERM = true, FP8 = true;
    const float* bgu; const int* tile_e; unsigned char* act;
    __device__ __forceinline__ void operator()(const f32x4 (&acc)[2][2][4][2], const Unit& u, int wr, int wc, int fr, int fq) const {
        const int e = tile_e[u.pm]; const int row0 = u.pm * 256 + wr * 64 + fr; const int j0 = u.pn * 128 + wc * 32 + 8 * fq;
        float bg[8], bu[8];
        { const float* bp = bgu + (size_t)e * 2048 + 2 * j0;
#pragma unroll
          for (int q = 0; q < 4; ++q) { const f32x4 t = *(const f32x4*)(bp + 4 * q); bg[2 * q] = t[0]; bu[2 * q] = t[1]; bg[2 * q + 1] = t[2]; bu[2 * q + 1] = t[3]; } }
#pragma unroll
        EPI_ROWS(ai, m) { float v[8];
#pragma unroll
            for (int j = 0; j < 8; ++j) { const float gt = acc[ai][0][m][j >> 2][j & 3] + bg[j], up = acc[ai][1][m][j >> 2][j & 3] + bu[j];
                const float g = fminf(gt, 7.0f), uu = fminf(fmaxf(up, -7.0f), 7.0f); v[j] = (uu + 1.0f) * (g * sigmoidf_(1.702f * g)); }
            u32x2 w8; w8.x = (unsigned)pk4_fp8(v[0], v[1], v[2], v[3]); w8.y = (unsigned)pk4_fp8(v[4], v[5], v[6], v[7]);
            __builtin_nontemporal_store(w8, (u32x2*)(act + (size_t)(row0 + ai * 128 + m * 16) * 1024 + j0)); }
    }
};

struct EpiDown {
    static constexpr bool PERM = true, FP8 = true;
    const float* bd; const int* tile_e; bf16_t* y;
    __device__ __forceinline__ void operator()(const f32x4 (&acc)[2][2][4][2], const Unit& u, int wr, int wc, int fr, int fq) const {
        const int e = tile_e[u.pm]; const int lane = fq * 16 + fr; char* slot = epi_slot(wr, wc); const int col0 = u.pn * 256 + wc * 64 + 8 * fq;
        f32x4 b[2][2];
#pragma unroll
        for (int bj = 0; bj < 2; ++bj)
#pragma unroll
            for (int n = 0; n < 2; ++n) b[bj][n] = *(const f32x4*)(bd + (size_t)e * 1024 + col0 + bj * 32 + 4 * n);
        bf16_t* base = y + (size_t)(u.pm * 256 + wr * 64 + (lane >> 3)) * 1024 + u.pn * 256 + wc * 64 + (lane & 7) * 8;
#pragma unroll
        EPI_ROWS(ai, m) { u32x4 w[2];
#pragma unroll
            for (int bj = 0; bj < 2; ++bj) { const f32x4 v0 = acc[ai][bj][m][0] + b[bj][0], v1 = acc[ai][bj][m][1] + b[bj][1];
                w[bj].x = cvt_pk_bf16(v0[0], v0[1]); w[bj].y = cvt_pk_bf16(v0[2], v0[3]); w[bj].z = cvt_pk_bf16(v1[0], v1[1]); w[bj].w = cvt_pk_bf16(v1[2], v1[3]); }
            slot_put(slot, fr, fq, w[0], w[1]);
#pragma unroll
            for (int half = 0; half < 2; ++half) st_nt(base + (size_t)(ai * 128 + m * 16 + half * 8) * 1024, slot_get(slot, half, lane)); }
    }
};

__device__ __forceinline__ int win_colmap(int n) {
    if (n < 3072) return n;
    if (n < 7680) { const int off = n - 3072, which = off / 1536, hcol = off % 1536, head = hcol >> 6, p = hcol & 63;
        int dim = p; if (which < 2 && p < 16) dim = (p & 1) ? (p >> 1) + 8 : (p >> 1);
        return 3088 + which * 1536 + head * 64 + dim; }
    if (n < 9728) return 7696 + (n - 7680);
    if (n < 9744) return 3072 + (n - 9728);
    return -1;
}
__device__ __forceinline__ int gu_colmap(int n) { const int t = n >> 8, w = n & 255, wc = w >> 6, bj = (w >> 5) & 1, rho = w & 31; return 2 * (128 * t + 32 * wc + rho) + bj; }

__device__ __forceinline__ void transpose_tile(const float* src, int ld_src, bf16_t* dst, int K, int n0, int k0, int scol, char* lds) {
    const int t = tid_(), nl = t & 127, kq = t >> 7;
#pragma unroll
    for (int cc = 0; cc < 4; ++cc) { const int c = kq * 4 + cc; float v[8];
#pragma unroll
        for (int j = 0; j < 8; ++j) v[j] = scol >= 0 ? src[(size_t)(k0 + c * 8 + j) * ld_src + scol] : 0.f;
        *(u32x4*)(lds + nl * 256 + ((c ^ (nl & 15)) << 4)) = pack8(v); }
    __syncthreads();
#pragma unroll
    for (int pass = 0; pass < 4; ++pass) { const int idx = t + 512 * pass, n2 = idx >> 4, c2 = idx & 15;
        *(u32x4*)(dst + (size_t)(n0 + n2) * K + k0 + c2 * 8) = *(const u32x4*)(lds + n2 * 256 + ((c2 ^ (n2 & 15)) << 4)); }
    __syncthreads();
}

__device__ __forceinline__ void transpose_tile8(const float* src, int ld_src, unsigned char* dst, int K, int n0, int k0, int scol, float scale, char* lds) {
    const int t = tid_(), nl = t & 127, kq = t >> 7;
#pragma unroll
    for (int cc = 0; cc < 4; ++cc) { const int c = kq * 4 + cc; float v[16];
#pragma unroll
        for (int j = 0; j < 16; ++j) v[j] = src[(size_t)(k0 + c * 16 + j) * ld_src + scol] * scale;
        u32x4 w; w.x = (unsigned)pk4_fp8(v[0], v[1], v[2], v[3]); w.y = (unsigned)pk4_fp8(v[4], v[5], v[6], v[7]); w.z = (unsigned)pk4_fp8(v[8], v[9], v[10], v[11]); w.w = (unsigned)pk4_fp8(v[12], v[13], v[14], v[15]);
        *(u32x4*)(lds + nl * 256 + ((c ^ (nl & 15)) << 4)) = w; }
    __syncthreads();
#pragma unroll
    for (int pass = 0; pass < 4; ++pass) { const int idx = t + 512 * pass, n2 = idx >> 4, c2 = idx & 15;
        *(u32x4*)(dst + (size_t)(n0 + n2) * K + k0 + c2 * 16) = *(const u32x4*)(lds + n2 * 256 + ((c2 ^ (n2 & 15)) << 4)); }
    __syncthreads();
}

template <int MAP> __device__ __forceinline__ int tile_rowmap(int o) {
    if (MAP == 1) { const int d = o & 63; const int pp = d < 16 ? (d < 8 ? 2 * d : 2 * (d - 8) + 1) : d; return (o & 64) + pp; }
    if (MAP == 2) { const int wcl = o >> 6, w = o & 63; return 64 * wcl + 32 * (w & 1) + (w >> 1); }
    return o;
}
template <int MAP, bool F8> __device__ __forceinline__ void transpose_fast(const float* src  , int ld_src, unsigned char* dst, int Kb  , int n0, int k0, float scale, char* lds) {
    constexpr int KPT = F8 ? 16 : 8;
    const int t = tid_(), ng = t & 31, kg = t >> 5;
    f32x4 v[KPT];
#pragma unroll
    for (int j = 0; j < KPT; ++j) v[j] = *(const f32x4*)(src + (size_t)(k0 + kg * KPT + j) * ld_src + 4 * ng);
#pragma unroll
    for (int i = 0; i < 4; ++i) { const int row = tile_rowmap<MAP>(4 * ng + i); u32x4 w;
        if (F8) { w.x = (unsigned)pk4_fp8(v[0][i] * scale, v[1][i] * scale, v[2][i] * scale, v[3][i] * scale); w.y = (unsigned)pk4_fp8(v[4][i] * scale, v[5][i] * scale, v[6][i] * scale, v[7][i] * scale);
                  w.z = (unsigned)pk4_fp8(v[8 % KPT][i] * scale, v[9 % KPT][i] * scale, v[10 % KPT][i] * scale, v[11 % KPT][i] * scale); w.w = (unsigned)pk4_fp8(v[12 % KPT][i] * scale, v[13 % KPT][i] * scale, v[14 % KPT][i] * scale, v[15 % KPT][i] * scale); }
        else { w.x = cvt_pk_bf16(v[0][i], v[1][i]); w.y = cvt_pk_bf16(v[2][i], v[3][i]); w.z = cvt_pk_bf16(v[4][i], v[5][i]); w.w = cvt_pk_bf16(v[6][i], v[7][i]); }
        *(u32x4*)(lds + row * 256 + ((kg ^ (row & 15)) << 4)) = w; }
    __syncthreads();
#pragma unroll
    for (int pass = 0; pass < 4; ++pass) { const int idx = t + 512 * pass, n2 = idx >> 4, c2 = idx & 15;
        *(u32x4*)(dst + (size_t)(n0 + n2) * Kb + (size_t)k0 * (F8 ? 1 : 2) + c2 * 16) = *(const u32x4*)(lds + n2 * 256 + ((c2 ^ (n2 & 15)) << 4)); }
    __syncthreads();
}

__device__ __forceinline__ void phase_prologue(const Params& p, char* lds) {
    unsigned char* ws = opaque(p.ws);
    const int tid = tid_(), lane = tid & 63, wid = tid >> 6, G = gridDim.x, bid = blockIdx.x;
    { bf16_t* xn = (bf16_t*)(ws + WS_XN);
      for (int row = bid * 8 + wid; row < NTOK; row += G * 8) { const float* xr = p.x + (size_t)row * 1024; f32x4 v[4]; float ss = 0.f;
#pragma unroll
          for (int i = 0; i < 4; ++i) { v[i] = *(const f32x4*)(xr + i * 256 + lane * 4); ss += v[i][0] * v[i][0] + v[i][1] * v[i][1] + v[i][2] * v[i][2] + v[i][3] * v[i][3]; }
          ss = wave_sum(ss); const float rs = rsqrtf(ss * (1.0f / 1024.0f) + EPS);
#pragma unroll
          for (int i = 0; i < 4; ++i) { const f32x4 g = *(const f32x4*)(p.norm_mix_g + i * 256 + lane * 4); u32x2 w; w.x = cvt_pk_bf16(v[i][0] * rs * g[0], v[i][1] * rs * g[1]); w.y = cvt_pk_bf16(v[i][2] * rs * g[2], v[i][3] * rs * g[3]);
              *(u32x2*)(xn + (size_t)row * 1024 + i * 256 + lane * 4) = w; } } }
    { float* rc = (float*)(ws + WS_ROPE_C); float* rsn = (float*)(ws + WS_ROPE_S); float* rwg = (float*)(ws + WS_RWG);
      for (int i = bid * 512 + tid; i < SEQ * 8; i += G * 512) { const int s = i >> 3, f = i & 7; const double inv = pow(500000.0, -(double)f * 0.125); const float ang = (float)s * (float)inv; rc[i] = (float)cos((double)ang); rsn[i] = (float)sin((double)ang); }
      for (int i = bid * 512 + tid; i < 1024 * 32; i += G * 512) rwg[i] = p.router_w[i] * p.norm_ffn_g[i >> 5]; }
    { constexpr int T0 = 78 * 8, T1 = T0 + 64, T2 = T1 + 32, T3 = T2 + 64, T4 = T3 + 32 * 64, T5 = T4 + 32 * 32;
      const int nl = tid & 127;
      for (int tile = bid; tile < T5; tile += G) {
          if (tile < T0) { const int nt_ = tile >> 3, kt = tile & 7; bf16_t* d = (bf16_t*)(ws + WS_W_IN); unsigned char* d8 = ws + WS_W_IN;
              if (nt_ < 24) transpose_fast<0, false>(p.w_in + nt_ * 128, INW, d8, 2048, nt_ * 128, kt * 128, 1.f, lds);
              else if (nt_ < 48) transpose_fast<1, false>(p.w_in + 3088 + (nt_ - 24) * 128, INW, d8, 2048, nt_ * 128, kt * 128, 1.f, lds);
              else if (nt_ < 60) transpose_fast<0, false>(p.w_in + 3088 + (nt_ - 24) * 128, INW, d8, 2048, nt_ * 128, kt * 128, 1.f, lds);
              else if (nt_ < 76) transpose_fast<0, false>(p.w_in + 7696 + (nt_ - 60) * 128, INW, d8, 2048, nt_ * 128, kt * 128, 1.f, lds);
              else transpose_tile(p.w_in, INW, d, 1024, nt_ * 128, kt * 128, win_colmap(nt_ * 128 + nl), lds); }
          else if (tile < T1) { const int q = tile - T0, nt_ = q >> 3, kt = q & 7; transpose_fast<0, false>(p.w_branch_gla + nt_ * 128, 1024, ws + WS_W_G, 2048, nt_ * 128, kt * 128, 1.f, lds); }
          else if (tile < T2) { const int q = tile - T1, nt_ = q >> 2, kt = q & 3; transpose_fast<0, false>(p.w_branch_att + nt_ * 128, 1024, ws + WS_W_A, 1024, nt_ * 128, kt * 128, 1.f, lds); }
          else if (tile < T3) { const int q = tile - T2, nt_ = q >> 3, kt = q & 7; transpose_fast<0, false>(p.w_mix_out + nt_ * 128, 1024, ws + WS_W_MIX, 2048, nt_ * 128, kt * 128, 1.f, lds); }
          else if (tile < T4) { const int q = tile - T3, e = q >> 6, r = q & 63, nt_ = r >> 2, kt = r & 3;
              transpose_fast<2, true>(p.e_w_gu + (size_t)e * 1024 * 2048 + nt_ * 128, 2048, ws + WS_W_GU + (size_t)e * 2048 * 1024, 1024, nt_ * 128, kt * 256, 32.0f, lds); }
          else { const int q = tile - T4, e = q >> 5, r = q & 31, nt_ = r >> 2, kt = r & 3;
              transpose_fast<0, true>(p.e_w_d + (size_t)e * 1024 * 1024 + nt_ * 128, 1024, ws + WS_W_D + (size_t)e * 1024 * 1024, 1024, nt_ * 128, kt * 256, 32.0f, lds); }
      } }
}

constexpr int AT_KCS = 385 * 16;
constexpr int AT_VH = 385 * 64;
constexpr int AT_K = 0, AT_V = 8 * AT_KCS, AT_WL = AT_V + 2 * AT_VH, AT_STG = AT_WL + 8 * 128, AT_END = AT_STG + 8 * 4096;
static_assert(AT_END <= LDS_BYTES, "attention LDS");
__device__ __forceinline__ void attn_item(const Params& p, int item, char* lds) {
    unsigned char* ws = opaque(p.ws);
    const int tid = tid_(), lane = tid & 63, r32 = lane & 31, hi = lane >> 5; const int w = __builtin_amdgcn_readfirstlane(tid >> 6);
    const int jj = item & 15, bh = item >> 4, head = bh % 24, b = bh / 24, g = head >> 3, sh = 2 * g, d = 1 << sh, NL = SEQ >> sh, ppr = 16 >> sh;
    const int r = jj / ppr, j = jj % ppr;
    const size_t hb = ((size_t)bh * SEQ + (size_t)r * NL) * 64;
    const bf16_t* Q = (const bf16_t*)(ws + WS_AQ) + hb; const bf16_t* Kg = (const bf16_t*)(ws + WS_AK) + hb; const bf16_t* Vg = (const bf16_t*)(ws + WS_AV) + hb;
    const int kn0 = 256 * j - 128;
#pragma unroll
    for (int i = 0; i < 6; ++i) { const int idx = tid + 512 * i, key = idx >> 3, c = idx & 7;
        if (kn0 + key >= 0) { const u32x4 kv = *(const u32x4*)(Kg + (ptrdiff_t)(kn0 + key) * 64 + c * 8); const u32x4 vv = *(const u32x4*)(Vg + (ptrdiff_t)(kn0 + key) * 64 + c * 8);
            *(u32x4*)(lds + AT_K + c * AT_KCS + key * 16) = kv; *(u32x4*)(lds + AT_V + (c >> 2) * AT_VH + key * 64 + (c & 3) * 16) = vv; } }
    bf16x8 qf[4];
#pragma unroll
    for (int d0 = 0; d0 < 4; ++d0) qf[d0] = *(const bf16x8*)(Q + (size_t)(256 * j + 32 * w + r32) * 64 + d0 * 16 + hi * 8);
    __syncthreads();
    const LDS3 char* l3 = (const LDS3 char*)lds;
    f32x16 s[5]; const int ktmin = (j == 0) ? 4 : 0;
#pragma unroll
    for (int t5 = 0; t5 < 5; ++t5) { const int kt = w + t5;
        if (kt >= ktmin) { f32x16 a = {};
#pragma unroll
            for (int d0 = 0; d0 < 4; ++d0) { const bf16x8 kf = *(const LDS3 bf16x8*)(l3 + AT_K + (2 * d0 + hi) * AT_KCS + (kt * 32 + r32) * 16); a = MFMA32(kf, qf[d0], a); }
            s[t5] = a; }
        else {
#pragma unroll
            for (int rr = 0; rr < 16; ++rr) s[t5][rr] = -1e30f; } }
#pragma unroll
    for (int rr = 0; rr < 16; ++rr) { const int c = crow(rr, hi); if (c < r32) s[0][rr] = -1e30f; if (c > r32) s[4][rr] = -1e30f; }
    float mx = -1e30f;
#pragma unroll
    for (int t5 = 0; t5 < 5; ++t5)
#pragma unroll
        for (int rr = 0; rr < 16; ++rr) mx = fmaxf(mx, s[t5][rr]);
    mx = fmaxf(mx, __shfl_xor(mx, 32));
    float l = 0.f;
#pragma unroll
    for (int t5 = 0; t5 < 5; ++t5)
#pragma unroll
        for (int rr = 0; rr < 16; ++rr) { const float e = __builtin_amdgcn_exp2f(s[t5][rr] - mx); s[t5][rr] = e; l += e; }
    l += __shfl_xor(l, 32);
    f32x16 o[2]; o[0] = f32x16{}; o[1] = f32x16{};
    const int blk = (lane >> 4) & 1, q4 = (lane & 15) >> 2, p4 = lane & 3;
#pragma unroll
    for (int t5 = 0; t5 < 5; ++t5) { const int kt = w + t5;
        if (kt >= ktmin) {
#pragma unroll
            for (int ss = 0; ss < 2; ++ss) { float pv[8];
#pragma unroll
                for (int q = 0; q < 8; ++q) pv[q] = s[t5][8 * ss + q];
                const bf16x8 pa = __builtin_bit_cast(bf16x8, pack8(pv));
#pragma unroll
                for (int dh = 0; dh < 2; ++dh) { const LDS3 char* vp = l3 + AT_V + dh * AT_VH + (kt * 32 + 16 * ss + 4 * hi + q4) * 64 + (16 * blk + 4 * p4) * 2;
                    const bf16x8 vf = cat8(tr16(vp), tr16(vp + 8 * 64)); o[dh] = MFMA32(pa, vf, o[dh]); } } } }
    const int n_q = 256 * j + 32 * w + r32; const int tok = b * SEQ + n_q * d + r;
    if (hi == 0) { ((float*)(ws + WS_LSE))[((size_t)g * NTOK + tok) * 8 + (head & 7)] = (mx + __builtin_amdgcn_logf(l)) * LN2;
        ((float*)(lds + AT_WL))[w * 32 + r32] = __builtin_amdgcn_rcpf(l); }
    bf16_t* stg = (bf16_t*)(lds + AT_STG) + w * 2048;
#pragma unroll
    for (int rr = 0; rr < 16; ++rr) { const int qr = crow(rr, hi); const float rl = ((const float*)(lds + AT_WL))[w * 32 + qr];
#pragma unroll
        for (int dh = 0; dh < 2; ++dh) stg[qr * 64 + dh * 32 + r32] = (bf16_t)(cvt_pk_bf16(o[dh][rr] * rl, 0.f) & 0xffffu); }
    bf16_t* og = (bf16_t*)(ws + WS_OATT) + (size_t)g * NTOK * 512;
#pragma unroll
    for (int i = 0; i < 4; ++i) { const int idx = i * 64 + lane, row = idx >> 3, ch = idx & 7; const int tk = b * SEQ + (256 * j + 32 * w + row) * d + r;
        *(u32x4*)(og + (size_t)tk * 512 + (head & 7) * 64 + ch * 8) = *(const u32x4*)(stg + row * 64 + ch * 8); }
    __syncthreads();
}

constexpr int G1_BB = 0;
constexpr int G1_QE = G1_BB + 64 * 128 * 4;
constexpr int G1_KE = G1_QE + 64 * 272;
constexpr int G1_KD = G1_KE + 64 * 272;
constexpr int G1_V = G1_KD + 64 * 320;
constexpr int G1_GLR = G1_V + 64 * 576;
constexpr int G1_GUP = G1_GLR + 64 * 16 * 4;
constexpr int G1_SEG = G1_GUP + 16 * 128 * 4;
constexpr int G1_BIAS = G1_SEG + 4 * 128 * 4;
constexpr int G1_END = G1_BIAS + 128 * 4;
constexpr int G1_SU = 0;
constexpr int G1_SO = 128 * 528;
static_assert(G1_SO + 64 * 528 <= G1_GLR, "gla1 staging");
static_assert(G1_END <= LDS_BYTES, "gla1 LDS");
__device__ __forceinline__ float logsigmoidf_(float z) { return fminf(z, 0.f) - log1pf(__expf(-fabsf(z))); }
__device__ __forceinline__ void gla1_item(const Params& p, int item, char* lds) {
    unsigned char* ws = opaque(p.ws);
    const int tid = tid_(), lane = tid & 63, r32 = lane & 31, hi = lane >> 5; const int w = __builtin_amdgcn_readfirstlane(tid >> 6);
    const int n = item & 63, bh = item >> 6, h = bh & 3, b = bh >> 2; const int tok0 = b * SEQ + n * 64;
    float* BB = (float*)(lds + G1_BB); float* GLRs = (float*)(lds + G1_GLR); float* GUP = (float*)(lds + G1_GUP); float* SEGs = (float*)(lds + G1_SEG); float* BIAS = (float*)(lds + G1_BIAS);
    for (int i = tid; i < 64 * 16; i += 512) GLRs[i] = ((const float*)(ws + WS_GLR))[(size_t)tok0 * 16 + i];
    for (int i = tid; i < 16 * 128; i += 512) GUP[i] = p.gla_gate_up[(i >> 7) * 512 + h * 128 + (i & 127)];
    if (tid < 128) BIAS[tid] = p.gla_gate_bias[h * 128 + tid];
    __syncthreads();
    { const int d = tid & 127, seg = tid >> 7; float gu[16];
#pragma unroll
      for (int r = 0; r < 16; ++r) gu[r] = GUP[r * 128 + d];
      const float bias = BIAS[d]; float run = 0.f;
#pragma unroll 4
      for (int ii = 0; ii < 16; ++ii) { const int i = seg * 16 + ii; float z = bias;
#pragma unroll
          for (int r4 = 0; r4 < 4; ++r4) { const f32x4 gl = *(const f32x4*)(GLRs + i * 16 + r4 * 4); z += gl[0] * gu[r4 * 4] + gl[1] * gu[r4 * 4 + 1] + gl[2] * gu[r4 * 4 + 2] + gl[3] * gu[r4 * 4 + 3]; }
          run += logsigmoidf_(z) * (1.0f / 16.0f); BB[i * 128 + d] = run; }
      SEGs[seg * 128 + d] = run;
      __syncthreads();
      float off = 0.f; for (int s2 = 0; s2 < seg; ++s2) off += SEGs[s2 * 128 + d];
      if (seg > 0) { for (int ii = 0; ii < 16; ++ii) BB[(seg * 16 + ii) * 128 + d] += off; }
      __syncthreads(); }
    { const bf16_t* gq = (const bf16_t*)(ws + WS_GQ); const bf16_t* gk = (const bf16_t*)(ws + WS_GK); const bf16_t* gv = (const bf16_t*)(ws + WS_GV); bf16_t* qeg = (bf16_t*)(ws + WS_QE);
#pragma unroll
      for (int pp = 0; pp < 2; ++pp) { const int idx = tid + 512 * pp, i = idx >> 4, c = idx & 15, d0 = c * 8; const size_t go = (size_t)(tok0 + i) * 512 + h * 128 + d0;
          float q[8], k[8], qe[8], ke[8], kd[8]; unpack8(*(const u32x4*)(gq + go), q); unpack8(*(const u32x4*)(gk + go), k);
#pragma unroll
          for (int j = 0; j < 8; ++j) { const float bb = BB[i * 128 + d0 + j], bl = BB[63 * 128 + d0 + j]; qe[j] = q[j] * __expf(bb) * 0.08838834764831845f; ke[j] = k[j] * __expf(-bb); kd[j] = k[j] * __expf(bl - bb); }
          const u32x4 qw = pack8(qe); *(u32x4*)(lds + G1_QE + i * 272 + c * 16) = qw; *(u32x4*)(qeg + go) = qw;
          *(u32x4*)(lds + G1_KE + i * 272 + c * 16) = pack8(ke); *(u32x4*)(lds + G1_KD + i * 320 + c * 16) = pack8(kd); }
#pragma unroll
      for (int pp = 0; pp < 4; ++pp) { const int idx = tid + 512 * pp, jv = idx >> 5, c = idx & 31; *(u32x4*)(lds + G1_V + jv * 576 + c * 16) = *(const u32x4*)(gv + (size_t)(tok0 + jv) * 1024 + h * 256 + c * 8); }
      if (tid < 128) ((float*)(ws + WS_DEC))[(size_t)item * 128 + tid] = __expf(BB[63 * 128 + tid]);
      __syncthreads(); }
    const LDS3 char* l3 = (const LDS3 char*)lds; const int blk = (lane >> 4) & 1, q4 = (lane & 15) >> 2, p4 = lane & 3;
    {
      const int it = w & 1, vq = w >> 1; f32x16 oi[2]; oi[0] = f32x16{}; oi[1] = f32x16{};
#pragma unroll
      for (int jt = 0; jt < 2; ++jt) { if (jt <= it) { f32x16 x = {};
#pragma unroll
          for (int s = 0; s < 8; ++s) { const bf16x8 a = *(const LDS3 bf16x8*)(l3 + G1_KE + (jt * 32 + r32) * 272 + (16 * s + 8 * hi) * 2), bq = *(const LDS3 bf16x8*)(l3 + G1_QE + (it * 32 + r32) * 272 + (16 * s + 8 * hi) * 2); x = MFMA32(a, bq, x); }
          if (jt == it) {
#pragma unroll
              for (int rr = 0; rr < 16; ++rr) if (crow(rr, hi) > r32) x[rr] = 0.f; }
#pragma unroll
          for (int ss = 0; ss < 2; ++ss) { float xv[8];
#pragma unroll
              for (int q = 0; q < 8; ++q) xv[q] = x[8 * ss + q];
              const bf16x8 xa = __builtin_bit_cast(bf16x8, pack8(xv));
#pragma unroll
              for (int vi = 0; vi < 2; ++vi) { const int vt = 2 * vq + vi; const LDS3 char* vp = l3 + G1_V + (jt * 32 + 16 * ss + 4 * hi + q4) * 576 + (vt * 32 + 16 * blk + 4 * p4) * 2;
                  const bf16x8 vf = cat8(tr16(vp), tr16(vp + 8 * 576)); oi[vi] = MFMA32(xa, vf, oi[vi]); } } } }
      const int dt = w & 3, vg = w >> 2; f32x16 uu[4]; uu[0] = f32x16{}; uu[1] = f32x16{}; uu[2] = f32x16{}; uu[3] = f32x16{};
#pragma unroll
      for (int ks = 0; ks < 4; ++ks) { const LDS3 char* ap = l3 + G1_KD + (16 * ks + 8 * hi + q4) * 320 + (dt * 32 + 16 * blk + 4 * p4) * 2; const bf16x8 a = cat8(tr16(ap), tr16(ap + 4 * 320));
#pragma unroll
          for (int vi = 0; vi < 4; ++vi) { const int vt = 4 * vg + vi; const LDS3 char* vp = l3 + G1_V + (16 * ks + 8 * hi + q4) * 576 + (vt * 32 + 16 * blk + 4 * p4) * 2; const bf16x8 vf = cat8(tr16(vp), tr16(vp + 4 * 576)); uu[vi] = MFMA32(a, vf, uu[vi]); } }
      __syncthreads();
      bf16_t* SU = (bf16_t*)(lds + G1_SU); bf16_t* SO = (bf16_t*)(lds + G1_SO);
#pragma unroll
      for (int vi = 0; vi < 4; ++vi)
#pragma unroll
          for (int rr = 0; rr < 16; ++rr) SU[(dt * 32 + crow(rr, hi)) * 264 + (4 * vg + vi) * 32 + r32] = (bf16_t)(cvt_pk_bf16(uu[vi][rr], 0.f) & 0xffffu);
#pragma unroll
      for (int vi = 0; vi < 2; ++vi)
#pragma unroll
          for (int rr = 0; rr < 16; ++rr) SO[(it * 32 + crow(rr, hi)) * 264 + (2 * vq + vi) * 32 + r32] = (bf16_t)(cvt_pk_bf16(oi[vi][rr], 0.f) & 0xffffu);
      __syncthreads();
      bf16_t* ug = (bf16_t*)(ws + WS_U) + (size_t)item * 128 * 256; bf16_t* og = (bf16_t*)(ws + WS_OINTRA);
#pragma unroll
      for (int pp = 0; pp < 8; ++pp) { const int idx = tid + 512 * pp, row = idx >> 5, c = idx & 31; *(u32x4*)(ug + (size_t)row * 256 + c * 8) = *(const u32x4*)(SU + row * 264 + c * 8); }
#pragma unroll
      for (int pp = 0; pp < 4; ++pp) { const int idx = tid + 512 * pp, row = idx >> 5, c = idx & 31; *(u32x4*)(og + (size_t)(tok0 + row) * 1024 + h * 256 + c * 8) = *(const u32x4*)(SO + row * 264 + c * 8); } }
    __syncthreads();
}

__device__ __forceinline__ void phase_scan_combine(const Params& p) {
    unsigned char* ws = opaque(p.ws); const int G = gridDim.x;
    { const bf16_t* U = (const bf16_t*)(ws + WS_U); bf16_t* PV = (bf16_t*)(ws + WS_PREV); const float* DEC = (const float*)(ws + WS_DEC);
      for (int idx = blockIdx.x * 512 + tid_(); idx < 16 * 128 * 64; idx += G * 512) { const int bh = idx >> 13, rem = idx & 8191, d = rem >> 6, vq = rem & 63;
          float st[4] = {0.f, 0.f, 0.f, 0.f}; const size_t e0 = ((size_t)bh * 64 * 128 + d) * 256 + vq * 4;
#pragma unroll 8
          for (int n = 0; n < 64; ++n) { const size_t e = e0 + (size_t)n * 128 * 256; const u32x2 uw = *(const u32x2*)(U + e); const float dc = DEC[(size_t)(bh * 64 + n) * 128 + d];
              u32x2 pw; pw.x = cvt_pk_bf16(st[0], st[1]); pw.y = cvt_pk_bf16(st[2], st[3]); *(u32x2*)(PV + e) = pw;
              st[0] = dc * st[0] + bf_lo(uw.x); st[1] = dc * st[1] + bf_hi(uw.x); st[2] = dc * st[2] + bf_lo(uw.y); st[3] = dc * st[3] + bf_hi(uw.y); } } }
    { const bf16_t* OG = (const bf16_t*)(ws + WS_OATT); const float* LSE = (const float*)(ws + WS_LSE); bf16_t* YA = (bf16_t*)(ws + WS_YATT);
      for (int idx = blockIdx.x * 512 + tid_(); idx < NTOK * 64; idx += G * 512) { const int tok = idx >> 6, jc = idx & 63, jh = jc >> 3;
          const float l0 = LSE[(size_t)tok * 8 + jh], l1 = LSE[((size_t)NTOK + tok) * 8 + jh], l2 = LSE[((size_t)2 * NTOK + tok) * 8 + jh];
          const float m = fmaxf(l0, fmaxf(l1, l2)); float a0 = __expf(l0 - m), a1 = __expf(l1 - m), a2 = __expf(l2 - m); const float inv = __builtin_amdgcn_rcpf(a0 + a1 + a2); a0 *= inv; a1 *= inv; a2 *= inv;
          float o0[8], o1[8], o2[8], y[8]; const size_t off = (size_t)tok * 512 + jc * 8;
          unpack8(*(const u32x4*)(OG + off), o0); unpack8(*(const u32x4*)(OG + (size_t)NTOK * 512 + off), o1); unpack8(*(const u32x4*)(OG + (size_t)2 * NTOK * 512 + off), o2);
#pragma unroll
          for (int q = 0; q < 8; ++q) y[q] = a0 * o0[q] + a1 * o1[q] + a2 * o2[q];
          *(u32x4*)(YA + off) = pack8(y); } }
}

constexpr int G3_PREV = 0;
constexpr int G3_SS = G3_PREV + 128 * 576;
constexpr int G3_OI = G3_SS + 8 * 32 * 4;
constexpr int G3_GR = G3_OI + 64 * 528;
constexpr int G3_END = G3_GR + 64 * 528;
static_assert(G3_END <= LDS_XB, "gla3 LDS");
__device__ __forceinline__ void gla3_item(const Params& p, int item, char* lds) {
    unsigned char* ws = opaque(p.ws);
    const int tid = tid_(), lane = tid & 63, r32 = lane & 31, hi = lane >> 5; const int w = __builtin_amdgcn_readfirstlane(tid >> 6);
    const int n = item & 63, bh = item >> 6, h = bh & 3, b = bh >> 2; const int tok0 = b * SEQ + n * 64;
    const bf16_t* PV = (const bf16_t*)(ws + WS_PREV) + (size_t)item * 128 * 256;
    bf16_t* SOI = (bf16_t*)(lds + G3_OI); bf16_t* SGR = (bf16_t*)(lds + G3_GR);
#pragma unroll
    for (int pp = 0; pp < 8; ++pp) { const int idx = tid + 512 * pp, d = idx >> 5, c = idx & 31; *(u32x4*)(lds + G3_PREV + d * 576 + c * 16) = *(const u32x4*)(PV + (size_t)d * 256 + c * 8); }
#pragma unroll
    for (int pp = 0; pp < 4; ++pp) { const int idx = tid + 512 * pp, row = idx >> 5, c = idx & 31; const size_t go = (size_t)(tok0 + row) * 1024 + h * 256 + c * 8;
        *(u32x4*)(SOI + row * 264 + c * 8) = *(const u32x4*)((const bf16_t*)(ws + WS_OINTRA) + go); *(u32x4*)(SGR + row * 264 + c * 8) = *(const u32x4*)((const bf16_t*)(ws + WS_GR) + go); }
    const int it = w & 1, vq = w >> 1; const bf16_t* qeg = (const bf16_t*)(ws + WS_QE) + (size_t)(tok0 + it * 32 + r32) * 512 + h * 128;
    bf16x8 qa[8];
#pragma unroll
    for (int s = 0; s < 8; ++s) qa[s] = *(const bf16x8*)(qeg + 16 * s + 8 * hi);
    __syncthreads();
    const LDS3 char* l3 = (const LDS3 char*)lds; const int blk = (lane >> 4) & 1, q4 = (lane & 15) >> 2, p4 = lane & 3;
    f32x16 o[2];
#pragma unroll
    for (int vi = 0; vi < 2; ++vi)
#pragma unroll
        for (int rr = 0; rr < 16; ++rr) o[vi][rr] = bf2f(SOI[(it * 32 + crow(rr, hi)) * 264 + (2 * vq + vi) * 32 + r32]);
#pragma unroll
    for (int s = 0; s < 8; ++s)
#pragma unroll
        for (int vi = 0; vi < 2; ++vi) { const int vt = 2 * vq + vi; const LDS3 char* pp_ = l3 + G3_PREV + (16 * s + 8 * hi + q4) * 576 + (vt * 32 + 16 * blk + 4 * p4) * 2; const bf16x8 pf = cat8(tr16(pp_), tr16(pp_ + 4 * 576)); o[vi] = MFMA32(qa[s], pf, o[vi]); }
    float* SS = (float*)(lds + G3_SS);
#pragma unroll
    for (int rr = 0; rr < 16; ++rr) { float q = o[0][rr] * o[0][rr] + o[1][rr] * o[1][rr]; q += __shfl_xor(q, 16); q += __shfl_xor(q, 8); q += __shfl_xor(q, 4); q += __shfl_xor(q, 2); q += __shfl_xor(q, 1);
        if (r32 == 0) SS[w * 32 + crow(rr, hi)] = q; }
    __syncthreads();
    float ng[2]; ng[0] = p.gla_norm_g[(2 * vq) * 32 + r32]; ng[1] = p.gla_norm_g[(2 * vq + 1) * 32 + r32];
#pragma unroll
    for (int rr = 0; rr < 16; ++rr) { const int row = crow(rr, hi); const float tot = SS[(it + 0) * 32 + row] + SS[(it + 2) * 32 + row] + SS[(it + 4) * 32 + row] + SS[(it + 6) * 32 + row];
        const float rs = rsqrtf(tot * (1.0f / 256.0f) + EPS);
#pragma unroll
        for (int vi = 0; vi < 2; ++vi) { const int li = (it * 32 + row) * 264 + (2 * vq + vi) * 32 + r32; const float y = o[vi][rr] * rs * ng[vi] * bf2f(SGR[li]); SOI[li] = (bf16_t)(cvt_pk_bf16(y, 0.f) & 0xffffu); } }
    __syncthreads();
    bf16_t* yg = (bf16_t*)(ws + WS_YGLA);
#pragma unroll
    for (int pp = 0; pp < 4; ++pp) { const int idx = tid + 512 * pp, row = idx >> 5, c = idx & 31; *(u32x4*)(yg + (size_t)(tok0 + row) * 1024 + h * 256 + c * 8) = *(const u32x4*)(SOI + row * 264 + c * 8); }
    __syncthreads();
}

constexpr int RT_RSTD = 0;
constexpr int RT_LOG = 256;
constexpr int RT_CNT = RT_LOG + 64 * 32 * 4;
__device__ __forceinline__ void route_group(const Params& p, int grp, char* lds) {
    unsigned char* ws = opaque(p.ws); const int tid = tid_(), lane = tid & 63; const int w = __builtin_amdgcn_readfirstlane(tid >> 6);
    const float* H = (const float*)(ws + WS_H); const float* RWG = (const float*)(ws + WS_RWG);
    float* RSTD = (float*)(lds + RT_RSTD); float* LOGS = (float*)(lds + RT_LOG); int* LCNT = (int*)(lds + RT_CNT);
    const int tok0 = grp * 64;
    if (tid < 32) LCNT[tid] = 0;
    if (w < 4) { const int tl = lane & 15, kq = lane >> 4; const float* hr = H + (size_t)(tok0 + w * 16 + tl) * 1024 + kq * 256; const float* br = RWG + (size_t)(kq * 256) * 32 + tl;
        f32x4 a0 = {0.f, 0.f, 0.f, 0.f}, a1 = {0.f, 0.f, 0.f, 0.f}; float ss = 0.f;
#pragma unroll 4
        for (int m4 = 0; m4 < 64; ++m4) { const f32x4 hv = *(const f32x4*)(hr + m4 * 4);
#pragma unroll
            for (int q = 0; q < 4; ++q) { const float b0 = br[(size_t)(m4 * 4 + q) * 32], b1 = br[(size_t)(m4 * 4 + q) * 32 + 16];
                a0 = __builtin_amdgcn_mfma_f32_16x16x4f32(hv[q], b0, a0, 0, 0, 0); a1 = __builtin_amdgcn_mfma_f32_16x16x4f32(hv[q], b1, a1, 0, 0, 0); ss += hv[q] * hv[q]; } }
        ss += __shfl_xor(ss, 16); ss += __shfl_xor(ss, 32);
        const float rs = rsqrtf(ss * (1.0f / 1024.0f) + EPS);
        if (kq == 0) RSTD[w * 16 + tl] = rs;
#pragma unroll
        for (int rg = 0; rg < 4; ++rg) { const int t = w * 16 + 4 * kq + rg; LOGS[t * 32 + tl] = a0[rg]; LOGS[t * 32 + 16 + tl] = a1[rg]; } }
    __syncthreads();
    if (tid < 64) { const int tok = tok0 + tid; const float rs = RSTD[tid]; float lg[32];
#pragma unroll
        for (int e = 0; e < 32; ++e) lg[e] = LOGS[tid * 32 + e] * rs + p.router_b[e];
        int be[4]; float bv[4];
#pragma unroll
        for (int k = 0; k < 4; ++k) { float best = -3.0e38f; int bi = 0;
#pragma unroll
            for (int e = 0; e < 32; ++e) { const bool tk = lg[e] > best; best = tk ? lg[e] : best; bi = tk ? e : bi; }
            be[k] = bi; bv[k] = best;
#pragma unroll
            for (int e = 0; e < 32; ++e) lg[e] = (e == bi) ? -3.0e38f : lg[e]; }
        const float e1 = __expf(bv[1] - bv[0]), e2 = __expf(bv[2] - bv[0]), e3 = __expf(bv[3] - bv[0]); const float inv = 1.0f / (1.0f + e1 + e2 + e3);
        const float gt[4] = {inv, e1 * inv, e2 * inv, e3 * inv};
#pragma unroll
        for (int k = 0; k < 4; ++k) { const int pos = atomicAdd(&LCNT[be[k]], 1);
            ((int*)(ws + WS_TOPE))[tok * 4 + k] = be[k]; ((float*)(ws + WS_TOPG))[tok * 4 + k] = gt[k]; ((int*)(ws + WS_TOPP))[tok * 4 + k] = pos; } }
    { unsigned char* HN = ws + WS_HN;
#pragma unroll 2
      for (int i = 0; i < 8; ++i) { const int idx = tid + 512 * i, t = idx >> 6, c = idx & 63; const float rs = RSTD[t]; const size_t off = (size_t)(tok0 + t) * 1024 + c * 16; u32x4 wv;
#pragma unroll
          for (int q = 0; q < 4; ++q) { const f32x4 h0 = *(const f32x4*)(H + off + 4 * q), g0 = *(const f32x4*)(p.norm_ffn_g + c * 16 + 4 * q); wv[q] = (unsigned)pk4_fp8(h0[0] * rs * g0[0], h0[1] * rs * g0[1], h0[2] * rs * g0[2], h0[3] * rs * g0[3]); }
          *(u32x4*)(HN + off) = wv; } }
    __syncthreads();
    if (tid < 32) ((int*)(ws + WS_CNT))[grp * 32 + tid] = LCNT[tid];
    __syncthreads();
}

constexpr int DP_TOT = 0;
constexpr int DP_PART = 512;
__device__ __forceinline__ void dispatch_tables(const Params& p, int grp, char* lds) {
    unsigned char* ws = opaque(p.ws); const int tid = tid_(); const int* CNT = (const int*)(ws + WS_CNT); int* T = (int*)(lds + DP_TOT); int* PART = (int*)(lds + DP_PART);
    { const int e = tid & 31, part = tid >> 5; int tot = 0, pre = 0;
      for (int g2 = part * 16; g2 < part * 16 + 16; ++g2) { const int c = CNT[g2 * 32 + e]; tot += c; if (g2 < grp) pre += c; }
      PART[part * 32 + e] = tot; PART[512 + part * 32 + e] = pre; }
    __syncthreads();
    if (tid < 32) { int tot = 0, pre = 0; for (int q = 0; q < 16; ++q) { tot += PART[q * 32 + tid]; pre += PART[512 + q * 32 + tid]; } T[tid] = tot; T[64 + tid] = pre; }
    __syncthreads();
    if (tid == 0) { int base = 0; for (int e = 0; e < 32; ++e) { T[32 + e] = base; base += (T[e] + 255) >> 8; } T[96] = base; }
    __syncthreads();
}
__device__ __forceinline__ void dispatch_group(const Params& p, int grp, char* lds) {
    unsigned char* ws = opaque(p.ws); const int tid = tid_();
    dispatch_tables(p, grp, lds);
    const int* T = (const int*)(lds + DP_TOT); int* DEST = (int*)(lds + DP_PART + 4096);
    if (tid < 256) { const int tok = grp * 64 + (tid >> 2); const int e = ((const int*)(ws + WS_TOPE))[tok * 4 + (tid & 3)], lp = ((const int*)(ws + WS_TOPP))[tok * 4 + (tid & 3)];
        const int dest = T[32 + e] * 256 + T[64 + e] + lp; DEST[tid] = dest; ((int*)(ws + WS_SLOT))[tok * 4 + (tid & 3)] = dest; }
    __syncthreads();
    const unsigned char* HN = ws + WS_HN; unsigned char* XP = ws + WS_XPAD;
#pragma unroll 4
    for (int i = 0; i < 32; ++i) { const int idx = tid + 512 * i, pr = idx >> 6, c = idx & 63; const int tok = grp * 64 + (pr >> 2);
        *(u32x4*)(XP + (size_t)DEST[pr] * 1024 + c * 16) = *(const u32x4*)(HN + (size_t)tok * 1024 + c * 16); }
    __syncthreads();
}

__device__ __forceinline__ void phase_combine(const Params& p) {
    unsigned char* ws = opaque(p.ws); const int tid = tid_(), lane = tid & 63, wid = tid >> 6, G = gridDim.x;
    const float* H = (const float*)(ws + WS_H); const bf16_t* YP = (const bf16_t*)(ws + WS_YPAD);
    for (int tok = blockIdx.x * 8 + wid; tok < NTOK; tok += G * 8) {
        int sl[4]; float gt[4];
#pragma unroll
        for (int k = 0; k < 4; ++k) { sl[k] = ((const int*)(ws + WS_SLOT))[tok * 4 + k]; gt[k] = ((const float*)(ws + WS_TOPG))[tok * 4 + k]; }
        f32x4 v[4]; float ss = 0.f;
#pragma unroll
        for (int i = 0; i < 4; ++i) { const int col = i * 256 + lane * 4; v[i] = *(const f32x4*)(H + (size_t)tok * 1024 + col);
#pragma unroll
            for (int k = 0; k < 4; ++k) { const u32x2 yw = *(const u32x2*)(YP + (size_t)sl[k] * 1024 + col); v[i][0] += gt[k] * bf_lo(yw.x); v[i][1] += gt[k] * bf_hi(yw.x); v[i][2] += gt[k] * bf_lo(yw.y); v[i][3] += gt[k] * bf_hi(yw.y); }
            ss += v[i][0] * v[i][0] + v[i][1] * v[i][1] + v[i][2] * v[i][2] + v[i][3] * v[i][3]; }
        ss = wave_sum(ss); const float rs = rsqrtf(ss * (1.0f / 1024.0f) + EPS);
#pragma unroll
        for (int i = 0; i < 4; ++i) { const int col = i * 256 + lane * 4; const f32x4 g = *(const f32x4*)(p.norm_final_g + col); f32x4 o; o[0] = v[i][0] * rs * g[0]; o[1] = v[i][1] * rs * g[1]; o[2] = v[i][2] * rs * g[2]; o[3] = v[i][3] * rs * g[3];
            *(f32x4*)(p.out + (size_t)tok * 1024 + col) = o; } }
}


#define XB_TMO      128
#define XB_XCNT(j)  (256  + 64 * (j))
#define XB_XSUB(j)  (1280 + 64 * (j))
#define XB_XGEN(j)  (2304 + 64 * (j))
#define XB_TOP      3328
#define XB_TOPGEN   3392
#define XCD_BAR_WORDS 3456
#define XB_SPIN_CAP (1u << 18)
__device__ __forceinline__ unsigned xb_ld(unsigned* p)              { return __hip_atomic_load(p, __ATOMIC_RELAXED, __HIP_MEMORY_SCOPE_AGENT); }
__device__ __forceinline__ unsigned xb_add(unsigned* p, unsigned v) { return __hip_atomic_fetch_add(p, v, __ATOMIC_RELAXED, __HIP_MEMORY_SCOPE_AGENT); }
__device__ __forceinline__ unsigned xb_xcc_id() { return (unsigned)__builtin_amdgcn_s_getreg((3 << 11) | 20) & 0xFu; }
#define XB_SPIN(cond, bar) do { unsigned _sp = 0; while (cond) { __builtin_amdgcn_s_sleep(1); \
    if ((++_sp & 255u) == 0u) { if (xb_ld(&(bar)[XB_TMO])) break; if (_sp > XB_SPIN_CAP) { atomicAdd(&(bar)[XB_TMO], 1u); break; } } } } while (0)
struct XcdBarrier { unsigned* bar; unsigned x; volatile LDS3 unsigned* st; };
__device__ __forceinline__ XcdBarrier xcd_barrier_post(unsigned* bar, volatile LDS3 unsigned* st) {
    XcdBarrier b; b.bar = bar; b.x = xb_xcc_id(); b.st = st;
    if (tid_() == 0) (void)xb_add(&bar[XB_XCNT(b.x)], 1u);
    return b;
}
__device__ __forceinline__ void xcd_barrier_complete(unsigned* bar, unsigned x, unsigned& nloc, unsigned& nx) {
    const unsigned G = gridDim.x * gridDim.y * gridDim.z;
    unsigned sum, cnt, mine, sp = 0u;
    for (;;) {
        sum = 0u; cnt = 0u; mine = 0u;
#pragma unroll
        for (unsigned j = 0; j < 16; ++j) { const unsigned c = xb_ld(&bar[XB_XCNT(j)]); sum += c; cnt += (c > 0u) ? 1u : 0u; mine = (j == x) ? c : mine; }
        if (sum == G) break;
        __builtin_amdgcn_s_sleep(1);
        if ((++sp & 255u) == 0u) { if (xb_ld(&bar[XB_TMO])) break; if (sp > XB_SPIN_CAP) { atomicAdd(&bar[XB_TMO], 1u); break; } }
    }
    nloc = mine > 0u ? mine : 1u; nx = cnt > 0u ? cnt : 1u;
}
__device__ __forceinline__ void xcd_barrier(const XcdBarrier& b) {
    asm volatile("s_waitcnt vmcnt(0)" ::: "memory");
    __syncthreads();
    if (tid_() == 0) {
        unsigned* bar = b.bar;
        __builtin_amdgcn_s_waitcnt(0);
        unsigned nloc = b.st[0], nx = b.st[1];
        if (nloc == 0u) { xcd_barrier_complete(bar, b.x, nloc, nx); b.st[0] = nloc; b.st[1] = nx; }
        const unsigned old = xb_add(&bar[XB_XSUB(b.x)], 1u);
        const unsigned gen = old / nloc;
        if (old + 1u == (gen + 1u) * nloc) {
            __builtin_amdgcn_fence(__ATOMIC_RELEASE, "agent");
            asm volatile("s_waitcnt vmcnt(0)" ::: "memory");
            const unsigned og = xb_add(&bar[XB_TOP], 1u);
            const unsigned tg = og / nx;
            if (og + 1u == (tg + 1u) * nx) xb_add(&bar[XB_TOPGEN], 1u);
            else XB_SPIN(xb_ld(&bar[XB_TOPGEN]) == tg, bar);
            __builtin_amdgcn_fence(__ATOMIC_ACQUIRE, "agent");
            xb_add(&bar[XB_XGEN(b.x)], 1u);
            asm volatile("s_waitcnt vmcnt(0)" ::: "memory");
        } else {
            XB_SPIN(xb_ld(&bar[XB_XGEN(b.x)]) == gen, bar);
            __builtin_amdgcn_fence(__ATOMIC_ACQUIRE, "agent");
            asm volatile("s_waitcnt vmcnt(0)" ::: "memory");
        }
    }
    __syncthreads();
}

__global__ void __launch_bounds__(512, 2) mega_fwd(Params p) {
    cg::grid_group grid = cg::this_grid();
    char* lds = smem; LDS3 unsigned char* lds3 = (LDS3 unsigned char*)smem;
    const int G = gridDim.x, bid = blockIdx.x;
    if (tid_() < 4) ((volatile LDS3 unsigned*)(lds3 + LDS_XB))[tid_()] = 0u;
    __syncthreads();
    const XcdBarrier xb = xcd_barrier_post((unsigned*)(p.ws + WS_BAR), (volatile LDS3 unsigned*)(lds3 + LDS_XB));
    for (int rep = 0; rep < REP_P0; ++rep) phase_prologue(p, lds);
    if (p.ws == nullptr) grid.sync();
    xcd_barrier(xb);
    for (int rep = 0; rep < REP_P1; ++rep) { unsigned char* ws = opaque(p.ws); pg8::DenseProb S; S.init(ws + WS_XN, ws + WS_W_IN, NTOK, INWP, 1024, G, bid);
      EpiProj E; E.ws = ws;
      pg8::gemm_phase(lds3, S, E); }
    xcd_barrier(xb);
    for (int rep = 0; rep < REP_ATT; ++rep) for (int item = bid; item < 4 * 24 * 16; item += G) attn_item(p, item, lds);
    for (int rep = 0; rep < REP_GLA1; ++rep) for (int item = bid; item < 1024; item += G) gla1_item(p, item, lds);
    xcd_barrier(xb);
    for (int rep = 0; rep < REP_P3; ++rep) phase_scan_combine(p);
    xcd_barrier(xb);
    for (int rep = 0; rep < REP_P4; ++rep) for (int item = bid; item < 1024; item += G) gla3_item(p, item, lds);
    xcd_barrier(xb);
    for (int rep = 0; rep < REP_P5; ++rep) {
    { unsigned char* ws = opaque(p.ws); pg8::DenseProb S; S.init(ws + WS_YATT, ws + WS_W_A, NTOK, 1024, 512, G, bid);
      EpiGate<0> E; E.gate = (const bf16_t*)(ws + WS_SA); E.t1 = nullptr; E.out = (bf16_t*)(ws + WS_T1);
      pg8::gemm_phase(lds3, S, E); }
    { unsigned char* ws = opaque(p.ws); pg8::DenseProb S; S.init(ws + WS_YGLA, ws + WS_W_G, NTOK, 1024, 1024, G, bid);
      EpiGate<1> E; E.gate = (const bf16_t*)(ws + WS_SG); E.t1 = (const bf16_t*)(ws + WS_T1); E.out = (bf16_t*)(ws + WS_MERGED);
      pg8::gemm_phase(lds3, S, E); }
    }
    xcd_barrier(xb);
    for (int rep = 0; rep < REP_P6; ++rep) { unsigned char* ws = opaque(p.ws); pg8::DenseProb S; S.init(ws + WS_MERGED, ws + WS_W_MIX, NTOK, 1024, 1024, G, bid);
      EpiResid E; E.x = p.x; E.h = (float*)(ws + WS_H);
      pg8::gemm_phase(lds3, S, E); }
    xcd_barrier(xb);
    for (int rep = 0; rep < REP_P7; ++rep) for (int grp = bid; grp < 256; grp += G) route_group(p, grp, lds);
    xcd_barrier(xb);
    for (int rep = 0; rep < REP_P8; ++rep) for (int grp = bid; grp < 256; grp += G) dispatch_group(p, grp, lds);
    if (bid == 0) { unsigned char* ws = opaque(p.ws); dispatch_tables(p, -1, lds); const int* T = (const int*)(lds + DP_TOT); int* TE = (int*)(ws + WS_TILEE);
        if (tid_() < 32) { const int e = tid_(); for (int t = T[32 + e]; t < T[32 + e] + ((T[e] + 255) >> 8); ++t) TE[16 + t] = e; }
        if (tid_() == 0) TE[0] = T[96]; }
    xcd_barrier(xb);
    for (int rep = 0; rep < REP_P9; ++rep) { unsigned char* ws = opaque(p.ws); const int* TE = (const int*)(ws + WS_TILEE);
      pg8::MoeProb S; S.A = (const char*)(ws + WS_XPAD); S.Bt = (const char*)(ws + WS_W_GU); S.K = 512  ; S.nN = 8; S.T = TE[0]; S.G = G; S.c = bid; S.estride = (size_t)2048 * 1024; S.tile_e = TE + 16;
      EpiAct E; E.bgu = p.e_b_gu; E.tile_e = TE + 16; E.act = ws + WS_ACT;
      pg8::gemm_phase(lds3, S, E); }
    xcd_barrier(xb);
    for (int rep = 0; rep < REP_P10; ++rep) { unsigned char* ws = opaque(p.ws); const int* TE = (const int*)(ws + WS_TILEE);
      pg8::MoeProb S; S.A = (const char*)(ws + WS_ACT); S.Bt = (const char*)(ws + WS_W_D); S.K = 512  ; S.nN = 4; S.T = TE[0]; S.G = G; S.c = bid; S.estride = (size_t)1024 * 1024; S.tile_e = TE + 16;
      EpiDown E; E.bd = p.e_b_d; E.tile_e = TE + 16; E.y = (bf16_t*)(ws + WS_YPAD);
      pg8::gemm_phase(lds3, S, E); }
    xcd_barrier(xb);
    for (int rep = 0; rep < REP_P11; ++rep) phase_combine(p);
}

extern "C" void kernel_launch(void* const* d_in, const int* in_sizes, int n_in, void* d_out, int out_size, void* d_ws, size_t ws_size, hipStream_t stream) {
    static int grid = 0;
    if (grid == 0) {
        if (n_in != 17 || ws_size < WS_END) { fprintf(stderr, "kernel_launch: expected 17 inputs and >= %zu bytes of workspace (got %d, %zu); nothing launched\n", (size_t)WS_END, n_in, ws_size); grid = -1; return; }
        int dev = 0, cus = 0, per_cu = 0;
        if (hipGetDevice(&dev) != hipSuccess || hipDeviceGetAttribute(&cus, hipDeviceAttributeMultiprocessorCount, dev) != hipSuccess) { fprintf(stderr, "kernel_launch: device query failed\n"); grid = -1; return; }
        if (hipFuncSetAttribute((const void*)mega_fwd, hipFuncAttributeMaxDynamicSharedMemorySize, LDS_BYTES) != hipSuccess) { fprintf(stderr, "kernel_launch: hipFuncSetAttribute failed\n"); grid = -1; return; }
        if (hipOccupancyMaxActiveBlocksPerMultiprocessor(&per_cu, (const void*)mega_fwd, 512, LDS_BYTES) != hipSuccess || per_cu < 1) { fprintf(stderr, "kernel_launch: occupancy query failed (%d)\n", per_cu); grid = -1; return; }
        grid = cus;
    }
    if (grid < 0) return;
    Params p{};
    p.x = (const float*)d_in[0]; p.norm_mix_g = (const float*)d_in[1]; p.w_in = (const float*)d_in[2]; p.gla_gate_up = (const float*)d_in[3]; p.gla_gate_bias = (const float*)d_in[4]; p.gla_norm_g = (const float*)d_in[5];
    p.w_branch_gla = (const float*)d_in[6]; p.w_branch_att = (const float*)d_in[7]; p.w_mix_out = (const float*)d_in[8]; p.norm_ffn_g = (const float*)d_in[9]; p.router_w = (const float*)d_in[10]; p.router_b = (const float*)d_in[11];
    p.e_w_gu = (const float*)d_in[12]; p.e_b_gu = (const float*)d_in[13]; p.e_w_d = (const float*)d_in[14]; p.e_b_d = (const float*)d_in[15]; p.norm_final_g = (const float*)d_in[16];
    p.out = (float*)d_out; p.ws = (unsigned char*)d_ws;
    if (hipMemsetAsync((char*)d_ws + WS_BAR, 0, 3456 * 4, stream) != hipSuccess) { fprintf(stderr, "kernel_launch: memset of the barrier words failed\n"); return; }
    void* args[] = {&p};
    hipError_t e = hipLaunchCooperativeKernel((const void*)mega_fwd, dim3(grid), dim3(512), args, LDS_BYTES, stream);
    if (e != hipSuccess) fprintf(stderr, "kernel_launch: cooperative launch failed: %s (grid %d)\n", hipGetErrorString(e), grid);
}
```

```cpp
#include <hip/hip_runtime.h>
#include <hip/hip_cooperative_groups.h>
#include <cstdio>
#include <cstdint>
namespace cg = cooperative_groups;
#ifndef REP_P0
#define REP_P0 1
#define REP_P1 1
#define REP_ATT 1
#define REP_GLA1 1
#define REP_P3 1
#define REP_P4 1
#define REP_P5 1
#define REP_P6 1
#define REP_P7 1
#define REP_P8 1
#define REP_P9 1
#define REP_P10 1
#define REP_P11 1
#endif

#define LDS3 __attribute__((address_space(3)))
typedef unsigned short bf16_t;
typedef short bf16x8 __attribute__((ext_vector_type(8)));
typedef short s16x4 __attribute__((ext_vector_type(4)));
typedef short v4i16_t __attribute__((ext_vector_type(4)));
typedef float f32x4 __attribute__((ext_vector_type(4)));
typedef float f32x2 __attribute__((ext_vector_type(2)));
typedef float f32x16 __attribute__((ext_vector_type(16)));
typedef unsigned u32x4 __attribute__((ext_vector_type(4)));
typedef unsigned u32x2 __attribute__((ext_vector_type(2)));
typedef int i32x8 __attribute__((ext_vector_type(8)));
typedef int i32x4 __attribute__((ext_vector_type(4)));

constexpr int NTOK = 16384, DM = 1024, SEQ = 4096, NB = 4;
constexpr int INW = 9744, INWP = 9984;
constexpr int NEXP = 32, TOPK = 4, FF = 1024;
constexpr int MAXT = 288;
constexpr float EPS = 1e-5f;
constexpr float QSCALE = 0.125f * 1.4426950408889634f;
constexpr float LN2 = 0.6931471805599453f;

constexpr size_t al256(size_t x) { return (x + 255) & ~(size_t)255; }
constexpr size_t WS_W_IN = 0;
constexpr size_t WS_W_G = WS_W_IN + (size_t)INWP * 1024 * 2;
constexpr size_t WS_W_A = WS_W_G + (size_t)1024 * 1024 * 2;
constexpr size_t WS_W_MIX = WS_W_A + (size_t)1024 * 512 * 2;
constexpr size_t WS_W_GU = WS_W_MIX + (size_t)1024 * 1024 * 2;
constexpr size_t WS_W_D = WS_W_GU + (size_t)NEXP * 2048 * 1024;
constexpr size_t WS_ROPE_C = WS_W_D + (size_t)NEXP * 1024 * 1024;
constexpr size_t WS_ROPE_S = WS_ROPE_C + (size_t)SEQ * 8 * 4;
constexpr size_t WS_RWG = WS_ROPE_S + (size_t)SEQ * 8 * 4;
constexpr size_t WS_H = WS_RWG + (size_t)1024 * 32 * 4;
constexpr size_t WS_HN = WS_H + (size_t)NTOK * 1024 * 4;
constexpr size_t WS_TOPE = WS_HN + (size_t)NTOK * 1024;
constexpr size_t WS_TOPG = WS_TOPE + (size_t)NTOK * 4 * 4;
constexpr size_t WS_TOPP = WS_TOPG + (size_t)NTOK * 4 * 4;
constexpr size_t WS_SLOT = WS_TOPP + (size_t)NTOK * 4 * 4;
constexpr size_t WS_CNT = WS_SLOT + (size_t)NTOK * 4 * 4;
constexpr size_t WS_TILEE = WS_CNT + (size_t)256 * 32 * 4;
constexpr size_t WS_REGB = al256(WS_TILEE + (size_t)(MAXT + 32) * 4);
constexpr size_t WS_XN = WS_REGB;
constexpr size_t WS_GQ = WS_XN + (size_t)NTOK * 1024 * 2;
constexpr size_t WS_GK = WS_GQ + (size_t)NTOK * 512 * 2;
constexpr size_t WS_GV = WS_GK + (size_t)NTOK * 512 * 2;
constexpr size_t WS_GR = WS_GV + (size_t)NTOK * 1024 * 2;
constexpr size_t WS_SG = WS_GR + (size_t)NTOK * 1024 * 2;
constexpr size_t WS_SA = WS_SG + (size_t)NTOK * 1024 * 2;
constexpr size_t WS_AQ = WS_SA + (size_t)NTOK * 1024 * 2;
constexpr size_t WS_AK = WS_AQ + (size_t)NTOK * 1536 * 2;
constexpr size_t WS_AV = WS_AK + (size_t)NTOK * 1536 * 2;
constexpr size_t WS_GLR = WS_AV + (size_t)NTOK * 1536 * 2;
constexpr size_t WS_OATT = WS_GLR + (size_t)NTOK * 16 * 4;
constexpr size_t WS_LSE = WS_OATT + (size_t)3 * NTOK * 512 * 2;
constexpr size_t WS_QE = WS_LSE + (size_t)3 * NTOK * 8 * 4;
constexpr size_t WS_OINTRA = WS_QE + (size_t)NTOK * 512 * 2;
constexpr size_t WS_U = WS_OINTRA + (size_t)NTOK * 1024 * 2;
constexpr size_t WS_DEC = WS_U + (size_t)1024 * 128 * 256 * 2;
constexpr size_t WS_REGB_END = WS_DEC + (size_t)1024 * 128 * 4;
constexpr size_t WS_PREV = WS_AQ;
constexpr size_t WS_YGLA = WS_AV;
constexpr size_t WS_YATT = WS_XN;
constexpr size_t WS_T1 = WS_GQ;
constexpr size_t WS_MERGED = WS_GV;
constexpr size_t PADROWS = (size_t)MAXT * 256;
constexpr size_t WS_XPAD = WS_REGB;
constexpr size_t WS_ACT = WS_XPAD + PADROWS * 1024;
constexpr size_t WS_YPAD = WS_ACT + PADROWS * 1024;
constexpr size_t WS_PAD_END = WS_YPAD + PADROWS * 1024;
constexpr size_t WS_BAR = al256(WS_REGB_END > WS_PAD_END ? WS_REGB_END : WS_PAD_END);
constexpr size_t WS_END = WS_BAR + 3456 * 4;
static_assert(WS_PAD_END <= WS_REGB_END + (1u << 30), "map");

constexpr int LDS_XB = 147456;
constexpr int LDS_BYTES = 147456 + 16;

struct Params {
    const float *x, *norm_mix_g, *w_in, *gla_gate_up, *gla_gate_bias, *gla_norm_g, *w_branch_gla, *w_branch_att, *w_mix_out, *norm_ffn_g,
        *router_w, *router_b, *e_w_gu, *e_b_gu, *e_w_d, *e_b_d, *norm_final_g;
    float* out;
    unsigned char* ws;
};

__device__ __forceinline__ int tid_() { int t = threadIdx.x; asm volatile("" : "+v"(t)); return t; }
__device__ __forceinline__ unsigned char* opaque(unsigned char* q) { return q; }
__device__ __forceinline__ unsigned cvt_pk_bf16(float lo, float hi) { unsigned r; asm volatile("v_cvt_pk_bf16_f32 %0, %1, %2" : "=v"(r) : "v"(lo), "v"(hi)); return r; }
__device__ __forceinline__ float bf_lo(unsigned w) { return __uint_as_float(w << 16); }
__device__ __forceinline__ float bf_hi(unsigned w) { return __uint_as_float(w & 0xffff0000u); }
__device__ __forceinline__ float bf2f(bf16_t b) { return __uint_as_float(((unsigned)b) << 16); }
__device__ __forceinline__ u32x4 pack8(const float* v) { u32x4 w; w.x = cvt_pk_bf16(v[0], v[1]); w.y = cvt_pk_bf16(v[2], v[3]); w.z = cvt_pk_bf16(v[4], v[5]); w.w = cvt_pk_bf16(v[6], v[7]); return w; }
__device__ __forceinline__ void unpack8(u32x4 w, float* v) { v[0] = bf_lo(w.x); v[1] = bf_hi(w.x); v[2] = bf_lo(w.y); v[3] = bf_hi(w.y); v[4] = bf_lo(w.z); v[5] = bf_hi(w.z); v[6] = bf_lo(w.w); v[7] = bf_hi(w.w); }
__device__ __forceinline__ float sigmoidf_(float v) { return __builtin_amdgcn_rcpf(1.0f + __builtin_amdgcn_exp2f(v * -1.4426950408889634f)); }
__device__ __forceinline__ float wave_sum(float v) { v += __shfl_xor(v, 32); v += __shfl_xor(v, 16); v += __shfl_xor(v, 8); v += __shfl_xor(v, 4); v += __shfl_xor(v, 2); v += __shfl_xor(v, 1); return v; }
__device__ __forceinline__ s16x4 tr16(const LDS3 char* p) { return __builtin_bit_cast(s16x4, __builtin_amdgcn_ds_read_tr16_b64_v4i16((LDS3 v4i16_t*)p)); }
__device__ __forceinline__ bf16x8 cat8(s16x4 a, s16x4 b) { return (bf16x8){a[0], a[1], a[2], a[3], b[0], b[1], b[2], b[3]}; }
__device__ __forceinline__ int crow(int r, int hi) { return (r & 3) + 8 * (r >> 2) + 4 * hi; }
__device__ __forceinline__ void st_nt(void* p, u32x4 v) { __builtin_nontemporal_store(v, (u32x4*)p); }
__device__ __forceinline__ int pk4_fp8(float a, float b, float c, float d) { int w = __builtin_amdgcn_cvt_pk_fp8_f32(a, b, 0, false); return __builtin_amdgcn_cvt_pk_fp8_f32(c, d, w, true); }
#define MFMA32(a, b, c) __builtin_amdgcn_mfma_f32_32x32x16_bf16(a, b, c, 0, 0, 0)

namespace pg8 {
constexpr int BM = 256, BK = 64, HALF = 128, HTB = HALF * BK * 2, STAGE_BYTES = 8 * HTB, NXCD = 8, WGM = 8;
constexpr bool GEMM_ALIGN_EPI = true;
constexpr bool GEMM_SP2 = true;
__host__ __device__ __forceinline__ int lds_byte(int r, int c) { const int st = (r >> 4) * 2 + (c >> 5), rr = r & 15, cc = c & 31, ob = rr * 64 + cc * 2; return st * 1024 + (ob ^ (((ob >> 9) & 1) << 5)); }
__host__ __device__ __forceinline__ void stage_rc(int b, int& R, int& C) { const int st = b / 1024, sb = b % 1024, swz = sb ^ (((sb >> 9) & 1) << 5); R = (st >> 1) * 16 + swz / 64; C = (st & 1) * 32 + (swz % 64) / 2; }
__host__ __device__ __forceinline__ int perm32(int rho) { const int n = rho >> 4, i = rho & 15; return 8 * (i >> 2) + 4 * n + (i & 3); }
struct Unit { int pm, pn; };

struct DenseProb {
    const char* A; const char* Bt; int K; int nM, nN, nwg, G, c;
    __device__ void init(const void* A_, const void* Bt_, int M, int N, int K_, int G_, int c_) { A = (const char*)A_; Bt = (const char*)Bt_; K = K_; nM = M / BM; nN = N / BM; nwg = nM * nN; G = G_; c = c_; }
    __device__ __forceinline__ bool next(int i, Unit& u) const {
        const long L = (long)i * G + c; if (L >= nwg) return false;
        int wgid = (int)L; { const int q = nwg / NXCD, r = nwg % NXCD, xcd = wgid % NXCD, off = wgid / NXCD; wgid = (xcd < r ? xcd * (q + 1) : r * (q + 1) + (xcd - r) * q) + off; }
        const int nig = WGM * nN, gid = wgid / nig, fm = gid * WGM, gsz = (nM - fm) < WGM ? (nM - fm) : WGM;
        u.pm = fm + ((wgid % nig) % gsz); u.pn = (wgid % nig) / gsz; return true;
    }
    __device__ __forceinline__ const char* a_ptr(const Unit& u) const { return A + (size_t)u.pm * BM * K * 2; }
    __device__ __forceinline__ const char* b_ptr(const Unit& u) const { return Bt + (size_t)u.pn * BM * K * 2; }
};
struct MoeProb {
    const char* A; const char* Bt; int K; int nN, T, G, c; size_t estride; const int* tile_e;
    __device__ __forceinline__ bool next(int i, Unit& u) const { const long L = (long)i * G + c; if (L >= (long)T * nN) return false; u.pm = (int)(L / nN); u.pn = (int)(L % nN); return true; }
    __device__ __forceinline__ const char* a_ptr(const Unit& u) const { return A + (size_t)u.pm * BM * K * 2; }
    __device__ __forceinline__ const char* b_ptr(const Unit& u) const { return Bt + (size_t)tile_e[u.pm] * estride + (size_t)u.pn * BM * K * 2; }
};

template <class Epi, class Prob>
__device__ __forceinline__ void gemm_phase(LDS3 unsigned char* lds, const Prob& S, const Epi& E) {
    const int tid = tid_(), wid = __builtin_amdgcn_readfirstlane(tid >> 6), lane = tid & 63, wr = wid >> 2, wc = wid & 3, fr = lane & 15, fq = lane >> 4;
    const int K = S.K, nt = K / BK;
    unsigned voffA[2], voffB[2];
#pragma unroll
    for (int i = 0; i < 2; ++i) { int R, C; stage_rc(tid * 16 + i * 8192, R, C); const int Rb = Epi::PERM ? (2 * (R & ~31) + perm32(R & 31)) : R;
        voffA[i] = (unsigned)(R * K + C) * 2u; voffB[i] = (unsigned)(Rb * K + C) * 2u; }
    const size_t kstep = (size_t)(BK * 2);
    const size_t hstep = (size_t)HALF * K * 2;
    const size_t hstepB = Epi::PERM ? (size_t)32 * K * 2 : hstep;
    const unsigned ldsw = (unsigned)wid * 1024u;
    const int aoff = lds_byte(wr * 64 + fr, fq * 8), boff = lds_byte(wc * 32 + fr, fq * 8);
#define PG8_SA(b, h) (((b) * 2 + (h)) * HTB)
#define PG8_SB(b, h) ((4 + (b) * 2 + (h)) * HTB)
#define PG8_STAGE(bufoff, gbase, voff) do { _Pragma("unroll") for (int _i = 0; _i < 2; ++_i) \
        __builtin_amdgcn_global_load_lds((const unsigned*)((const char*)(gbase) + (voff)[_i]), (LDS3 unsigned*)(lds + (bufoff) + ldsw + _i * 8192), 16, 0, 0); } while (0)
#define PG8_LD8(ptr) __builtin_shufflevector(*(const LDS3 i32x4*)(ptr), *(const LDS3 i32x4*)((ptr) + 1024), 0, 1, 2, 3, 4, 5, 6, 7)
#define PG8_LO(x) __builtin_bit_cast(bf16x8, __builtin_shufflevector(x, x, 0, 1, 2, 3))
#define PG8_HI(x) __builtin_bit_cast(bf16x8, __builtin_shufflevector(x, x, 4, 5, 6, 7))
#define PG8_LDA(dst, b, h) do { _Pragma("unroll") for (int m = 0; m < 4; ++m) dst[m] = PG8_LD8(lds + PG8_SA(b, h) + aoff + m * 2048); } while (0)
#define PG8_LDB(dst, b, h) do { _Pragma("unroll") for (int n = 0; n < 2; ++n) dst[n] = PG8_LD8(lds + PG8_SB(b, h) + boff + n * 2048); } while (0)
#define PG8_MMA(ai, bj, At, Bt) do { __builtin_amdgcn_s_setprio(1); _Pragma("unroll") for (int m = 0; m < 4; ++m) _Pragma("unroll") for (int n = 0; n < 2; ++n) { \
        if constexpr (Epi::FP8) asm volatile("v_mfma_scale_f32_16x16x128_f8f6f4 %0, %1, %2, %0, %3, %4 op_sel_hi:[0,0,0]" : "+v"(acc[ai][bj][m][n]) : "v"(Bt[n]), "v"(At[m]), "v"(sc_w), "v"(sc_1)); \
        else { acc[ai][bj][m][n] = __builtin_amdgcn_mfma_f32_16x16x32_bf16(PG8_LO(Bt[n]), PG8_LO(At[m]), acc[ai][bj][m][n], 0, 0, 0); acc[ai][bj][m][n] = __builtin_amdgcn_mfma_f32_16x16x32_bf16(PG8_HI(Bt[n]), PG8_HI(At[m]), acc[ai][bj][m][n], 0, 0, 0); } } __builtin_amdgcn_s_setprio(0); } while (0)
#define PG8_WAIT_V(n) asm volatile("s_waitcnt vmcnt(" #n ")" ::: "memory")
#define PG8_WAIT_L(n) asm volatile("s_waitcnt lgkmcnt(" #n ")" ::: "memory")
#define PG8_BAR __builtin_amdgcn_s_barrier()
#define PG8_SCHED __builtin_amdgcn_sched_barrier(0)
    Unit cur, nxt; int ui = 0;
    if (!S.next(0, cur)) return;
    f32x4 acc[2][2][4][2];
#pragma unroll
    for (int a = 0; a < 2; ++a)
#pragma unroll
        for (int b = 0; b < 2; ++b)
#pragma unroll
            for (int m = 0; m < 4; ++m)
#pragma unroll
                for (int n = 0; n < 2; ++n) acc[a][b][m][n] = (f32x4){0.f, 0.f, 0.f, 0.f};
    i32x8 At[4], B0[2], B1[2];
    int sc_w = 0x7A7A7A7A  , sc_1 = 0x7F7F7F7F; asm volatile("" : "+v"(sc_w), "+v"(sc_1));
    const char* cA = S.a_ptr(cur); const char* cB = S.b_ptr(cur);
    if constexpr (GEMM_SP2) {
        PG8_STAGE(PG8_SB(0, 0), cB, voffB); PG8_STAGE(PG8_SB(0, 1), cB + hstepB, voffB); PG8_STAGE(PG8_SA(0, 0), cA, voffA); PG8_STAGE(PG8_SA(0, 1), cA + hstep, voffA);
        if (wr == 1) PG8_BAR;
        PG8_WAIT_V(2); PG8_BAR;
        PG8_STAGE(PG8_SB(1, 0), cB + kstep, voffB); PG8_STAGE(PG8_SA(1, 0), cA + kstep, voffA); PG8_STAGE(PG8_SB(1, 1), cB + hstepB + kstep, voffB);
        PG8_WAIT_V(6); PG8_BAR;
    } else {
    PG8_STAGE(PG8_SB(0, 0), cB, voffB); PG8_STAGE(PG8_SA(0, 0), cA, voffA); PG8_STAGE(PG8_SB(0, 1), cB + hstepB, voffB); PG8_STAGE(PG8_SA(0, 1), cA + hstep, voffA);
    if (wr == 1) PG8_BAR;
    PG8_WAIT_V(4); PG8_BAR;
    PG8_STAGE(PG8_SB(1, 0), cB + kstep, voffB); PG8_STAGE(PG8_SA(1, 0), cA + kstep, voffA); PG8_STAGE(PG8_SB(1, 1), cB + hstepB + kstep, voffB);
    PG8_WAIT_V(6); PG8_BAR;
    }
    for (;;) {
        const bool has_next = S.next(ui + 1, nxt);
        const char* nA = has_next ? S.a_ptr(nxt) : cA; const char* nB = has_next ? S.b_ptr(nxt) : cB;
        for (int t = 0; t < nt; t += 2) {
            const bool last = (t == nt - 2);
            const char* a1 = cA + (size_t)(t + 1) * kstep;
            const char* a2 = last ? nA : cA + (size_t)(t + 2) * kstep; const char* b2 = last ? nB : cB + (size_t)(t + 2) * kstep;
            const char* a3 = a2 + kstep; const char* b3 = b2 + kstep;
            if constexpr (GEMM_SP2) {
            PG8_LDB(B0, 0, 0); PG8_LDB(B1, 0, 1); PG8_SCHED; PG8_LDA(At, 0, 0); PG8_STAGE(PG8_SA(1, 1), a1 + hstep, voffA);
            PG8_WAIT_V(8); PG8_WAIT_L(0); PG8_BAR; PG8_MMA(0, 0, At, B0); PG8_MMA(0, 1, At, B1); PG8_BAR; PG8_SCHED;
            PG8_LDA(At, 0, 1); PG8_STAGE(PG8_SB(0, 0), b2, voffB); PG8_STAGE(PG8_SB(0, 1), b2 + hstepB, voffB); PG8_STAGE(PG8_SA(0, 0), a2, voffA);
            PG8_WAIT_V(8); PG8_WAIT_L(0); PG8_BAR; PG8_MMA(1, 0, At, B0); PG8_MMA(1, 1, At, B1); PG8_BAR; PG8_SCHED;
            PG8_LDB(B0, 1, 0); PG8_LDB(B1, 1, 1); PG8_SCHED; PG8_LDA(At, 1, 0); PG8_STAGE(PG8_SA(0, 1), a2 + hstep, voffA);
            PG8_WAIT_V(8); PG8_WAIT_L(0); PG8_BAR; PG8_MMA(0, 0, At, B0); PG8_MMA(0, 1, At, B1); PG8_BAR; PG8_SCHED;
            PG8_LDA(At, 1, 1); PG8_STAGE(PG8_SB(1, 0), b3, voffB); PG8_STAGE(PG8_SB(1, 1), b3 + hstepB, voffB); PG8_STAGE(PG8_SA(1, 0), a3, voffA);
            PG8_WAIT_V(8); PG8_WAIT_L(0); PG8_BAR; PG8_MMA(1, 0, At, B0); PG8_MMA(1, 1, At, B1); PG8_BAR; PG8_SCHED;
            } else {
            PG8_LDB(B0, 0, 0); PG8_SCHED; PG8_LDA(At, 0, 0); PG8_STAGE(PG8_SA(1, 1), a1 + hstep, voffA);
            PG8_WAIT_L(8); PG8_BAR; PG8_WAIT_L(0); PG8_MMA(0, 0, At, B0); PG8_BAR; PG8_SCHED;
            PG8_LDB(B1, 0, 1); PG8_STAGE(PG8_SB(0, 0), b2, voffB);
            PG8_BAR; PG8_WAIT_L(0); PG8_MMA(0, 1, At, B1); PG8_BAR;
            PG8_LDA(At, 0, 1); PG8_STAGE(PG8_SA(0, 0), a2, voffA);
            PG8_BAR; PG8_WAIT_L(0); PG8_MMA(1, 0, At, B0); PG8_BAR; PG8_SCHED;
            PG8_STAGE(PG8_SB(0, 1), b2 + hstepB, voffB);
            PG8_WAIT_V(6); PG8_BAR; PG8_MMA(1, 1, At, B1); PG8_BAR;
            PG8_LDB(B0, 1, 0); PG8_SCHED; PG8_LDA(At, 1, 0); PG8_STAGE(PG8_SA(0, 1), a2 + hstep, voffA);
            PG8_WAIT_L(8); PG8_BAR; PG8_WAIT_L(0); PG8_MMA(0, 0, At, B0); PG8_BAR; PG8_SCHED;
            PG8_LDB(B1, 1, 1); PG8_STAGE(PG8_SB(1, 0), b3, voffB);
            PG8_BAR; PG8_WAIT_L(0); PG8_MMA(0, 1, At, B1); PG8_BAR;
            PG8_LDA(At, 1, 1); PG8_STAGE(PG8_SA(1, 0), a3, voffA);
            PG8_BAR; PG8_WAIT_L(0); PG8_MMA(1, 0, At, B0); PG8_BAR; PG8_SCHED;
            PG8_STAGE(PG8_SB(1, 1), b3 + hstepB, voffB);
            PG8_WAIT_V(6); PG8_BAR; PG8_MMA(1, 1, At, B1); PG8_BAR;
            }
        }
        if constexpr (GEMM_ALIGN_EPI) { if (wr == 0) PG8_BAR; }
        if constexpr (Epi::FP8) asm volatile("s_nop 15\n\ts_nop 15" ::: "memory");
        E(acc, cur, wr, wc, fr, fq);
        if (!has_next) break;
#pragma unroll
        for (int a = 0; a < 2; ++a)
#pragma unroll
            for (int b = 0; b < 2; ++b)
#pragma unroll
                for (int m = 0; m < 4; ++m)
#pragma unroll
                    for (int n = 0; n < 2; ++n) acc[a][b][m][n] = (f32x4){0.f, 0.f, 0.f, 0.f};
        if constexpr (Epi::FP8) asm volatile("s_nop 7" ::: "memory");
        cur = nxt; cA = nA; cB = nB; ++ui;
        if constexpr (GEMM_ALIGN_EPI) { if (wr == 1) PG8_BAR; }
    }
    PG8_WAIT_V(0);
    if constexpr (!GEMM_ALIGN_EPI) { if (wr == 0) PG8_BAR; }
    PG8_BAR;
#undef PG8_SA
#undef PG8_SB
#undef PG8_STAGE
#undef PG8_LDA
#undef PG8_LDB
#undef PG8_MMA
#undef PG8_LD8
#undef PG8_LO
#undef PG8_HI
#undef PG8_WAIT_V
#undef PG8_WAIT_L
#undef PG8_BAR
#undef PG8_SCHED
}
}
using pg8::Unit;

extern __shared__ __attribute__((aligned(16))) char smem[];
__device__ __forceinline__ char* smem_base() { return smem; }

constexpr int EPI_LDS = 131072;
__device__ __forceinline__ char* epi_slot(int wr, int wc) { return smem_base() + EPI_LDS + (wr * 4 + wc) * 2048; }
__device__ __forceinline__ void slot_put(char* slot, int fr, int fq, u32x4 w0, u32x4 w1) {
    *(u32x4*)(slot + fr * 128 + (((fq) ^ (fr & 7)) << 4)) = w0; *(u32x4*)(slot + fr * 128 + (((4 + fq) ^ (fr & 7)) << 4)) = w1; }
__device__ __forceinline__ u32x4 slot_get(const char* slot, int half, int lane) { const int row = half * 8 + (lane >> 3), ch = lane & 7; return *(const u32x4*)(slot + row * 128 + ((ch ^ (row & 7)) << 4)); }

#define EPI_ROWS(ai, m) for (int ai = 0; ai < 2; ++ai) _Pragma("unroll") for (int m = 0; m < 4; ++m)

struct EpiProj {
    static constexpr bool PERM = true, FP8 = false;
    unsigned char* ws;
    __device__ __forceinline__ void operator()(const f32x4 (&acc)[2][2][4][2], const Unit& u, int wr, int wc, int fr, int fq) const {
        const int pn = u.pn; const int lane = fq * 16 + fr; char* slot = epi_slot(wr, wc);
        const int rowq = u.pm * 256 + wr * 64 + (lane >> 3);
        if (pn < 12 || (pn >= 30 && pn < 38)) {
            size_t boff; int ld, col0, act;
            if (pn < 2) { boff = WS_GQ; ld = 512; col0 = pn * 256; act = 0; }
            else if (pn < 4) { boff = WS_GK; ld = 512; col0 = (pn - 2) * 256; act = 0; }
            else if (pn < 8) { boff = WS_GV; ld = 1024; col0 = (pn - 4) * 256; act = 0; }
            else if (pn < 12) { boff = WS_GR; ld = 1024; col0 = (pn - 8) * 256; act = 1; }
            else if (pn < 34) { boff = WS_SG; ld = 1024; col0 = (pn - 30) * 256; act = 2; }
            else { boff = WS_SA; ld = 1024; col0 = (pn - 34) * 256; act = 2; }
            bf16_t* base = (bf16_t*)(ws + boff) + col0 + wc * 64 + (lane & 7) * 8;
#pragma unroll
            EPI_ROWS(ai, m) { u32x4 w[2];
#pragma unroll
                for (int bj = 0; bj < 2; ++bj) { float v[8];
#pragma unroll
                    for (int j = 0; j < 4; ++j) { v[j] = acc[ai][bj][m][0][j]; v[4 + j] = acc[ai][bj][m][1][j]; }
                    if (act == 1) {
#pragma unroll
                        for (int j = 0; j < 8; ++j) v[j] = v[j] * sigmoidf_(v[j]); }
                    if (act == 2) {
#pragma unroll
                        for (int j = 0; j < 8; ++j) v[j] = sigmoidf_(v[j]); }
                    w[bj] = pack8(v); }
                slot_put(slot, fr, fq, w[0], w[1]);
#pragma unroll
                for (int half = 0; half < 2; ++half) st_nt(base + (size_t)(rowq + ai * 128 + m * 16 + half * 8) * ld, slot_get(slot, half, lane)); }
        } else if (pn < 30) {
            const int which = (pn - 12) / 6, t6 = (pn - 12) % 6, sh = (t6 >> 1) * 2, dmask = (1 << sh) - 1, NL = SEQ >> sh;
            bf16_t* base = (bf16_t*)(ws + WS_AQ + (size_t)which * ((size_t)NTOK * 1536 * 2)) + (lane & 7) * 8;
            const bool rot = (which < 2) && (fq < 2);
            f32x4 frev;
#pragma unroll
            for (int q = 0; q < 4; ++q) frev[q] = rot ? __builtin_amdgcn_exp2f(-(float)(4 * fq + q) * (0.125f * 18.931568569324174f)) * 0.15915494309189535f : 0.f;
            const float sc = which == 0 ? QSCALE : 1.0f;
            const int head = t6 * 4 + wc;
#pragma unroll
            EPI_ROWS(ai, m) { const int s = (u.pm * 256 + wr * 64 + fr + ai * 128 + m * 16) & (SEQ - 1);
                f32x4 cs, sn;
#pragma unroll
                for (int q = 0; q < 4; ++q) { const float rev = __builtin_amdgcn_fractf((float)s * frev[q]); cs[q] = __builtin_amdgcn_cosf(rev); sn[q] = __builtin_amdgcn_sinf(rev); }
                u32x4 w[2];
#pragma unroll
                for (int bj = 0; bj < 2; ++bj) { float v[8];
#pragma unroll
                    for (int j = 0; j < 4; ++j) { v[j] = acc[ai][bj][m][0][j]; v[4 + j] = acc[ai][bj][m][1][j]; }
                    if (bj == 0) { const float a0 = v[0] * cs[0] - v[1] * sn[0], a1 = v[1] * cs[0] + v[0] * sn[0], a2 = v[2] * cs[1] - v[3] * sn[1], a3 = v[3] * cs[1] + v[2] * sn[1];
                      const float a4 = v[4] * cs[2] - v[5] * sn[2], a5 = v[5] * cs[2] + v[4] * sn[2], a6 = v[6] * cs[3] - v[7] * sn[3], a7 = v[7] * cs[3] + v[6] * sn[3];
                      v[0] = a0; v[1] = a1; v[2] = a2; v[3] = a3; v[4] = a4; v[5] = a5; v[6] = a6; v[7] = a7; }
#pragma unroll
                    for (int j = 0; j < 8; ++j) v[j] *= sc;
                    w[bj] = pack8(v); }
                slot_put(slot, fr, fq, w[0], w[1]);
#pragma unroll
                for (int half = 0; half < 2; ++half) { const int row = rowq + ai * 128 + m * 16 + half * 8, b = row >> 12, s2 = row & (SEQ - 1), r = s2 & dmask, n = s2 >> sh;
                    st_nt(base + ((size_t)(b * 24 + head) * SEQ + (size_t)r * NL + n) * 64, slot_get(slot, half, lane)); } }
        } else {
            const int row0 = u.pm * 256 + wr * 64 + fr;
            if (wc == 0 && fq < 2) { float* glr = (float*)(ws + WS_GLR);
#pragma unroll
                EPI_ROWS(ai, m) { float* rowp = glr + (size_t)(row0 + ai * 128 + m * 16) * 16 + 8 * fq; *(f32x4*)rowp = acc[ai][0][m][0]; *(f32x4*)(rowp + 4) = acc[ai][0][m][1]; } }
        }
    }
};

template <int MODE> struct EpiGate {
    static constexpr bool PERM = true, FP8 = false;
    const bf16_t* gate; const bf16_t* t1; bf16_t* out;
    __device__ __forceinline__ void operator()(const f32x4 (&acc)[2][2][4][2], const Unit& u, int wr, int wc, int fr, int fq) const {
        const int lane = fq * 16 + fr; char* slot = epi_slot(wr, wc);
        const size_t off0 = (size_t)(u.pm * 256 + wr * 64 + (lane >> 3)) * 1024 + u.pn * 256 + wc * 64 + (lane & 7) * 8;
#pragma unroll
        for (int ai = 0; ai < 2; ++ai) { u32x4 gw[4][2], tw[4][2];
#pragma unroll
            for (int m = 0; m < 4; ++m)
#pragma unroll
                for (int half = 0; half < 2; ++half) { const size_t off = off0 + (size_t)(ai * 128 + m * 16 + half * 8) * 1024; gw[m][half] = *(const u32x4*)(gate + off); if (MODE == 1) tw[m][half] = *(const u32x4*)(t1 + off); }
#pragma unroll
            for (int m = 0; m < 4; ++m) { u32x4 w[2];
#pragma unroll
                for (int bj = 0; bj < 2; ++bj) { float v[8];
#pragma unroll
                    for (int j = 0; j < 4; ++j) { v[j] = acc[ai][bj][m][0][j]; v[4 + j] = acc[ai][bj][m][1][j]; }
                    w[bj] = pack8(v); }
                slot_put(slot, fr, fq, w[0], w[1]);
#pragma unroll
                for (int half = 0; half < 2; ++half) { float a[8], g[8]; unpack8(slot_get(slot, half, lane), a); unpack8(gw[m][half], g);
#pragma unroll
                    for (int j = 0; j < 8; ++j) a[j] *= g[j];
                    if (MODE == 1) { float t[8]; unpack8(tw[m][half], t);
#pragma unroll
                        for (int j = 0; j < 8; ++j) a[j] += t[j]; }
                    *(u32x4*)(out + off0 + (size_t)(ai * 128 + m * 16 + half * 8) * 1024) = pack8(a); } } }
    }
};

struct EpiResid {
    static constexpr bool PERM = false, FP8 = false;
    const float* x; float* h;
    __device__ __forceinline__ void operator()(const f32x4 (&acc)[2][2][4][2], const Unit& u, int wr, int wc, int fr, int fq) const {
        const int lane = fq * 16 + fr; char* slot = epi_slot(wr, wc);
        const size_t off0 = (size_t)(u.pm * 256 + wr * 64 + (lane >> 3)) * 1024 + u.pn * 256 + wc * 32 + (lane & 7) * 4;
#pragma unroll
        for (int ai = 0; ai < 2; ++ai)
#pragma unroll
            for (int bj = 0; bj < 2; ++bj) { f32x4 xv[4][2];
#pragma unroll
                for (int m = 0; m < 4; ++m)
#pragma unroll
                    for (int half = 0; half < 2; ++half) xv[m][half] = *(const f32x4*)(x + off0 + (size_t)(ai * 128 + m * 16 + half * 8) * 1024 + bj * 128);
#pragma unroll
                for (int m = 0; m < 4; ++m) { slot_put(slot, fr, fq, __builtin_bit_cast(u32x4, acc[ai][bj][m][0]), __builtin_bit_cast(u32x4, acc[ai][bj][m][1]));
#pragma unroll
                    for (int half = 0; half < 2; ++half) { const f32x4 a = __builtin_bit_cast(f32x4, slot_get(slot, half, lane));
                        *(f32x4*)(h + off0 + (size_t)(ai * 128 + m * 16 + half * 8) * 1024 + bj * 128) = a + xv[m][half]; } } }
    }
};

struct EpiAct {
    static constexpr bool PERM = true, FP8 = true;
    const float* bgu; const int* tile_e; unsigned char* act;
    __device__ __forceinline__ void operator()(const f32x4 (&acc)[2][2][4][2], const Unit& u, int wr, int wc, int fr, int fq) const {
        const int e = tile_e[u.pm]; const int row0 = u.pm * 256 + wr * 64 + fr; const int j0 = u.pn * 128 + wc * 32 + 8 * fq;
        float bg[8], bu[8];
        { const float* bp = bgu + (size_t)e * 2048 + 2 * j0;
#pragma unroll
          for (int q = 0; q < 4; ++q) { const f32x4 t = *(const f32x4*)(bp + 4 * q); bg[2 * q] = t[0]; bu[2 * q] = t[1]; bg[2 * q + 1] = t[2]; bu[2 * q + 1] = t[3]; } }
#pragma unroll
        EPI_ROWS(ai, m) { float v[8];
#pragma unroll
            for (int j = 0; j < 8; ++j) { const float gt = acc[ai][0][m][j >> 2][j & 3] + bg[j], up = acc[ai][1][m][j >> 2][j & 3] + bu[j];
                const float g = fminf(gt, 7.0f), uu = fminf(fmaxf(up, -7.0f), 7.0f); v[j] = (uu + 1.0f) * (g * sigmoidf_(1.702f * g)); }
            u32x2 w8; w8.x = (unsigned)pk4_fp8(v[0], v[1], v[2], v[3]); w8.y = (unsigned)pk4_fp8(v[4], v[5], v[6], v[7]);
            *(u32x2*)(act + (size_t)(row0 + ai * 128 + m * 16) * 1024 + j0) = w8; }
    }
};

struct EpiDown {
    static constexpr bool PERM = true, FP8 = true;
    const float* bd; const int* tile_e; unsigned char* y;
    __device__ __forceinline__ void operator()(const f32x4 (&acc)[2][2][4][2], const Unit& u, int wr, int wc, int fr, int fq) const {
        const int e = tile_e[u.pm]; const int lane = fq * 16 + fr; char* slot = epi_slot(wr, wc); const int col0 = u.pn * 256 + wc * 64 + 8 * fq;
        f32x4 b[2][2];
#pragma unroll
        for (int bj = 0; bj < 2; ++bj)
#pragma unroll
            for (int n = 0; n < 2; ++n) b[bj][n] = *(const f32x4*)(bd + (size_t)e * 1024 + col0 + bj * 32 + 4 * n);
        unsigned char* base = y + (size_t)(u.pm * 256 + wr * 64 + (lane >> 2)) * 1024 + u.pn * 256 + wc * 64 + (lane & 3) * 16;
#pragma unroll
        EPI_ROWS(ai, m) { u32x2 w[2];
#pragma unroll
            for (int bj = 0; bj < 2; ++bj) { const f32x4 v0 = acc[ai][bj][m][0] + b[bj][0], v1 = acc[ai][bj][m][1] + b[bj][1];
                w[bj].x = (unsigned)pk4_fp8(v0[0], v0[1], v0[2], v0[3]); w[bj].y = (unsigned)pk4_fp8(v1[0], v1[1], v1[2], v1[3]); }
            *(u32x2*)(slot + fr * 64 + 8 * fq) = w[0]; *(u32x2*)(slot + fr * 64 + 32 + 8 * fq) = w[1];
            const u32x4 o = *(const u32x4*)(slot + (lane >> 2) * 64 + (lane & 3) * 16);
            *(u32x4*)(base + (size_t)(ai * 128 + m * 16) * 1024) = o; }
    }
};

__device__ __forceinline__ int win_colmap(int n) {
    if (n < 3072) return n;
    if (n < 7680) { const int off = n - 3072, which = off / 1536, hcol = off % 1536, head = hcol >> 6, p = hcol & 63;
        int dim = p; if (which < 2 && p < 16) dim = (p & 1) ? (p >> 1) + 8 : (p >> 1);
        return 3088 + which * 1536 + head * 64 + dim; }
    if (n < 9728) return 7696 + (n - 7680);
    if (n < 9744) return 3072 + (n - 9728);
    return -1;
}
__device__ __forceinline__ int gu_colmap(int n) { const int t = n >> 8, w = n & 255, wc = w >> 6, bj = (w >> 5) & 1, rho = w & 31; return 2 * (128 * t + 32 * wc + rho) + bj; }

__device__ __forceinline__ void transpose_tile(const float* src, int ld_src, bf16_t* dst, int K, int n0, int k0, int scol, char* lds) {
    const int t = tid_(), nl = t & 127, kq = t >> 7;
#pragma unroll
    for (int cc = 0; cc < 4; ++cc) { const int c = kq * 4 + cc; float v[8];
#pragma unroll
        for (int j = 0; j < 8; ++j) v[j] = scol >= 0 ? src[(size_t)(k0 + c * 8 + j) * ld_src + scol] : 0.f;
        *(u32x4*)(lds + nl * 256 + ((c ^ (nl & 15)) << 4)) = pack8(v); }
    __syncthreads();
#pragma unroll
    for (int pass = 0; pass < 4; ++pass) { const int idx = t + 512 * pass, n2 = idx >> 4, c2 = idx & 15;
        *(u32x4*)(dst + (size_t)(n0 + n2) * K + k0 + c2 * 8) = *(const u32x4*)(lds + n2 * 256 + ((c2 ^ (n2 & 15)) << 4)); }
    __syncthreads();
}

__device__ __forceinline__ void transpose_tile8(const float* src, int ld_src, unsigned char* dst, int K, int n0, int k0, int scol, float scale, char* lds) {
    const int t = tid_(), nl = t & 127, kq = t >> 7;
#pragma unroll
    for (int cc = 0; cc < 4; ++cc) { const int c = kq * 4 + cc; float v[16];
#pragma unroll
        for (int j = 0; j < 16; ++j) v[j] = src[(size_t)(k0 + c * 16 + j) * ld_src + scol] * scale;
        u32x4 w; w.x = (unsigned)pk4_fp8(v[0], v[1], v[2], v[3]); w.y = (unsigned)pk4_fp8(v[4], v[5], v[6], v[7]); w.z = (unsigned)pk4_fp8(v[8], v[9], v[10], v[11]); w.w = (unsigned)pk4_fp8(v[12], v[13], v[14], v[15]);
        *(u32x4*)(lds + nl * 256 + ((c ^ (nl & 15)) << 4)) = w; }
    __syncthreads();
#pragma unroll
    for (int pass = 0; pass < 4; ++pass) { const int idx = t + 512 * pass, n2 = idx >> 4, c2 = idx & 15;
        *(u32x4*)(dst + (size_t)(n0 + n2) * K + k0 + c2 * 16) = *(const u32x4*)(lds + n2 * 256 + ((c2 ^ (n2 & 15)) << 4)); }
    __syncthreads();
}

template <int MAP> __device__ __forceinline__ int tile_rowmap(int o) {
    if (MAP == 1) { const int d = o & 63; const int pp = d < 16 ? (d < 8 ? 2 * d : 2 * (d - 8) + 1) : d; return (o & 64) + pp; }
    if (MAP == 2) { const int wcl = o >> 6, w = o & 63; return 64 * wcl + 32 * (w & 1) + (w >> 1); }
    return o;
}
template <int MAP, bool F8> __device__ __forceinline__ void transpose_fast(const float* src  , int ld_src, unsigned char* dst, int Kb  , int n0, int k0, float scale, char* lds) {
    constexpr int KPT = F8 ? 16 : 8;
    const int t = tid_(), ng = t & 31, kg = t >> 5;
    f32x4 v[KPT];
#pragma unroll
    for (int j = 0; j < KPT; ++j) v[j] = *(const f32x4*)(src + (size_t)(k0 + kg * KPT + j) * ld_src + 4 * ng);
#pragma unroll
    for (int i = 0; i < 4; ++i) { const int row = tile_rowmap<MAP>(4 * ng + i); u32x4 w;
        if (F8) { w.x = (unsigned)pk4_fp8(v[0][i] * scale, v[1][i] * scale, v[2][i] * scale, v[3][i] * scale); w.y = (unsigned)pk4_fp8(v[4][i] * scale, v[5][i] * scale, v[6][i] * scale, v[7][i] * scale);
                  w.z = (unsigned)pk4_fp8(v[8 % KPT][i] * scale, v[9 % KPT][i] * scale, v[10 % KPT][i] * scale, v[11 % KPT][i] * scale); w.w = (unsigned)pk4_fp8(v[12 % KPT][i] * scale, v[13 % KPT][i] * scale, v[14 % KPT][i] * scale, v[15 % KPT][i] * scale); }
        else { w.x = cvt_pk_bf16(v[0][i], v[1][i]); w.y = cvt_pk_bf16(v[2][i], v[3][i]); w.z = cvt_pk_bf16(v[4][i], v[5][i]); w.w = cvt_pk_bf16(v[6][i], v[7][i]); }
        *(u32x4*)(lds + row * 256 + ((kg ^ (row & 15)) << 4)) = w; }
    __syncthreads();
#pragma unroll
    for (int pass = 0; pass < 4; ++pass) { const int idx = t + 512 * pass, n2 = idx >> 4, c2 = idx & 15;
        *(u32x4*)(dst + (size_t)(n0 + n2) * Kb + (size_t)k0 * (F8 ? 1 : 2) + c2 * 16) = *(const u32x4*)(lds + n2 * 256 + ((c2 ^ (n2 & 15)) << 4)); }
    __syncthreads();
}

__device__ __forceinline__ void phase_prologue(const Params& p, char* lds) {
    unsigned char* ws = opaque(p.ws);
    const int tid = tid_(), lane = tid & 63, wid = tid >> 6, G = gridDim.x, bid = blockIdx.x;
    { bf16_t* xn = (bf16_t*)(ws + WS_XN);
      for (int row = bid * 8 + wid; row < NTOK; row += G * 8) { const float* xr = p.x + (size_t)row * 1024; f32x4 v[4]; float ss = 0.f;
#pragma unroll
          for (int i = 0; i < 4; ++i) { v[i] = *(const f32x4*)(xr + i * 256 + lane * 4); ss += v[i][0] * v[i][0] + v[i][1] * v[i][1] + v[i][2] * v[i][2] + v[i][3] * v[i][3]; }
          ss = wave_sum(ss); const float rs = rsqrtf(ss * (1.0f / 1024.0f) + EPS);
#pragma unroll
          for (int i = 0; i < 4; ++i) { const f32x4 g = *(const f32x4*)(p.norm_mix_g + i * 256 + lane * 4); u32x2 w; w.x = cvt_pk_bf16(v[i][0] * rs * g[0], v[i][1] * rs * g[1]); w.y = cvt_pk_bf16(v[i][2] * rs * g[2], v[i][3] * rs * g[3]);
              *(u32x2*)(xn + (size_t)row * 1024 + i * 256 + lane * 4) = w; } } }
    { float* rc = (float*)(ws + WS_ROPE_C); float* rsn = (float*)(ws + WS_ROPE_S); float* rwg = (float*)(ws + WS_RWG);
      for (int i = bid * 512 + tid; i < SEQ * 8; i += G * 512) { const int s = i >> 3, f = i & 7; const double inv = pow(500000.0, -(double)f * 0.125); const float ang = (float)s * (float)inv; rc[i] = (float)cos((double)ang); rsn[i] = (float)sin((double)ang); }
      for (int i = bid * 512 + tid; i < 1024 * 32; i += G * 512) rwg[i] = p.router_w[i] * p.norm_ffn_g[i >> 5]; }
    { constexpr int T0 = 78 * 8, T1 = T0 + 64, T2 = T1 + 32, T3 = T2 + 64, T4 = T3 + 32 * 64, T5 = T4 + 32 * 32;
      const int nl = tid & 127;
      for (int tile = bid; tile < T3; tile += G) {
          if (tile < T0) { const int nt_ = tile >> 3, kt = tile & 7; bf16_t* d = (bf16_t*)(ws + WS_W_IN); unsigned char* d8 = ws + WS_W_IN;
              if (nt_ < 24) transpose_fast<0, false>(p.w_in + nt_ * 128, INW, d8, 2048, nt_ * 128, kt * 128, 1.f, lds);
              else if (nt_ < 48) transpose_fast<1, false>(p.w_in + 3088 + (nt_ - 24) * 128, INW, d8, 2048, nt_ * 128, kt * 128, 1.f, lds);
              else if (nt_ < 60) transpose_fast<0, false>(p.w_in + 3088 + (nt_ - 24) * 128, INW, d8, 2048, nt_ * 128, kt * 128, 1.f, lds);
              else if (nt_ < 76) transpose_fast<0, false>(p.w_in + 7696 + (nt_ - 60) * 128, INW, d8, 2048, nt_ * 128, kt * 128, 1.f, lds);
              else transpose_tile(p.w_in, INW, d, 1024, nt_ * 128, kt * 128, win_colmap(nt_ * 128 + nl), lds); }
          else if (tile < T1) { const int q = tile - T0, nt_ = q >> 3, kt = q & 7; transpose_fast<0, false>(p.w_branch_gla + nt_ * 128, 1024, ws + WS_W_G, 2048, nt_ * 128, kt * 128, 1.f, lds); }
          else if (tile < T2) { const int q = tile - T1, nt_ = q >> 2, kt = q & 3; transpose_fast<0, false>(p.w_branch_att + nt_ * 128, 1024, ws + WS_W_A, 1024, nt_ * 128, kt * 128, 1.f, lds); }
          else if (tile < T3) { const int q = tile - T2, nt_ = q >> 3, kt = q & 7; transpose_fast<0, false>(p.w_mix_out + nt_ * 128, 1024, ws + WS_W_MIX, 2048, nt_ * 128, kt * 128, 1.f, lds); }
      } }
}

constexpr int N_EXPERT_TILES = 32 * 64 + 32 * 32;
__device__ __forceinline__ void expert_convert(const Params& p, char* lds, int first, int stride) {
    unsigned char* ws = opaque(p.ws);
    for (int q0 = first; q0 < N_EXPERT_TILES; q0 += stride) {
        if (q0 < 32 * 64) { const int q = q0, e = q >> 6, r = q & 63, nt_ = r >> 2, kt = r & 3;
            transpose_fast<2, true>(p.e_w_gu + (size_t)e * 1024 * 2048 + nt_ * 128, 2048, ws + WS_W_GU + (size_t)e * 2048 * 1024, 1024, nt_ * 128, kt * 256, 32.0f, lds); }
        else { const int q = q0 - 32 * 64, e = q >> 5, r = q & 31, nt_ = r >> 2, kt = r & 3;
            transpose_fast<0, true>(p.e_w_d + (size_t)e * 1024 * 1024 + nt_ * 128, 1024, ws + WS_W_D + (size_t)e * 1024 * 1024, 1024, nt_ * 128, kt * 256, 32.0f, lds); }
    }
}

constexpr int AT_KCS = 385 * 16;
constexpr int AT_VH = 385 * 64;
constexpr int AT_K = 0, AT_V = 8 * AT_KCS, AT_WL = AT_V + 2 * AT_VH, AT_STG = AT_WL + 8 * 128, AT_END = AT_STG + 8 * 4096;
static_assert(AT_END <= LDS_BYTES, "attention LDS");
struct AttnPre { u32x4 k[6], v[6]; };
__device__ __forceinline__ void attn_fetch(const Params& p, int item, AttnPre& r) {
    unsigned char* ws = opaque(p.ws); const int tid = tid_();
    const int jj = item & 15, bh = item >> 4, head = bh % 24, g = head >> 3, sh = 2 * g, NL = SEQ >> sh, ppr = 16 >> sh; const int rr_ = jj / ppr, j = jj % ppr;
    const size_t hb = ((size_t)bh * SEQ + (size_t)rr_ * NL) * 64; const bf16_t* Kg = (const bf16_t*)(ws + WS_AK) + hb; const bf16_t* Vg = (const bf16_t*)(ws + WS_AV) + hb; const int kn0 = 256 * j - 128;
#pragma unroll
    for (int i = 0; i < 6; ++i) { const int idx = tid + 512 * i, key = idx >> 3, c = idx & 7;
        if (kn0 + key >= 0) { r.k[i] = *(const u32x4*)(Kg + (ptrdiff_t)(kn0 + key) * 64 + c * 8); r.v[i] = *(const u32x4*)(Vg + (ptrdiff_t)(kn0 + key) * 64 + c * 8); } }
}
__device__ __forceinline__ void attn_item(const Params& p, int item, int nitem, bool has_next, AttnPre& pre, char* lds) {
    unsigned char* ws = opaque(p.ws);
    const int tid = tid_(), lane = tid & 63, r32 = lane & 31, hi = lane >> 5; const int w = __builtin_amdgcn_readfirstlane(tid >> 6);
    const int jj = item & 15, bh = item >> 4, head = bh % 24, b = bh / 24, g = head >> 3, sh = 2 * g, d = 1 << sh, NL = SEQ >> sh, ppr = 16 >> sh;
    const int r = jj / ppr, j = jj % ppr;
    const size_t hb = ((size_t)bh * SEQ + (size_t)r * NL) * 64;
    const bf16_t* Q = (const bf16_t*)(ws + WS_AQ) + hb;
    const int kn0 = 256 * j - 128;
    bf16x8 qf[4];
#pragma unroll
    for (int d0 = 0; d0 < 4; ++d0) qf[d0] = *(const bf16x8*)(Q + (size_t)(256 * j + 32 * w + r32) * 64 + d0 * 16 + hi * 8);
#pragma unroll
    for (int i = 0; i < 6; ++i) { const int idx = tid + 512 * i, key = idx >> 3, c = idx & 7;
        if (kn0 + key >= 0) { *(u32x4*)(lds + AT_K + c * AT_KCS + key * 16) = pre.k[i]; *(u32x4*)(lds + AT_V + (c >> 2) * AT_VH + key * 64 + (c & 3) * 16) = pre.v[i]; } }
    __syncthreads();
    if (has_next) attn_fetch(p, nitem, pre);
    const LDS3 char* l3 = (const LDS3 char*)lds;
    f32x16 s[5]; const int ktmin = (j == 0) ? 4 : 0;
#pragma unroll
    for (int t5 = 0; t5 < 5; ++t5) { const int kt = w + t5;
        if (kt >= ktmin) { f32x16 a = {};
#pragma unroll
            for (int d0 = 0; d0 < 4; ++d0) { const bf16x8 kf = *(const LDS3 bf16x8*)(l3 + AT_K + (2 * d0 + hi) * AT_KCS + (kt * 32 + r32) * 16); a = MFMA32(kf, qf[d0], a); }
            s[t5] = a; }
        else {
#pragma unroll
            for (int rr = 0; rr < 16; ++rr) s[t5][rr] = -1e30f; } }
#pragma unroll
    for (int rr = 0; rr < 16; ++rr) { const int c = crow(rr, hi); if (c < r32) s[0][rr] = -1e30f; if (c > r32) s[4][rr] = -1e30f; }
    float mx = -1e30f;
#pragma unroll
    for (int t5 = 0; t5 < 5; ++t5)
#pragma unroll
        for (int rr = 0; rr < 16; ++rr) mx = fmaxf(mx, s[t5][rr]);
    mx = fmaxf(mx, __shfl_xor(mx, 32));
    float l = 0.f;
#pragma unroll
    for (int t5 = 0; t5 < 5; ++t5)
#pragma unroll
        for (int rr = 0; rr < 16; ++rr) { const float e = __builtin_amdgcn_exp2f(s[t5][rr] - mx); s[t5][rr] = e; l += e; }
    l += __shfl_xor(l, 32);
    f32x16 o[2]; o[0] = f32x16{}; o[1] = f32x16{};
    const int blk = (lane >> 4) & 1, q4 = (lane & 15) >> 2, p4 = lane & 3;
#pragma unroll
    for (int t5 = 0; t5 < 5; ++t5) { const int kt = w + t5;
        if (kt >= ktmin) {
#pragma unroll
            for (int ss = 0; ss < 2; ++ss) { float pv[8];
#pragma unroll
                for (int q = 0; q < 8; ++q) pv[q] = s[t5][8 * ss + q];
                const bf16x8 pa = __builtin_bit_cast(bf16x8, pack8(pv));
#pragma unroll
                for (int dh = 0; dh < 2; ++dh) { const LDS3 char* vp = l3 + AT_V + dh * AT_VH + (kt * 32 + 16 * ss + 4 * hi + q4) * 64 + (16 * blk + 4 * p4) * 2;
                    const bf16x8 vf = cat8(tr16(vp), tr16(vp + 8 * 64)); o[dh] = MFMA32(pa, vf, o[dh]); } } } }
    const int n_q = 256 * j + 32 * w + r32; const int tok = b * SEQ + n_q * d + r;
    if (hi == 0) { ((float*)(ws + WS_LSE))[((size_t)g * NTOK + tok) * 8 + (head & 7)] = (mx + __builtin_amdgcn_logf(l)) * LN2;
        ((float*)(lds + AT_WL))[w * 32 + r32] = __builtin_amdgcn_rcpf(l); }
    bf16_t* stg = (bf16_t*)(lds + AT_STG) + w * 2048;
#pragma unroll
    for (int rr = 0; rr < 16; ++rr) { const int qr = crow(rr, hi); const float rl = ((const float*)(lds + AT_WL))[w * 32 + qr];
#pragma unroll
        for (int dh = 0; dh < 2; ++dh) stg[qr * 64 + dh * 32 + r32] = (bf16_t)(cvt_pk_bf16(o[dh][rr] * rl, 0.f) & 0xffffu); }
    bf16_t* og = (bf16_t*)(ws + WS_OATT) + (size_t)g * NTOK * 512;
#pragma unroll
    for (int i = 0; i < 4; ++i) { const int idx = i * 64 + lane, row = idx >> 3, ch = idx & 7; const int tk = b * SEQ + (256 * j + 32 * w + row) * d + r;
        *(u32x4*)(og + (size_t)tk * 512 + (head & 7) * 64 + ch * 8) = *(const u32x4*)(stg + row * 64 + ch * 8); }
    __syncthreads();
}

constexpr int G1_BB = 0;
constexpr int G1_QE = G1_BB + 64 * 128 * 4;
constexpr int G1_KE = G1_QE + 64 * 272;
constexpr int G1_KD = G1_KE + 64 * 272;
constexpr int G1_V = G1_KD + 64 * 320;
constexpr int G1_GLR = G1_V + 64 * 576;
constexpr int G1_GUP = G1_GLR + 64 * 16 * 4;
constexpr int G1_SEG = G1_GUP + 16 * 128 * 4;
constexpr int G1_BIAS = G1_SEG + 4 * 128 * 4;
constexpr int G1_END = G1_BIAS + 128 * 4;
constexpr int G1_SU = 0;
constexpr int G1_SO = 128 * 528;
static_assert(G1_SO + 64 * 528 <= G1_GLR, "gla1 staging");
static_assert(G1_END <= LDS_BYTES, "gla1 LDS");
__device__ __forceinline__ float logsigmoidf_(float z) { return fminf(z, 0.f) - log1pf(__expf(-fabsf(z))); }
__device__ __forceinline__ void gla1_item(const Params& p, int item, char* lds) {
    unsigned char* ws = opaque(p.ws);
    const int tid = tid_(), lane = tid & 63, r32 = lane & 31, hi = lane >> 5; const int w = __builtin_amdgcn_readfirstlane(tid >> 6);
    const int n = item & 63, bh = item >> 6, h = bh & 3, b = bh >> 2; const int tok0 = b * SEQ + n * 64;
    float* BB = (float*)(lds + G1_BB); float* GLRs = (float*)(lds + G1_GLR); float* GUP = (float*)(lds + G1_GUP); float* SEGs = (float*)(lds + G1_SEG); float* BIAS = (float*)(lds + G1_BIAS);
    for (int i = tid; i < 64 * 16; i += 512) GLRs[i] = ((const float*)(ws + WS_GLR))[(size_t)tok0 * 16 + i];
    for (int i = tid; i < 16 * 128; i += 512) GUP[i] = p.gla_gate_up[(i >> 7) * 512 + h * 128 + (i & 127)];
    if (tid < 128) BIAS[tid] = p.gla_gate_bias[h * 128 + tid];
    __syncthreads();
    { const int d = tid & 127, seg = tid >> 7; float gu[16];
#pragma unroll
      for (int r = 0; r < 16; ++r) gu[r] = GUP[r * 128 + d];
      const float bias = BIAS[d]; float run = 0.f;
#pragma unroll 4
      for (int ii = 0; ii < 16; ++ii) { const int i = seg * 16 + ii; float z = bias;
#pragma unroll
          for (int r4 = 0; r4 < 4; ++r4) { const f32x4 gl = *(const f32x4*)(GLRs + i * 16 + r4 * 4); z += gl[0] * gu[r4 * 4] + gl[1] * gu[r4 * 4 + 1] + gl[2] * gu[r4 * 4 + 2] + gl[3] * gu[r4 * 4 + 3]; }
          run += logsigmoidf_(z) * (1.0f / 16.0f); BB[i * 128 + d] = run; }
      SEGs[seg * 128 + d] = run;
      __syncthreads();
      float off = 0.f; for (int s2 = 0; s2 < seg; ++s2) off += SEGs[s2 * 128 + d];
      if (seg > 0) { for (int ii = 0; ii < 16; ++ii) BB[(seg * 16 + ii) * 128 + d] += off; }
      __syncthreads(); }
    { const bf16_t* gq = (const bf16_t*)(ws + WS_GQ); const bf16_t* gk = (const bf16_t*)(ws + WS_GK); const bf16_t* gv = (const bf16_t*)(ws + WS_GV); bf16_t* qeg = (bf16_t*)(ws + WS_QE);
#pragma unroll
      for (int pp = 0; pp < 2; ++pp) { const int idx = tid + 512 * pp, i = idx >> 4, c = idx & 15, d0 = c * 8; const size_t go = (size_t)(tok0 + i) * 512 + h * 128 + d0;
          float q[8], k[8], qe[8], ke[8], kd[8]; unpack8(*(const u32x4*)(gq + go), q); unpack8(*(const u32x4*)(gk + go), k);
#pragma unroll
          for (int j = 0; j < 8; ++j) { const float bb = BB[i * 128 + d0 + j], bl = BB[63 * 128 + d0 + j]; qe[j] = q[j] * __expf(bb) * 0.08838834764831845f; ke[j] = k[j] * __expf(-bb); kd[j] = k[j] * __expf(bl - bb); }
          const u32x4 qw = pack8(qe); *(u32x4*)(lds + G1_QE + i * 272 + c * 16) = qw; *(u32x4*)(qeg + go) = qw;
          *(u32x4*)(lds + G1_KE + i * 272 + c * 16) = pack8(ke); *(u32x4*)(lds + G1_KD + i * 320 + c * 16) = pack8(kd); }
#pragma unroll
      for (int pp = 0; pp < 4; ++pp) { const int idx = tid + 512 * pp, jv = idx >> 5, c = idx & 31; *(u32x4*)(lds + G1_V + jv * 576 + c * 16) = *(const u32x4*)(gv + (size_t)(tok0 + jv) * 1024 + h * 256 + c * 8); }
      if (tid < 128) ((float*)(ws + WS_DEC))[(size_t)item * 128 + tid] = __expf(BB[63 * 128 + tid]);
      __syncthreads(); }
    const LDS3 char* l3 = (const LDS3 char*)lds; const int blk = (lane >> 4) & 1, q4 = (lane & 15) >> 2, p4 = lane & 3;
    {
      const int it = w & 1, vq = w >> 1; f32x16 oi[2]; oi[0] = f32x16{}; oi[1] = f32x16{};
#pragma unroll
      for (int jt = 0; jt < 2; ++jt) { if (jt <= it) { f32x16 x = {};
#pragma unroll
          for (int s = 0; s < 8; ++s) { const bf16x8 a = *(const LDS3 bf16x8*)(l3 + G1_KE + (jt * 32 + r32) * 272 + (16 * s + 8 * hi) * 2), bq = *(const LDS3 bf16x8*)(l3 + G1_QE + (it * 32 + r32) * 272 + (16 * s + 8 * hi) * 2); x = MFMA32(a, bq, x); }
          if (jt == it) {
#pragma unroll
              for (int rr = 0; rr < 16; ++rr) if (crow(rr, hi) > r32) x[rr] = 0.f; }
#pragma unroll
          for (int ss = 0; ss < 2; ++ss) { float xv[8];
#pragma unroll
              for (int q = 0; q < 8; ++q) xv[q] = x[8 * ss + q];
              const bf16x8 xa = __builtin_bit_cast(bf16x8, pack8(xv));
#pragma unroll
              for (int vi = 0; vi < 2; ++vi) { const int vt = 2 * vq + vi; const LDS3 char* vp = l3 + G1_V + (jt * 32 + 16 * ss + 4 * hi + q4) * 576 + (vt * 32 + 16 * blk + 4 * p4) * 2;
                  const bf16x8 vf = cat8(tr16(vp), tr16(vp + 8 * 576)); oi[vi] = MFMA32(xa, vf, oi[vi]); } } } }
      const int dt = w & 3, vg = w >> 2; f32x16 uu[4]; uu[0] = f32x16{}; uu[1] = f32x16{}; uu[2] = f32x16{}; uu[3] = f32x16{};
#pragma unroll
      for (int ks = 0; ks < 4; ++ks) { const LDS3 char* ap = l3 + G1_KD + (16 * ks + 8 * hi + q4) * 320 + (dt * 32 + 16 * blk + 4 * p4) * 2; const bf16x8 a = cat8(tr16(ap), tr16(ap + 4 * 320));
#pragma unroll
          for (int vi = 0; vi < 4; ++vi) { const int vt = 4 * vg + vi; const LDS3 char* vp = l3 + G1_V + (16 * ks + 8 * hi + q4) * 576 + (vt * 32 + 16 * blk + 4 * p4) * 2; const bf16x8 vf = cat8(tr16(vp), tr16(vp + 4 * 576)); uu[vi] = MFMA32(a, vf, uu[vi]); } }
      __syncthreads();
      bf16_t* SU = (bf16_t*)(lds + G1_SU); bf16_t* SO = (bf16_t*)(lds + G1_SO);
#pragma unroll
      for (int vi = 0; vi < 4; ++vi)
#pragma unroll
          for (int rr = 0; rr < 16; ++rr) SU[(dt * 32 + crow(rr, hi)) * 264 + (4 * vg + vi) * 32 + r32] = (bf16_t)(cvt_pk_bf16(uu[vi][rr], 0.f) & 0xffffu);
#pragma unroll
      for (int vi = 0; vi < 2; ++vi)
#pragma unroll
          for (int rr = 0; rr < 16; ++rr) SO[(it * 32 + crow(rr, hi)) * 264 + (2 * vq + vi) * 32 + r32] = (bf16_t)(cvt_pk_bf16(oi[vi][rr], 0.f) & 0xffffu);
      __syncthreads();
      bf16_t* ug = (bf16_t*)(ws + WS_U) + (size_t)item * 128 * 256; bf16_t* og = (bf16_t*)(ws + WS_OINTRA);
#pragma unroll
      for (int pp = 0; pp < 8; ++pp) { const int idx = tid + 512 * pp, row = idx >> 5, c = idx & 31; *(u32x4*)(ug + (size_t)row * 256 + c * 8) = *(const u32x4*)(SU + row * 264 + c * 8); }
#pragma unroll
      for (int pp = 0; pp < 4; ++pp) { const int idx = tid + 512 * pp, row = idx >> 5, c = idx & 31; *(u32x4*)(og + (size_t)(tok0 + row) * 1024 + h * 256 + c * 8) = *(const u32x4*)(SO + row * 264 + c * 8); } }
    __syncthreads();
}

__device__ __forceinline__ void phase_scan_combine(const Params& p) {
    unsigned char* ws = opaque(p.ws); const int G = gridDim.x;
    { const bf16_t* U = (const bf16_t*)(ws + WS_U); bf16_t* PV = (bf16_t*)(ws + WS_PREV); const float* DEC = (const float*)(ws + WS_DEC);
      for (int idx = blockIdx.x * 512 + tid_(); idx < 16 * 128 * 64; idx += G * 512) { const int bh = idx >> 13, rem = idx & 8191, d = rem >> 6, vq = rem & 63;
          float st[4] = {0.f, 0.f, 0.f, 0.f}; const size_t e0 = ((size_t)bh * 64 * 128 + d) * 256 + vq * 4;
#pragma unroll 8
          for (int n = 0; n < 64; ++n) { const size_t e = e0 + (size_t)n * 128 * 256; const u32x2 uw = *(const u32x2*)(U + e); const float dc = DEC[(size_t)(bh * 64 + n) * 128 + d];
              u32x2 pw; pw.x = cvt_pk_bf16(st[0], st[1]); pw.y = cvt_pk_bf16(st[2], st[3]); *(u32x2*)(PV + e) = pw;
              st[0] = dc * st[0] + bf_lo(uw.x); st[1] = dc * st[1] + bf_hi(uw.x); st[2] = dc * st[2] + bf_lo(uw.y); st[3] = dc * st[3] + bf_hi(uw.y); } } }
    { const bf16_t* OG = (const bf16_t*)(ws + WS_OATT); const float* LSE = (const float*)(ws + WS_LSE); bf16_t* YA = (bf16_t*)(ws + WS_YATT);
      for (int idx = blockIdx.x * 512 + tid_(); idx < NTOK * 64; idx += G * 512) { const int tok = idx >> 6, jc = idx & 63, jh = jc >> 3;
          const float l0 = LSE[(size_t)tok * 8 + jh], l1 = LSE[((size_t)NTOK + tok) * 8 + jh], l2 = LSE[((size_t)2 * NTOK + tok) * 8 + jh];
          const float m = fmaxf(l0, fmaxf(l1, l2)); float a0 = __expf(l0 - m), a1 = __expf(l1 - m), a2 = __expf(l2 - m); const float inv = __builtin_amdgcn_rcpf(a0 + a1 + a2); a0 *= inv; a1 *= inv; a2 *= inv;
          float o0[8], o1[8], o2[8], y[8]; const size_t off = (size_t)tok * 512 + jc * 8;
          unpack8(*(const u32x4*)(OG + off), o0); unpack8(*(const u32x4*)(OG + (size_t)NTOK * 512 + off), o1); unpack8(*(const u32x4*)(OG + (size_t)2 * NTOK * 512 + off), o2);
#pragma unroll
          for (int q = 0; q < 8; ++q) y[q] = a0 * o0[q] + a1 * o1[q] + a2 * o2[q];
          *(u32x4*)(YA + off) = pack8(y); } }
}

constexpr int G3_PREV = 0;
constexpr int G3_SS = G3_PREV + 128 * 576;
constexpr int G3_OI = G3_SS + 8 * 32 * 4;
constexpr int G3_GR = G3_OI + 64 * 528;
constexpr int G3_END = G3_GR + 64 * 528;
static_assert(G3_END <= LDS_XB, "gla3 LDS");
__device__ __forceinline__ void gla3_item(const Params& p, int item, char* lds) {
    unsigned char* ws = opaque(p.ws);
    const int tid = tid_(), lane = tid & 63, r32 = lane & 31, hi = lane >> 5; const int w = __builtin_amdgcn_readfirstlane(tid >> 6);
    const int n = item & 63, bh = item >> 6, h = bh & 3, b = bh >> 2; const int tok0 = b * SEQ + n * 64;
    const bf16_t* PV = (const bf16_t*)(ws + WS_PREV) + (size_t)item * 128 * 256;
    bf16_t* SOI = (bf16_t*)(lds + G3_OI); bf16_t* SGR = (bf16_t*)(lds + G3_GR);
#pragma unroll
    for (int pp = 0; pp < 8; ++pp) { const int idx = tid + 512 * pp, d = idx >> 5, c = idx & 31; *(u32x4*)(lds + G3_PREV + d * 576 + c * 16) = *(const u32x4*)(PV + (size_t)d * 256 + c * 8); }
#pragma unroll
    for (int pp = 0; pp < 4; ++pp) { const int idx = tid + 512 * pp, row = idx >> 5, c = idx & 31; const size_t go = (size_t)(tok0 + row) * 1024 + h * 256 + c * 8;
        *(u32x4*)(SOI + row * 264 + c * 8) = *(const u32x4*)((const bf16_t*)(ws + WS_OINTRA) + go); *(u32x4*)(SGR + row * 264 + c * 8) = *(const u32x4*)((const bf16_t*)(ws + WS_GR) + go); }
    const int it = w & 1, vq = w >> 1; const bf16_t* qeg = (const bf16_t*)(ws + WS_QE) + (size_t)(tok0 + it * 32 + r32) * 512 + h * 128;
    bf16x8 qa[8];
#pragma unroll
    for (int s = 0; s < 8; ++s) qa[s] = *(const bf16x8*)(qeg + 16 * s + 8 * hi);
    __syncthreads();
    const LDS3 char* l3 = (const LDS3 char*)lds; const int blk = (lane >> 4) & 1, q4 = (lane & 15) >> 2, p4 = lane & 3;
    f32x16 o[2];
#pragma unroll
    for (int vi = 0; vi < 2; ++vi)
#pragma unroll
        for (int rr = 0; rr < 16; ++rr) o[vi][rr] = bf2f(SOI[(it * 32 + crow(rr, hi)) * 264 + (2 * vq + vi) * 32 + r32]);
#pragma unroll
    for (int s = 0; s < 8; ++s)
#pragma unroll
        for (int vi = 0; vi < 2; ++vi) { const int vt = 2 * vq + vi; const LDS3 char* pp_ = l3 + G3_PREV + (16 * s + 8 * hi + q4) * 576 + (vt * 32 + 16 * blk + 4 * p4) * 2; const bf16x8 pf = cat8(tr16(pp_), tr16(pp_ + 4 * 576)); o[vi] = MFMA32(qa[s], pf, o[vi]); }
    float* SS = (float*)(lds + G3_SS);
#pragma unroll
    for (int rr = 0; rr < 16; ++rr) { float q = o[0][rr] * o[0][rr] + o[1][rr] * o[1][rr]; q += __shfl_xor(q, 16); q += __shfl_xor(q, 8); q += __shfl_xor(q, 4); q += __shfl_xor(q, 2); q += __shfl_xor(q, 1);
        if (r32 == 0) SS[w * 32 + crow(rr, hi)] = q; }
    __syncthreads();
    float ng[2]; ng[0] = p.gla_norm_g[(2 * vq) * 32 + r32]; ng[1] = p.gla_norm_g[(2 * vq + 1) * 32 + r32];
#pragma unroll
    for (int rr = 0; rr < 16; ++rr) { const int row = crow(rr, hi); const float tot = SS[(it + 0) * 32 + row] + SS[(it + 2) * 32 + row] + SS[(it + 4) * 32 + row] + SS[(it + 6) * 32 + row];
        const float rs = rsqrtf(tot * (1.0f / 256.0f) + EPS);
#pragma unroll
        for (int vi = 0; vi < 2; ++vi) { const int li = (it * 32 + row) * 264 + (2 * vq + vi) * 32 + r32; const float y = o[vi][rr] * rs * ng[vi] * bf2f(SGR[li]); SOI[li] = (bf16_t)(cvt_pk_bf16(y, 0.f) & 0xffffu); } }
    __syncthreads();
    bf16_t* yg = (bf16_t*)(ws + WS_YGLA);
#pragma unroll
    for (int pp = 0; pp < 4; ++pp) { const int idx = tid + 512 * pp, row = idx >> 5, c = idx & 31; *(u32x4*)(yg + (size_t)(tok0 + row) * 1024 + h * 256 + c * 8) = *(const u32x4*)(SOI + row * 264 + c * 8); }
    __syncthreads();
}

constexpr int RT_RSTD = 0;
constexpr int RT_LOG = 256;
constexpr int RT_CNT = RT_LOG + 64 * 32 * 4;
__device__ __forceinline__ void route_group(const Params& p, int grp, char* lds) {
    unsigned char* ws = opaque(p.ws); const int tid = tid_(), lane = tid & 63; const int w = __builtin_amdgcn_readfirstlane(tid >> 6);
    const float* H = (const float*)(ws + WS_H); const float* RWG = (const float*)(ws + WS_RWG);
    float* RSTD = (float*)(lds + RT_RSTD); float* LOGS = (float*)(lds + RT_LOG); int* LCNT = (int*)(lds + RT_CNT);
    const int tok0 = grp * 64;
    if (tid < 32) LCNT[tid] = 0;
    if (w < 4) { const int tl = lane & 15, kq = lane >> 4; const float* hr = H + (size_t)(tok0 + w * 16 + tl) * 1024 + kq * 256; const float* br = RWG + (size_t)(kq * 256) * 32 + tl;
        f32x4 a0 = {0.f, 0.f, 0.f, 0.f}, a1 = {0.f, 0.f, 0.f, 0.f}; float ss = 0.f;
#pragma unroll 4
        for (int m4 = 0; m4 < 64; ++m4) { const f32x4 hv = *(const f32x4*)(hr + m4 * 4);
#pragma unroll
            for (int q = 0; q < 4; ++q) { const float b0 = br[(size_t)(m4 * 4 + q) * 32], b1 = br[(size_t)(m4 * 4 + q) * 32 + 16];
                a0 = __builtin_amdgcn_mfma_f32_16x16x4f32(hv[q], b0, a0, 0, 0, 0); a1 = __builtin_amdgcn_mfma_f32_16x16x4f32(hv[q], b1, a1, 0, 0, 0); ss += hv[q] * hv[q]; } }
        ss += __shfl_xor(ss, 16); ss += __shfl_xor(ss, 32);
        const float rs = rsqrtf(ss * (1.0f / 1024.0f) + EPS);
        if (kq == 0) RSTD[w * 16 + tl] = rs;
#pragma unroll
        for (int rg = 0; rg < 4; ++rg) { const int t = w * 16 + 4 * kq + rg; LOGS[t * 32 + tl] = a0[rg]; LOGS[t * 32 + 16 + tl] = a1[rg]; } }
    __syncthreads();
    if (tid < 64) { const int tok = tok0 + tid; const float rs = RSTD[tid]; float lg[32];
#pragma unroll
        for (int e = 0; e < 32; ++e) lg[e] = LOGS[tid * 32 + e] * rs + p.router_b[e];
        int be[4]; float bv[4];
#pragma unroll
        for (int k = 0; k < 4; ++k) { float best = -3.0e38f; int bi = 0;
#pragma unroll
            for (int e = 0; e < 32; ++e) { const bool tk = lg[e] > best; best = tk ? lg[e] : best; bi = tk ? e : bi; }
            be[k] = bi; bv[k] = best;
#pragma unroll
            for (int e = 0; e < 32; ++e) lg[e] = (e == bi) ? -3.0e38f : lg[e]; }
        const float e1 = __expf(bv[1] - bv[0]), e2 = __expf(bv[2] - bv[0]), e3 = __expf(bv[3] - bv[0]); const float inv = 1.0f / (1.0f + e1 + e2 + e3);
        const float gt[4] = {inv, e1 * inv, e2 * inv, e3 * inv};
#pragma unroll
        for (int k = 0; k < 4; ++k) { const int pos = atomicAdd(&LCNT[be[k]], 1);
            ((int*)(ws + WS_TOPE))[tok * 4 + k] = be[k]; ((float*)(ws + WS_TOPG))[tok * 4 + k] = gt[k]; ((int*)(ws + WS_TOPP))[tok * 4 + k] = pos; } }
    { unsigned char* HN = ws + WS_HN;
#pragma unroll 2
      for (int i = 0; i < 8; ++i) { const int idx = tid + 512 * i, t = idx >> 6, c = idx & 63; const float rs = RSTD[t]; const size_t off = (size_t)(tok0 + t) * 1024 + c * 16; u32x4 wv;
#pragma unroll
          for (int q = 0; q < 4; ++q) { const f32x4 h0 = *(const f32x4*)(H + off + 4 * q), g0 = *(const f32x4*)(p.norm_ffn_g + c * 16 + 4 * q); wv[q] = (unsigned)pk4_fp8(h0[0] * rs * g0[0], h0[1] * rs * g0[1], h0[2] * rs * g0[2], h0[3] * rs * g0[3]); }
          *(u32x4*)(HN + off) = wv; } }
    __syncthreads();
    if (tid < 32) ((int*)(ws + WS_CNT))[grp * 32 + tid] = LCNT[tid];
    __syncthreads();
}

constexpr int DP_TOT = 0;
constexpr int DP_PART = 512;
__device__ __forceinline__ void dispatch_tables(const Params& p, int grp, char* lds) {
    unsigned char* ws = opaque(p.ws); const int tid = tid_(); const int* CNT = (const int*)(ws + WS_CNT); int* T = (int*)(lds + DP_TOT); int* PART = (int*)(lds + DP_PART);
    { const int e = tid & 31, part = tid >> 5; int tot = 0, pre = 0;
      for (int g2 = part * 16; g2 < part * 16 + 16; ++g2) { const int c = CNT[g2 * 32 + e]; tot += c; if (g2 < grp) pre += c; }
      PART[part * 32 + e] = tot; PART[512 + part * 32 + e] = pre; }
    __syncthreads();
    if (tid < 32) { int tot = 0, pre = 0; for (int q = 0; q < 16; ++q) { tot += PART[q * 32 + tid]; pre += PART[512 + q * 32 + tid]; } T[tid] = tot; T[64 + tid] = pre; }
    __syncthreads();
    if (tid == 0) { int base = 0; for (int e = 0; e < 32; ++e) { T[32 + e] = base; base += (T[e] + 255) >> 8; } T[96] = base; }
    __syncthreads();
}
__device__ __forceinline__ void dispatch_group(const Params& p, int grp, char* lds) {
    unsigned char* ws = opaque(p.ws); const int tid = tid_();
    dispatch_tables(p, grp, lds);
    const int* T = (const int*)(lds + DP_TOT); int* DEST = (int*)(lds + DP_PART + 4096);
    if (tid < 256) { const int tok = grp * 64 + (tid >> 2); const int e = ((const int*)(ws + WS_TOPE))[tok * 4 + (tid & 3)], lp = ((const int*)(ws + WS_TOPP))[tok * 4 + (tid & 3)];
        const int dest = T[32 + e] * 256 + T[64 + e] + lp; DEST[tid] = dest; ((int*)(ws + WS_SLOT))[tok * 4 + (tid & 3)] = dest; }
    __syncthreads();
    const unsigned char* HN = ws + WS_HN; unsigned char* XP = ws + WS_XPAD;
#pragma unroll 4
    for (int i = 0; i < 32; ++i) { const int idx = tid + 512 * i, pr = idx >> 6, c = idx & 63; const int tok = grp * 64 + (pr >> 2);
        *(u32x4*)(XP + (size_t)DEST[pr] * 1024 + c * 16) = *(const u32x4*)(HN + (size_t)tok * 1024 + c * 16); }
    __syncthreads();
}

__device__ __forceinline__ void phase_combine(const Params& p) {
    unsigned char* ws = opaque(p.ws); const int tid = tid_(), lane = tid & 63, wid = tid >> 6, G = gridDim.x;
    const float* H = (const float*)(ws + WS_H); const unsigned char* YP = ws + WS_YPAD;
    for (int tok = blockIdx.x * 8 + wid; tok < NTOK; tok += G * 8) {
        int sl[4]; float gt[4];
#pragma unroll
        for (int k = 0; k < 4; ++k) { sl[k] = ((const int*)(ws + WS_SLOT))[tok * 4 + k]; gt[k] = ((const float*)(ws + WS_TOPG))[tok * 4 + k]; }
        f32x4 v[4]; float ss = 0.f;
#pragma unroll
        for (int i = 0; i < 4; ++i) { const int col = i * 256 + lane * 4; v[i] = *(const f32x4*)(H + (size_t)tok * 1024 + col);
#pragma unroll
            for (int k = 0; k < 4; ++k) { const unsigned yw = *(const unsigned*)(YP + (size_t)sl[k] * 1024 + col); const f32x2 lo = __builtin_amdgcn_cvt_pk_f32_fp8((int)yw, false), hi2 = __builtin_amdgcn_cvt_pk_f32_fp8((int)yw, true); v[i][0] += gt[k] * lo[0]; v[i][1] += gt[k] * lo[1]; v[i][2] += gt[k] * hi2[0]; v[i][3] += gt[k] * hi2[1]; }
            ss += v[i][0] * v[i][0] + v[i][1] * v[i][1] + v[i][2] * v[i][2] + v[i][3] * v[i][3]; }
        ss = wave_sum(ss); const float rs = rsqrtf(ss * (1.0f / 1024.0f) + EPS);
#pragma unroll
        for (int i = 0; i < 4; ++i) { const int col = i * 256 + lane * 4; const f32x4 g = *(const f32x4*)(p.norm_final_g + col); f32x4 o; o[0] = v[i][0] * rs * g[0]; o[1] = v[i][1] * rs * g[1]; o[2] = v[i][2] * rs * g[2]; o[3] = v[i][3] * rs * g[3];
            *(f32x4*)(p.out + (size_t)tok * 1024 + col) = o; } }
}


#define XB_TMO      128
#define XB_XCNT(j)  (256  + 64 * (j))
#define XB_XSUB(j)  (1280 + 64 * (j))
#define XB_XGEN(j)  (2304 + 64 * (j))
#define XB_TOP      3328
#define XB_TOPGEN   3392
#define XCD_BAR_WORDS 3456
#define XB_SPIN_CAP (1u << 18)
__device__ __forceinline__ unsigned xb_ld(unsigned* p)              { return __hip_atomic_load(p, __ATOMIC_RELAXED, __HIP_MEMORY_SCOPE_AGENT); }
__device__ __forceinline__ unsigned xb_add(unsigned* p, unsigned v) { return __hip_atomic_fetch_add(p, v, __ATOMIC_RELAXED, __HIP_MEMORY_SCOPE_AGENT); }
__device__ __forceinline__ unsigned xb_xcc_id() { return (unsigned)__builtin_amdgcn_s_getreg((3 << 11) | 20) & 0xFu; }
#define XB_SPIN(cond, bar) do { unsigned _sp = 0; while (cond) { __builtin_amdgcn_s_sleep(1); \
    if ((++_sp & 255u) == 0u) { if (xb_ld(&(bar)[XB_TMO])) break; if (_sp > XB_SPIN_CAP) { atomicAdd(&(bar)[XB_TMO], 1u); break; } } } } while (0)
struct XcdBarrier { unsigned* bar; unsigned x; volatile LDS3 unsigned* st; };
__device__ __forceinline__ XcdBarrier xcd_barrier_post(unsigned* bar, volatile LDS3 unsigned* st) {
    XcdBarrier b; b.bar = bar; b.x = xb_xcc_id(); b.st = st;
    if (tid_() == 0) (void)xb_add(&bar[XB_XCNT(b.x)], 1u);
    return b;
}
__device__ __forceinline__ void xcd_barrier_complete(unsigned* bar, unsigned x, unsigned& nloc, unsigned& nx) {
    const unsigned G = gridDim.x * gridDim.y * gridDim.z;
    unsigned sum, cnt, mine, sp = 0u;
    for (;;) {
        sum = 0u; cnt = 0u; mine = 0u;
#pragma unroll
        for (unsigned j = 0; j < 16; ++j) { const unsigned c = xb_ld(&bar[XB_XCNT(j)]); sum += c; cnt += (c > 0u) ? 1u : 0u; mine = (j == x) ? c : mine; }
        if (sum == G) break;
        __builtin_amdgcn_s_sleep(1);
        if ((++sp & 255u) == 0u) { if (xb_ld(&bar[XB_TMO])) break; if (sp > XB_SPIN_CAP) { atomicAdd(&bar[XB_TMO], 1u); break; } }
    }
    nloc = mine > 0u ? mine : 1u; nx = cnt > 0u ? cnt : 1u;
}
__device__ __forceinline__ void xcd_barrier(const XcdBarrier& b) {
    asm volatile("s_waitcnt vmcnt(0)" ::: "memory");
    __syncthreads();
    if (tid_() == 0) {
        unsigned* bar = b.bar;
        __builtin_amdgcn_s_waitcnt(0);
        unsigned nloc = b.st[0], nx = b.st[1];
        if (nloc == 0u) { xcd_barrier_complete(bar, b.x, nloc, nx); b.st[0] = nloc; b.st[1] = nx; }
        const unsigned old = xb_add(&bar[XB_XSUB(b.x)], 1u);
        const unsigned gen = old / nloc;
        if (old + 1u == (gen + 1u) * nloc) {
            __builtin_amdgcn_fence(__ATOMIC_RELEASE, "agent");
            asm volatile("s_waitcnt vmcnt(0)" ::: "memory");
            const unsigned og = xb_add(&bar[XB_TOP], 1u);
            const unsigned tg = og / nx;
            if (og + 1u == (tg + 1u) * nx) xb_add(&bar[XB_TOPGEN], 1u);
            else XB_SPIN(xb_ld(&bar[XB_TOPGEN]) == tg, bar);
            __builtin_amdgcn_fence(__ATOMIC_ACQUIRE, "agent");
            xb_add(&bar[XB_XGEN(b.x)], 1u);
            asm volatile("s_waitcnt vmcnt(0)" ::: "memory");
        } else {
            XB_SPIN(xb_ld(&bar[XB_XGEN(b.x)]) == gen, bar);
            __builtin_amdgcn_fence(__ATOMIC_ACQUIRE, "agent");
            asm volatile("s_waitcnt vmcnt(0)" ::: "memory");
        }
    }
    __syncthreads();
}

__global__ void __launch_bounds__(512, 2) mega_fwd(Params p) {
    cg::grid_group grid = cg::this_grid();
    char* lds = smem; LDS3 unsigned char* lds3 = (LDS3 unsigned char*)smem;
    const int G = gridDim.x, bid = blockIdx.x;
    if (tid_() < 4) ((volatile LDS3 unsigned*)(lds3 + LDS_XB))[tid_()] = 0u;
    __syncthreads();
    const XcdBarrier xb = xcd_barrier_post((unsigned*)(p.ws + WS_BAR), (volatile LDS3 unsigned*)(lds3 + LDS_XB));
    for (int rep = 0; rep < REP_P0; ++rep) phase_prologue(p, lds);
    if (p.ws == nullptr) grid.sync();
    xcd_barrier(xb);
    for (int rep = 0; rep < REP_P1; ++rep) { const int nconv = (G >= 64) ? (G * 3) / 16 : 0, ngemm = G - nconv;
      if (bid >= ngemm) { expert_convert(p, lds, bid - ngemm, nconv); }
      else { unsigned char* ws = opaque(p.ws); pg8::DenseProb S; S.init(ws + WS_XN, ws + WS_W_IN, NTOK, INWP, 1024, ngemm, bid);
        EpiProj E; E.ws = ws;
        pg8::gemm_phase(lds3, S, E); }
      if (nconv == 0) expert_convert(p, lds, bid, G); }
    xcd_barrier(xb);
    for (int rep = 0; rep < REP_ATT; ++rep) { AttnPre pre; if (bid < 4 * 24 * 16) attn_fetch(p, bid, pre);
        for (int item = bid; item < 4 * 24 * 16; item += G) attn_item(p, item, item + G, item + G < 4 * 24 * 16, pre, lds); }
    for (int rep = 0; rep < REP_GLA1; ++rep) for (int item = bid; item < 1024; item += G) gla1_item(p, item, lds);
    xcd_barrier(xb);
    for (int rep = 0; rep < REP_P3; ++rep) phase_scan_combine(p);
    xcd_barrier(xb);
    for (int rep = 0; rep < REP_P4; ++rep) for (int item = bid; item < 1024; item += G) gla3_item(p, item, lds);
    xcd_barrier(xb);
    for (int rep = 0; rep < REP_P5; ++rep) {
    { unsigned char* ws = opaque(p.ws); pg8::DenseProb S; S.init(ws + WS_YATT, ws + WS_W_A, NTOK, 1024, 512, G, bid);
      EpiGate<0> E; E.gate = (const bf16_t*)(ws + WS_SA); E.t1 = nullptr; E.out = (bf16_t*)(ws + WS_T1);
      pg8::gemm_phase(lds3, S, E); }
    { unsigned char* ws = opaque(p.ws); pg8::DenseProb S; S.init(ws + WS_YGLA, ws + WS_W_G, NTOK, 1024, 1024, G, bid);
      EpiGate<1> E; E.gate = (const bf16_t*)(ws + WS_SG); E.t1 = (const bf16_t*)(ws + WS_T1); E.out = (bf16_t*)(ws + WS_MERGED);
      pg8::gemm_phase(lds3, S, E); }
    }
    xcd_barrier(xb);
    for (int rep = 0; rep < REP_P6; ++rep) { unsigned char* ws = opaque(p.ws); pg8::DenseProb S; S.init(ws + WS_MERGED, ws + WS_W_MIX, NTOK, 1024, 1024, G, bid);
      EpiResid E; E.x = p.x; E.h = (float*)(ws + WS_H);
      pg8::gemm_phase(lds3, S, E); }
    xcd_barrier(xb);
    for (int rep = 0; rep < REP_P7; ++rep) for (int grp = bid; grp < 256; grp += G) route_group(p, grp, lds);
    xcd_barrier(xb);
    for (int rep = 0; rep < REP_P8; ++rep) for (int grp = bid; grp < 256; grp += G) dispatch_group(p, grp, lds);
    if (bid == 0) { unsigned char* ws = opaque(p.ws); dispatch_tables(p, -1, lds); const int* T = (const int*)(lds + DP_TOT); int* TE = (int*)(ws + WS_TILEE);
        if (tid_() < 32) { const int e = tid_(); for (int t = T[32 + e]; t < T[32 + e] + ((T[e] + 255) >> 8); ++t) TE[16 + t] = e; }
        if (tid_() == 0) TE[0] = T[96]; }
    xcd_barrier(xb);
    for (int rep = 0; rep < REP_P9; ++rep) { unsigned char* ws = opaque(p.ws); const int* TE = (const int*)(ws + WS_TILEE);
      pg8::MoeProb S; S.A = (const char*)(ws + WS_XPAD); S.Bt = (const char*)(ws + WS_W_GU); S.K = 512  ; S.nN = 8; S.T = TE[0]; S.G = G; S.c = bid; S.estride = (size_t)2048 * 1024; S.tile_e = TE + 16;
      EpiAct E; E.bgu = p.e_b_gu; E.tile_e = TE + 16; E.act = ws + WS_ACT;
      pg8::gemm_phase(lds3, S, E); }
    xcd_barrier(xb);
    for (int rep = 0; rep < REP_P10; ++rep) { unsigned char* ws = opaque(p.ws); const int* TE = (const int*)(ws + WS_TILEE);
      pg8::MoeProb S; S.A = (const char*)(ws + WS_ACT); S.Bt = (const char*)(ws + WS_W_D); S.K = 512  ; S.nN = 4; S.T = TE[0]; S.G = G; S.c = bid; S.estride = (size_t)1024 * 1024; S.tile_e = TE + 16;
      EpiDown E; E.bd = p.e_b_d; E.tile_e = TE + 16; E.y = ws + WS_YPAD;
      pg8::gemm_phase(lds3, S, E); }
    xcd_barrier(xb);
    for (int rep = 0; rep < REP_P11; ++rep) phase_combine(p);
}

extern "C" void kernel_launch(void* const* d_in, const int* in_sizes, int n_in, void* d_out, int out_size, void* d_ws, size_t ws_size, hipStream_t stream) {
    static int grid = 0;
    if (grid == 0) {
        if (n_in != 17 || ws_size < WS_END) { fprintf(stderr, "kernel_launch: expected 17 inputs and >= %zu bytes of workspace (got %d, %zu); nothing launched\n", (size_t)WS_END, n_in, ws_size); grid = -1; return; }
        int dev = 0, cus = 0, per_cu = 0;
        if (hipGetDevice(&dev) != hipSuccess || hipDeviceGetAttribute(&cus, hipDeviceAttributeMultiprocessorCount, dev) != hipSuccess) { fprintf(stderr, "kernel_launch: device query failed\n"); grid = -1; return; }
        if (hipFuncSetAttribute((const void*)mega_fwd, hipFuncAttributeMaxDynamicSharedMemorySize, LDS_BYTES) != hipSuccess) { fprintf(stderr, "kernel_launch: hipFuncSetAttribute failed\n"); grid = -1; return; }
        if (hipOccupancyMaxActiveBlocksPerMultiprocessor(&per_cu, (const void*)mega_fwd, 512, LDS_BYTES) != hipSuccess || per_cu < 1) { fprintf(stderr, "kernel_launch: occupancy query failed (%d)\n", per_cu); grid = -1; return; }
        grid = cus;
    }
    if (grid < 0) return;
    Params p{};
    p.x = (const float*)d_in[0]; p.norm_mix_g = (const float*)d_in[1]; p.w_in = (const float*)d_in[2]; p.gla_gate_up = (const float*)d_in[3]; p.gla_gate_bias = (const float*)d_in[4]; p.gla_norm_g = (const float*)d_in[5];
    p.w_branch_gla = (const float*)d_in[6]; p.w_branch_att = (const float*)d_in[7]; p.w_mix_out = (const float*)d_in[8]; p.norm_ffn_g = (const float*)d_in[9]; p.router_w = (const float*)d_in[10]; p.router_b = (const float*)d_in[11];
    p.e_w_gu = (const float*)d_in[12]; p.e_b_gu = (const float*)d_in[13]; p.e_w_d = (const float*)d_in[14]; p.e_b_d = (const float*)d_in[15]; p.norm_final_g = (const float*)d_in[16];
    p.out = (float*)d_out; p.ws = (unsigned char*)d_ws;
    if (hipMemsetAsync((char*)d_ws + WS_BAR, 0, 3456 * 4, stream) != hipSuccess) { fprintf(stderr, "kernel_launch: memset of the barrier words failed\n"); return; }
    void* args[] = {&p};
    hipError_t e = hipLaunchCooperativeKernel((const void*)mega_fwd, dim3(grid), dim3(512), args, LDS_BYTES, stream);
    if (e != hipSuccess) fprintf(stderr, "kernel_launch: cooperative launch failed: %s (grid %d)\n", hipGetErrorString(e), grid);
}
```

```cpp
#include <hip/hip_runtime.h>
#include <hip/hip_cooperative_groups.h>
#include <cstdio>
#include <cstdint>
namespace cg = cooperative_groups;
#ifndef REP_P0
#define REP_P0 1
#define REP_P1 1
#define REP_ATT 1
#define REP_GLA1 1
#define REP_P3 1
#define REP_P4 1
#define REP_P5 1
#define REP_P6 1
#define REP_P7 1
#define REP_P8 1
#define REP_P9 1
#define REP_P10 1
#define REP_P11 1
#endif

#define LDS3 __attribute__((address_space(3)))
typedef unsigned short bf16_t;
typedef short bf16x8 __attribute__((ext_vector_type(8)));
typedef short s16x4 __attribute__((ext_vector_type(4)));
typedef short v4i16_t __attribute__((ext_vector_type(4)));
typedef float f32x4 __attribute__((ext_vector_type(4)));
typedef float f32x2 __attribute__((ext_vector_type(2)));
typedef float f32x16 __attribute__((ext_vector_type(16)));
typedef unsigned u32x4 __attribute__((ext_vector_type(4)));
typedef unsigned u32x2 __attribute__((ext_vector_type(2)));
typedef int i32x8 __attribute__((ext_vector_type(8)));
typedef int i32x4 __attribute__((ext_vector_type(4)));

constexpr int NTOK = 16384, DM = 1024, SEQ = 4096, NB = 4;
constexpr int INW = 9744, INWP = 9984;
constexpr int NEXP = 32, TOPK = 4, FF = 1024;
constexpr int MAXT = 288;
constexpr float EPS = 1e-5f;
constexpr float QSCALE = 0.125f * 1.4426950408889634f;
constexpr float LN2 = 0.6931471805599453f;

constexpr size_t al256(size_t x) { return (x + 255) & ~(size_t)255; }
constexpr size_t WS_W_IN = 0;
constexpr size_t WS_W_G = WS_W_IN + (size_t)INWP * 1024 * 2;
constexpr size_t WS_W_A = WS_W_G + (size_t)1024 * 1024 * 2;
constexpr size_t WS_W_MIX = WS_W_A + (size_t)1024 * 512 * 2;
constexpr size_t WS_W_GU = WS_W_MIX + (size_t)1024 * 1024 * 2;
constexpr size_t WS_W_D = WS_W_GU + (size_t)NEXP * 2048 * 1024;
constexpr size_t WS_ROPE_C = WS_W_D + (size_t)NEXP * 1024 * 1024;
constexpr size_t WS_ROPE_S = WS_ROPE_C + (size_t)SEQ * 8 * 4;
constexpr size_t WS_RWG = WS_ROPE_S + (size_t)SEQ * 8 * 4;
constexpr size_t WS_H = WS_RWG + (size_t)1024 * 32 * 4;
constexpr size_t WS_HN = WS_H + (size_t)NTOK * 1024 * 4;
constexpr size_t WS_TOPE = WS_HN + (size_t)NTOK * 1024;
constexpr size_t WS_TOPG = WS_TOPE + (size_t)NTOK * 4 * 4;
constexpr size_t WS_TOPP = WS_TOPG + (size_t)NTOK * 4 * 4;
constexpr size_t WS_SLOT = WS_TOPP + (size_t)NTOK * 4 * 4;
constexpr size_t WS_CNT = WS_SLOT + (size_t)NTOK * 4 * 4;
constexpr size_t WS_TILEE = WS_CNT + (size_t)256 * 32 * 4;
constexpr size_t WS_REGB = al256(WS_TILEE + (size_t)(MAXT + 32) * 4);
constexpr size_t WS_XN = WS_REGB;
constexpr size_t WS_GQ = WS_XN + (size_t)NTOK * 1024 * 2;
constexpr size_t WS_GK = WS_GQ + (size_t)NTOK * 512 * 2;
constexpr size_t WS_GV = WS_GK + (size_t)NTOK * 512 * 2;
constexpr size_t WS_GR = WS_GV + (size_t)NTOK * 1024 * 2;
constexpr size_t WS_SG = WS_GR + (size_t)NTOK * 1024 * 2;
constexpr size_t WS_SA = WS_SG + (size_t)NTOK * 1024 * 2;
constexpr size_t WS_AQ = WS_SA + (size_t)NTOK * 1024 * 2;
constexpr size_t WS_AK = WS_AQ + (size_t)NTOK * 1536 * 2;
constexpr size_t WS_AV = WS_AK + (size_t)NTOK * 1536 * 2;
constexpr size_t WS_GLR = WS_AV + (size_t)NTOK * 1536 * 2;
constexpr size_t WS_OATT = WS_GLR + (size_t)NTOK * 16 * 4;
constexpr size_t WS_LSE = WS_OATT + (size_t)3 * NTOK * 512 * 2;
constexpr size_t WS_QE = WS_LSE + (size_t)3 * NTOK * 8 * 4;
constexpr size_t WS_OINTRA = WS_QE + (size_t)NTOK * 512 * 2;
constexpr size_t WS_U = WS_OINTRA + (size_t)NTOK * 1024 * 2;
constexpr size_t WS_DEC = WS_U + (size_t)1024 * 128 * 256 * 2;
constexpr size_t WS_REGB_END = WS_DEC + (size_t)1024 * 128 * 4;
constexpr size_t WS_PREV = WS_AQ;
constexpr size_t WS_YGLA = WS_AV;
constexpr size_t WS_YATT = WS_XN;
constexpr size_t WS_T1 = WS_GQ;
constexpr size_t WS_MERGED = WS_GV;
constexpr size_t PADROWS = (size_t)MAXT * 256;
constexpr size_t WS_XPAD = WS_REGB;
constexpr size_t WS_ACT = WS_XPAD + PADROWS * 1024;
constexpr size_t WS_YPAD = WS_ACT + PADROWS * 1024;
constexpr size_t WS_PAD_END = WS_YPAD + PADROWS * 1024;
constexpr size_t WS_BAR = al256(WS_REGB_END > WS_PAD_END ? WS_REGB_END : WS_PAD_END);
constexpr size_t WS_END = WS_BAR + 3456 * 4;
static_assert(WS_PAD_END <= WS_REGB_END + (1u << 30), "map");

constexpr int LDS_XB = 147456;
constexpr int LDS_BYTES = 147456 + 16;

struct Params {
    const float *x, *norm_mix_g, *w_in, *gla_gate_up, *gla_gate_bias, *gla_norm_g, *w_branch_gla, *w_branch_att, *w_mix_out, *norm_ffn_g,
        *router_w, *router_b, *e_w_gu, *e_b_gu, *e_w_d, *e_b_d, *norm_final_g;
    float* out;
    unsigned char* ws;
};

__device__ __forceinline__ int tid_() { int t = threadIdx.x; asm volatile("" : "+v"(t)); return t; }
__device__ __forceinline__ unsigned char* opaque(unsigned char* q) { return q; }
__device__ __forceinline__ unsigned cvt_pk_bf16(float lo, float hi) { unsigned r; asm volatile("v_cvt_pk_bf16_f32 %0, %1, %2" : "=v"(r) : "v"(lo), "v"(hi)); return r; }
__device__ __forceinline__ float bf_lo(unsigned w) { return __uint_as_float(w << 16); }
__device__ __forceinline__ float bf_hi(unsigned w) { return __uint_as_float(w & 0xffff0000u); }
__device__ __forceinline__ float bf2f(bf16_t b) { return __uint_as_float(((unsigned)b) << 16); }
__device__ __forceinline__ u32x4 pack8(const float* v) { u32x4 w; w.x = cvt_pk_bf16(v[0], v[1]); w.y = cvt_pk_bf16(v[2], v[3]); w.z = cvt_pk_bf16(v[4], v[5]); w.w = cvt_pk_bf16(v[6], v[7]); return w; }
__device__ __forceinline__ void unpack8(u32x4 w, float* v) { v[0] = bf_lo(w.x); v[1] = bf_hi(w.x); v[2] = bf_lo(w.y); v[3] = bf_hi(w.y); v[4] = bf_lo(w.z); v[5] = bf_hi(w.z); v[6] = bf_lo(w.w); v[7] = bf_hi(w.w); }
__device__ __forceinline__ float sigmoidf_(float v) { return __builtin_amdgcn_rcpf(1.0f + __builtin_amdgcn_exp2f(v * -1.4426950408889634f)); }
__device__ __forceinline__ float wave_sum(float v) { v += __shfl_xor(v, 32); v += __shfl_xor(v, 16); v += __shfl_xor(v, 8); v += __shfl_xor(v, 4); v += __shfl_xor(v, 2); v += __shfl_xor(v, 1); return v; }
__device__ __forceinline__ s16x4 tr16(const LDS3 char* p) { return __builtin_bit_cast(s16x4, __builtin_amdgcn_ds_read_tr16_b64_v4i16((LDS3 v4i16_t*)p)); }
__device__ __forceinline__ bf16x8 cat8(s16x4 a, s16x4 b) { return (bf16x8){a[0], a[1], a[2], a[3], b[0], b[1], b[2], b[3]}; }
__device__ __forceinline__ int crow(int r, int hi) { return (r & 3) + 8 * (r >> 2) + 4 * hi; }
__device__ __forceinline__ void st_nt(void* p, u32x4 v) { __builtin_nontemporal_store(v, (u32x4*)p); }
__device__ __forceinline__ int pk4_fp8(float a, float b, float c, float d) { int w = __builtin_amdgcn_cvt_pk_fp8_f32(a, b, 0, false); return __builtin_amdgcn_cvt_pk_fp8_f32(c, d, w, true); }
#define MFMA32(a, b, c) __builtin_amdgcn_mfma_f32_32x32x16_bf16(a, b, c, 0, 0, 0)

namespace pg8 {
constexpr int BM = 256, BK = 64, HALF = 128, HTB = HALF * BK * 2, STAGE_BYTES = 8 * HTB, NXCD = 8, WGM = 8;
constexpr bool GEMM_ALIGN_EPI = true;
constexpr bool GEMM_SP2 = true;
__host__ __device__ __forceinline__ int lds_byte(int r, int c) { const int st = (r >> 4) * 2 + (c >> 5), rr = r & 15, cc = c & 31, ob = rr * 64 + cc * 2; return st * 1024 + (ob ^ (((ob >> 9) & 1) << 5)); }
__host__ __device__ __forceinline__ void stage_rc(int b, int& R, int& C) { const int st = b / 1024, sb = b % 1024, swz = sb ^ (((sb >> 9) & 1) << 5); R = (st >> 1) * 16 + swz / 64; C = (st & 1) * 32 + (swz % 64) / 2; }
__host__ __device__ __forceinline__ int perm32(int rho) { const int n = rho >> 4, i = rho & 15; return 8 * (i >> 2) + 4 * n + (i & 3); }
struct Unit { int pm, pn; };

struct DenseProb {
    const char* A; const char* Bt; int K; int nM, nN, nwg, G, c;
    __device__ void init(const void* A_, const void* Bt_, int M, int N, int K_, int G_, int c_) { A = (const char*)A_; Bt = (const char*)Bt_; K = K_; nM = M / BM; nN = N / BM; nwg = nM * nN; G = G_; c = c_; }
    __device__ __forceinline__ bool next(int i, Unit& u) const {
        const long L = (long)i * G + c; if (L >= nwg) return false;
        int wgid = (int)L; { const int q = nwg / NXCD, r = nwg % NXCD, xcd = wgid % NXCD, off = wgid / NXCD; wgid = (xcd < r ? xcd * (q + 1) : r * (q + 1) + (xcd - r) * q) + off; }
        const int nig = WGM * nN, gid = wgid / nig, fm = gid * WGM, gsz = (nM - fm) < WGM ? (nM - fm) : WGM;
        u.pm = fm + ((wgid % nig) % gsz); u.pn = (wgid % nig) / gsz; return true;
    }
    __device__ __forceinline__ const char* a_ptr(const Unit& u) const { return A + (size_t)u.pm * BM * K * 2; }
    __device__ __forceinline__ const char* b_ptr(const Unit& u) const { return Bt + (size_t)u.pn * BM * K * 2; }
};
struct MoeProb {
    const char* A; const char* Bt; int K; int nN, T, G, c; size_t estride; const int* tile_e;
    __device__ __forceinline__ bool next(int i, Unit& u) const { const long L = (long)i * G + c; if (L >= (long)T * nN) return false; u.pm = (int)(L / nN); u.pn = (int)(L % nN); return true; }
    __device__ __forceinline__ const char* a_ptr(const Unit& u) const { return A + (size_t)u.pm * BM * K * 2; }
    __device__ __forceinline__ const char* b_ptr(const Unit& u) const { return Bt + (size_t)tile_e[u.pm] * estride + (size_t)u.pn * BM * K * 2; }
};

template <class Epi, class Prob>
__device__ __forceinline__ void gemm_phase(LDS3 unsigned char* lds, const Prob& S, const Epi& E) {
    const int tid = tid_(), wid = __builtin_amdgcn_readfirstlane(tid >> 6), lane = tid & 63, wr = wid >> 2, wc = wid & 3, fr = lane & 15, fq = lane >> 4;
    const int K = S.K, nt = K / BK;
    unsigned voffA[2], voffB[2];
#pragma unroll
    for (int i = 0; i < 2; ++i) { int R, C; stage_rc(tid * 16 + i * 8192, R, C); const int Rb = Epi::PERM ? (2 * (R & ~31) + perm32(R & 31)) : R;
        voffA[i] = (unsigned)(R * K + C) * 2u; voffB[i] = (unsigned)(Rb * K + C) * 2u; }
    const size_t kstep = (size_t)(BK * 2);
    const size_t hstep = (size_t)HALF * K * 2;
    const size_t hstepB = Epi::PERM ? (size_t)32 * K * 2 : hstep;
    const unsigned ldsw = (unsigned)wid * 1024u;
    const int aoff = lds_byte(wr * 64 + fr, fq * 8), boff = lds_byte(wc * 32 + fr, fq * 8);
#define PG8_SA(b, h) (((b) * 2 + (h)) * HTB)
#define PG8_SB(b, h) ((4 + (b) * 2 + (h)) * HTB)
#define PG8_STAGE(bufoff, gbase, voff) do { _Pragma("unroll") for (int _i = 0; _i < 2; ++_i) \
        __builtin_amdgcn_global_load_lds((const unsigned*)((const char*)(gbase) + (voff)[_i]), (LDS3 unsigned*)(lds + (bufoff) + ldsw + _i * 8192), 16, 0, 0); } while (0)
#define PG8_LD8(ptr) __builtin_shufflevector(*(const LDS3 i32x4*)(ptr), *(const LDS3 i32x4*)((ptr) + 1024), 0, 1, 2, 3, 4, 5, 6, 7)
#define PG8_LO(x) __builtin_bit_cast(bf16x8, __builtin_shufflevector(x, x, 0, 1, 2, 3))
#define PG8_HI(x) __builtin_bit_cast(bf16x8, __builtin_shufflevector(x, x, 4, 5, 6, 7))
#define PG8_LDA(dst, b, h) do { _Pragma("unroll") for (int m = 0; m < 4; ++m) dst[m] = PG8_LD8(lds + PG8_SA(b, h) + aoff + m * 2048); } while (0)
#define PG8_LDB(dst, b, h) do { _Pragma("unroll") for (int n = 0; n < 2; ++n) dst[n] = PG8_LD8(lds + PG8_SB(b, h) + boff + n * 2048); } while (0)
#define PG8_MMA(ai, bj, At, Bt) do { __builtin_amdgcn_s_setprio(1); _Pragma("unroll") for (int m = 0; m < 4; ++m) _Pragma("unroll") for (int n = 0; n < 2; ++n) { \
        if constexpr (Epi::FP8) asm volatile("v_mfma_scale_f32_16x16x128_f8f6f4 %0, %1, %2, %0, %3, %4 op_sel_hi:[0,0,0]" : "+v"(acc[ai][bj][m][n]) : "v"(Bt[n]), "v"(At[m]), "v"(sc_w), "v"(sc_1)); \
        else { acc[ai][bj][m][n] = __builtin_amdgcn_mfma_f32_16x16x32_bf16(PG8_LO(Bt[n]), PG8_LO(At[m]), acc[ai][bj][m][n], 0, 0, 0); acc[ai][bj][m][n] = __builtin_amdgcn_mfma_f32_16x16x32_bf16(PG8_HI(Bt[n]), PG8_HI(At[m]), acc[ai][bj][m][n], 0, 0, 0); } } __builtin_amdgcn_s_setprio(0); } while (0)
#define PG8_WAIT_V(n) asm volatile("s_waitcnt vmcnt(" #n ")" ::: "memory")
#define PG8_WAIT_L(n) asm volatile("s_waitcnt lgkmcnt(" #n ")" ::: "memory")
#define PG8_BAR __builtin_amdgcn_s_barrier()
#define PG8_SCHED __builtin_amdgcn_sched_barrier(0)
    Unit cur, nxt; int ui = 0;
    if (!S.next(0, cur)) return;
    f32x4 acc[2][2][4][2];
#pragma unroll
    for (int a = 0; a < 2; ++a)
#pragma unroll
        for (int b = 0; b < 2; ++b)
#pragma unroll
            for (int m = 0; m < 4; ++m)
#pragma unroll
                for (int n = 0; n < 2; ++n) acc[a][b][m][n] = (f32x4){0.f, 0.f, 0.f, 0.f};
    i32x8 At[4], B0[2], B1[2];
    int sc_w = 0x7A7A7A7A  , sc_1 = 0x7F7F7F7F; asm volatile("" : "+v"(sc_w), "+v"(sc_1));
    const char* cA = S.a_ptr(cur); const char* cB = S.b_ptr(cur);
    if constexpr (GEMM_SP2) {
        PG8_STAGE(PG8_SB(0, 0), cB, voffB); PG8_STAGE(PG8_SB(0, 1), cB + hstepB, voffB); PG8_STAGE(PG8_SA(0, 0), cA, voffA); PG8_STAGE(PG8_SA(0, 1), cA + hstep, voffA);
        if (wr == 1) PG8_BAR;
        PG8_WAIT_V(2); PG8_BAR;
        PG8_STAGE(PG8_SB(1, 0), cB + kstep, voffB); PG8_STAGE(PG8_SA(1, 0), cA + kstep, voffA); PG8_STAGE(PG8_SB(1, 1), cB + hstepB + kstep, voffB);
        PG8_WAIT_V(6); PG8_BAR;
    } else {
    PG8_STAGE(PG8_SB(0, 0), cB, voffB); PG8_STAGE(PG8_SA(0, 0), cA, voffA); PG8_STAGE(PG8_SB(0, 1), cB + hstepB, voffB); PG8_STAGE(PG8_SA(0, 1), cA + hstep, voffA);
    if (wr == 1) PG8_BAR;
    PG8_WAIT_V(4); PG8_BAR;
    PG8_STAGE(PG8_SB(1, 0), cB + kstep, voffB); PG8_STAGE(PG8_SA(1, 0), cA + kstep, voffA); PG8_STAGE(PG8_SB(1, 1), cB + hstepB + kstep, voffB);
    PG8_WAIT_V(6); PG8_BAR;
    }
    for (;;) {
        const bool has_next = S.next(ui + 1, nxt);
        const char* nA = has_next ? S.a_ptr(nxt) : cA; const char* nB = has_next ? S.b_ptr(nxt) : cB;
        for (int t = 0; t < nt; t += 2) {
            const bool last = (t == nt - 2);
            const char* a1 = cA + (size_t)(t + 1) * kstep;
            const char* a2 = last ? nA : cA + (size_t)(t + 2) * kstep; const char* b2 = last ? nB : cB + (size_t)(t + 2) * kstep;
            const char* a3 = a2 + kstep; const char* b3 = b2 + kstep;
            if constexpr (GEMM_SP2) {
            PG8_LDB(B0, 0, 0); PG8_LDB(B1, 0, 1); PG8_SCHED; PG8_LDA(At, 0, 0); PG8_STAGE(PG8_SA(1, 1), a1 + hstep, voffA);
            PG8_WAIT_V(8); PG8_WAIT_L(0); PG8_BAR; PG8_MMA(0, 0, At, B0); PG8_MMA(0, 1, At, B1); PG8_BAR; PG8_SCHED;
            PG8_LDA(At, 0, 1); PG8_STAGE(PG8_SB(0, 0), b2, voffB); PG8_STAGE(PG8_SB(0, 1), b2 + hstepB, voffB); PG8_STAGE(PG8_SA(0, 0), a2, voffA);
            PG8_WAIT_V(8); PG8_WAIT_L(0); PG8_BAR; PG8_MMA(1, 0, At, B0); PG8_MMA(1, 1, At, B1); PG8_BAR; PG8_SCHED;
            PG8_LDB(B0, 1, 0); PG8_LDB(B1, 1, 1); PG8_SCHED; PG8_LDA(At, 1, 0); PG8_STAGE(PG8_SA(0, 1), a2 + hstep, voffA);
            PG8_WAIT_V(8); PG8_WAIT_L(0); PG8_BAR; PG8_MMA(0, 0, At, B0); PG8_MMA(0, 1, At, B1); PG8_BAR; PG8_SCHED;
            PG8_LDA(At, 1, 1); PG8_STAGE(PG8_SB(1, 0), b3, voffB); PG8_STAGE(PG8_SB(1, 1), b3 + hstepB, voffB); PG8_STAGE(PG8_SA(1, 0), a3, voffA);
            PG8_WAIT_V(8); PG8_WAIT_L(0); PG8_BAR; PG8_MMA(1, 0, At, B0); PG8_MMA(1, 1, At, B1); PG8_BAR; PG8_SCHED;
            } else {
            PG8_LDB(B0, 0, 0); PG8_SCHED; PG8_LDA(At, 0, 0); PG8_STAGE(PG8_SA(1, 1), a1 + hstep, voffA);
            PG8_WAIT_L(8); PG8_BAR; PG8_WAIT_L(0); PG8_MMA(0, 0, At, B0); PG8_BAR; PG8_SCHED;
            PG8_LDB(B1, 0, 1); PG8_STAGE(PG8_SB(0, 0), b2, voffB);
            PG8_BAR; PG8_WAIT_L(0); PG8_MMA(0, 1, At, B1); PG8_BAR;
            PG8_LDA(At, 0, 1); PG8_STAGE(PG8_SA(0, 0), a2, voffA);
            PG8_BAR; PG8_WAIT_L(0); PG8_MMA(1, 0, At, B0); PG8_BAR; PG8_SCHED;
            PG8_STAGE(PG8_SB(0, 1), b2 + hstepB, voffB);
            PG8_WAIT_V(6); PG8_BAR; PG8_MMA(1, 1, At, B1); PG8_BAR;
            PG8_LDB(B0, 1, 0); PG8_SCHED; PG8_LDA(At, 1, 0); PG8_STAGE(PG8_SA(0, 1), a2 + hstep, voffA);
            PG8_WAIT_L(8); PG8_BAR; PG8_WAIT_L(0); PG8_MMA(0, 0, At, B0); PG8_BAR; PG8_SCHED;
            PG8_LDB(B1, 1, 1); PG8_STAGE(PG8_SB(1, 0), b3, voffB);
            PG8_BAR; PG8_WAIT_L(0); PG8_MMA(0, 1, At, B1); PG8_BAR;
            PG8_LDA(At, 1, 1); PG8_STAGE(PG8_SA(1, 0), a3, voffA);
            PG8_BAR; PG8_WAIT_L(0); PG8_MMA(1, 0, At, B0); PG8_BAR; PG8_SCHED;
            PG8_STAGE(PG8_SB(1, 1), b3 + hstepB, voffB);
            PG8_WAIT_V(6); PG8_BAR; PG8_MMA(1, 1, At, B1); PG8_BAR;
            }
        }
        if constexpr (GEMM_ALIGN_EPI) { if (wr == 0) PG8_BAR; }
        if constexpr (Epi::FP8) asm volatile("s_nop 15\n\ts_nop 15" ::: "memory");
        E(acc, cur, wr, wc, fr, fq);
        if (!has_next) break;
#pragma unroll
        for (int a = 0; a < 2; ++a)
#pragma unroll
            for (int b = 0; b < 2; ++b)
#pragma unroll
                for (int m = 0; m < 4; ++m)
#pragma unroll
                    for (int n = 0; n < 2; ++n) acc[a][b][m][n] = (f32x4){0.f, 0.f, 0.f, 0.f};
        if constexpr (Epi::FP8) asm volatile("s_nop 7" ::: "memory");
        cur = nxt; cA = nA; cB = nB; ++ui;
        if constexpr (GEMM_ALIGN_EPI) { if (wr == 1) PG8_BAR; }
    }
    PG8_WAIT_V(0);
    if constexpr (!GEMM_ALIGN_EPI) { if (wr == 0) PG8_BAR; }
    PG8_BAR;
#undef PG8_SA
#undef PG8_SB
#undef PG8_STAGE
#undef PG8_LDA
#undef PG8_LDB
#undef PG8_MMA
#undef PG8_LD8
#undef PG8_LO
#undef PG8_HI
#undef PG8_WAIT_V
#undef PG8_WAIT_L
#undef PG8_BAR
#undef PG8_SCHED
}
}
using pg8::Unit;

extern __shared__ __attribute__((aligned(16))) char smem[];
__device__ __forceinline__ char* smem_base() { return smem; }

constexpr int EPI_LDS = 131072;
__device__ __forceinline__ char* epi_slot(int wr, int wc) { return smem_base() + EPI_LDS + (wr * 4 + wc) * 2048; }
__device__ __forceinline__ void slot_put(char* slot, int fr, int fq, u32x4 w0, u32x4 w1) {
    *(u32x4*)(slot + fr * 128 + (((fq) ^ (fr & 7)) << 4)) = w0; *(u32x4*)(slot + fr * 128 + (((4 + fq) ^ (fr & 7)) << 4)) = w1; }
__device__ __forceinline__ u32x4 slot_get(const char* slot, int half, int lane) { const int row = half * 8 + (lane >> 3), ch = lane & 7; return *(const u32x4*)(slot + row * 128 + ((ch ^ (row & 7)) << 4)); }

#define EPI_ROWS(ai, m) for (int ai = 0; ai < 2; ++ai) _Pragma("unroll") for (int m = 0; m < 4; ++m)

struct EpiProj {
    static constexpr bool PERM = true, FP8 = false;
    unsigned char* ws;
    __device__ __forceinline__ void operator()(const f32x4 (&acc)[2][2][4][2], const Unit& u, int wr, int wc, int fr, int fq) const {
        const int pn = u.pn; const int lane = fq * 16 + fr; char* slot = epi_slot(wr, wc);
        const int rowq = u.pm * 256 + wr * 64 + (lane >> 3);
        if (pn < 12 || (pn >= 30 && pn < 38)) {
            size_t boff; int ld, col0, act;
            if (pn < 2) { boff = WS_GQ; ld = 512; col0 = pn * 256; act = 0; }
            else if (pn < 4) { boff = WS_GK; ld = 512; col0 = (pn - 2) * 256; act = 0; }
            else if (pn < 8) { boff = WS_GV; ld = 1024; col0 = (pn - 4) * 256; act = 0; }
            else if (pn < 12) { boff = WS_GR; ld = 1024; col0 = (pn - 8) * 256; act = 1; }
            else if (pn < 34) { boff = WS_SG; ld = 1024; col0 = (pn - 30) * 256; act = 2; }
            else { boff = WS_SA; ld = 1024; col0 = (pn - 34) * 256; act = 2; }
            bf16_t* base = (bf16_t*)(ws + boff) + col0 + wc * 64 + (lane & 7) * 8;
#pragma unroll
            EPI_ROWS(ai, m) { u32x4 w[2];
#pragma unroll
                for (int bj = 0; bj < 2; ++bj) { float v[8];
#pragma unroll
                    for (int j = 0; j < 4; ++j) { v[j] = acc[ai][bj][m][0][j]; v[4 + j] = acc[ai][bj][m][1][j]; }
                    if (act == 1) {
#pragma unroll
                        for (int j = 0; j < 8; ++j) v[j] = v[j] * sigmoidf_(v[j]); }
                    if (act == 2) {
#pragma unroll
                        for (int j = 0; j < 8; ++j) v[j] = sigmoidf_(v[j]); }
                    w[bj] = pack8(v); }
                slot_put(slot, fr, fq, w[0], w[1]);
#pragma unroll
                for (int half = 0; half < 2; ++half) st_nt(base + (size_t)(rowq + ai * 128 + m * 16 + half * 8) * ld, slot_get(slot, half, lane)); }
        } else if (pn < 30) {
            const int which = (pn - 12) / 6, t6 = (pn - 12) % 6, sh = (t6 >> 1) * 2, dmask = (1 << sh) - 1, NL = SEQ >> sh;
            bf16_t* base = (bf16_t*)(ws + WS_AQ + (size_t)which * ((size_t)NTOK * 1536 * 2)) + (lane & 7) * 8;
            const bool rot = (which < 2) && (fq < 2);
            f32x4 frev;
#pragma unroll
            for (int q = 0; q < 4; ++q) frev[q] = rot ? __builtin_amdgcn_exp2f(-(float)(4 * fq + q) * (0.125f * 18.931568569324174f)) * 0.15915494309189535f : 0.f;
            const float sc = which == 0 ? QSCALE : 1.0f;
            const int head = t6 * 4 + wc;
#pragma unroll
            EPI_ROWS(ai, m) { const int s = (u.pm * 256 + wr * 64 + fr + ai * 128 + m * 16) & (SEQ - 1);
                f32x4 cs, sn;
#pragma unroll
                for (int q = 0; q < 4; ++q) { const float rev = __builtin_amdgcn_fractf((float)s * frev[q]); cs[q] = __builtin_amdgcn_cosf(rev); sn[q] = __builtin_amdgcn_sinf(rev); }
                u32x4 w[2];
#pragma unroll
                for (int bj = 0; bj < 2; ++bj) { float v[8];
#pragma unroll
                    for (int j = 0; j < 4; ++j) { v[j] = acc[ai][bj][m][0][j]; v[4 + j] = acc[ai][bj][m][1][j]; }
                    if (bj == 0) { const float a0 = v[0] * cs[0] - v[1] * sn[0], a1 = v[1] * cs[0] + v[0] * sn[0], a2 = v[2] * cs[1] - v[3] * sn[1], a3 = v[3] * cs[1] + v[2] * sn[1];
                      const float a4 = v[4] * cs[2] - v[5] * sn[2], a5 = v[5] * cs[2] + v[4] * sn[2], a6 = v[6] * cs[3] - v[7] * sn[3], a7 = v[7] * cs[3] + v[6] * sn[3];
                      v[0] = a0; v[1] = a1; v[2] = a2; v[3] = a3; v[4] = a4; v[5] = a5; v[6] = a6; v[7] = a7; }
#pragma unroll
                    for (int j = 0; j < 8; ++j) v[j] *= sc;
                    w[bj] = pack8(v); }
                slot_put(slot, fr, fq, w[0], w[1]);
#pragma unroll
                for (int half = 0; half < 2; ++half) { const int row = rowq + ai * 128 + m * 16 + half * 8, b = row >> 12, s2 = row & (SEQ - 1), r = s2 & dmask, n = s2 >> sh;
                    st_nt(base + ((size_t)(b * 24 + head) * SEQ + (size_t)r * NL + n) * 64, slot_get(slot, half, lane)); } }
        } else {
            const int row0 = u.pm * 256 + wr * 64 + fr;
            if (wc == 0 && fq < 2) { float* glr = (float*)(ws + WS_GLR);
#pragma unroll
                EPI_ROWS(ai, m) { float* rowp = glr + (size_t)(row0 + ai * 128 + m * 16) * 16 + 8 * fq; *(f32x4*)rowp = acc[ai][0][m][0]; *(f32x4*)(rowp + 4) = acc[ai][0][m][1]; } }
        }
    }
};

template <int MODE> struct EpiGate {
    static constexpr bool PERM = true, FP8 = false;
    const bf16_t* gate; const bf16_t* t1; bf16_t* out;
    __device__ __forceinline__ void operator()(const f32x4 (&acc)[2][2][4][2], const Unit& u, int wr, int wc, int fr, int fq) const {
        const int lane = fq * 16 + fr; char* slot = epi_slot(wr, wc);
        const size_t off0 = (size_t)(u.pm * 256 + wr * 64 + (lane >> 3)) * 1024 + u.pn * 256 + wc * 64 + (lane & 7) * 8;
#pragma unroll
        for (int ai = 0; ai < 2; ++ai) { u32x4 gw[4][2], tw[4][2];
#pragma unroll
            for (int m = 0; m < 4; ++m)
#pragma unroll
                for (int half = 0; half < 2; ++half) { const size_t off = off0 + (size_t)(ai * 128 + m * 16 + half * 8) * 1024; gw[m][half] = *(const u32x4*)(gate + off); if (MODE == 1) tw[m][half] = *(const u32x4*)(t1 + off); }
#pragma unroll
            for (int m = 0; m < 4; ++m) { u32x4 w[2];
#pragma unroll
                for (int bj = 0; bj < 2; ++bj) { float v[8];
#pragma unroll
                    for (int j = 0; j < 4; ++j) { v[j] = acc[ai][bj][m][0][j]; v[4 + j] = acc[ai][bj][m][1][j]; }
                    w[bj] = pack8(v); }
                slot_put(slot, fr, fq, w[0], w[1]);
#pragma unroll
                for (int half = 0; half < 2; ++half) { float a[8], g[8]; unpack8(slot_get(slot, half, lane), a); unpack8(gw[m][half], g);
#pragma unroll
                    for (int j = 0; j < 8; ++j) a[j] *= g[j];
                    if (MODE == 1) { float t[8]; unpack8(tw[m][half], t);
#pragma unroll
                        for (int j = 0; j < 8; ++j) a[j] += t[j]; }
                    *(u32x4*)(out + off0 + (size_t)(ai * 128 + m * 16 + half * 8) * 1024) = pack8(a); } } }
    }
};

struct EpiResid {
    static constexpr bool PERM = false, FP8 = false;
    const float* x; float* h;
    __device__ __forceinline__ void operator()(const f32x4 (&acc)[2][2][4][2], const Unit& u, int wr, int wc, int fr, int fq) const {
        const int lane = fq * 16 + fr; char* slot = epi_slot(wr, wc);
        const size_t off0 = (size_t)(u.pm * 256 + wr * 64 + (lane >> 3)) * 1024 + u.pn * 256 + wc * 32 + (lane & 7) * 4;
#pragma unroll
        for (int ai = 0; ai < 2; ++ai)
#pragma unroll
            for (int bj = 0; bj < 2; ++bj) { f32x4 xv[4][2];
#pragma unroll
                for (int m = 0; m < 4; ++m)
#pragma unroll
                    for (int half = 0; half < 2; ++half) xv[m][half] = *(const f32x4*)(x + off0 + (size_t)(ai * 128 + m * 16 + half * 8) * 1024 + bj * 128);
#pragma unroll
                for (int m = 0; m < 4; ++m) { slot_put(slot, fr, fq, __builtin_bit_cast(u32x4, acc[ai][bj][m][0]), __builtin_bit_cast(u32x4, acc[ai][bj][m][1]));
#pragma unroll
                    for (int half = 0; half < 2; ++half) { const f32x4 a = __builtin_bit_cast(f32x4, slot_get(slot, half, lane));
                        *(f32x4*)(h + off0 + (size_t)(ai * 128 + m * 16 + half * 8) * 1024 + bj * 128) = a + xv[m][half]; } } }
    }
};

struct EpiAct {
    static constexpr bool PERM = true, FP8 = true;
    const float* bgu; const int* tile_e; unsigned char* act;
    __device__ __forceinline__ void operator()(const f32x4 (&acc)[2][2][4][2], const Unit& u, int wr, int wc, int fr, int fq) const {
        const int e = tile_e[u.pm]; const int row0 = u.pm * 256 + wr * 64 + fr; const int j0 = u.pn * 128 + wc * 32 + 8 * fq;
        float bg[8], bu[8];
        { const float* bp = bgu + (size_t)e * 2048 + 2 * j0;
#pragma unroll
          for (int q = 0; q < 4; ++q) { const f32x4 t = *(const f32x4*)(bp + 4 * q); bg[2 * q] = t[0]; bu[2 * q] = t[1]; bg[2 * q + 1] = t[2]; bu[2 * q + 1] = t[3]; } }
#pragma unroll
        EPI_ROWS(ai, m) { float v[8];
#pragma unroll
            for (int j = 0; j < 8; ++j) { const float gt = acc[ai][0][m][j >> 2][j & 3] + bg[j], up = acc[ai][1][m][j >> 2][j & 3] + bu[j];
                const float g = fminf(gt, 7.0f), uu = fminf(fmaxf(up, -7.0f), 7.0f); v[j] = (uu + 1.0f) * (g * sigmoidf_(1.702f * g)); }
            u32x2 w8; w8.x = (unsigned)pk4_fp8(v[0], v[1], v[2], v[3]); w8.y = (unsigned)pk4_fp8(v[4], v[5], v[6], v[7]);
            *(u32x2*)(act + (size_t)(row0 + ai * 128 + m * 16) * 1024 + j0) = w8; }
    }
};

struct EpiDown {
    static constexpr bool PERM = true, FP8 = true;
    const float* bd; const int* tile_e; unsigned char* y;
    __device__ __forceinline__ void operator()(const f32x4 (&acc)[2][2][4][2], const Unit& u, int wr, int wc, int fr, int fq) const {
        const int e = tile_e[u.pm]; const int lane = fq * 16 + fr; char* slot = epi_slot(wr, wc); const int col0 = u.pn * 256 + wc * 64 + 8 * fq;
        f32x4 b[2][2];
#pragma unroll
        for (int bj = 0; bj < 2; ++bj)
#pragma unroll
            for (int n = 0; n < 2; ++n) b[bj][n] = *(const f32x4*)(bd + (size_t)e * 1024 + col0 + bj * 32 + 4 * n);
        unsigned char* base = y + (size_t)(u.pm * 256 + wr * 64 + (lane >> 2)) * 1024 + u.pn * 256 + wc * 64 + (lane & 3) * 16;
#pragma unroll
        EPI_ROWS(ai, m) { u32x2 w[2];
#pragma unroll
            for (int bj = 0; bj < 2; ++bj) { const f32x4 v0 = acc[ai][bj][m][0] + b[bj][0], v1 = acc[ai][bj][m][1] + b[bj][1];
                w[bj].x = (unsigned)pk4_fp8(v0[0], v0[1], v0[2], v0[3]); w[bj].y = (unsigned)pk4_fp8(v1[0], v1[1], v1[2], v1[3]); }
            *(u32x2*)(slot + fr * 64 + 8 * fq) = w[0]; *(u32x2*)(slot + fr * 64 + 32 + 8 * fq) = w[1];
            const u32x4 o = *(const u32x4*)(slot + (lane >> 2) * 64 + (lane & 3) * 16);
            *(u32x4*)(base + (size_t)(ai * 128 + m * 16) * 1024) = o; }
    }
};

__device__ __forceinline__ int win_colmap(int n) {
    if (n < 3072) return n;
    if (n < 7680) { const int off = n - 3072, which = off / 1536, hcol = off % 1536, head = hcol >> 6, p = hcol & 63;
        int dim = p; if (which < 2 && p < 16) dim = (p & 1) ? (p >> 1) + 8 : (p >> 1);
        return 3088 + which * 1536 + head * 64 + dim; }
    if (n < 9728) return 7696 + (n - 7680);
    if (n < 9744) return 3072 + (n - 9728);
    return -1;
}
__device__ __forceinline__ int gu_colmap(int n) { const int t = n >> 8, w = n & 255, wc = w >> 6, bj = (w >> 5) & 1, rho = w & 31; return 2 * (128 * t + 32 * wc + rho) + bj; }

__device__ __forceinline__ void transpose_tile(const float* src, int ld_src, bf16_t* dst, int K, int n0, int k0, int scol, char* lds) {
    const int t = tid_(), nl = t & 127, kq = t >> 7;
#pragma unroll
    for (int cc = 0; cc < 4; ++cc) { const int c = kq * 4 + cc; float v[8];
#pragma unroll
        for (int j = 0; j < 8; ++j) v[j] = scol >= 0 ? src[(size_t)(k0 + c * 8 + j) * ld_src + scol] : 0.f;
        *(u32x4*)(lds + nl * 256 + ((c ^ (nl & 15)) << 4)) = pack8(v); }
    __syncthreads();
#pragma unroll
    for (int pass = 0; pass < 4; ++pass) { const int idx = t + 512 * pass, n2 = idx >> 4, c2 = idx & 15;
        *(u32x4*)(dst + (size_t)(n0 + n2) * K + k0 + c2 * 8) = *(const u32x4*)(lds + n2 * 256 + ((c2 ^ (n2 & 15)) << 4)); }
    __syncthreads();
}

__device__ __forceinline__ void transpose_tile8(const float* src, int ld_src, unsigned char* dst, int K, int n0, int k0, int scol, float scale, char* lds) {
    const int t = tid_(), nl = t & 127, kq = t >> 7;
#pragma unroll
    for (int cc = 0; cc < 4; ++cc) { const int c = kq * 4 + cc; float v[16];
#pragma unroll
        for (int j = 0; j < 16; ++j) v[j] = src[(size_t)(k0 + c * 16 + j) * ld_src + scol] * scale;
        u32x4 w; w.x = (unsigned)pk4_fp8(v[0], v[1], v[2], v[3]); w.y = (unsigned)pk4_fp8(v[4], v[5], v[6], v[7]); w.z = (unsigned)pk4_fp8(v[8], v[9], v[10], v[11]); w.w = (unsigned)pk4_fp8(v[12], v[13], v[14], v[15]);
        *(u32x4*)(lds + nl * 256 + ((c ^ (nl & 15)) << 4)) = w; }
    __syncthreads();
#pragma unroll
    for (int pass = 0; pass < 4; ++pass) { const int idx = t + 512 * pass, n2 = idx >> 4, c2 = idx & 15;
        *(u32x4*)(dst + (size_t)(n0 + n2) * K + k0 + c2 * 16) = *(const u32x4*)(lds + n2 * 256 + ((c2 ^ (n2 & 15)) << 4)); }
    __syncthreads();
}

template <int MAP> __device__ __forceinline__ int tile_rowmap(int o) {
    if (MAP == 1) { const int d = o & 63; const int pp = d < 16 ? (d < 8 ? 2 * d : 2 * (d - 8) + 1) : d; return (o & 64) + pp; }
    if (MAP == 2) { const int wcl = o >> 6, w = o & 63; return 64 * wcl + 32 * (w & 1) + (w >> 1); }
    return o;
}
template <int MAP, bool F8> __device__ __forceinline__ void transpose_fast(const float* src  , int ld_src, unsigned char* dst, int Kb  , int n0, int k0, float scale, char* lds) {
    constexpr int KPT = F8 ? 16 : 8;
    const int t = tid_(), ng = t & 31, kg = t >> 5;
    f32x4 v[KPT];
#pragma unroll
    for (int j = 0; j < KPT; ++j) v[j] = *(const f32x4*)(src + (size_t)(k0 + kg * KPT + j) * ld_src + 4 * ng);
#pragma unroll
    for (int i = 0; i < 4; ++i) { const int row = tile_rowmap<MAP>(4 * ng + i); u32x4 w;
        if (F8) { w.x = (unsigned)pk4_fp8(v[0][i] * scale, v[1][i] * scale, v[2][i] * scale, v[3][i] * scale); w.y = (unsigned)pk4_fp8(v[4][i] * scale, v[5][i] * scale, v[6][i] * scale, v[7][i] * scale);
                  w.z = (unsigned)pk4_fp8(v[8 % KPT][i] * scale, v[9 % KPT][i] * scale, v[10 % KPT][i] * scale, v[11 % KPT][i] * scale); w.w = (unsigned)pk4_fp8(v[12 % KPT][i] * scale, v[13 % KPT][i] * scale, v[14 % KPT][i] * scale, v[15 % KPT][i] * scale); }
        else { w.x = cvt_pk_bf16(v[0][i], v[1][i]); w.y = cvt_pk_bf16(v[2][i], v[3][i]); w.z = cvt_pk_bf16(v[4][i], v[5][i]); w.w = cvt_pk_bf16(v[6][i], v[7][i]); }
        *(u32x4*)(lds + row * 256 + ((kg ^ (row & 15)) << 4)) = w; }
    __syncthreads();
#pragma unroll
    for (int pass = 0; pass < 4; ++pass) { const int idx = t + 512 * pass, n2 = idx >> 4, c2 = idx & 15;
        *(u32x4*)(dst + (size_t)(n0 + n2) * Kb + (size_t)k0 * (F8 ? 1 : 2) + c2 * 16) = *(const u32x4*)(lds + n2 * 256 + ((c2 ^ (n2 & 15)) << 4)); }
    __syncthreads();
}

__device__ __forceinline__ void phase_prologue(const Params& p, char* lds) {
    unsigned char* ws = opaque(p.ws);
    const int tid = tid_(), lane = tid & 63, wid = tid >> 6, G = gridDim.x, bid = blockIdx.x;
    { bf16_t* xn = (bf16_t*)(ws + WS_XN);
      for (int row = bid * 8 + wid; row < NTOK; row += G * 8) { const float* xr = p.x + (size_t)row * 1024; f32x4 v[4]; float ss = 0.f;
#pragma unroll
          for (int i = 0; i < 4; ++i) { v[i] = *(const f32x4*)(xr + i * 256 + lane * 4); ss += v[i][0] * v[i][0] + v[i][1] * v[i][1] + v[i][2] * v[i][2] + v[i][3] * v[i][3]; }
          ss = wave_sum(ss); const float rs = rsqrtf(ss * (1.0f / 1024.0f) + EPS);
#pragma unroll
          for (int i = 0; i < 4; ++i) { const f32x4 g = *(const f32x4*)(p.norm_mix_g + i * 256 + lane * 4); u32x2 w; w.x = cvt_pk_bf16(v[i][0] * rs * g[0], v[i][1] * rs * g[1]); w.y = cvt_pk_bf16(v[i][2] * rs * g[2], v[i][3] * rs * g[3]);
              *(u32x2*)(xn + (size_t)row * 1024 + i * 256 + lane * 4) = w; } } }
    { float* rwg = (float*)(ws + WS_RWG);
      for (int i = bid * 512 + tid; i < 1024 * 32; i += G * 512) rwg[i] = p.router_w[i] * p.norm_ffn_g[i >> 5]; }
    { constexpr int T0 = 78 * 8, T1 = T0 + 64, T2 = T1 + 32, T3 = T2 + 64, T4 = T3 + 32 * 64, T5 = T4 + 32 * 32;
      const int nl = tid & 127;
      for (int tile = bid; tile < T3; tile += G) {
          if (tile < T0) { const int nt_ = tile >> 3, kt = tile & 7; bf16_t* d = (bf16_t*)(ws + WS_W_IN); unsigned char* d8 = ws + WS_W_IN;
              if (nt_ < 24) transpose_fast<0, false>(p.w_in + nt_ * 128, INW, d8, 2048, nt_ * 128, kt * 128, 1.f, lds);
              else if (nt_ < 48) transpose_fast<1, false>(p.w_in + 3088 + (nt_ - 24) * 128, INW, d8, 2048, nt_ * 128, kt * 128, 1.f, lds);
              else if (nt_ < 60) transpose_fast<0, false>(p.w_in + 3088 + (nt_ - 24) * 128, INW, d8, 2048, nt_ * 128, kt * 128, 1.f, lds);
              else if (nt_ < 76) transpose_fast<0, false>(p.w_in + 7696 + (nt_ - 60) * 128, INW, d8, 2048, nt_ * 128, kt * 128, 1.f, lds);
              else transpose_tile(p.w_in, INW, d, 1024, nt_ * 128, kt * 128, win_colmap(nt_ * 128 + nl), lds); }
          else if (tile < T1) { const int q = tile - T0, nt_ = q >> 3, kt = q & 7; transpose_fast<0, false>(p.w_branch_gla + nt_ * 128, 1024, ws + WS_W_G, 2048, nt_ * 128, kt * 128, 1.f, lds); }
          else if (tile < T2) { const int q = tile - T1, nt_ = q >> 2, kt = q & 3; transpose_fast<0, false>(p.w_branch_att + nt_ * 128, 1024, ws + WS_W_A, 1024, nt_ * 128, kt * 128, 1.f, lds); }
          else if (tile < T3) { const int q = tile - T2, nt_ = q >> 3, kt = q & 7; transpose_fast<0, false>(p.w_mix_out + nt_ * 128, 1024, ws + WS_W_MIX, 2048, nt_ * 128, kt * 128, 1.f, lds); }
      } }
}

constexpr int N_EXPERT_TILES = 32 * 64 + 32 * 32;
__device__ __forceinline__ void expert_convert(const Params& p, char* lds, int first, int stride) {
    unsigned char* ws = opaque(p.ws);
    for (int q0 = first; q0 < N_EXPERT_TILES; q0 += stride) {
        if (q0 < 32 * 64) { const int q = q0, e = q >> 6, r = q & 63, nt_ = r >> 2, kt = r & 3;
            transpose_fast<2, true>(p.e_w_gu + (size_t)e * 1024 * 2048 + nt_ * 128, 2048, ws + WS_W_GU + (size_t)e * 2048 * 1024, 1024, nt_ * 128, kt * 256, 32.0f, lds); }
        else { const int q = q0 - 32 * 64, e = q >> 5, r = q & 31, nt_ = r >> 2, kt = r & 3;
            transpose_fast<0, true>(p.e_w_d + (size_t)e * 1024 * 1024 + nt_ * 128, 1024, ws + WS_W_D + (size_t)e * 1024 * 1024, 1024, nt_ * 128, kt * 256, 32.0f, lds); }
    }
}

constexpr int AT_KCS = 385 * 16;
constexpr int AT_VH = 385 * 64;
constexpr int AT_K = 0, AT_V = 8 * AT_KCS, AT_WL = AT_V + 2 * AT_VH, AT_STG = AT_WL + 8 * 128, AT_END = AT_STG + 8 * 4096;
static_assert(AT_END <= LDS_BYTES, "attention LDS");
struct AttnPre { u32x4 k[6], v[6]; bf16x8 q[4]; };
__device__ __forceinline__ void attn_fetch(const Params& p, int item, AttnPre& r) {
    unsigned char* ws = opaque(p.ws); const int tid = tid_();
    const int jj = item & 15, bh = item >> 4, head = bh % 24, g = head >> 3, sh = 2 * g, NL = SEQ >> sh, ppr = 16 >> sh; const int rr_ = jj / ppr, j = jj % ppr;
    const size_t hb = ((size_t)bh * SEQ + (size_t)rr_ * NL) * 64; const bf16_t* Kg = (const bf16_t*)(ws + WS_AK) + hb; const bf16_t* Vg = (const bf16_t*)(ws + WS_AV) + hb; const int kn0 = 256 * j - 128;
    { const int lane = tid & 63, r32 = lane & 31, hi = lane >> 5, w = tid >> 6; const bf16_t* Q = (const bf16_t*)(ws + WS_AQ) + hb;
#pragma unroll
      for (int d0 = 0; d0 < 4; ++d0) r.q[d0] = *(const bf16x8*)(Q + (size_t)(256 * j + 32 * w + r32) * 64 + d0 * 16 + hi * 8); }
#pragma unroll
    for (int i = 0; i < 6; ++i) { const int idx = tid + 512 * i, key = idx >> 3, c = idx & 7;
        if (kn0 + key >= 0) { r.k[i] = *(const u32x4*)(Kg + (ptrdiff_t)(kn0 + key) * 64 + c * 8); r.v[i] = *(const u32x4*)(Vg + (ptrdiff_t)(kn0 + key) * 64 + c * 8); } }
}
__device__ __forceinline__ void attn_item(const Params& p, int item, int nitem, bool has_next, AttnPre& pre, char* lds) {
    unsigned char* ws = opaque(p.ws);
    const int tid = tid_(), lane = tid & 63, r32 = lane & 31, hi = lane >> 5; const int w = __builtin_amdgcn_readfirstlane(tid >> 6);
    const int jj = item & 15, bh = item >> 4, head = bh % 24, b = bh / 24, g = head >> 3, sh = 2 * g, d = 1 << sh, NL = SEQ >> sh, ppr = 16 >> sh;
    const int r = jj / ppr, j = jj % ppr;
    const size_t hb = ((size_t)bh * SEQ + (size_t)r * NL) * 64;
    const bf16_t* Q = (const bf16_t*)(ws + WS_AQ) + hb;
    const int kn0 = 256 * j - 128;
    bf16x8 qf[4];
#pragma unroll
    for (int d0 = 0; d0 < 4; ++d0) qf[d0] = pre.q[d0];
#pragma unroll
    for (int i = 0; i < 6; ++i) { const int idx = tid + 512 * i, key = idx >> 3, c = idx & 7;
        if (kn0 + key >= 0) { *(u32x4*)(lds + AT_K + c * AT_KCS + key * 16) = pre.k[i]; *(u32x4*)(lds + AT_V + (c >> 2) * AT_VH + key * 64 + (c & 3) * 16) = pre.v[i]; } }
    __syncthreads();
    if (has_next) attn_fetch(p, nitem, pre);
    const LDS3 char* l3 = (const LDS3 char*)lds;
    f32x16 s[5]; const int ktmin = (j == 0) ? 4 : 0;
#pragma unroll
    for (int t5 = 0; t5 < 5; ++t5) { const int kt = w + t5;
        if (kt >= ktmin) { f32x16 a = {};
#pragma unroll
            for (int d0 = 0; d0 < 4; ++d0) { const bf16x8 kf = *(const LDS3 bf16x8*)(l3 + AT_K + (2 * d0 + hi) * AT_KCS + (kt * 32 + r32) * 16); a = MFMA32(kf, qf[d0], a); }
            s[t5] = a; }
        else {
#pragma unroll
            for (int rr = 0; rr < 16; ++rr) s[t5][rr] = -1e30f; } }
#pragma unroll
    for (int rr = 0; rr < 16; ++rr) { const int c = crow(rr, hi); if (c < r32) s[0][rr] = -1e30f; if (c > r32) s[4][rr] = -1e30f; }
    float mx = -1e30f;
#pragma unroll
    for (int t5 = 0; t5 < 5; ++t5)
#pragma unroll
        for (int rr = 0; rr < 16; ++rr) mx = fmaxf(mx, s[t5][rr]);
    mx = fmaxf(mx, __shfl_xor(mx, 32));
    float l = 0.f;
#pragma unroll
    for (int t5 = 0; t5 < 5; ++t5)
#pragma unroll
        for (int rr = 0; rr < 16; ++rr) { const float e = __builtin_amdgcn_exp2f(s[t5][rr] - mx); s[t5][rr] = e; l += e; }
    l += __shfl_xor(l, 32);
    f32x16 o[2]; o[0] = f32x16{}; o[1] = f32x16{};
    const int blk = (lane >> 4) & 1, q4 = (lane & 15) >> 2, p4 = lane & 3;
#pragma unroll
    for (int t5 = 0; t5 < 5; ++t5) { const int kt = w + t5;
        if (kt >= ktmin) {
#pragma unroll
            for (int ss = 0; ss < 2; ++ss) { float pv[8];
#pragma unroll
                for (int q = 0; q < 8; ++q) pv[q] = s[t5][8 * ss + q];
                const bf16x8 pa = __builtin_bit_cast(bf16x8, pack8(pv));
#pragma unroll
                for (int dh = 0; dh < 2; ++dh) { const LDS3 char* vp = l3 + AT_V + dh * AT_VH + (kt * 32 + 16 * ss + 4 * hi + q4) * 64 + (16 * blk + 4 * p4) * 2;
                    const bf16x8 vf = cat8(tr16(vp), tr16(vp + 8 * 64)); o[dh] = MFMA32(pa, vf, o[dh]); } } } }
    const int n_q = 256 * j + 32 * w + r32; const int tok = b * SEQ + n_q * d + r;
    if (hi == 0) { ((float*)(ws + WS_LSE))[((size_t)g * NTOK + tok) * 8 + (head & 7)] = (mx + __builtin_amdgcn_logf(l)) * LN2;
        ((float*)(lds + AT_WL))[w * 32 + r32] = __builtin_amdgcn_rcpf(l); }
    bf16_t* stg = (bf16_t*)(lds + AT_STG) + w * 2048;
#pragma unroll
    for (int rr = 0; rr < 16; ++rr) { const int qr = crow(rr, hi); const float rl = ((const float*)(lds + AT_WL))[w * 32 + qr];
#pragma unroll
        for (int dh = 0; dh < 2; ++dh) stg[qr * 64 + dh * 32 + r32] = (bf16_t)(cvt_pk_bf16(o[dh][rr] * rl, 0.f) & 0xffffu); }
    bf16_t* og = (bf16_t*)(ws + WS_OATT) + (size_t)g * NTOK * 512;
#pragma unroll
    for (int i = 0; i < 4; ++i) { const int idx = i * 64 + lane, row = idx >> 3, ch = idx & 7; const int tk = b * SEQ + (256 * j + 32 * w + row) * d + r;
        *(u32x4*)(og + (size_t)tk * 512 + (head & 7) * 64 + ch * 8) = *(const u32x4*)(stg + row * 64 + ch * 8); }
    __syncthreads();
}

constexpr int G1_BB = 0;
constexpr int G1_QE = G1_BB + 64 * 128 * 4;
constexpr int G1_KE = G1_QE + 64 * 272;
constexpr int G1_KD = G1_KE + 64 * 272;
constexpr int G1_V = G1_KD + 64 * 320;
constexpr int G1_GLR = G1_V + 64 * 576;
constexpr int G1_GUP = G1_GLR + 64 * 16 * 4;
constexpr int G1_SEG = G1_GUP + 16 * 128 * 4;
constexpr int G1_BIAS = G1_SEG + 4 * 128 * 4;
constexpr int G1_END = G1_BIAS + 128 * 4;
constexpr int G1_SU = 0;
constexpr int G1_SO = 128 * 528;
static_assert(G1_SO + 64 * 528 <= G1_GLR, "gla1 staging");
static_assert(G1_END <= LDS_BYTES, "gla1 LDS");
__device__ __forceinline__ float logsigmoidf_(float z) { return fminf(z, 0.f) - log1pf(__expf(-fabsf(z))); }
struct G1Pre { u32x4 q[2], k[2], v[4]; float glr[2]; };
__device__ __forceinline__ void gla1_fetch(const Params& p, int item, G1Pre& r) {
    unsigned char* ws = opaque(p.ws); const int tid = tid_();
    const int n = item & 63, bh = item >> 6, h = bh & 3, b = bh >> 2; const int tok0 = b * SEQ + n * 64;
    const bf16_t* gq = (const bf16_t*)(ws + WS_GQ); const bf16_t* gk = (const bf16_t*)(ws + WS_GK); const bf16_t* gv = (const bf16_t*)(ws + WS_GV);
#pragma unroll
    for (int pp = 0; pp < 2; ++pp) { const int idx = tid + 512 * pp, i = idx >> 4, c = idx & 15; const size_t go = (size_t)(tok0 + i) * 512 + h * 128 + c * 8; r.q[pp] = *(const u32x4*)(gq + go); r.k[pp] = *(const u32x4*)(gk + go);
        r.glr[pp] = ((const float*)(ws + WS_GLR))[(size_t)tok0 * 16 + idx]; }
#pragma unroll
    for (int pp = 0; pp < 4; ++pp) { const int idx = tid + 512 * pp, jv = idx >> 5, c = idx & 31; r.v[pp] = *(const u32x4*)(gv + (size_t)(tok0 + jv) * 1024 + h * 256 + c * 8); }
}
__device__ __forceinline__ void gla1_head_operands(const Params& p, int h, char* lds) {
    const int tid = tid_(); float* GUP = (float*)(lds + G1_GUP); float* BIAS = (float*)(lds + G1_BIAS);
    for (int i = tid; i < 16 * 128; i += 512) GUP[i] = p.gla_gate_up[(i >> 7) * 512 + h * 128 + (i & 127)];
    if (tid < 128) BIAS[tid] = p.gla_gate_bias[h * 128 + tid];
}
__device__ __forceinline__ void gla1_item(const Params& p, int item, int nitem, bool has_next, bool reload_head, G1Pre& pre, char* lds) {
    unsigned char* ws = opaque(p.ws);
    const int tid = tid_(), lane = tid & 63, r32 = lane & 31, hi = lane >> 5; const int w = __builtin_amdgcn_readfirstlane(tid >> 6);
    const int n = item & 63, bh = item >> 6, h = bh & 3, b = bh >> 2; const int tok0 = b * SEQ + n * 64;
    float* BB = (float*)(lds + G1_BB); float* GLRs = (float*)(lds + G1_GLR); float* GUP = (float*)(lds + G1_GUP); float* SEGs = (float*)(lds + G1_SEG); float* BIAS = (float*)(lds + G1_BIAS);
    u32x4 qraw[2], kraw[2], vraw[4];
#pragma unroll
    for (int pp = 0; pp < 2; ++pp) { qraw[pp] = pre.q[pp]; kraw[pp] = pre.k[pp]; GLRs[tid + 512 * pp] = pre.glr[pp]; }
#pragma unroll
    for (int pp = 0; pp < 4; ++pp) vraw[pp] = pre.v[pp];
    if (reload_head) gla1_head_operands(p, h, lds);
    __syncthreads();
    if (has_next) gla1_fetch(p, nitem, pre);
    { const int d = tid & 127, seg = tid >> 7; float gu[16];
#pragma unroll
      for (int r = 0; r < 16; ++r) gu[r] = GUP[r * 128 + d];
      const float bias = BIAS[d]; float run = 0.f;
#pragma unroll 4
      for (int ii = 0; ii < 16; ++ii) { const int i = seg * 16 + ii; float z = bias;
#pragma unroll
          for (int r4 = 0; r4 < 4; ++r4) { const f32x4 gl = *(const f32x4*)(GLRs + i * 16 + r4 * 4); z += gl[0] * gu[r4 * 4] + gl[1] * gu[r4 * 4 + 1] + gl[2] * gu[r4 * 4 + 2] + gl[3] * gu[r4 * 4 + 3]; }
          run += logsigmoidf_(z) * (1.0f / 16.0f); BB[i * 128 + d] = run; }
      SEGs[seg * 128 + d] = run;
      __syncthreads();
      float off = 0.f; for (int s2 = 0; s2 < seg; ++s2) off += SEGs[s2 * 128 + d];
      if (seg > 0) { for (int ii = 0; ii < 16; ++ii) BB[(seg * 16 + ii) * 128 + d] += off; }
      __syncthreads(); }
    { const bf16_t* gq = (const bf16_t*)(ws + WS_GQ); const bf16_t* gk = (const bf16_t*)(ws + WS_GK); const bf16_t* gv = (const bf16_t*)(ws + WS_GV); bf16_t* qeg = (bf16_t*)(ws + WS_QE);
#pragma unroll
      for (int pp = 0; pp < 2; ++pp) { const int idx = tid + 512 * pp, i = idx >> 4, c = idx & 15, d0 = c * 8; const size_t go = (size_t)(tok0 + i) * 512 + h * 128 + d0;
          float q[8], k[8], qe[8], ke[8], kd[8]; unpack8(qraw[pp], q); unpack8(kraw[pp], k);
#pragma unroll
          for (int j = 0; j < 8; ++j) { const float bb = BB[i * 128 + d0 + j], bl = BB[63 * 128 + d0 + j]; qe[j] = q[j] * __expf(bb) * 0.08838834764831845f; ke[j] = k[j] * __expf(-bb); kd[j] = k[j] * __expf(bl - bb); }
          const u32x4 qw = pack8(qe); *(u32x4*)(lds + G1_QE + i * 272 + c * 16) = qw; *(u32x4*)(qeg + go) = qw;
          *(u32x4*)(lds + G1_KE + i * 272 + c * 16) = pack8(ke); *(u32x4*)(lds + G1_KD + i * 320 + c * 16) = pack8(kd); }
#pragma unroll
      for (int pp = 0; pp < 4; ++pp) { const int idx = tid + 512 * pp, jv = idx >> 5, c = idx & 31; *(u32x4*)(lds + G1_V + jv * 576 + c * 16) = vraw[pp]; }
      if (tid < 128) ((float*)(ws + WS_DEC))[(size_t)item * 128 + tid] = __expf(BB[63 * 128 + tid]);
      __syncthreads(); }
    const LDS3 char* l3 = (const LDS3 char*)lds; const int blk = (lane >> 4) & 1, q4 = (lane & 15) >> 2, p4 = lane & 3;
    {
      const int it = w & 1, vq = w >> 1; f32x16 oi[2]; oi[0] = f32x16{}; oi[1] = f32x16{};
#pragma unroll
      for (int jt = 0; jt < 2; ++jt) { if (jt <= it) { f32x16 x = {};
#pragma unroll
          for (int s = 0; s < 8; ++s) { const bf16x8 a = *(const LDS3 bf16x8*)(l3 + G1_KE + (jt * 32 + r32) * 272 + (16 * s + 8 * hi) * 2), bq = *(const LDS3 bf16x8*)(l3 + G1_QE + (it * 32 + r32) * 272 + (16 * s + 8 * hi) * 2); x = MFMA32(a, bq, x); }
          if (jt == it) {
#pragma unroll
              for (int rr = 0; rr < 16; ++rr) if (crow(rr, hi) > r32) x[rr] = 0.f; }
#pragma unroll
          for (int ss = 0; ss < 2; ++ss) { float xv[8];
#pragma unroll
              for (int q = 0; q < 8; ++q) xv[q] = x[8 * ss + q];
              const bf16x8 xa = __builtin_bit_cast(bf16x8, pack8(xv));
#pragma unroll
              for (int vi = 0; vi < 2; ++vi) { const int vt = 2 * vq + vi; const LDS3 char* vp = l3 + G1_V + (jt * 32 + 16 * ss + 4 * hi + q4) * 576 + (vt * 32 + 16 * blk + 4 * p4) * 2;
                  const bf16x8 vf = cat8(tr16(vp), tr16(vp + 8 * 576)); oi[vi] = MFMA32(xa, vf, oi[vi]); } } } }
      const int dt = w & 3, vg = w >> 2; f32x16 uu[4]; uu[0] = f32x16{}; uu[1] = f32x16{}; uu[2] = f32x16{}; uu[3] = f32x16{};
#pragma unroll
      for (int ks = 0; ks < 4; ++ks) { const LDS3 char* ap = l3 + G1_KD + (16 * ks + 8 * hi + q4) * 320 + (dt * 32 + 16 * blk + 4 * p4) * 2; const bf16x8 a = cat8(tr16(ap), tr16(ap + 4 * 320));
#pragma unroll
          for (int vi = 0; vi < 4; ++vi) { const int vt = 4 * vg + vi; const LDS3 char* vp = l3 + G1_V + (16 * ks + 8 * hi + q4) * 576 + (vt * 32 + 16 * blk + 4 * p4) * 2; const bf16x8 vf = cat8(tr16(vp), tr16(vp + 4 * 576)); uu[vi] = MFMA32(a, vf, uu[vi]); } }
      __syncthreads();
      bf16_t* SU = (bf16_t*)(lds + G1_SU); bf16_t* SO = (bf16_t*)(lds + G1_SO);
#pragma unroll
      for (int vi = 0; vi < 4; ++vi)
#pragma unroll
          for (int rr = 0; rr < 16; ++rr) SU[(dt * 32 + crow(rr, hi)) * 264 + (4 * vg + vi) * 32 + r32] = (bf16_t)(cvt_pk_bf16(uu[vi][rr], 0.f) & 0xffffu);
#pragma unroll
      for (int vi = 0; vi < 2; ++vi)
#pragma unroll
          for (int rr = 0; rr < 16; ++rr) SO[(it * 32 + crow(rr, hi)) * 264 + (2 * vq + vi) * 32 + r32] = (bf16_t)(cvt_pk_bf16(oi[vi][rr], 0.f) & 0xffffu);
      __syncthreads();
      bf16_t* ug = (bf16_t*)(ws + WS_U) + (size_t)item * 128 * 256; bf16_t* og = (bf16_t*)(ws + WS_OINTRA);
#pragma unroll
      for (int pp = 0; pp < 8; ++pp) { const int idx = tid + 512 * pp, row = idx >> 5, c = idx & 31; *(u32x4*)(ug + (size_t)row * 256 + c * 8) = *(const u32x4*)(SU + row * 264 + c * 8); }
#pragma unroll
      for (int pp = 0; pp < 4; ++pp) { const int idx = tid + 512 * pp, row = idx >> 5, c = idx & 31; *(u32x4*)(og + (size_t)(tok0 + row) * 1024 + h * 256 + c * 8) = *(const u32x4*)(SO + row * 264 + c * 8); } }
    __syncthreads();
}

__device__ __forceinline__ void phase_scan_combine(const Params& p) {
    unsigned char* ws = opaque(p.ws); const int G = gridDim.x;
    { const bf16_t* U = (const bf16_t*)(ws + WS_U); bf16_t* PV = (bf16_t*)(ws + WS_PREV); const float* DEC = (const float*)(ws + WS_DEC);
      for (int idx = blockIdx.x * 512 + tid_(); idx < 16 * 128 * 64; idx += G * 512) { const int bh = idx >> 13, rem = idx & 8191, d = rem >> 6, vq = rem & 63;
          float st[4] = {0.f, 0.f, 0.f, 0.f}; const size_t e0 = ((size_t)bh * 64 * 128 + d) * 256 + vq * 4;
#pragma unroll 8
          for (int n = 0; n < 64; ++n) { const size_t e = e0 + (size_t)n * 128 * 256; const u32x2 uw = *(const u32x2*)(U + e); const float dc = DEC[(size_t)(bh * 64 + n) * 128 + d];
              u32x2 pw; pw.x = cvt_pk_bf16(st[0], st[1]); pw.y = cvt_pk_bf16(st[2], st[3]); *(u32x2*)(PV + e) = pw;
              st[0] = dc * st[0] + bf_lo(uw.x); st[1] = dc * st[1] + bf_hi(uw.x); st[2] = dc * st[2] + bf_lo(uw.y); st[3] = dc * st[3] + bf_hi(uw.y); } } }
    { const bf16_t* OG = (const bf16_t*)(ws + WS_OATT); const float* LSE = (const float*)(ws + WS_LSE); bf16_t* YA = (bf16_t*)(ws + WS_YATT);
#pragma unroll 2
      for (int idx = blockIdx.x * 512 + tid_(); idx < NTOK * 64; idx += G * 512) { const int tok = idx >> 6, jc = idx & 63, jh = jc >> 3;
          const float l0 = LSE[(size_t)tok * 8 + jh], l1 = LSE[((size_t)NTOK + tok) * 8 + jh], l2 = LSE[((size_t)2 * NTOK + tok) * 8 + jh];
          const float m = fmaxf(l0, fmaxf(l1, l2)); float a0 = __expf(l0 - m), a1 = __expf(l1 - m), a2 = __expf(l2 - m); const float inv = __builtin_amdgcn_rcpf(a0 + a1 + a2); a0 *= inv; a1 *= inv; a2 *= inv;
          float o0[8], o1[8], o2[8], y[8]; const size_t off = (size_t)tok * 512 + jc * 8;
          unpack8(*(const u32x4*)(OG + off), o0); unpack8(*(const u32x4*)(OG + (size_t)NTOK * 512 + off), o1); unpack8(*(const u32x4*)(OG + (size_t)2 * NTOK * 512 + off), o2);
#pragma unroll
          for (int q = 0; q < 8; ++q) y[q] = a0 * o0[q] + a1 * o1[q] + a2 * o2[q];
          *(u32x4*)(YA + off) = pack8(y); } }
}

constexpr int G3_PREV = 0;
constexpr int G3_SS = G3_PREV + 128 * 576;
constexpr int G3_OI = G3_SS + 8 * 32 * 4;
constexpr int G3_GR = G3_OI + 64 * 528;
constexpr int G3_END = G3_GR + 64 * 528;
static_assert(G3_END <= LDS_XB, "gla3 LDS");
struct G3Pre { u32x4 pv[8], oi[4], gr[4]; };
__device__ __forceinline__ void gla3_fetch(const Params& p, int item, G3Pre& r) {
    unsigned char* ws = opaque(p.ws); const int tid = tid_();
    const int n = item & 63, bh = item >> 6, h = bh & 3, b = bh >> 2; const int tok0 = b * SEQ + n * 64;
    const bf16_t* PV = (const bf16_t*)(ws + WS_PREV) + (size_t)item * 128 * 256;
#pragma unroll
    for (int pp = 0; pp < 8; ++pp) { const int idx = tid + 512 * pp, d = idx >> 5, c = idx & 31; r.pv[pp] = *(const u32x4*)(PV + (size_t)d * 256 + c * 8); }
#pragma unroll
    for (int pp = 0; pp < 4; ++pp) { const int idx = tid + 512 * pp, row = idx >> 5, c = idx & 31; const size_t go = (size_t)(tok0 + row) * 1024 + h * 256 + c * 8;
        r.oi[pp] = *(const u32x4*)((const bf16_t*)(ws + WS_OINTRA) + go); r.gr[pp] = *(const u32x4*)((const bf16_t*)(ws + WS_GR) + go); }
}
__device__ __forceinline__ void gla3_item(const Params& p, int item, int nitem, bool has_next, G3Pre& pre, char* lds) {
    unsigned char* ws = opaque(p.ws);
    const int tid = tid_(), lane = tid & 63, r32 = lane & 31, hi = lane >> 5; const int w = __builtin_amdgcn_readfirstlane(tid >> 6);
    const int n = item & 63, bh = item >> 6, h = bh & 3, b = bh >> 2; const int tok0 = b * SEQ + n * 64;
    bf16_t* SOI = (bf16_t*)(lds + G3_OI); bf16_t* SGR = (bf16_t*)(lds + G3_GR);
#pragma unroll
    for (int pp = 0; pp < 8; ++pp) { const int idx = tid + 512 * pp, d = idx >> 5, c = idx & 31; *(u32x4*)(lds + G3_PREV + d * 576 + c * 16) = pre.pv[pp]; }
#pragma unroll
    for (int pp = 0; pp < 4; ++pp) { const int idx = tid + 512 * pp, row = idx >> 5, c = idx & 31; *(u32x4*)(SOI + row * 264 + c * 8) = pre.oi[pp]; *(u32x4*)(SGR + row * 264 + c * 8) = pre.gr[pp]; }
    const int it = w & 1, vq = w >> 1; const bf16_t* qeg = (const bf16_t*)(ws + WS_QE) + (size_t)(tok0 + it * 32 + r32) * 512 + h * 128;
    bf16x8 qa[8];
#pragma unroll
    for (int s = 0; s < 8; ++s) qa[s] = *(const bf16x8*)(qeg + 16 * s + 8 * hi);
    __syncthreads();
    if (has_next) gla3_fetch(p, nitem, pre);
    const LDS3 char* l3 = (const LDS3 char*)lds; const int blk = (lane >> 4) & 1, q4 = (lane & 15) >> 2, p4 = lane & 3;
    f32x16 o[2];
#pragma unroll
    for (int vi = 0; vi < 2; ++vi)
#pragma unroll
        for (int rr = 0; rr < 16; ++rr) o[vi][rr] = bf2f(SOI[(it * 32 + crow(rr, hi)) * 264 + (2 * vq + vi) * 32 + r32]);
#pragma unroll
    for (int s = 0; s < 8; ++s)
#pragma unroll
        for (int vi = 0; vi < 2; ++vi) { const int vt = 2 * vq + vi; const LDS3 char* pp_ = l3 + G3_PREV + (16 * s + 8 * hi + q4) * 576 + (vt * 32 + 16 * blk + 4 * p4) * 2; const bf16x8 pf = cat8(tr16(pp_), tr16(pp_ + 4 * 576)); o[vi] = MFMA32(qa[s], pf, o[vi]); }
    float* SS = (float*)(lds + G3_SS);
#pragma unroll
    for (int rr = 0; rr < 16; ++rr) { float q = o[0][rr] * o[0][rr] + o[1][rr] * o[1][rr]; q += __shfl_xor(q, 16); q += __shfl_xor(q, 8); q += __shfl_xor(q, 4); q += __shfl_xor(q, 2); q += __shfl_xor(q, 1);
        if (r32 == 0) SS[w * 32 + crow(rr, hi)] = q; }
    __syncthreads();
    float ng[2]; ng[0] = p.gla_norm_g[(2 * vq) * 32 + r32]; ng[1] = p.gla_norm_g[(2 * vq + 1) * 32 + r32];
#pragma unroll
    for (int rr = 0; rr < 16; ++rr) { const int row = crow(rr, hi); const float tot = SS[(it + 0) * 32 + row] + SS[(it + 2) * 32 + row] + SS[(it + 4) * 32 + row] + SS[(it + 6) * 32 + row];
        const float rs = rsqrtf(tot * (1.0f / 256.0f) + EPS);
#pragma unroll
        for (int vi = 0; vi < 2; ++vi) { const int li = (it * 32 + row) * 264 + (2 * vq + vi) * 32 + r32; const float y = o[vi][rr] * rs * ng[vi] * bf2f(SGR[li]); SOI[li] = (bf16_t)(cvt_pk_bf16(y, 0.f) & 0xffffu); } }
    __syncthreads();
    bf16_t* yg = (bf16_t*)(ws + WS_YGLA);
#pragma unroll
    for (int pp = 0; pp < 4; ++pp) { const int idx = tid + 512 * pp, row = idx >> 5, c = idx & 31; *(u32x4*)(yg + (size_t)(tok0 + row) * 1024 + h * 256 + c * 8) = *(const u32x4*)(SOI + row * 264 + c * 8); }
    __syncthreads();
}

constexpr int RT_RSTD = 0;
constexpr int RT_LOG = 256;
constexpr int RT_CNT = RT_LOG + 64 * 32 * 4;
__device__ __forceinline__ void route_group(const Params& p, int grp, char* lds) {
    unsigned char* ws = opaque(p.ws); const int tid = tid_(), lane = tid & 63; const int w = __builtin_amdgcn_readfirstlane(tid >> 6);
    const float* H = (const float*)(ws + WS_H); const float* RWG = (const float*)(ws + WS_RWG);
    float* RSTD = (float*)(lds + RT_RSTD); float* LOGS = (float*)(lds + RT_LOG); int* LCNT = (int*)(lds + RT_CNT);
    const int tok0 = grp * 64;
    if (tid < 32) LCNT[tid] = 0;
    if (w < 4) { const int tl = lane & 15, kq = lane >> 4; const float* hr = H + (size_t)(tok0 + w * 16 + tl) * 1024 + kq * 256; const float* br = RWG + (size_t)(kq * 256) * 32 + tl;
        f32x4 a0 = {0.f, 0.f, 0.f, 0.f}, a1 = {0.f, 0.f, 0.f, 0.f}; float ss = 0.f;
#pragma unroll 4
        for (int m4 = 0; m4 < 64; ++m4) { const f32x4 hv = *(const f32x4*)(hr + m4 * 4);
#pragma unroll
            for (int q = 0; q < 4; ++q) { const float b0 = br[(size_t)(m4 * 4 + q) * 32], b1 = br[(size_t)(m4 * 4 + q) * 32 + 16];
                a0 = __builtin_amdgcn_mfma_f32_16x16x4f32(hv[q], b0, a0, 0, 0, 0); a1 = __builtin_amdgcn_mfma_f32_16x16x4f32(hv[q], b1, a1, 0, 0, 0); ss += hv[q] * hv[q]; } }
        ss += __shfl_xor(ss, 16); ss += __shfl_xor(ss, 32);
        const float rs = rsqrtf(ss * (1.0f / 1024.0f) + EPS);
        if (kq == 0) RSTD[w * 16 + tl] = rs;
#pragma unroll
        for (int rg = 0; rg < 4; ++rg) { const int t = w * 16 + 4 * kq + rg; LOGS[t * 32 + tl] = a0[rg]; LOGS[t * 32 + 16 + tl] = a1[rg]; } }
    __syncthreads();
    if (tid < 64) { const int tok = tok0 + tid; const float rs = RSTD[tid]; float lg[32];
#pragma unroll
        for (int e = 0; e < 32; ++e) lg[e] = LOGS[tid * 32 + e] * rs + p.router_b[e];
        int be[4]; float bv[4];
#pragma unroll
        for (int k = 0; k < 4; ++k) { float best = -3.0e38f; int bi = 0;
#pragma unroll
            for (int e = 0; e < 32; ++e) { const bool tk = lg[e] > best; best = tk ? lg[e] : best; bi = tk ? e : bi; }
            be[k] = bi; bv[k] = best;
#pragma unroll
            for (int e = 0; e < 32; ++e) lg[e] = (e == bi) ? -3.0e38f : lg[e]; }
        const float e1 = __expf(bv[1] - bv[0]), e2 = __expf(bv[2] - bv[0]), e3 = __expf(bv[3] - bv[0]); const float inv = 1.0f / (1.0f + e1 + e2 + e3);
        const float gt[4] = {inv, e1 * inv, e2 * inv, e3 * inv};
#pragma unroll
        for (int k = 0; k < 4; ++k) { const int pos = atomicAdd(&LCNT[be[k]], 1);
            ((int*)(ws + WS_TOPE))[tok * 4 + k] = be[k]; ((float*)(ws + WS_TOPG))[tok * 4 + k] = gt[k]; ((int*)(ws + WS_TOPP))[tok * 4 + k] = pos; } }
    { unsigned char* HN = ws + WS_HN;
#pragma unroll 2
      for (int i = 0; i < 8; ++i) { const int idx = tid + 512 * i, t = idx >> 6, c = idx & 63; const float rs = RSTD[t]; const size_t off = (size_t)(tok0 + t) * 1024 + c * 16; u32x4 wv;
#pragma unroll
          for (int q = 0; q < 4; ++q) { const f32x4 h0 = *(const f32x4*)(H + off + 4 * q), g0 = *(const f32x4*)(p.norm_ffn_g + c * 16 + 4 * q); wv[q] = (unsigned)pk4_fp8(h0[0] * rs * g0[0], h0[1] * rs * g0[1], h0[2] * rs * g0[2], h0[3] * rs * g0[3]); }
          *(u32x4*)(HN + off) = wv; } }
    __syncthreads();
    if (tid < 32) ((int*)(ws + WS_CNT))[grp * 32 + tid] = LCNT[tid];
    __syncthreads();
}

constexpr int DP_TOT = 0;
constexpr int DP_PART = 512;
__device__ __forceinline__ void dispatch_tables(const Params& p, int grp, char* lds) {
    unsigned char* ws = opaque(p.ws); const int tid = tid_(); const int* CNT = (const int*)(ws + WS_CNT); int* T = (int*)(lds + DP_TOT); int* PART = (int*)(lds + DP_PART);
    { const int e = tid & 31, part = tid >> 5; int tot = 0, pre = 0;
      for (int g2 = part * 16; g2 < part * 16 + 16; ++g2) { const int c = CNT[g2 * 32 + e]; tot += c; if (g2 < grp) pre += c; }
      PART[part * 32 + e] = tot; PART[512 + part * 32 + e] = pre; }
    __syncthreads();
    if (tid < 32) { int tot = 0, pre = 0; for (int q = 0; q < 16; ++q) { tot += PART[q * 32 + tid]; pre += PART[512 + q * 32 + tid]; } T[tid] = tot; T[64 + tid] = pre; }
    __syncthreads();
    if (tid == 0) { int base = 0; for (int e = 0; e < 32; ++e) { T[32 + e] = base; base += (T[e] + 255) >> 8; } T[96] = base; }
    __syncthreads();
}
__device__ __forceinline__ void dispatch_group(const Params& p, int grp, char* lds) {
    unsigned char* ws = opaque(p.ws); const int tid = tid_();
    dispatch_tables(p, grp, lds);
    const int* T = (const int*)(lds + DP_TOT); int* DEST = (int*)(lds + DP_PART + 4096);
    if (tid < 256) { const int tok = grp * 64 + (tid >> 2); const int e = ((const int*)(ws + WS_TOPE))[tok * 4 + (tid & 3)], lp = ((const int*)(ws + WS_TOPP))[tok * 4 + (tid & 3)];
        const int dest = T[32 + e] * 256 + T[64 + e] + lp; DEST[tid] = dest; ((int*)(ws + WS_SLOT))[tok * 4 + (tid & 3)] = dest; }
    __syncthreads();
    const unsigned char* HN = ws + WS_HN; unsigned char* XP = ws + WS_XPAD;
#pragma unroll 4
    for (int i = 0; i < 32; ++i) { const int idx = tid + 512 * i, pr = idx >> 6, c = idx & 63; const int tok = grp * 64 + (pr >> 2);
        *(u32x4*)(XP + (size_t)DEST[pr] * 1024 + c * 16) = *(const u32x4*)(HN + (size_t)tok * 1024 + c * 16); }
    __syncthreads();
}

__device__ __forceinline__ void phase_combine(const Params& p) {
    unsigned char* ws = opaque(p.ws); const int tid = tid_(), lane = tid & 63, wid = tid >> 6, G = gridDim.x;
    const float* H = (const float*)(ws + WS_H); const unsigned char* YP = ws + WS_YPAD;
    for (int tok = blockIdx.x * 8 + wid; tok < NTOK; tok += G * 8) {
        int sl[4]; float gt[4];
#pragma unroll
        for (int k = 0; k < 4; ++k) { sl[k] = ((const int*)(ws + WS_SLOT))[tok * 4 + k]; gt[k] = ((const float*)(ws + WS_TOPG))[tok * 4 + k]; }
        f32x4 v[4]; float ss = 0.f;
#pragma unroll
        for (int i = 0; i < 4; ++i) { const int col = i * 256 + lane * 4; v[i] = *(const f32x4*)(H + (size_t)tok * 1024 + col);
#pragma unroll
            for (int k = 0; k < 4; ++k) { const unsigned yw = *(const unsigned*)(YP + (size_t)sl[k] * 1024 + col); const f32x2 lo = __builtin_amdgcn_cvt_pk_f32_fp8((int)yw, false), hi2 = __builtin_amdgcn_cvt_pk_f32_fp8((int)yw, true); v[i][0] += gt[k] * lo[0]; v[i][1] += gt[k] * lo[1]; v[i][2] += gt[k] * hi2[0]; v[i][3] += gt[k] * hi2[1]; }
            ss += v[i][0] * v[i][0] + v[i][1] * v[i][1] + v[i][2] * v[i][2] + v[i][3] * v[i][3]; }
        ss = wave_sum(ss); const float rs = rsqrtf(ss * (1.0f / 1024.0f) + EPS);
#pragma unroll
        for (int i = 0; i < 4; ++i) { const int col = i * 256 + lane * 4; const f32x4 g = *(const f32x4*)(p.norm_final_g + col); f32x4 o; o[0] = v[i][0] * rs * g[0]; o[1] = v[i][1] * rs * g[1]; o[2] = v[i][2] * rs * g[2]; o[3] = v[i][3] * rs * g[3];
            *(f32x4*)(p.out + (size_t)tok * 1024 + col) = o; } }
}


#define XB_TMO      128
#define XB_XCNT(j)  (256  + 64 * (j))
#define XB_XSUB(j)  (1280 + 64 * (j))
#define XB_XGEN(j)  (2304 + 64 * (j))
#define XB_TOP      3328
#define XB_TOPGEN   3392
#define XCD_BAR_WORDS 3456
#define XB_SPIN_CAP (1u << 18)
__device__ __forceinline__ unsigned xb_ld(unsigned* p)              { return __hip_atomic_load(p, __ATOMIC_RELAXED, __HIP_MEMORY_SCOPE_AGENT); }
__device__ __forceinline__ unsigned xb_add(unsigned* p, unsigned v) { return __hip_atomic_fetch_add(p, v, __ATOMIC_RELAXED, __HIP_MEMORY_SCOPE_AGENT); }
__device__ __forceinline__ unsigned xb_xcc_id() { return (unsigned)__builtin_amdgcn_s_getreg((3 << 11) | 20) & 0xFu; }
#define XB_SPIN(cond, bar) do { unsigned _sp = 0; while (cond) { __builtin_amdgcn_s_sleep(1); \
    if ((++_sp & 255u) == 0u) { if (xb_ld(&(bar)[XB_TMO])) break; if (_sp > XB_SPIN_CAP) { atomicAdd(&(bar)[XB_TMO], 1u); break; } } } } while (0)
struct XcdBarrier { unsigned* bar; unsigned x; volatile LDS3 unsigned* st; };
__device__ __forceinline__ XcdBarrier xcd_barrier_post(unsigned* bar, volatile LDS3 unsigned* st) {
    XcdBarrier b; b.bar = bar; b.x = xb_xcc_id(); b.st = st;
    if (tid_() == 0) (void)xb_add(&bar[XB_XCNT(b.x)], 1u);
    return b;
}
__device__ __forceinline__ void xcd_barrier_complete(unsigned* bar, unsigned x, unsigned& nloc, unsigned& nx) {
    const unsigned G = gridDim.x * gridDim.y * gridDim.z;
    unsigned sum, cnt, mine, sp = 0u;
    for (;;) {
        sum = 0u; cnt = 0u; mine = 0u;
#pragma unroll
        for (unsigned j = 0; j < 16; ++j) { const unsigned c = xb_ld(&bar[XB_XCNT(j)]); sum += c; cnt += (c > 0u) ? 1u : 0u; mine = (j == x) ? c : mine; }
        if (sum == G) break;
        __builtin_amdgcn_s_sleep(1);
        if ((++sp & 255u) == 0u) { if (xb_ld(&bar[XB_TMO])) break; if (sp > XB_SPIN_CAP) { atomicAdd(&bar[XB_TMO], 1u); break; } }
    }
    nloc = mine > 0u ? mine : 1u; nx = cnt > 0u ? cnt : 1u;
}
__device__ __forceinline__ void xcd_barrier(const XcdBarrier& b) {
    asm volatile("s_waitcnt vmcnt(0)" ::: "memory");
    __syncthreads();
    if (tid_() == 0) {
        unsigned* bar = b.bar;
        __builtin_amdgcn_s_waitcnt(0);
        unsigned nloc = b.st[0], nx = b.st[1];
        if (nloc == 0u) { xcd_barrier_complete(bar, b.x, nloc, nx); b.st[0] = nloc; b.st[1] = nx; }
        const unsigned old = xb_add(&bar[XB_XSUB(b.x)], 1u);
        const unsigned gen = old / nloc;
        if (old + 1u == (gen + 1u) * nloc) {
            __builtin_amdgcn_fence(__ATOMIC_RELEASE, "agent");
            asm volatile("s_waitcnt vmcnt(0)" ::: "memory");
            const unsigned og = xb_add(&bar[XB_TOP], 1u);
            const unsigned tg = og / nx;
            if (og + 1u == (tg + 1u) * nx) xb_add(&bar[XB_TOPGEN], 1u);
            else XB_SPIN(xb_ld(&bar[XB_TOPGEN]) == tg, bar);
            __builtin_amdgcn_fence(__ATOMIC_ACQUIRE, "agent");
            xb_add(&bar[XB_XGEN(b.x)], 1u);
            asm volatile("s_waitcnt vmcnt(0)" ::: "memory");
        } else {
            XB_SPIN(xb_ld(&bar[XB_XGEN(b.x)]) == gen, bar);
            __builtin_amdgcn_fence(__ATOMIC_ACQUIRE, "agent");
            asm volatile("s_waitcnt vmcnt(0)" ::: "memory");
        }
    }
    __syncthreads();
}

__global__ void __launch_bounds__(512, 2) mega_fwd(Params p) {
    cg::grid_group grid = cg::this_grid();
    char* lds = smem; LDS3 unsigned char* lds3 = (LDS3 unsigned char*)smem;
    const int G = gridDim.x, bid = blockIdx.x;
    if (tid_() < 4) ((volatile LDS3 unsigned*)(lds3 + LDS_XB))[tid_()] = 0u;
    __syncthreads();
    const XcdBarrier xb = xcd_barrier_post((unsigned*)(p.ws + WS_BAR), (volatile LDS3 unsigned*)(lds3 + LDS_XB));
    for (int rep = 0; rep < REP_P0; ++rep) phase_prologue(p, lds);
    if (p.ws == nullptr) grid.sync();
    xcd_barrier(xb);
    for (int rep = 0; rep < REP_P1; ++rep) { const int nconv = (G >= 64) ? (G * 3) / 16 : 0, ngemm = G - nconv;
      if (bid >= ngemm) { expert_convert(p, lds, bid - ngemm, nconv); }
      else { unsigned char* ws = opaque(p.ws); pg8::DenseProb S; S.init(ws + WS_XN, ws + WS_W_IN, NTOK, INWP, 1024, ngemm, bid);
        EpiProj E; E.ws = ws;
        pg8::gemm_phase(lds3, S, E); }
      if (nconv == 0) expert_convert(p, lds, bid, G); }
    xcd_barrier(xb);
    for (int rep = 0; rep < REP_ATT; ++rep) { AttnPre pre; if (bid < 4 * 24 * 16) attn_fetch(p, bid, pre);
        for (int item = bid; item < 4 * 24 * 16; item += G) attn_item(p, item, item + G, item + G < 4 * 24 * 16, pre, lds); }
    for (int rep = 0; rep < REP_GLA1; ++rep) { G1Pre pre; if (bid < 1024) gla1_fetch(p, bid, pre); int hprev = -1;
        for (int item = bid; item < 1024; item += G) { const int h = (item >> 6) & 3; gla1_item(p, item, item + G, item + G < 1024, h != hprev, pre, lds); hprev = h; } }
    xcd_barrier(xb);
    for (int rep = 0; rep < REP_P3; ++rep) phase_scan_combine(p);
    xcd_barrier(xb);
    for (int rep = 0; rep < REP_P4; ++rep) { G3Pre pre; if (bid < 1024) gla3_fetch(p, bid, pre);
        for (int item = bid; item < 1024; item += G) gla3_item(p, item, item + G, item + G < 1024, pre, lds); }
    xcd_barrier(xb);
    for (int rep = 0; rep < REP_P5; ++rep) {
    { unsigned char* ws = opaque(p.ws); pg8::DenseProb S; S.init(ws + WS_YATT, ws + WS_W_A, NTOK, 1024, 512, G, bid);
      EpiGate<0> E; E.gate = (const bf16_t*)(ws + WS_SA); E.t1 = nullptr; E.out = (bf16_t*)(ws + WS_T1);
      pg8::gemm_phase(lds3, S, E); }
    { unsigned char* ws = opaque(p.ws); pg8::DenseProb S; S.init(ws + WS_YGLA, ws + WS_W_G, NTOK, 1024, 1024, G, bid);
      EpiGate<1> E; E.gate = (const bf16_t*)(ws + WS_SG); E.t1 = (const bf16_t*)(ws + WS_T1); E.out = (bf16_t*)(ws + WS_MERGED);
      pg8::gemm_phase(lds3, S, E); }
    }
    xcd_barrier(xb);
    for (int rep = 0; rep < REP_P6; ++rep) { unsigned char* ws = opaque(p.ws); pg8::DenseProb S; S.init(ws + WS_MERGED, ws + WS_W_MIX, NTOK, 1024, 1024, G, bid);
      EpiResid E; E.x = p.x; E.h = (float*)(ws + WS_H);
      pg8::gemm_phase(lds3, S, E); }
    xcd_barrier(xb);
    for (int rep = 0; rep < REP_P7; ++rep) for (int grp = bid; grp < 256; grp += G) route_group(p, grp, lds);
    xcd_barrier(xb);
    for (int rep = 0; rep < REP_P8; ++rep) for (int grp = bid; grp < 256; grp += G) dispatch_group(p, grp, lds);
    if (bid == 0) { unsigned char* ws = opaque(p.ws); dispatch_tables(p, -1, lds); const int* T = (const int*)(lds + DP_TOT); int* TE = (int*)(ws + WS_TILEE);
        if (tid_() < 32) { const int e = tid_(); for (int t = T[32 + e]; t < T[32 + e] + ((T[e] + 255) >> 8); ++t) TE[16 + t] = e; }
        if (tid_() == 0) TE[0] = T[96]; }
    xcd_barrier(xb);
    for (int rep = 0; rep < REP_P9; ++rep) { unsigned char* ws = opaque(p.ws); const int* TE = (const int*)(ws + WS_TILEE);
      pg8::MoeProb S; S.A = (const char*)(ws + WS_XPAD); S.Bt = (const char*)(ws + WS_W_GU); S.K = 512  ; S.nN = 8; S.T = TE[0]; S.G = G; S.c = bid; S.estride = (size_t)2048 * 1024; S.tile_e = TE + 16;
      EpiAct E; E.bgu = p.e_b_gu; E.tile_e = TE + 16; E.act = ws + WS_ACT;
      pg8::gemm_phase(lds3, S, E); }
    xcd_barrier(xb);
    for (int rep = 0; rep < REP_P10; ++rep) { unsigned char* ws = opaque(p.ws); const int* TE = (const int*)(ws + WS_TILEE);
      pg8::MoeProb S; S.A = (const char*)(ws + WS_ACT); S.Bt = (const char*)(ws + WS_W_D); S.K = 512  ; S.nN = 4; S.T = TE[0]; S.G = G; S.c = bid; S.estride = (size_t)1024 * 1024; S.tile_e = TE + 16;
      EpiDown E; E.bd = p.e_b_d; E.tile_e = TE + 16; E.y = ws + WS_YPAD;
      pg8::gemm_phase(lds3, S, E); }
    xcd_barrier(xb);
    for (int rep = 0; rep < REP_P11; ++rep) phase_combine(p);
}

extern "C" void kernel_launch(void* const* d_in, const int* in_sizes, int n_in, void* d_out, int out_size, void* d_ws, size_t ws_size, hipStream_t stream) {
    static int grid = 0;
    if (grid == 0) {
        if (n_in != 17 || ws_size < WS_END) { fprintf(stderr, "kernel_launch: expected 17 inputs and >= %zu bytes of workspace (got %d, %zu); nothing launched\n", (size_t)WS_END, n_in, ws_size); grid = -1; return; }
        int dev = 0, cus = 0, per_cu = 0;
        if (hipGetDevice(&dev) != hipSuccess || hipDeviceGetAttribute(&cus, hipDeviceAttributeMultiprocessorCount, dev) != hipSuccess) { fprintf(stderr, "kernel_launch: device query failed\n"); grid = -1; return; }
        if (hipFuncSetAttribute((const void*)mega_fwd, hipFuncAttributeMaxDynamicSharedMemorySize, LDS_BYTES) != hipSuccess) { fprintf(stderr, "kernel_launch: hipFuncSetAttribute failed\n"); grid = -1; return; }
        if (hipOccupancyMaxActiveBlocksPerMultiprocessor(&per_cu, (const void*)mega_fwd, 512, LDS_BYTES) != hipSuccess || per_cu < 1) { fprintf(stderr, "kernel_launch: occupancy query failed (%d)\n", per_cu); grid = -1; return; }
        grid = cus;
    }
    if (grid < 0) return;
    Params p{};
    p.x = (const float*)d_in[0]; p.norm_mix_g = (const float*)d_in[1]; p.w_in = (const float*)d_in[2]; p.gla_gate_up = (const float*)d_in[3]; p.gla_gate_bias = (const float*)d_in[4]; p.gla_norm_g = (const float*)d_in[5];
    p.w_branch_gla = (const float*)d_in[6]; p.w_branch_att = (const float*)d_in[7]; p.w_mix_out = (const float*)d_in[8]; p.norm_ffn_g = (const float*)d_in[9]; p.router_w = (const float*)d_in[10]; p.router_b = (const float*)d_in[11];
    p.e_w_gu = (const float*)d_in[12]; p.e_b_gu = (const float*)d_in[13]; p.e_w_d = (const float*)d_in[14]; p.e_b_d = (const float*)d_in[15]; p.norm_final_g = (const float*)d_in[16];
    p.out = (float*)d_out; p.ws = (unsigned char*)d_ws;
    if (hipMemsetAsync((char*)d_ws + WS_BAR, 0, 3456 * 4, stream) != hipSuccess) { fprintf(stderr, "kernel_launch: memset of the barrier words failed\n"); return; }
    void* args[] = {&p};
    hipError_t e = hipLaunchCooperativeKernel((const void*)mega_fwd, dim3(grid), dim3(512), args, LDS_BYTES, stream);
    if (e != hipSuccess) fprintf(stderr, "kernel_launch: cooperative launch failed: %s (grid %d)\n", hipGetErrorString(e), grid);
}
```

```cpp
#include <hip/hip_runtime.h>
#include <hip/hip_cooperative_groups.h>
#include <cstdio>
#include <cstdint>
namespace cg = cooperative_groups;
#ifndef REP_P0
#define REP_P0 1
#define REP_P1 1
#define REP_ATT 1
#define REP_GLA1 1
#define REP_P3 1
#define REP_P4 1
#define REP_P5 1
#define REP_P6 1
#define REP_P7 1
#define REP_P8 1
#define REP_P9 1
#define REP_P10 1
#define REP_P11 1
#endif

#define LDS3 __attribute__((address_space(3)))
typedef unsigned short bf16_t;
typedef short bf16x8 __attribute__((ext_vector_type(8)));
typedef short s16x4 __attribute__((ext_vector_type(4)));
typedef short v4i16_t __attribute__((ext_vector_type(4)));
typedef float f32x4 __attribute__((ext_vector_type(4)));
typedef float f32x2 __attribute__((ext_vector_type(2)));
typedef float f32x16 __attribute__((ext_vector_type(16)));
typedef unsigned u32x4 __attribute__((ext_vector_type(4)));
typedef unsigned u32x2 __attribute__((ext_vector_type(2)));
typedef int i32x8 __attribute__((ext_vector_type(8)));
typedef int i32x4 __attribute__((ext_vector_type(4)));

constexpr int NTOK = 16384, DM = 1024, SEQ = 4096, NB = 4;
constexpr int INW = 9744, INWP = 9984;
constexpr int NEXP = 32, TOPK = 4, FF = 1024;
constexpr int MAXT = 288;
constexpr float EPS = 1e-5f;
constexpr float QSCALE = 0.125f * 1.4426950408889634f;
constexpr float LN2 = 0.6931471805599453f;

constexpr size_t al256(size_t x) { return (x + 255) & ~(size_t)255; }
constexpr size_t WS_W_IN = 0;
constexpr size_t WS_W_G = WS_W_IN + (size_t)INWP * 1024 * 2;
constexpr size_t WS_W_A = WS_W_G + (size_t)1024 * 1024 * 2;
constexpr size_t WS_W_MIX = WS_W_A + (size_t)1024 * 512 * 2;
constexpr size_t WS_W_GU = WS_W_MIX + (size_t)1024 * 1024 * 2;
constexpr size_t WS_W_D = WS_W_GU + (size_t)NEXP * 2048 * 1024;
constexpr size_t WS_ROPE_C = WS_W_D + (size_t)NEXP * 1024 * 1024;
constexpr size_t WS_ROPE_S = WS_ROPE_C + (size_t)SEQ * 8 * 4;
constexpr size_t WS_RWG = WS_ROPE_S + (size_t)SEQ * 8 * 4;
constexpr size_t WS_H = WS_RWG + (size_t)1024 * 32 * 4;
constexpr size_t WS_HN = WS_H + (size_t)NTOK * 1024 * 4;
constexpr size_t WS_TOPE = WS_HN + (size_t)NTOK * 1024;
constexpr size_t WS_TOPG = WS_TOPE + (size_t)NTOK * 4 * 4;
constexpr size_t WS_TOPP = WS_TOPG + (size_t)NTOK * 4 * 4;
constexpr size_t WS_SLOT = WS_TOPP + (size_t)NTOK * 4 * 4;
constexpr size_t WS_CNT = WS_SLOT + (size_t)NTOK * 4 * 4;
constexpr size_t WS_TILEE = WS_CNT + (size_t)256 * 32 * 4;
constexpr size_t WS_REGB = al256(WS_TILEE + (size_t)(MAXT + 32) * 4);
constexpr size_t WS_XN = WS_REGB;
constexpr size_t WS_GQ = WS_XN + (size_t)NTOK * 1024 * 2;
constexpr size_t WS_GK = WS_GQ + (size_t)NTOK * 512 * 2;
constexpr size_t WS_GV = WS_GK + (size_t)NTOK * 512 * 2;
constexpr size_t WS_GR = WS_GV + (size_t)NTOK * 1024 * 2;
constexpr size_t WS_SG = WS_GR + (size_t)NTOK * 1024 * 2;
constexpr size_t WS_SA = WS_SG + (size_t)NTOK * 1024 * 2;
constexpr size_t WS_AQ = WS_SA + (size_t)NTOK * 1024 * 2;
constexpr size_t WS_AK = WS_AQ + (size_t)NTOK * 1536 * 2;
constexpr size_t WS_AV = WS_AK + (size_t)NTOK * 1536 * 2;
constexpr size_t WS_GLR = WS_AV + (size_t)NTOK * 1536 * 2;
constexpr size_t WS_OATT = WS_GLR + (size_t)NTOK * 16 * 4;
constexpr size_t WS_LSE = WS_OATT + (size_t)3 * NTOK * 512 * 2;
constexpr size_t WS_QE = WS_LSE + (size_t)3 * NTOK * 8 * 4;
constexpr size_t WS_OINTRA = WS_QE + (size_t)NTOK * 512 * 2;
constexpr size_t WS_U = WS_OINTRA + (size_t)NTOK * 1024 * 2;
constexpr size_t WS_DEC = WS_U + (size_t)1024 * 128 * 256 * 2;
constexpr size_t WS_REGB_END = WS_DEC + (size_t)1024 * 128 * 4;
constexpr size_t WS_PREV = WS_AQ;
constexpr size_t WS_YGLA = WS_AV;
constexpr size_t WS_YATT = WS_XN;
constexpr size_t WS_T1 = WS_GQ;
constexpr size_t WS_MERGED = WS_GV;
constexpr size_t PADROWS = (size_t)MAXT * 256;
constexpr size_t WS_XPAD = WS_REGB;
constexpr size_t WS_ACT = WS_XPAD + PADROWS * 1024;
constexpr size_t WS_YPAD = WS_ACT + PADROWS * 1024;
constexpr size_t WS_PAD_END = WS_YPAD + PADROWS * 1024;
constexpr size_t WS_BAR = al256(WS_REGB_END > WS_PAD_END ? WS_REGB_END : WS_PAD_END);
constexpr size_t WS_END = WS_BAR + 3456 * 4;
static_assert(WS_PAD_END <= WS_REGB_END + (1u << 30), "map");

constexpr int LDS_XB = 147456;
constexpr int LDS_TAB_OFF = 147456 + 16;
constexpr int LDS_BYTES = 147456 + 16 + 1024;

struct Params {
    const float *x, *norm_mix_g, *w_in, *gla_gate_up, *gla_gate_bias, *gla_norm_g, *w_branch_gla, *w_branch_att, *w_mix_out, *norm_ffn_g,
        *router_w, *router_b, *e_w_gu, *e_b_gu, *e_w_d, *e_b_d, *norm_final_g;
    float* out;
    unsigned char* ws;
};

__device__ __forceinline__ int tid_() { int t = threadIdx.x; asm volatile("" : "+v"(t)); return t; }
__device__ __forceinline__ unsigned char* opaque(unsigned char* q) { return q; }
__device__ __forceinline__ unsigned cvt_pk_bf16(float lo, float hi) { unsigned r; asm volatile("v_cvt_pk_bf16_f32 %0, %1, %2" : "=v"(r) : "v"(lo), "v"(hi)); return r; }
__device__ __forceinline__ float bf_lo(unsigned w) { return __uint_as_float(w << 16); }
__device__ __forceinline__ float bf_hi(unsigned w) { return __uint_as_float(w & 0xffff0000u); }
__device__ __forceinline__ float bf2f(bf16_t b) { return __uint_as_float(((unsigned)b) << 16); }
__device__ __forceinline__ u32x4 pack8(const float* v) { u32x4 w; w.x = cvt_pk_bf16(v[0], v[1]); w.y = cvt_pk_bf16(v[2], v[3]); w.z = cvt_pk_bf16(v[4], v[5]); w.w = cvt_pk_bf16(v[6], v[7]); return w; }
__device__ __forceinline__ void unpack8(u32x4 w, float* v) { v[0] = bf_lo(w.x); v[1] = bf_hi(w.x); v[2] = bf_lo(w.y); v[3] = bf_hi(w.y); v[4] = bf_lo(w.z); v[5] = bf_hi(w.z); v[6] = bf_lo(w.w); v[7] = bf_hi(w.w); }
__device__ __forceinline__ float sigmoidf_(float v) { return __builtin_amdgcn_rcpf(1.0f + __builtin_amdgcn_exp2f(v * -1.4426950408889634f)); }
__device__ __forceinline__ float wave_sum(float v) { v += __shfl_xor(v, 32); v += __shfl_xor(v, 16); v += __shfl_xor(v, 8); v += __shfl_xor(v, 4); v += __shfl_xor(v, 2); v += __shfl_xor(v, 1); return v; }
__device__ __forceinline__ s16x4 tr16(const LDS3 char* p) { return __builtin_bit_cast(s16x4, __builtin_amdgcn_ds_read_tr16_b64_v4i16((LDS3 v4i16_t*)p)); }
__device__ __forceinline__ bf16x8 cat8(s16x4 a, s16x4 b) { return (bf16x8){a[0], a[1], a[2], a[3], b[0], b[1], b[2], b[3]}; }
__device__ __forceinline__ int crow(int r, int hi) { return (r & 3) + 8 * (r >> 2) + 4 * hi; }
__device__ __forceinline__ void st_nt(void* p, u32x4 v) { __builtin_nontemporal_store(v, (u32x4*)p); }
__device__ __forceinline__ int pk4_fp8(float a, float b, float c, float d) { int w = __builtin_amdgcn_cvt_pk_fp8_f32(a, b, 0, false); return __builtin_amdgcn_cvt_pk_fp8_f32(c, d, w, true); }
__device__ __forceinline__ f32x4 bf4_to_f32(u32x2 w) { f32x4 r; r[0] = bf_lo(w.x); r[1] = bf_hi(w.x); r[2] = bf_lo(w.y); r[3] = bf_hi(w.y); return r; }
#define MFMA32(a, b, c) __builtin_amdgcn_mfma_f32_32x32x16_bf16(a, b, c, 0, 0, 0)

namespace pg8 {
constexpr int BM = 256, BK = 64, HALF = 128, HTB = HALF * BK * 2, STAGE_BYTES = 8 * HTB, NXCD = 8, WGM = 8;
constexpr bool GEMM_ALIGN_EPI = true;
constexpr bool GEMM_SP2 = true;
__host__ __device__ __forceinline__ int lds_byte(int r, int c) { const int st = (r >> 4) * 2 + (c >> 5), rr = r & 15, cc = c & 31, ob = rr * 64 + cc * 2; return st * 1024 + (ob ^ (((ob >> 9) & 1) << 5)); }
__host__ __device__ __forceinline__ void stage_rc(int b, int& R, int& C) { const int st = b / 1024, sb = b % 1024, swz = sb ^ (((sb >> 9) & 1) << 5); R = (st >> 1) * 16 + swz / 64; C = (st & 1) * 32 + (swz % 64) / 2; }
__host__ __device__ __forceinline__ int perm32(int rho) { const int n = rho >> 4, i = rho & 15; return 8 * (i >> 2) + 4 * n + (i & 3); }
struct Unit { int pm, pn; };

struct DenseProb {
    const char* A; const char* Bt; int K; int nM, nN, nwg, G, c;
    __device__ void init(const void* A_, const void* Bt_, int M, int N, int K_, int G_, int c_) { A = (const char*)A_; Bt = (const char*)Bt_; K = K_; nM = M / BM; nN = N / BM; nwg = nM * nN; G = G_; c = c_; }
    __device__ __forceinline__ bool next(int i, Unit& u) const {
        const long L = (long)i * G + c; if (L >= nwg) return false;
        int wgid = (int)L; { const int q = nwg / NXCD, r = nwg % NXCD, xcd = wgid % NXCD, off = wgid / NXCD; wgid = (xcd < r ? xcd * (q + 1) : r * (q + 1) + (xcd - r) * q) + off; }
        const int nig = WGM * nN, gid = wgid / nig, fm = gid * WGM, gsz = (nM - fm) < WGM ? (nM - fm) : WGM;
        u.pm = fm + ((wgid % nig) % gsz); u.pn = (wgid % nig) / gsz; return true;
    }
    __device__ __forceinline__ const char* a_ptr(const Unit& u) const { return A + (size_t)u.pm * BM * K * 2; }
    __device__ __forceinline__ const char* b_ptr(const Unit& u) const { return Bt + (size_t)u.pn * BM * K * 2; }
    static constexpr bool GATHER = false;
    __device__ __forceinline__ const int* rows(const Unit&) const { return nullptr; }
};
template <bool GATHER_> struct MoeProbT {
    static constexpr bool GATHER = GATHER_;
    const char* A; const char* Bt; int K; int nN, T, G, c; size_t estride; const int* tile_e; const int* rowoff;
    __device__ __forceinline__ bool next(int i, Unit& u) const { const long L = (long)i * G + c; if (L >= (long)T * nN) return false; u.pm = (int)(L / nN); u.pn = (int)(L % nN); return true; }
    __device__ __forceinline__ const char* a_ptr(const Unit& u) const { return GATHER ? A : A + (size_t)u.pm * BM * K * 2; }
    __device__ __forceinline__ const char* b_ptr(const Unit& u) const { return Bt + (size_t)tile_e[u.pm] * estride + (size_t)u.pn * BM * K * 2; }
    __device__ __forceinline__ const int* rows(const Unit& u) const { return rowoff + u.pm * BM; }
};

template <class Epi, class Prob>
__device__ __forceinline__ void gemm_phase(LDS3 unsigned char* lds, const Prob& S, const Epi& E) {
    const int tid = tid_(), wid = __builtin_amdgcn_readfirstlane(tid >> 6), lane = tid & 63, wr = wid >> 2, wc = wid & 3, fr = lane & 15, fq = lane >> 4;
    const int K = S.K, nt = K / BK;
    unsigned voffA[2], voffB[2]; int Rrow[2];
#pragma unroll
    for (int i = 0; i < 2; ++i) { int R, C; stage_rc(tid * 16 + i * 8192, R, C); const int Rb = Epi::PERM ? (2 * (R & ~31) + perm32(R & 31)) : R;
        voffA[i] = (unsigned)(R * K + C) * 2u; voffB[i] = (unsigned)(Rb * K + C) * 2u; Rrow[i] = R; if (Prob::GATHER) voffA[i] = (unsigned)C * 2u; }
    const size_t kstep = (size_t)(BK * 2);
    const size_t hstep = (size_t)HALF * K * 2;
    const size_t hstepB = Epi::PERM ? (size_t)32 * K * 2 : hstep;
    const unsigned ldsw = (unsigned)wid * 1024u;
    const int aoff = lds_byte(wr * 64 + fr, fq * 8), boff = lds_byte(wc * 32 + fr, fq * 8);
#define PG8_SA(b, h) (((b) * 2 + (h)) * HTB)
#define PG8_SB(b, h) ((4 + (b) * 2 + (h)) * HTB)
#define PG8_STAGE(bufoff, gbase, voff) do { _Pragma("unroll") for (int _i = 0; _i < 2; ++_i) \
        __builtin_amdgcn_global_load_lds((const unsigned*)((const char*)(gbase) + (voff)[_i]), (LDS3 unsigned*)(lds + (bufoff) + ldsw + _i * 8192), 16, 0, 0); } while (0)
#define PG8_LD8(ptr) __builtin_shufflevector(*(const LDS3 i32x4*)(ptr), *(const LDS3 i32x4*)((ptr) + 1024), 0, 1, 2, 3, 4, 5, 6, 7)
#define PG8_LO(x) __builtin_bit_cast(bf16x8, __builtin_shufflevector(x, x, 0, 1, 2, 3))
#define PG8_HI(x) __builtin_bit_cast(bf16x8, __builtin_shufflevector(x, x, 4, 5, 6, 7))
#define PG8_LDA(dst, b, h) do { _Pragma("unroll") for (int m = 0; m < 4; ++m) dst[m] = PG8_LD8(lds + PG8_SA(b, h) + aoff + m * 2048); } while (0)
#define PG8_LDB(dst, b, h) do { _Pragma("unroll") for (int n = 0; n < 2; ++n) dst[n] = PG8_LD8(lds + PG8_SB(b, h) + boff + n * 2048); } while (0)
#define PG8_MMA(ai, bj, At, Bt) do { __builtin_amdgcn_s_setprio(1); _Pragma("unroll") for (int m = 0; m < 4; ++m) _Pragma("unroll") for (int n = 0; n < 2; ++n) { \
        if constexpr (Epi::FP8) asm volatile("v_mfma_scale_f32_16x16x128_f8f6f4 %0, %1, %2, %0, %3, %4 op_sel_hi:[0,0,0]" : "+v"(acc[ai][bj][m][n]) : "v"(Bt[n]), "v"(At[m]), "v"(sc_w), "v"(sc_1)); \
        else { acc[ai][bj][m][n] = __builtin_amdgcn_mfma_f32_16x16x32_bf16(PG8_LO(Bt[n]), PG8_LO(At[m]), acc[ai][bj][m][n], 0, 0, 0); acc[ai][bj][m][n] = __builtin_amdgcn_mfma_f32_16x16x32_bf16(PG8_HI(Bt[n]), PG8_HI(At[m]), acc[ai][bj][m][n], 0, 0, 0); } } __builtin_amdgcn_s_setprio(0); } while (0)
#define PG8_WAIT_V(n) asm volatile("s_waitcnt vmcnt(" #n ")" ::: "memory")
#define PG8_WAIT_L(n) asm volatile("s_waitcnt lgkmcnt(" #n ")" ::: "memory")
#define PG8_BAR __builtin_amdgcn_s_barrier()
#define PG8_SCHED __builtin_amdgcn_sched_barrier(0)
    Unit cur, nxt; int ui = 0;
    if (!S.next(0, cur)) return;
    f32x4 acc[2][2][4][2];
#pragma unroll
    for (int a = 0; a < 2; ++a)
#pragma unroll
        for (int b = 0; b < 2; ++b)
#pragma unroll
            for (int m = 0; m < 4; ++m)
#pragma unroll
                for (int n = 0; n < 2; ++n) acc[a][b][m][n] = (f32x4){0.f, 0.f, 0.f, 0.f};
    i32x8 At[4], B0[2], B1[2];
    int sc_w = 0x7A7A7A7A  , sc_1 = 0x7F7F7F7F; asm volatile("" : "+v"(sc_w), "+v"(sc_1));
    const char* cA = S.a_ptr(cur); const char* cB = S.b_ptr(cur);
    unsigned vAc[2][2], vAn[2][2];
    LDS3 int* rtab = (LDS3 int*)(lds + LDS_TAB_OFF);
    if constexpr (Prob::GATHER) { const int* rw = S.rows(cur);
#pragma unroll
        for (int h = 0; h < 2; ++h)
#pragma unroll
            for (int i = 0; i < 2; ++i) vAc[h][i] = (unsigned)rw[h * HALF + Rrow[i]] + voffA[i];
    } else {
#pragma unroll
        for (int h = 0; h < 2; ++h)
#pragma unroll
            for (int i = 0; i < 2; ++i) vAc[h][i] = voffA[i] + (unsigned)(h * hstep);
    }
#pragma unroll
    for (int h = 0; h < 2; ++h)
#pragma unroll
        for (int i = 0; i < 2; ++i) vAn[h][i] = vAc[h][i];
    if constexpr (GEMM_SP2) {
        PG8_STAGE(PG8_SB(0, 0), cB, voffB); PG8_STAGE(PG8_SB(0, 1), cB + hstepB, voffB); PG8_STAGE(PG8_SA(0, 0), cA, vAc[0]); PG8_STAGE(PG8_SA(0, 1), cA, vAc[1]);
        if (wr == 1) PG8_BAR;
        PG8_WAIT_V(2); PG8_BAR;
        PG8_STAGE(PG8_SB(1, 0), cB + kstep, voffB); PG8_STAGE(PG8_SA(1, 0), cA + kstep, vAc[0]); PG8_STAGE(PG8_SB(1, 1), cB + hstepB + kstep, voffB);
        PG8_WAIT_V(6); PG8_BAR;
    } else {
    PG8_STAGE(PG8_SB(0, 0), cB, voffB); PG8_STAGE(PG8_SA(0, 0), cA, vAc[0]); PG8_STAGE(PG8_SB(0, 1), cB + hstepB, voffB); PG8_STAGE(PG8_SA(0, 1), cA, vAc[1]);
    if (wr == 1) PG8_BAR;
    PG8_WAIT_V(4); PG8_BAR;
    PG8_STAGE(PG8_SB(1, 0), cB + kstep, voffB); PG8_STAGE(PG8_SA(1, 0), cA + kstep, vAc[0]); PG8_STAGE(PG8_SB(1, 1), cB + hstepB + kstep, voffB);
    PG8_WAIT_V(6); PG8_BAR;
    }
    for (;;) {
        const bool has_next = S.next(ui + 1, nxt);
        const char* nA = has_next ? S.a_ptr(nxt) : cA; const char* nB = has_next ? S.b_ptr(nxt) : cB;
        if constexpr (Prob::GATHER) { if (has_next && wid < 4) __builtin_amdgcn_global_load_lds((const unsigned*)(S.rows(nxt) + wid * 64 + lane), (LDS3 unsigned*)(lds + LDS_TAB_OFF + wid * 256), 4, 0, 0); }
        for (int t = 0; t < nt; t += 2) {
            const bool last = (t == nt - 2);
            const char* a1 = cA + (size_t)(t + 1) * kstep;
            const char* a2 = last ? nA : cA + (size_t)(t + 2) * kstep; const char* b2 = last ? nB : cB + (size_t)(t + 2) * kstep;
            const char* a3 = a2 + kstep; const char* b3 = b2 + kstep;
            if constexpr (Prob::GATHER) { if (last && has_next) {
#pragma unroll
                for (int h = 0; h < 2; ++h)
#pragma unroll
                    for (int i = 0; i < 2; ++i) vAn[h][i] = (unsigned)rtab[h * HALF + Rrow[i]] + voffA[i]; } }
            unsigned vS[2][2];
#pragma unroll
            for (int h = 0; h < 2; ++h)
#pragma unroll
                for (int i = 0; i < 2; ++i) vS[h][i] = last ? vAn[h][i] : vAc[h][i];
            if constexpr (GEMM_SP2) {
            PG8_LDB(B0, 0, 0); PG8_LDB(B1, 0, 1); PG8_SCHED; PG8_LDA(At, 0, 0); PG8_STAGE(PG8_SA(1, 1), a1, vAc[1]);
            PG8_WAIT_V(8); PG8_WAIT_L(0); PG8_BAR; PG8_MMA(0, 0, At, B0); PG8_MMA(0, 1, At, B1); PG8_BAR; PG8_SCHED;
            PG8_LDA(At, 0, 1); PG8_STAGE(PG8_SB(0, 0), b2, voffB); PG8_STAGE(PG8_SB(0, 1), b2 + hstepB, voffB); PG8_STAGE(PG8_SA(0, 0), a2, vS[0]);
            PG8_WAIT_V(8); PG8_WAIT_L(0); PG8_BAR; PG8_MMA(1, 0, At, B0); PG8_MMA(1, 1, At, B1); PG8_BAR; PG8_SCHED;
            PG8_LDB(B0, 1, 0); PG8_LDB(B1, 1, 1); PG8_SCHED; PG8_LDA(At, 1, 0); PG8_STAGE(PG8_SA(0, 1), a2, vS[1]);
            PG8_WAIT_V(8); PG8_WAIT_L(0); PG8_BAR; PG8_MMA(0, 0, At, B0); PG8_MMA(0, 1, At, B1); PG8_BAR; PG8_SCHED;
            PG8_LDA(At, 1, 1); PG8_STAGE(PG8_SB(1, 0), b3, voffB); PG8_STAGE(PG8_SB(1, 1), b3 + hstepB, voffB); PG8_STAGE(PG8_SA(1, 0), a3, vS[0]);
            PG8_WAIT_V(8); PG8_WAIT_L(0); PG8_BAR; PG8_MMA(1, 0, At, B0); PG8_MMA(1, 1, At, B1); PG8_BAR; PG8_SCHED;
            } else {
            PG8_LDB(B0, 0, 0); PG8_SCHED; PG8_LDA(At, 0, 0); PG8_STAGE(PG8_SA(1, 1), a1, vAc[1]);
            PG8_WAIT_L(8); PG8_BAR; PG8_WAIT_L(0); PG8_MMA(0, 0, At, B0); PG8_BAR; PG8_SCHED;
            PG8_LDB(B1, 0, 1); PG8_STAGE(PG8_SB(0, 0), b2, voffB);
            PG8_BAR; PG8_WAIT_L(0); PG8_MMA(0, 1, At, B1); PG8_BAR;
            PG8_LDA(At, 0, 1); PG8_STAGE(PG8_SA(0, 0), a2, vS[0]);
            PG8_BAR; PG8_WAIT_L(0); PG8_MMA(1, 0, At, B0); PG8_BAR; PG8_SCHED;
            PG8_STAGE(PG8_SB(0, 1), b2 + hstepB, voffB);
            PG8_WAIT_V(6); PG8_BAR; PG8_MMA(1, 1, At, B1); PG8_BAR;
            PG8_LDB(B0, 1, 0); PG8_SCHED; PG8_LDA(At, 1, 0); PG8_STAGE(PG8_SA(0, 1), a2, vS[1]);
            PG8_WAIT_L(8); PG8_BAR; PG8_WAIT_L(0); PG8_MMA(0, 0, At, B0); PG8_BAR; PG8_SCHED;
            PG8_LDB(B1, 1, 1); PG8_STAGE(PG8_SB(1, 0), b3, voffB);
            PG8_BAR; PG8_WAIT_L(0); PG8_MMA(0, 1, At, B1); PG8_BAR;
            PG8_LDA(At, 1, 1); PG8_STAGE(PG8_SA(1, 0), a3, vS[0]);
            PG8_BAR; PG8_WAIT_L(0); PG8_MMA(1, 0, At, B0); PG8_BAR; PG8_SCHED;
            PG8_STAGE(PG8_SB(1, 1), b3 + hstepB, voffB);
            PG8_WAIT_V(6); PG8_BAR; PG8_MMA(1, 1, At, B1); PG8_BAR;
            }
        }
        if constexpr (GEMM_ALIGN_EPI) { if (wr == 0) PG8_BAR; }
        if constexpr (Epi::FP8) asm volatile("s_nop 15\n\ts_nop 15" ::: "memory");
        E(acc, cur, wr, wc, fr, fq);
        if (!has_next) break;
#pragma unroll
        for (int a = 0; a < 2; ++a)
#pragma unroll
            for (int b = 0; b < 2; ++b)
#pragma unroll
                for (int m = 0; m < 4; ++m)
#pragma unroll
                    for (int n = 0; n < 2; ++n) acc[a][b][m][n] = (f32x4){0.f, 0.f, 0.f, 0.f};
        if constexpr (Epi::FP8) asm volatile("s_nop 7" ::: "memory");
        cur = nxt; cA = nA; cB = nB; ++ui;
#pragma unroll
        for (int h = 0; h < 2; ++h)
#pragma unroll
            for (int i = 0; i < 2; ++i) vAc[h][i] = vAn[h][i];
        if constexpr (GEMM_ALIGN_EPI) { if (wr == 1) PG8_BAR; }
    }
    PG8_WAIT_V(0);
    if constexpr (!GEMM_ALIGN_EPI) { if (wr == 0) PG8_BAR; }
    PG8_BAR;
#undef PG8_SA
#undef PG8_SB
#undef PG8_STAGE
#undef PG8_LDA
#undef PG8_LDB
#undef PG8_MMA
#undef PG8_LD8
#undef PG8_LO
#undef PG8_HI
#undef PG8_WAIT_V
#undef PG8_WAIT_L
#undef PG8_BAR
#undef PG8_SCHED
}
}
using pg8::Unit;

extern __shared__ __attribute__((aligned(16))) char smem[];
__device__ __forceinline__ char* smem_base() { return smem; }

constexpr int EPI_LDS = 131072;
__device__ __forceinline__ char* epi_slot(int wr, int wc) { return smem_base() + EPI_LDS + (wr * 4 + wc) * 2048; }
__device__ __forceinline__ void slot_put(char* slot, int fr, int fq, u32x4 w0, u32x4 w1) {
    *(u32x4*)(slot + fr * 128 + (((fq) ^ (fr & 7)) << 4)) = w0; *(u32x4*)(slot + fr * 128 + (((4 + fq) ^ (fr & 7)) << 4)) = w1; }
__device__ __forceinline__ u32x4 slot_get(const char* slot, int half, int lane) { const int row = half * 8 + (lane >> 3), ch = lane & 7; return *(const u32x4*)(slot + row * 128 + ((ch ^ (row & 7)) << 4)); }

#define EPI_ROWS(ai, m) for (int ai = 0; ai < 2; ++ai) _Pragma("unroll") for (int m = 0; m < 4; ++m)

struct EpiProj {
    static constexpr bool PERM = true, FP8 = false;
    unsigned char* ws;
    __device__ __forceinline__ void operator()(const f32x4 (&acc)[2][2][4][2], const Unit& u, int wr, int wc, int fr, int fq) const {
        const int pn = u.pn; const int lane = fq * 16 + fr; char* slot = epi_slot(wr, wc);
        const int rowq = u.pm * 256 + wr * 64 + (lane >> 3);
        if (pn < 12 || (pn >= 30 && pn < 38)) {
            size_t boff; int ld, col0, act;
            if (pn < 2) { boff = WS_GQ; ld = 512; col0 = pn * 256; act = 0; }
            else if (pn < 4) { boff = WS_GK; ld = 512; col0 = (pn - 2) * 256; act = 0; }
            else if (pn < 8) { boff = WS_GV; ld = 1024; col0 = (pn - 4) * 256; act = 0; }
            else if (pn < 12) { boff = WS_GR; ld = 1024; col0 = (pn - 8) * 256; act = 1; }
            else if (pn < 34) { boff = WS_SG; ld = 1024; col0 = (pn - 30) * 256; act = 2; }
            else { boff = WS_SA; ld = 1024; col0 = (pn - 34) * 256; act = 2; }
            bf16_t* base = (bf16_t*)(ws + boff) + col0 + wc * 64 + (lane & 7) * 8;
#pragma unroll
            EPI_ROWS(ai, m) { u32x4 w[2];
#pragma unroll
                for (int bj = 0; bj < 2; ++bj) { float v[8];
#pragma unroll
                    for (int j = 0; j < 4; ++j) { v[j] = acc[ai][bj][m][0][j]; v[4 + j] = acc[ai][bj][m][1][j]; }
                    if (act == 1) {
#pragma unroll
                        for (int j = 0; j < 8; ++j) v[j] = v[j] * sigmoidf_(v[j]); }
                    if (act == 2) {
#pragma unroll
                        for (int j = 0; j < 8; ++j) v[j] = sigmoidf_(v[j]); }
                    w[bj] = pack8(v); }
                slot_put(slot, fr, fq, w[0], w[1]);
#pragma unroll
                for (int half = 0; half < 2; ++half) st_nt(base + (size_t)(rowq + ai * 128 + m * 16 + half * 8) * ld, slot_get(slot, half, lane)); }
        } else if (pn < 30) {
            const int which = (pn - 12) / 6, t6 = (pn - 12) % 6, sh = (t6 >> 1) * 2, dmask = (1 << sh) - 1, NL = SEQ >> sh;
            bf16_t* base = (bf16_t*)(ws + WS_AQ + (size_t)which * ((size_t)NTOK * 1536 * 2)) + (lane & 7) * 8;
            const bool rot = (which < 2) && (fq < 2);
            f32x4 frev;
#pragma unroll
            for (int q = 0; q < 4; ++q) frev[q] = rot ? __builtin_amdgcn_exp2f(-(float)(4 * fq + q) * (0.125f * 18.931568569324174f)) * 0.15915494309189535f : 0.f;
            const float sc = which == 0 ? QSCALE : 1.0f;
            const int head = t6 * 4 + wc;
#pragma unroll
            EPI_ROWS(ai, m) { const int s = (u.pm * 256 + wr * 64 + fr + ai * 128 + m * 16) & (SEQ - 1);
                f32x4 cs, sn;
#pragma unroll
                for (int q = 0; q < 4; ++q) { const float rev = __builtin_amdgcn_fractf((float)s * frev[q]); cs[q] = __builtin_amdgcn_cosf(rev); sn[q] = __builtin_amdgcn_sinf(rev); }
                u32x4 w[2];
#pragma unroll
                for (int bj = 0; bj < 2; ++bj) { float v[8];
#pragma unroll
                    for (int j = 0; j < 4; ++j) { v[j] = acc[ai][bj][m][0][j]; v[4 + j] = acc[ai][bj][m][1][j]; }
                    if (bj == 0) { const float a0 = v[0] * cs[0] - v[1] * sn[0], a1 = v[1] * cs[0] + v[0] * sn[0], a2 = v[2] * cs[1] - v[3] * sn[1], a3 = v[3] * cs[1] + v[2] * sn[1];
                      const float a4 = v[4] * cs[2] - v[5] * sn[2], a5 = v[5] * cs[2] + v[4] * sn[2], a6 = v[6] * cs[3] - v[7] * sn[3], a7 = v[7] * cs[3] + v[6] * sn[3];
                      v[0] = a0; v[1] = a1; v[2] = a2; v[3] = a3; v[4] = a4; v[5] = a5; v[6] = a6; v[7] = a7; }
#pragma unroll
                    for (int j = 0; j < 8; ++j) v[j] *= sc;
                    w[bj] = pack8(v); }
                slot_put(slot, fr, fq, w[0], w[1]);
#pragma unroll
                for (int half = 0; half < 2; ++half) { const int row = rowq + ai * 128 + m * 16 + half * 8, b = row >> 12, s2 = row & (SEQ - 1), r = s2 & dmask, n = s2 >> sh;
                    st_nt(base + ((size_t)(b * 24 + head) * SEQ + (size_t)r * NL + n) * 64, slot_get(slot, half, lane)); } }
        } else {
            const int row0 = u.pm * 256 + wr * 64 + fr;
            if (wc == 0 && fq < 2) { float* glr = (float*)(ws + WS_GLR);
#pragma unroll
                EPI_ROWS(ai, m) { float* rowp = glr + (size_t)(row0 + ai * 128 + m * 16) * 16 + 8 * fq; *(f32x4*)rowp = acc[ai][0][m][0]; *(f32x4*)(rowp + 4) = acc[ai][0][m][1]; } }
        }
    }
};

template <int MODE> struct EpiGate {
    static constexpr bool PERM = true, FP8 = false;
    const bf16_t* gate; const bf16_t* t1; bf16_t* out;
    __device__ __forceinline__ void operator()(const f32x4 (&acc)[2][2][4][2], const Unit& u, int wr, int wc, int fr, int fq) const {
        const int lane = fq * 16 + fr; char* slot = epi_slot(wr, wc);
        const size_t off0 = (size_t)(u.pm * 256 + wr * 64 + (lane >> 3)) * 1024 + u.pn * 256 + wc * 64 + (lane & 7) * 8;
#pragma unroll
        for (int ai = 0; ai < 2; ++ai) { u32x4 gw[4][2], tw[4][2];
#pragma unroll
            for (int m = 0; m < 4; ++m)
#pragma unroll
                for (int half = 0; half < 2; ++half) { const size_t off = off0 + (size_t)(ai * 128 + m * 16 + half * 8) * 1024; gw[m][half] = *(const u32x4*)(gate + off); if (MODE == 1) tw[m][half] = *(const u32x4*)(t1 + off); }
#pragma unroll
            for (int m = 0; m < 4; ++m) { u32x4 w[2];
#pragma unroll
                for (int bj = 0; bj < 2; ++bj) { float v[8];
#pragma unroll
                    for (int j = 0; j < 4; ++j) { v[j] = acc[ai][bj][m][0][j]; v[4 + j] = acc[ai][bj][m][1][j]; }
                    w[bj] = pack8(v); }
                slot_put(slot, fr, fq, w[0], w[1]);
#pragma unroll
                for (int half = 0; half < 2; ++half) { float a[8], g[8]; unpack8(slot_get(slot, half, lane), a); unpack8(gw[m][half], g);
#pragma unroll
                    for (int j = 0; j < 8; ++j) a[j] *= g[j];
                    if (MODE == 1) { float t[8]; unpack8(tw[m][half], t);
#pragma unroll
                        for (int j = 0; j < 8; ++j) a[j] += t[j]; }
                    *(u32x4*)(out + off0 + (size_t)(ai * 128 + m * 16 + half * 8) * 1024) = pack8(a); } } }
    }
};

struct EpiResid {
    static constexpr bool PERM = false, FP8 = false;
    const float* x; bf16_t* h;
    __device__ __forceinline__ void operator()(const f32x4 (&acc)[2][2][4][2], const Unit& u, int wr, int wc, int fr, int fq) const {
        const int lane = fq * 16 + fr; char* slot = epi_slot(wr, wc);
        const size_t off0 = (size_t)(u.pm * 256 + wr * 64 + (lane >> 3)) * 1024 + u.pn * 256 + wc * 32 + (lane & 7) * 4;
#pragma unroll
        for (int ai = 0; ai < 2; ++ai)
#pragma unroll
            for (int bj = 0; bj < 2; ++bj) { f32x4 xv[4][2];
#pragma unroll
                for (int m = 0; m < 4; ++m)
#pragma unroll
                    for (int half = 0; half < 2; ++half) xv[m][half] = *(const f32x4*)(x + off0 + (size_t)(ai * 128 + m * 16 + half * 8) * 1024 + bj * 128);
#pragma unroll
                for (int m = 0; m < 4; ++m) { slot_put(slot, fr, fq, __builtin_bit_cast(u32x4, acc[ai][bj][m][0]), __builtin_bit_cast(u32x4, acc[ai][bj][m][1]));
#pragma unroll
                    for (int half = 0; half < 2; ++half) { const f32x4 a = __builtin_bit_cast(f32x4, slot_get(slot, half, lane));
                        const f32x4 r = a + xv[m][half]; u32x2 w2; w2.x = cvt_pk_bf16(r[0], r[1]); w2.y = cvt_pk_bf16(r[2], r[3]);
                        *(u32x2*)(h + off0 + (size_t)(ai * 128 + m * 16 + half * 8) * 1024 + bj * 128) = w2; } } }
    }
};

struct EpiAct {
    static constexpr bool PERM = true, FP8 = true;
    const float* bgu; const int* tile_e; unsigned char* act;
    __device__ __forceinline__ void operator()(const f32x4 (&acc)[2][2][4][2], const Unit& u, int wr, int wc, int fr, int fq) const {
        const int e = tile_e[u.pm]; const int row0 = u.pm * 256 + wr * 64 + fr; const int j0 = u.pn * 128 + wc * 32 + 8 * fq;
        float bg[8], bu[8];
        { const float* bp = bgu + (size_t)e * 2048 + 2 * j0;
#pragma unroll
          for (int q = 0; q < 4; ++q) { const f32x4 t = *(const f32x4*)(bp + 4 * q); bg[2 * q] = t[0]; bu[2 * q] = t[1]; bg[2 * q + 1] = t[2]; bu[2 * q + 1] = t[3]; } }
#pragma unroll
        EPI_ROWS(ai, m) { float v[8];
#pragma unroll
            for (int j = 0; j < 8; ++j) { const float gt = acc[ai][0][m][j >> 2][j & 3] + bg[j], up = acc[ai][1][m][j >> 2][j & 3] + bu[j];
                const float g = fminf(gt, 7.0f), uu = fminf(fmaxf(up, -7.0f), 7.0f); v[j] = (uu + 1.0f) * (g * sigmoidf_(1.702f * g)); }
            u32x2 w8; w8.x = (unsigned)pk4_fp8(v[0], v[1], v[2], v[3]); w8.y = (unsigned)pk4_fp8(v[4], v[5], v[6], v[7]);
            *(u32x2*)(act + (size_t)(row0 + ai * 128 + m * 16) * 1024 + j0) = w8; }
    }
};

struct EpiDown {
    static constexpr bool PERM = true, FP8 = true;
    const float* bd; const int* tile_e; unsigned char* y;
    __device__ __forceinline__ void operator()(const f32x4 (&acc)[2][2][4][2], const Unit& u, int wr, int wc, int fr, int fq) const {
        const int e = tile_e[u.pm]; const int lane = fq * 16 + fr; char* slot = epi_slot(wr, wc); const int col0 = u.pn * 256 + wc * 64 + 8 * fq;
        f32x4 b[2][2];
#pragma unroll
        for (int bj = 0; bj < 2; ++bj)
#pragma unroll
            for (int n = 0; n < 2; ++n) b[bj][n] = *(const f32x4*)(bd + (size_t)e * 1024 + col0 + bj * 32 + 4 * n);
        unsigned char* base = y + (size_t)(u.pm * 256 + wr * 64 + (lane >> 2)) * 1024 + u.pn * 256 + wc * 64 + (lane & 3) * 16;
#pragma unroll
        EPI_ROWS(ai, m) { u32x2 w[2];
#pragma unroll
            for (int bj = 0; bj < 2; ++bj) { const f32x4 v0 = acc[ai][bj][m][0] + b[bj][0], v1 = acc[ai][bj][m][1] + b[bj][1];
                w[bj].x = (unsigned)pk4_fp8(v0[0], v0[1], v0[2], v0[3]); w[bj].y = (unsigned)pk4_fp8(v1[0], v1[1], v1[2], v1[3]); }
            *(u32x2*)(slot + fr * 64 + 8 * fq) = w[0]; *(u32x2*)(slot + fr * 64 + 32 + 8 * fq) = w[1];
            const u32x4 o = *(const u32x4*)(slot + (lane >> 2) * 64 + (lane & 3) * 16);
            *(u32x4*)(base + (size_t)(ai * 128 + m * 16) * 1024) = o; }
    }
};

__device__ __forceinline__ int win_colmap(int n) {
    if (n < 3072) return n;
    if (n < 7680) { const int off = n - 3072, which = off / 1536, hcol = off % 1536, head = hcol >> 6, p = hcol & 63;
        int dim = p; if (which < 2 && p < 16) dim = (p & 1) ? (p >> 1) + 8 : (p >> 1);
        return 3088 + which * 1536 + head * 64 + dim; }
    if (n < 9728) return 7696 + (n - 7680);
    if (n < 9744) return 3072 + (n - 9728);
    return -1;
}
__device__ __forceinline__ int gu_colmap(int n) { const int t = n >> 8, w = n & 255, wc = w >> 6, bj = (w >> 5) & 1, rho = w & 31; return 2 * (128 * t + 32 * wc + rho) + bj; }

__device__ __forceinline__ void transpose_tile(const float* src, int ld_src, bf16_t* dst, int K, int n0, int k0, int scol, char* lds) {
    const int t = tid_(), nl = t & 127, kq = t >> 7;
#pragma unroll
    for (int cc = 0; cc < 4; ++cc) { const int c = kq * 4 + cc; float v[8];
#pragma unroll
        for (int j = 0; j < 8; ++j) v[j] = scol >= 0 ? src[(size_t)(k0 + c * 8 + j) * ld_src + scol] : 0.f;
        *(u32x4*)(lds + nl * 256 + ((c ^ (nl & 15)) << 4)) = pack8(v); }
    __syncthreads();
#pragma unroll
    for (int pass = 0; pass < 4; ++pass) { const int idx = t + 512 * pass, n2 = idx >> 4, c2 = idx & 15;
        *(u32x4*)(dst + (size_t)(n0 + n2) * K + k0 + c2 * 8) = *(const u32x4*)(lds + n2 * 256 + ((c2 ^ (n2 & 15)) << 4)); }
    __syncthreads();
}

__device__ __forceinline__ void transpose_tile8(const float* src, int ld_src, unsigned char* dst, int K, int n0, int k0, int scol, float scale, char* lds) {
    const int t = tid_(), nl = t & 127, kq = t >> 7;
#pragma unroll
    for (int cc = 0; cc < 4; ++cc) { const int c = kq * 4 + cc; float v[16];
#pragma unroll
        for (int j = 0; j < 16; ++j) v[j] = src[(size_t)(k0 + c * 16 + j) * ld_src + scol] * scale;
        u32x4 w; w.x = (unsigned)pk4_fp8(v[0], v[1], v[2], v[3]); w.y = (unsigned)pk4_fp8(v[4], v[5], v[6], v[7]); w.z = (unsigned)pk4_fp8(v[8], v[9], v[10], v[11]); w.w = (unsigned)pk4_fp8(v[12], v[13], v[14], v[15]);
        *(u32x4*)(lds + nl * 256 + ((c ^ (nl & 15)) << 4)) = w; }
    __syncthreads();
#pragma unroll
    for (int pass = 0; pass < 4; ++pass) { const int idx = t + 512 * pass, n2 = idx >> 4, c2 = idx & 15;
        *(u32x4*)(dst + (size_t)(n0 + n2) * K + k0 + c2 * 16) = *(const u32x4*)(lds + n2 * 256 + ((c2 ^ (n2 & 15)) << 4)); }
    __syncthreads();
}

template <int MAP> __device__ __forceinline__ int tile_rowmap(int o) {
    if (MAP == 1) { const int d = o & 63; const int pp = d < 16 ? (d < 8 ? 2 * d : 2 * (d - 8) + 1) : d; return (o & 64) + pp; }
    if (MAP == 2) { const int wcl = o >> 6, w = o & 63; return 64 * wcl + 32 * (w & 1) + (w >> 1); }
    return o;
}
template <int MAP, bool F8> __device__ __forceinline__ void transpose_fast(const float* src  , int ld_src, unsigned char* dst, int Kb  , int n0, int k0, float scale, char* lds) {
    constexpr int KPT = F8 ? 16 : 8;
    const int t = tid_(), ng = t & 31, kg = t >> 5;
    f32x4 v[KPT];
#pragma unroll
    for (int j = 0; j < KPT; ++j) v[j] = *(const f32x4*)(src + (size_t)(k0 + kg * KPT + j) * ld_src + 4 * ng);
#pragma unroll
    for (int i = 0; i < 4; ++i) { const int row = tile_rowmap<MAP>(4 * ng + i); u32x4 w;
        if (F8) { w.x = (unsigned)pk4_fp8(v[0][i] * scale, v[1][i] * scale, v[2][i] * scale, v[3][i] * scale); w.y = (unsigned)pk4_fp8(v[4][i] * scale, v[5][i] * scale, v[6][i] * scale, v[7][i] * scale);
                  w.z = (unsigned)pk4_fp8(v[8 % KPT][i] * scale, v[9 % KPT][i] * scale, v[10 % KPT][i] * scale, v[11 % KPT][i] * scale); w.w = (unsigned)pk4_fp8(v[12 % KPT][i] * scale, v[13 % KPT][i] * scale, v[14 % KPT][i] * scale, v[15 % KPT][i] * scale); }
        else { w.x = cvt_pk_bf16(v[0][i], v[1][i]); w.y = cvt_pk_bf16(v[2][i], v[3][i]); w.z = cvt_pk_bf16(v[4][i], v[5][i]); w.w = cvt_pk_bf16(v[6][i], v[7][i]); }
        *(u32x4*)(lds + row * 256 + ((kg ^ (row & 15)) << 4)) = w; }
    __syncthreads();
#pragma unroll
    for (int pass = 0; pass < 4; ++pass) { const int idx = t + 512 * pass, n2 = idx >> 4, c2 = idx & 15;
        *(u32x4*)(dst + (size_t)(n0 + n2) * Kb + (size_t)k0 * (F8 ? 1 : 2) + c2 * 16) = *(const u32x4*)(lds + n2 * 256 + ((c2 ^ (n2 & 15)) << 4)); }
    __syncthreads();
}

__device__ __forceinline__ void phase_prologue(const Params& p, char* lds) {
    unsigned char* ws = opaque(p.ws);
    const int tid = tid_(), lane = tid & 63, wid = tid >> 6, G = gridDim.x, bid = blockIdx.x;
    { bf16_t* xn = (bf16_t*)(ws + WS_XN);
      for (int row = bid * 8 + wid; row < NTOK; row += G * 8) { const float* xr = p.x + (size_t)row * 1024; f32x4 v[4]; float ss = 0.f;
#pragma unroll
          for (int i = 0; i < 4; ++i) { v[i] = *(const f32x4*)(xr + i * 256 + lane * 4); ss += v[i][0] * v[i][0] + v[i][1] * v[i][1] + v[i][2] * v[i][2] + v[i][3] * v[i][3]; }
          ss = wave_sum(ss); const float rs = rsqrtf(ss * (1.0f / 1024.0f) + EPS);
#pragma unroll
          for (int i = 0; i < 4; ++i) { const f32x4 g = *(const f32x4*)(p.norm_mix_g + i * 256 + lane * 4); u32x2 w; w.x = cvt_pk_bf16(v[i][0] * rs * g[0], v[i][1] * rs * g[1]); w.y = cvt_pk_bf16(v[i][2] * rs * g[2], v[i][3] * rs * g[3]);
              *(u32x2*)(xn + (size_t)row * 1024 + i * 256 + lane * 4) = w; } } }
    { float* rwg = (float*)(ws + WS_RWG);
      for (int i = bid * 512 + tid; i < 1024 * 32; i += G * 512) rwg[i] = p.router_w[i] * p.norm_ffn_g[i >> 5]; }
    { constexpr int T0 = 78 * 8, T1 = T0 + 64, T2 = T1 + 32, T3 = T2 + 64, T4 = T3 + 32 * 64, T5 = T4 + 32 * 32;
      const int nl = tid & 127;
      for (int tile = bid; tile < T3; tile += G) {
          if (tile < T0) { const int nt_ = tile >> 3, kt = tile & 7; bf16_t* d = (bf16_t*)(ws + WS_W_IN); unsigned char* d8 = ws + WS_W_IN;
              if (nt_ < 24) transpose_fast<0, false>(p.w_in + nt_ * 128, INW, d8, 2048, nt_ * 128, kt * 128, 1.f, lds);
              else if (nt_ < 48) transpose_fast<1, false>(p.w_in + 3088 + (nt_ - 24) * 128, INW, d8, 2048, nt_ * 128, kt * 128, 1.f, lds);
              else if (nt_ < 60) transpose_fast<0, false>(p.w_in + 3088 + (nt_ - 24) * 128, INW, d8, 2048, nt_ * 128, kt * 128, 1.f, lds);
              else if (nt_ < 76) transpose_fast<0, false>(p.w_in + 7696 + (nt_ - 60) * 128, INW, d8, 2048, nt_ * 128, kt * 128, 1.f, lds);
              else transpose_tile(p.w_in, INW, d, 1024, nt_ * 128, kt * 128, win_colmap(nt_ * 128 + nl), lds); }
          else if (tile < T1) { const int q = tile - T0, nt_ = q >> 3, kt = q & 7; transpose_fast<0, false>(p.w_branch_gla + nt_ * 128, 1024, ws + WS_W_G, 2048, nt_ * 128, kt * 128, 1.f, lds); }
          else if (tile < T2) { const int q = tile - T1, nt_ = q >> 2, kt = q & 3; transpose_fast<0, false>(p.w_branch_att + nt_ * 128, 1024, ws + WS_W_A, 1024, nt_ * 128, kt * 128, 1.f, lds); }
          else if (tile < T3) { const int q = tile - T2, nt_ = q >> 3, kt = q & 7; transpose_fast<0, false>(p.w_mix_out + nt_ * 128, 1024, ws + WS_W_MIX, 2048, nt_ * 128, kt * 128, 1.f, lds); }
      } }
}

constexpr int N_EXPERT_TILES = 32 * 64 + 32 * 32;
__device__ __forceinline__ void expert_convert(const Params& p, char* lds, int first, int stride) {
    unsigned char* ws = opaque(p.ws);
    for (int q0 = first; q0 < N_EXPERT_TILES; q0 += stride) {
        if (q0 < 32 * 64) { const int q = q0, e = q >> 6, r = q & 63, nt_ = r >> 2, kt = r & 3;
            transpose_fast<2, true>(p.e_w_gu + (size_t)e * 1024 * 2048 + nt_ * 128, 2048, ws + WS_W_GU + (size_t)e * 2048 * 1024, 1024, nt_ * 128, kt * 256, 32.0f, lds); }
        else { const int q = q0 - 32 * 64, e = q >> 5, r = q & 31, nt_ = r >> 2, kt = r & 3;
            transpose_fast<0, true>(p.e_w_d + (size_t)e * 1024 * 1024 + nt_ * 128, 1024, ws + WS_W_D + (size_t)e * 1024 * 1024, 1024, nt_ * 128, kt * 256, 32.0f, lds); }
    }
}

constexpr int AT_KCS = 385 * 16;
constexpr int AT_VH = 385 * 64;
constexpr int AT_K = 0, AT_V = 8 * AT_KCS, AT_WL = AT_V + 2 * AT_VH, AT_STG = AT_WL + 8 * 128, AT_END = AT_STG + 8 * 4096;
static_assert(AT_END <= LDS_BYTES, "attention LDS");
struct AttnPre { u32x4 k[6], v[6]; bf16x8 q[4]; };
__device__ __forceinline__ void attn_fetch(const Params& p, int item, AttnPre& r) {
    unsigned char* ws = opaque(p.ws); const int tid = tid_();
    const int jj = item & 15, bh = item >> 4, head = bh % 24, g = head >> 3, sh = 2 * g, NL = SEQ >> sh, ppr = 16 >> sh; const int rr_ = jj / ppr, j = jj % ppr;
    const size_t hb = ((size_t)bh * SEQ + (size_t)rr_ * NL) * 64; const bf16_t* Kg = (const bf16_t*)(ws + WS_AK) + hb; const bf16_t* Vg = (const bf16_t*)(ws + WS_AV) + hb; const int kn0 = 256 * j - 128;
    { const int lane = tid & 63, r32 = lane & 31, hi = lane >> 5, w = tid >> 6; const bf16_t* Q = (const bf16_t*)(ws + WS_AQ) + hb;
#pragma unroll
      for (int d0 = 0; d0 < 4; ++d0) r.q[d0] = *(const bf16x8*)(Q + (size_t)(256 * j + 32 * w + r32) * 64 + d0 * 16 + hi * 8); }
#pragma unroll
    for (int i = 0; i < 6; ++i) { const int idx = tid + 512 * i, key = idx >> 3, c = idx & 7;
        if (kn0 + key >= 0) { r.k[i] = *(const u32x4*)(Kg + (ptrdiff_t)(kn0 + key) * 64 + c * 8); r.v[i] = *(const u32x4*)(Vg + (ptrdiff_t)(kn0 + key) * 64 + c * 8); } }
}
__device__ __forceinline__ void attn_item(const Params& p, int item, int nitem, bool has_next, AttnPre& pre, char* lds) {
    unsigned char* ws = opaque(p.ws);
    const int tid = tid_(), lane = tid & 63, r32 = lane & 31, hi = lane >> 5; const int w = __builtin_amdgcn_readfirstlane(tid >> 6);
    const int jj = item & 15, bh = item >> 4, head = bh % 24, b = bh / 24, g = head >> 3, sh = 2 * g, d = 1 << sh, NL = SEQ >> sh, ppr = 16 >> sh;
    const int r = jj / ppr, j = jj % ppr;
    const size_t hb = ((size_t)bh * SEQ + (size_t)r * NL) * 64;
    const bf16_t* Q = (const bf16_t*)(ws + WS_AQ) + hb;
    const int kn0 = 256 * j - 128;
    bf16x8 qf[4];
#pragma unroll
    for (int d0 = 0; d0 < 4; ++d0) qf[d0] = pre.q[d0];
#pragma unroll
    for (int i = 0; i < 6; ++i) { const int idx = tid + 512 * i, key = idx >> 3, c = idx & 7;
        if (kn0 + key >= 0) { *(u32x4*)(lds + AT_K + c * AT_KCS + key * 16) = pre.k[i]; *(u32x4*)(lds + AT_V + (c >> 2) * AT_VH + key * 64 + (c & 3) * 16) = pre.v[i]; } }
    __syncthreads();
    if (has_next) attn_fetch(p, nitem, pre);
    const LDS3 char* l3 = (const LDS3 char*)lds;
    f32x16 s[5]; const int ktmin = (j == 0) ? 4 : 0;
#pragma unroll
    for (int t5 = 0; t5 < 5; ++t5) { const int kt = w + t5;
        if (kt >= ktmin) { f32x16 a = {};
#pragma unroll
            for (int d0 = 0; d0 < 4; ++d0) { const bf16x8 kf = *(const LDS3 bf16x8*)(l3 + AT_K + (2 * d0 + hi) * AT_KCS + (kt * 32 + r32) * 16); a = MFMA32(kf, qf[d0], a); }
            s[t5] = a; }
        else {
#pragma unroll
            for (int rr = 0; rr < 16; ++rr) s[t5][rr] = -1e30f; } }
#pragma unroll
    for (int rr = 0; rr < 16; ++rr) { const int c = crow(rr, hi); if (c < r32) s[0][rr] = -1e30f; if (c > r32) s[4][rr] = -1e30f; }
    float mx = -1e30f;
#pragma unroll
    for (int t5 = 0; t5 < 5; ++t5)
#pragma unroll
        for (int rr = 0; rr < 16; ++rr) mx = fmaxf(mx, s[t5][rr]);
    mx = fmaxf(mx, __shfl_xor(mx, 32));
    float l = 0.f;
#pragma unroll
    for (int t5 = 0; t5 < 5; ++t5)
#pragma unroll
        for (int rr = 0; rr < 16; ++rr) { const float e = __builtin_amdgcn_exp2f(s[t5][rr] - mx); s[t5][rr] = e; l += e; }
    l += __shfl_xor(l, 32);
    f32x16 o[2]; o[0] = f32x16{}; o[1] = f32x16{};
    const int blk = (lane >> 4) & 1, q4 = (lane & 15) >> 2, p4 = lane & 3;
#pragma unroll
    for (int t5 = 0; t5 < 5; ++t5) { const int kt = w + t5;
        if (kt >= ktmin) {
#pragma unroll
            for (int ss = 0; ss < 2; ++ss) { float pv[8];
#pragma unroll
                for (int q = 0; q < 8; ++q) pv[q] = s[t5][8 * ss + q];
                const bf16x8 pa = __builtin_bit_cast(bf16x8, pack8(pv));
#pragma unroll
                for (int dh = 0; dh < 2; ++dh) { const LDS3 char* vp = l3 + AT_V + dh * AT_VH + (kt * 32 + 16 * ss + 4 * hi + q4) * 64 + (16 * blk + 4 * p4) * 2;
                    const bf16x8 vf = cat8(tr16(vp), tr16(vp + 8 * 64)); o[dh] = MFMA32(pa, vf, o[dh]); } } } }
    const int n_q = 256 * j + 32 * w + r32; const int tok = b * SEQ + n_q * d + r;
    if (hi == 0) { ((float*)(ws + WS_LSE))[((size_t)g * NTOK + tok) * 8 + (head & 7)] = (mx + __builtin_amdgcn_logf(l)) * LN2;
        ((float*)(lds + AT_WL))[w * 32 + r32] = __builtin_amdgcn_rcpf(l); }
    bf16_t* stg = (bf16_t*)(lds + AT_STG) + w * 2048;
#pragma unroll
    for (int rr = 0; rr < 16; ++rr) { const int qr = crow(rr, hi); const float rl = ((const float*)(lds + AT_WL))[w * 32 + qr];
#pragma unroll
        for (int dh = 0; dh < 2; ++dh) stg[qr * 64 + dh * 32 + r32] = (bf16_t)(cvt_pk_bf16(o[dh][rr] * rl, 0.f) & 0xffffu); }
    bf16_t* og = (bf16_t*)(ws + WS_OATT) + (size_t)g * NTOK * 512;
#pragma unroll
    for (int i = 0; i < 4; ++i) { const int idx = i * 64 + lane, row = idx >> 3, ch = idx & 7; const int tk = b * SEQ + (256 * j + 32 * w + row) * d + r;
        *(u32x4*)(og + (size_t)tk * 512 + (head & 7) * 64 + ch * 8) = *(const u32x4*)(stg + row * 64 + ch * 8); }
    __syncthreads();
}

constexpr int G1_BB = 0;
constexpr int G1_QE = G1_BB + 64 * 128 * 4;
constexpr int G1_KE = G1_QE + 64 * 272;
constexpr int G1_KD = G1_KE + 64 * 272;
constexpr int G1_V = G1_KD + 64 * 320;
constexpr int G1_GLR = G1_V + 64 * 576;
constexpr int G1_GUP = G1_GLR + 64 * 16 * 4;
constexpr int G1_SEG = G1_GUP + 16 * 128 * 4;
constexpr int G1_BIAS = G1_SEG + 4 * 128 * 4;
constexpr int G1_END = G1_BIAS + 128 * 4;
constexpr int G1_SU = 0;
constexpr int G1_SO = 128 * 528;
static_assert(G1_SO + 64 * 528 <= G1_GLR, "gla1 staging");
static_assert(G1_END <= LDS_BYTES, "gla1 LDS");
__device__ __forceinline__ float logsigmoidf_(float z) { return fminf(z, 0.f) - log1pf(__expf(-fabsf(z))); }
struct G1Pre { u32x4 q[2], k[2], v[4]; float glr[2]; };
__device__ __forceinline__ void gla1_fetch(const Params& p, int item, G1Pre& r) {
    unsigned char* ws = opaque(p.ws); const int tid = tid_();
    const int n = item & 63, bh = item >> 6, h = bh & 3, b = bh >> 2; const int tok0 = b * SEQ + n * 64;
    const bf16_t* gq = (const bf16_t*)(ws + WS_GQ); const bf16_t* gk = (const bf16_t*)(ws + WS_GK); const bf16_t* gv = (const bf16_t*)(ws + WS_GV);
#pragma unroll
    for (int pp = 0; pp < 2; ++pp) { const int idx = tid + 512 * pp, i = idx >> 4, c = idx & 15; const size_t go = (size_t)(tok0 + i) * 512 + h * 128 + c * 8; r.q[pp] = *(const u32x4*)(gq + go); r.k[pp] = *(const u32x4*)(gk + go);
        r.glr[pp] = ((const float*)(ws + WS_GLR))[(size_t)tok0 * 16 + idx]; }
#pragma unroll
    for (int pp = 0; pp < 4; ++pp) { const int idx = tid + 512 * pp, jv = idx >> 5, c = idx & 31; r.v[pp] = *(const u32x4*)(gv + (size_t)(tok0 + jv) * 1024 + h * 256 + c * 8); }
}
__device__ __forceinline__ void gla1_head_operands(const Params& p, int h, char* lds) {
    const int tid = tid_(); float* GUP = (float*)(lds + G1_GUP); float* BIAS = (float*)(lds + G1_BIAS);
    for (int i = tid; i < 16 * 128; i += 512) GUP[i] = p.gla_gate_up[(i >> 7) * 512 + h * 128 + (i & 127)];
    if (tid < 128) BIAS[tid] = p.gla_gate_bias[h * 128 + tid];
}
__device__ __forceinline__ void gla1_item(const Params& p, int item, int nitem, bool has_next, bool reload_head, G1Pre& pre, char* lds) {
    unsigned char* ws = opaque(p.ws);
    const int tid = tid_(), lane = tid & 63, r32 = lane & 31, hi = lane >> 5; const int w = __builtin_amdgcn_readfirstlane(tid >> 6);
    const int n = item & 63, bh = item >> 6, h = bh & 3, b = bh >> 2; const int tok0 = b * SEQ + n * 64;
    float* BB = (float*)(lds + G1_BB); float* GLRs = (float*)(lds + G1_GLR); float* GUP = (float*)(lds + G1_GUP); float* SEGs = (float*)(lds + G1_SEG); float* BIAS = (float*)(lds + G1_BIAS);
    u32x4 qraw[2], kraw[2], vraw[4];
#pragma unroll
    for (int pp = 0; pp < 2; ++pp) { qraw[pp] = pre.q[pp]; kraw[pp] = pre.k[pp]; GLRs[tid + 512 * pp] = pre.glr[pp]; }
#pragma unroll
    for (int pp = 0; pp < 4; ++pp) vraw[pp] = pre.v[pp];
    if (reload_head) gla1_head_operands(p, h, lds);
    __syncthreads();
    if (has_next) gla1_fetch(p, nitem, pre);
    { const int d = tid & 127, seg = tid >> 7; float gu[16];
#pragma unroll
      for (int r = 0; r < 16; ++r) gu[r] = GUP[r * 128 + d];
      const float bias = BIAS[d]; float run = 0.f;
#pragma unroll 4
      for (int ii = 0; ii < 16; ++ii) { const int i = seg * 16 + ii; float z = bias;
#pragma unroll
          for (int r4 = 0; r4 < 4; ++r4) { const f32x4 gl = *(const f32x4*)(GLRs + i * 16 + r4 * 4); z += gl[0] * gu[r4 * 4] + gl[1] * gu[r4 * 4 + 1] + gl[2] * gu[r4 * 4 + 2] + gl[3] * gu[r4 * 4 + 3]; }
          run += logsigmoidf_(z) * (1.0f / 16.0f); BB[i * 128 + d] = run; }
      SEGs[seg * 128 + d] = run;
      __syncthreads();
      float off = 0.f; for (int s2 = 0; s2 < seg; ++s2) off += SEGs[s2 * 128 + d];
      if (seg > 0) { for (int ii = 0; ii < 16; ++ii) BB[(seg * 16 + ii) * 128 + d] += off; }
      __syncthreads(); }
    { const bf16_t* gq = (const bf16_t*)(ws + WS_GQ); const bf16_t* gk = (const bf16_t*)(ws + WS_GK); const bf16_t* gv = (const bf16_t*)(ws + WS_GV); bf16_t* qeg = (bf16_t*)(ws + WS_QE);
#pragma unroll
      for (int pp = 0; pp < 2; ++pp) { const int idx = tid + 512 * pp, i = idx >> 4, c = idx & 15, d0 = c * 8; const size_t go = (size_t)(tok0 + i) * 512 + h * 128 + d0;
          float q[8], k[8], qe[8], ke[8], kd[8]; unpack8(qraw[pp], q); unpack8(kraw[pp], k);
#pragma unroll
          for (int j = 0; j < 8; ++j) { const float bb = BB[i * 128 + d0 + j], bl = BB[63 * 128 + d0 + j]; qe[j] = q[j] * __expf(bb) * 0.08838834764831845f; ke[j] = k[j] * __expf(-bb); kd[j] = k[j] * __expf(bl - bb); }
          const u32x4 qw = pack8(qe); *(u32x4*)(lds + G1_QE + i * 272 + c * 16) = qw; *(u32x4*)(qeg + go) = qw;
          *(u32x4*)(lds + G1_KE + i * 272 + c * 16) = pack8(ke); *(u32x4*)(lds + G1_KD + i * 320 + c * 16) = pack8(kd); }
#pragma unroll
      for (int pp = 0; pp < 4; ++pp) { const int idx = tid + 512 * pp, jv = idx >> 5, c = idx & 31; *(u32x4*)(lds + G1_V + jv * 576 + c * 16) = vraw[pp]; }
      if (tid < 128) ((float*)(ws + WS_DEC))[(size_t)item * 128 + tid] = __expf(BB[63 * 128 + tid]);
      __syncthreads(); }
    const LDS3 char* l3 = (const LDS3 char*)lds; const int blk = (lane >> 4) & 1, q4 = (lane & 15) >> 2, p4 = lane & 3;
    {
      const int it = w & 1, vq = w >> 1; f32x16 oi[2]; oi[0] = f32x16{}; oi[1] = f32x16{};
#pragma unroll
      for (int jt = 0; jt < 2; ++jt) { if (jt <= it) { f32x16 x = {};
#pragma unroll
          for (int s = 0; s < 8; ++s) { const bf16x8 a = *(const LDS3 bf16x8*)(l3 + G1_KE + (jt * 32 + r32) * 272 + (16 * s + 8 * hi) * 2), bq = *(const LDS3 bf16x8*)(l3 + G1_QE + (it * 32 + r32) * 272 + (16 * s + 8 * hi) * 2); x = MFMA32(a, bq, x); }
          if (jt == it) {
#pragma unroll
              for (int rr = 0; rr < 16; ++rr) if (crow(rr, hi) > r32) x[rr] = 0.f; }
#pragma unroll
          for (int ss = 0; ss < 2; ++ss) { float xv[8];
#pragma unroll
              for (int q = 0; q < 8; ++q) xv[q] = x[8 * ss + q];
              const bf16x8 xa = __builtin_bit_cast(bf16x8, pack8(xv));
#pragma unroll
              for (int vi = 0; vi < 2; ++vi) { const int vt = 2 * vq + vi; const LDS3 char* vp = l3 + G1_V + (jt * 32 + 16 * ss + 4 * hi + q4) * 576 + (vt * 32 + 16 * blk + 4 * p4) * 2;
                  const bf16x8 vf = cat8(tr16(vp), tr16(vp + 8 * 576)); oi[vi] = MFMA32(xa, vf, oi[vi]); } } } }
      const int dt = w & 3, vg = w >> 2; f32x16 uu[4]; uu[0] = f32x16{}; uu[1] = f32x16{}; uu[2] = f32x16{}; uu[3] = f32x16{};
#pragma unroll
      for (int ks = 0; ks < 4; ++ks) { const LDS3 char* ap = l3 + G1_KD + (16 * ks + 8 * hi + q4) * 320 + (dt * 32 + 16 * blk + 4 * p4) * 2; const bf16x8 a = cat8(tr16(ap), tr16(ap + 4 * 320));
#pragma unroll
          for (int vi = 0; vi < 4; ++vi) { const int vt = 4 * vg + vi; const LDS3 char* vp = l3 + G1_V + (16 * ks + 8 * hi + q4) * 576 + (vt * 32 + 16 * blk + 4 * p4) * 2; const bf16x8 vf = cat8(tr16(vp), tr16(vp + 4 * 576)); uu[vi] = MFMA32(a, vf, uu[vi]); } }
      __syncthreads();
      bf16_t* SU = (bf16_t*)(lds + G1_SU); bf16_t* SO = (bf16_t*)(lds + G1_SO);
#pragma unroll
      for (int vi = 0; vi < 4; ++vi)
#pragma unroll
          for (int rr = 0; rr < 16; ++rr) SU[(dt * 32 + crow(rr, hi)) * 264 + (4 * vg + vi) * 32 + r32] = (bf16_t)(cvt_pk_bf16(uu[vi][rr], 0.f) & 0xffffu);
#pragma unroll
      for (int vi = 0; vi < 2; ++vi)
#pragma unroll
          for (int rr = 0; rr < 16; ++rr) SO[(it * 32 + crow(rr, hi)) * 264 + (2 * vq + vi) * 32 + r32] = (bf16_t)(cvt_pk_bf16(oi[vi][rr], 0.f) & 0xffffu);
      __syncthreads();
      bf16_t* ug = (bf16_t*)(ws + WS_U) + (size_t)item * 128 * 256; bf16_t* og = (bf16_t*)(ws + WS_OINTRA);
#pragma unroll
      for (int pp = 0; pp < 8; ++pp) { const int idx = tid + 512 * pp, row = idx >> 5, c = idx & 31; *(u32x4*)(ug + (size_t)row * 256 + c * 8) = *(const u32x4*)(SU + row * 264 + c * 8); }
#pragma unroll
      for (int pp = 0; pp < 4; ++pp) { const int idx = tid + 512 * pp, row = idx >> 5, c = idx & 31; *(u32x4*)(og + (size_t)(tok0 + row) * 1024 + h * 256 + c * 8) = *(const u32x4*)(SO + row * 264 + c * 8); } }
    __syncthreads();
}

__device__ __forceinline__ void phase_scan_combine(const Params& p) {
    unsigned char* ws = opaque(p.ws); const int G = gridDim.x;
    { const bf16_t* U = (const bf16_t*)(ws + WS_U); bf16_t* PV = (bf16_t*)(ws + WS_PREV); const float* DEC = (const float*)(ws + WS_DEC);
      for (int idx = blockIdx.x * 512 + tid_(); idx < 16 * 128 * 64; idx += G * 512) { const int bh = idx >> 13, rem = idx & 8191, d = rem >> 6, vq = rem & 63;
          float st[4] = {0.f, 0.f, 0.f, 0.f}; const size_t e0 = ((size_t)bh * 64 * 128 + d) * 256 + vq * 4;
#pragma unroll 8
          for (int n = 0; n < 64; ++n) { const size_t e = e0 + (size_t)n * 128 * 256; const u32x2 uw = *(const u32x2*)(U + e); const float dc = DEC[(size_t)(bh * 64 + n) * 128 + d];
              u32x2 pw; pw.x = cvt_pk_bf16(st[0], st[1]); pw.y = cvt_pk_bf16(st[2], st[3]); *(u32x2*)(PV + e) = pw;
              st[0] = dc * st[0] + bf_lo(uw.x); st[1] = dc * st[1] + bf_hi(uw.x); st[2] = dc * st[2] + bf_lo(uw.y); st[3] = dc * st[3] + bf_hi(uw.y); } } }
    { const bf16_t* OG = (const bf16_t*)(ws + WS_OATT); const float* LSE = (const float*)(ws + WS_LSE); bf16_t* YA = (bf16_t*)(ws + WS_YATT);
#pragma unroll 2
      for (int idx = blockIdx.x * 512 + tid_(); idx < NTOK * 64; idx += G * 512) { const int tok = idx >> 6, jc = idx & 63, jh = jc >> 3;
          const float l0 = LSE[(size_t)tok * 8 + jh], l1 = LSE[((size_t)NTOK + tok) * 8 + jh], l2 = LSE[((size_t)2 * NTOK + tok) * 8 + jh];
          const float m = fmaxf(l0, fmaxf(l1, l2)); float a0 = __expf(l0 - m), a1 = __expf(l1 - m), a2 = __expf(l2 - m); const float inv = __builtin_amdgcn_rcpf(a0 + a1 + a2); a0 *= inv; a1 *= inv; a2 *= inv;
          float o0[8], o1[8], o2[8], y[8]; const size_t off = (size_t)tok * 512 + jc * 8;
          unpack8(*(const u32x4*)(OG + off), o0); unpack8(*(const u32x4*)(OG + (size_t)NTOK * 512 + off), o1); unpack8(*(const u32x4*)(OG + (size_t)2 * NTOK * 512 + off), o2);
#pragma unroll
          for (int q = 0; q < 8; ++q) y[q] = a0 * o0[q] + a1 * o1[q] + a2 * o2[q];
          *(u32x4*)(YA + off) = pack8(y); } }
}

constexpr int G3_PREV = 0;
constexpr int G3_SS = G3_PREV + 128 * 576;
constexpr int G3_OI = G3_SS + 8 * 32 * 4;
constexpr int G3_GR = G3_OI + 64 * 528;
constexpr int G3_END = G3_GR + 64 * 528;
static_assert(G3_END <= LDS_XB, "gla3 LDS");
struct G3Pre { u32x4 pv[8], oi[4], gr[4]; };
__device__ __forceinline__ void gla3_fetch(const Params& p, int item, G3Pre& r) {
    unsigned char* ws = opaque(p.ws); const int tid = tid_();
    const int n = item & 63, bh = item >> 6, h = bh & 3, b = bh >> 2; const int tok0 = b * SEQ + n * 64;
    const bf16_t* PV = (const bf16_t*)(ws + WS_PREV) + (size_t)item * 128 * 256;
#pragma unroll
    for (int pp = 0; pp < 8; ++pp) { const int idx = tid + 512 * pp, d = idx >> 5, c = idx & 31; r.pv[pp] = *(const u32x4*)(PV + (size_t)d * 256 + c * 8); }
#pragma unroll
    for (int pp = 0; pp < 4; ++pp) { const int idx = tid + 512 * pp, row = idx >> 5, c = idx & 31; const size_t go = (size_t)(tok0 + row) * 1024 + h * 256 + c * 8;
        r.oi[pp] = *(const u32x4*)((const bf16_t*)(ws + WS_OINTRA) + go); r.gr[pp] = *(const u32x4*)((const bf16_t*)(ws + WS_GR) + go); }
}
__device__ __forceinline__ void gla3_item(const Params& p, int item, int nitem, bool has_next, G3Pre& pre, char* lds) {
    unsigned char* ws = opaque(p.ws);
    const int tid = tid_(), lane = tid & 63, r32 = lane & 31, hi = lane >> 5; const int w = __builtin_amdgcn_readfirstlane(tid >> 6);
    const int n = item & 63, bh = item >> 6, h = bh & 3, b = bh >> 2; const int tok0 = b * SEQ + n * 64;
    bf16_t* SOI = (bf16_t*)(lds + G3_OI); bf16_t* SGR = (bf16_t*)(lds + G3_GR);
#pragma unroll
    for (int pp = 0; pp < 8; ++pp) { const int idx = tid + 512 * pp, d = idx >> 5, c = idx & 31; *(u32x4*)(lds + G3_PREV + d * 576 + c * 16) = pre.pv[pp]; }
#pragma unroll
    for (int pp = 0; pp < 4; ++pp) { const int idx = tid + 512 * pp, row = idx >> 5, c = idx & 31; *(u32x4*)(SOI + row * 264 + c * 8) = pre.oi[pp]; *(u32x4*)(SGR + row * 264 + c * 8) = pre.gr[pp]; }
    const int it = w & 1, vq = w >> 1; const bf16_t* qeg = (const bf16_t*)(ws + WS_QE) + (size_t)(tok0 + it * 32 + r32) * 512 + h * 128;
    bf16x8 qa[8];
#pragma unroll
    for (int s = 0; s < 8; ++s) qa[s] = *(const bf16x8*)(qeg + 16 * s + 8 * hi);
    __syncthreads();
    if (has_next) gla3_fetch(p, nitem, pre);
    const LDS3 char* l3 = (const LDS3 char*)lds; const int blk = (lane >> 4) & 1, q4 = (lane & 15) >> 2, p4 = lane & 3;
    f32x16 o[2];
#pragma unroll
    for (int vi = 0; vi < 2; ++vi)
#pragma unroll
        for (int rr = 0; rr < 16; ++rr) o[vi][rr] = bf2f(SOI[(it * 32 + crow(rr, hi)) * 264 + (2 * vq + vi) * 32 + r32]);
#pragma unroll
    for (int s = 0; s < 8; ++s)
#pragma unroll
        for (int vi = 0; vi < 2; ++vi) { const int vt = 2 * vq + vi; const LDS3 char* pp_ = l3 + G3_PREV + (16 * s + 8 * hi + q4) * 576 + (vt * 32 + 16 * blk + 4 * p4) * 2; const bf16x8 pf = cat8(tr16(pp_), tr16(pp_ + 4 * 576)); o[vi] = MFMA32(qa[s], pf, o[vi]); }
    float* SS = (float*)(lds + G3_SS);
#pragma unroll
    for (int rr = 0; rr < 16; ++rr) { float q = o[0][rr] * o[0][rr] + o[1][rr] * o[1][rr]; q += __shfl_xor(q, 16); q += __shfl_xor(q, 8); q += __shfl_xor(q, 4); q += __shfl_xor(q, 2); q += __shfl_xor(q, 1);
        if (r32 == 0) SS[w * 32 + crow(rr, hi)] = q; }
    __syncthreads();
    float ng[2]; ng[0] = p.gla_norm_g[(2 * vq) * 32 + r32]; ng[1] = p.gla_norm_g[(2 * vq + 1) * 32 + r32];
#pragma unroll
    for (int rr = 0; rr < 16; ++rr) { const int row = crow(rr, hi); const float tot = SS[(it + 0) * 32 + row] + SS[(it + 2) * 32 + row] + SS[(it + 4) * 32 + row] + SS[(it + 6) * 32 + row];
        const float rs = rsqrtf(tot * (1.0f / 256.0f) + EPS);
#pragma unroll
        for (int vi = 0; vi < 2; ++vi) { const int li = (it * 32 + row) * 264 + (2 * vq + vi) * 32 + r32; const float y = o[vi][rr] * rs * ng[vi] * bf2f(SGR[li]); SOI[li] = (bf16_t)(cvt_pk_bf16(y, 0.f) & 0xffffu); } }
    __syncthreads();
    bf16_t* yg = (bf16_t*)(ws + WS_YGLA);
#pragma unroll
    for (int pp = 0; pp < 4; ++pp) { const int idx = tid + 512 * pp, row = idx >> 5, c = idx & 31; *(u32x4*)(yg + (size_t)(tok0 + row) * 1024 + h * 256 + c * 8) = *(const u32x4*)(SOI + row * 264 + c * 8); }
    __syncthreads();
}

constexpr int RT_RSTD = 0;
constexpr int RT_LOG = 256;
constexpr int RT_CNT = RT_LOG + 64 * 32 * 4;
__device__ __forceinline__ void route_group(const Params& p, int grp, char* lds) {
    unsigned char* ws = opaque(p.ws); const int tid = tid_(), lane = tid & 63; const int w = __builtin_amdgcn_readfirstlane(tid >> 6);
    const bf16_t* H = (const bf16_t*)(ws + WS_H); const float* RWG = (const float*)(ws + WS_RWG);
    float* RSTD = (float*)(lds + RT_RSTD); float* LOGS = (float*)(lds + RT_LOG); int* LCNT = (int*)(lds + RT_CNT);
    const int tok0 = grp * 64;
    if (tid < 32) LCNT[tid] = 0;
    if (w < 4) { const int tl = lane & 15, kq = lane >> 4; const bf16_t* hr = H + (size_t)(tok0 + w * 16 + tl) * 1024 + kq * 256; const float* br = RWG + (size_t)(kq * 256) * 32 + tl;
        f32x4 a0 = {0.f, 0.f, 0.f, 0.f}, a1 = {0.f, 0.f, 0.f, 0.f}; float ss = 0.f;
#pragma unroll 4
        for (int m4 = 0; m4 < 64; ++m4) { const f32x4 hv = bf4_to_f32(*(const u32x2*)(hr + m4 * 4));
#pragma unroll
            for (int q = 0; q < 4; ++q) { const float b0 = br[(size_t)(m4 * 4 + q) * 32], b1 = br[(size_t)(m4 * 4 + q) * 32 + 16];
                a0 = __builtin_amdgcn_mfma_f32_16x16x4f32(hv[q], b0, a0, 0, 0, 0); a1 = __builtin_amdgcn_mfma_f32_16x16x4f32(hv[q], b1, a1, 0, 0, 0); ss += hv[q] * hv[q]; } }
        ss += __shfl_xor(ss, 16); ss += __shfl_xor(ss, 32);
        const float rs = rsqrtf(ss * (1.0f / 1024.0f) + EPS);
        if (kq == 0) RSTD[w * 16 + tl] = rs;
#pragma unroll
        for (int rg = 0; rg < 4; ++rg) { const int t = w * 16 + 4 * kq + rg; LOGS[t * 32 + tl] = a0[rg]; LOGS[t * 32 + 16 + tl] = a1[rg]; } }
    __syncthreads();
    if (tid < 64) { const int tok = tok0 + tid; const float rs = RSTD[tid]; float lg[32];
#pragma unroll
        for (int e = 0; e < 32; ++e) lg[e] = LOGS[tid * 32 + e] * rs + p.router_b[e];
        int be[4]; float bv[4];
#pragma unroll
        for (int k = 0; k < 4; ++k) { float best = -3.0e38f; int bi = 0;
#pragma unroll
            for (int e = 0; e < 32; ++e) { const bool tk = lg[e] > best; best = tk ? lg[e] : best; bi = tk ? e : bi; }
            be[k] = bi; bv[k] = best;
#pragma unroll
            for (int e = 0; e < 32; ++e) lg[e] = (e == bi) ? -3.0e38f : lg[e]; }
        const float e1 = __expf(bv[1] - bv[0]), e2 = __expf(bv[2] - bv[0]), e3 = __expf(bv[3] - bv[0]); const float inv = 1.0f / (1.0f + e1 + e2 + e3);
        const float gt[4] = {inv, e1 * inv, e2 * inv, e3 * inv};
#pragma unroll
        for (int k = 0; k < 4; ++k) { const int pos = atomicAdd(&LCNT[be[k]], 1);
            ((int*)(ws + WS_TOPE))[tok * 4 + k] = be[k]; ((float*)(ws + WS_TOPG))[tok * 4 + k] = gt[k]; ((int*)(ws + WS_TOPP))[tok * 4 + k] = pos; } }
    { unsigned char* HN = ws + WS_HN;
#pragma unroll 2
      for (int i = 0; i < 8; ++i) { const int idx = tid + 512 * i, t = idx >> 6, c = idx & 63; const float rs = RSTD[t]; const size_t off = (size_t)(tok0 + t) * 1024 + c * 16; u32x4 wv;
#pragma unroll
          for (int q = 0; q < 4; ++q) { const f32x4 h0 = bf4_to_f32(*(const u32x2*)(H + off + 4 * q)), g0 = *(const f32x4*)(p.norm_ffn_g + c * 16 + 4 * q); wv[q] = (unsigned)pk4_fp8(h0[0] * rs * g0[0], h0[1] * rs * g0[1], h0[2] * rs * g0[2], h0[3] * rs * g0[3]); }
          *(u32x4*)(HN + off) = wv; } }
    __syncthreads();
    if (tid < 32) ((int*)(ws + WS_CNT))[grp * 32 + tid] = LCNT[tid];
    __syncthreads();
}

constexpr int DP_TOT = 0;
constexpr int DP_PART = 512;
__device__ __forceinline__ void dispatch_tables(const Params& p, int grp, char* lds) {
    unsigned char* ws = opaque(p.ws); const int tid = tid_(); const int* CNT = (const int*)(ws + WS_CNT); int* T = (int*)(lds + DP_TOT); int* PART = (int*)(lds + DP_PART);
    { const int e = tid & 31, part = tid >> 5; int tot = 0, pre = 0;
      for (int g2 = part * 16; g2 < part * 16 + 16; ++g2) { const int c = CNT[g2 * 32 + e]; tot += c; if (g2 < grp) pre += c; }
      PART[part * 32 + e] = tot; PART[512 + part * 32 + e] = pre; }
    __syncthreads();
    if (tid < 32) { int tot = 0, pre = 0; for (int q = 0; q < 16; ++q) { tot += PART[q * 32 + tid]; pre += PART[512 + q * 32 + tid]; } T[tid] = tot; T[64 + tid] = pre; }
    __syncthreads();
    if (tid == 0) { int base = 0; for (int e = 0; e < 32; ++e) { T[32 + e] = base; base += (T[e] + 255) >> 8; } T[96] = base; }
    __syncthreads();
}
__device__ __forceinline__ void dispatch_group(const Params& p, int grp, char* lds) {
    unsigned char* ws = opaque(p.ws); const int tid = tid_();
    dispatch_tables(p, grp, lds);
    const int* T = (const int*)(lds + DP_TOT); int* DEST = (int*)(lds + DP_PART + 4096);
    if (tid < 256) { const int tok = grp * 64 + (tid >> 2); const int e = ((const int*)(ws + WS_TOPE))[tok * 4 + (tid & 3)], lp = ((const int*)(ws + WS_TOPP))[tok * 4 + (tid & 3)];
        const int dest = T[32 + e] * 256 + T[64 + e] + lp; DEST[tid] = dest; ((int*)(ws + WS_SLOT))[tok * 4 + (tid & 3)] = dest; }
    __syncthreads();
    if (tid < 256) ((int*)(ws + WS_XPAD))[DEST[tid]] = (grp * 64 + (tid >> 2)) * 1024;
    __syncthreads();
}

__device__ __forceinline__ void phase_combine(const Params& p) {
    unsigned char* ws = opaque(p.ws); const int tid = tid_(), lane = tid & 63, wid = tid >> 6, G = gridDim.x;
    const bf16_t* H = (const bf16_t*)(ws + WS_H); const unsigned char* YP = ws + WS_YPAD;
    for (int tok = blockIdx.x * 8 + wid; tok < NTOK; tok += G * 8) {
        int sl[4]; float gt[4];
#pragma unroll
        for (int k = 0; k < 4; ++k) { sl[k] = ((const int*)(ws + WS_SLOT))[tok * 4 + k]; gt[k] = ((const float*)(ws + WS_TOPG))[tok * 4 + k]; }
        f32x4 v[4]; float ss = 0.f;
#pragma unroll
        for (int i = 0; i < 4; ++i) { const int col = i * 256 + lane * 4; v[i] = bf4_to_f32(*(const u32x2*)(H + (size_t)tok * 1024 + col));
#pragma unroll
            for (int k = 0; k < 4; ++k) { const unsigned yw = *(const unsigned*)(YP + (size_t)sl[k] * 1024 + col); const f32x2 lo = __builtin_amdgcn_cvt_pk_f32_fp8((int)yw, false), hi2 = __builtin_amdgcn_cvt_pk_f32_fp8((int)yw, true); v[i][0] += gt[k] * lo[0]; v[i][1] += gt[k] * lo[1]; v[i][2] += gt[k] * hi2[0]; v[i][3] += gt[k] * hi2[1]; }
            ss += v[i][0] * v[i][0] + v[i][1] * v[i][1] + v[i][2] * v[i][2] + v[i][3] * v[i][3]; }
        ss = wave_sum(ss); const float rs = rsqrtf(ss * (1.0f / 1024.0f) + EPS);
#pragma unroll
        for (int i = 0; i < 4; ++i) { const int col = i * 256 + lane * 4; const f32x4 g = *(const f32x4*)(p.norm_final_g + col); f32x4 o; o[0] = v[i][0] * rs * g[0]; o[1] = v[i][1] * rs * g[1]; o[2] = v[i][2] * rs * g[2]; o[3] = v[i][3] * rs * g[3];
            *(f32x4*)(p.out + (size_t)tok * 1024 + col) = o; } }
}


#define XB_TMO      128
#define XB_XCNT(j)  (256  + 64 * (j))
#define XB_XSUB(j)  (1280 + 64 * (j))
#define XB_XGEN(j)  (2304 + 64 * (j))
#define XB_TOP      3328
#define XB_TOPGEN   3392
#define XCD_BAR_WORDS 3456
#define XB_SPIN_CAP (1u << 18)
__device__ __forceinline__ unsigned xb_ld(unsigned* p)              { return __hip_atomic_load(p, __ATOMIC_RELAXED, __HIP_MEMORY_SCOPE_AGENT); }
__device__ __forceinline__ unsigned xb_add(unsigned* p, unsigned v) { return __hip_atomic_fetch_add(p, v, __ATOMIC_RELAXED, __HIP_MEMORY_SCOPE_AGENT); }
__device__ __forceinline__ unsigned xb_xcc_id() { return (unsigned)__builtin_amdgcn_s_getreg((3 << 11) | 20) & 0xFu; }
#define XB_SPIN(cond, bar) do { unsigned _sp = 0; while (cond) { __builtin_amdgcn_s_sleep(1); \
    if ((++_sp & 255u) == 0u) { if (xb_ld(&(bar)[XB_TMO])) break; if (_sp > XB_SPIN_CAP) { atomicAdd(&(bar)[XB_TMO], 1u); break; } } } } while (0)
struct XcdBarrier { unsigned* bar; unsigned x; volatile LDS3 unsigned* st; };
__device__ __forceinline__ XcdBarrier xcd_barrier_post(unsigned* bar, volatile LDS3 unsigned* st) {
    XcdBarrier b; b.bar = bar; b.x = xb_xcc_id(); b.st = st;
    if (tid_() == 0) (void)xb_add(&bar[XB_XCNT(b.x)], 1u);
    return b;
}
__device__ __forceinline__ void xcd_barrier_complete(unsigned* bar, unsigned x, unsigned& nloc, unsigned& nx) {
    const unsigned G = gridDim.x * gridDim.y * gridDim.z;
    unsigned sum, cnt, mine, sp = 0u;
    for (;;) {
        sum = 0u; cnt = 0u; mine = 0u;
#pragma unroll
        for (unsigned j = 0; j < 16; ++j) { const unsigned c = xb_ld(&bar[XB_XCNT(j)]); sum += c; cnt += (c > 0u) ? 1u : 0u; mine = (j == x) ? c : mine; }
        if (sum == G) break;
        __builtin_amdgcn_s_sleep(1);
        if ((++sp & 255u) == 0u) { if (xb_ld(&bar[XB_TMO])) break; if (sp > XB_SPIN_CAP) { atomicAdd(&bar[XB_TMO], 1u); break; } }
    }
    nloc = mine > 0u ? mine : 1u; nx = cnt > 0u ? cnt : 1u;
}
__device__ __forceinline__ void xcd_barrier(const XcdBarrier& b) {
    asm volatile("s_waitcnt vmcnt(0)" ::: "memory");
    __syncthreads();
    if (tid_() == 0) {
        unsigned* bar = b.bar;
        __builtin_amdgcn_s_waitcnt(0);
        unsigned nloc = b.st[0], nx = b.st[1];
        if (nloc == 0u) { xcd_barrier_complete(bar, b.x, nloc, nx); b.st[0] = nloc; b.st[1] = nx; }
        const unsigned old = xb_add(&bar[XB_XSUB(b.x)], 1u);
        const unsigned gen = old / nloc;
        if (old + 1u == (gen + 1u) * nloc) {
            __builtin_amdgcn_fence(__ATOMIC_RELEASE, "agent");
            asm volatile("s_waitcnt vmcnt(0)" ::: "memory");
            const unsigned og = xb_add(&bar[XB_TOP], 1u);
            const unsigned tg = og / nx;
            if (og + 1u == (tg + 1u) * nx) xb_add(&bar[XB_TOPGEN], 1u);
            else XB_SPIN(xb_ld(&bar[XB_TOPGEN]) == tg, bar);
            __builtin_amdgcn_fence(__ATOMIC_ACQUIRE, "agent");
            xb_add(&bar[XB_XGEN(b.x)], 1u);
            asm volatile("s_waitcnt vmcnt(0)" ::: "memory");
        } else {
            XB_SPIN(xb_ld(&bar[XB_XGEN(b.x)]) == gen, bar);
            __builtin_amdgcn_fence(__ATOMIC_ACQUIRE, "agent");
            asm volatile("s_waitcnt vmcnt(0)" ::: "memory");
        }
    }
    __syncthreads();
}

__global__ void __launch_bounds__(512, 2) mega_fwd(Params p) {
    cg::grid_group grid = cg::this_grid();
    char* lds = smem; LDS3 unsigned char* lds3 = (LDS3 unsigned char*)smem;
    const int G = gridDim.x, bid = blockIdx.x;
    if (tid_() < 4) ((volatile LDS3 unsigned*)(lds3 + LDS_XB))[tid_()] = 0u;
    __syncthreads();
    const XcdBarrier xb = xcd_barrier_post((unsigned*)(p.ws + WS_BAR), (volatile LDS3 unsigned*)(lds3 + LDS_XB));
    for (int rep = 0; rep < REP_P0; ++rep) phase_prologue(p, lds);
    if (p.ws == nullptr) grid.sync();
    xcd_barrier(xb);
    for (int rep = 0; rep < REP_P1; ++rep) { const int nconv = (G >= 64) ? (G * 3) / 16 : 0, ngemm = G - nconv;
      if (bid >= ngemm) { expert_convert(p, lds, bid - ngemm, nconv); }
      else { unsigned char* ws = opaque(p.ws); pg8::DenseProb S; S.init(ws + WS_XN, ws + WS_W_IN, NTOK, INWP, 1024, ngemm, bid);
        EpiProj E; E.ws = ws;
        pg8::gemm_phase(lds3, S, E); }
      if (nconv == 0) expert_convert(p, lds, bid, G); }
    xcd_barrier(xb);
    for (int rep = 0; rep < REP_ATT; ++rep) { AttnPre pre; if (bid < 4 * 24 * 16) attn_fetch(p, bid, pre);
        for (int item = bid; item < 4 * 24 * 16; item += G) attn_item(p, item, item + G, item + G < 4 * 24 * 16, pre, lds); }
    for (int rep = 0; rep < REP_GLA1; ++rep) { G1Pre pre; if (bid < 1024) gla1_fetch(p, bid, pre); int hprev = -1;
        for (int item = bid; item < 1024; item += G) { const int h = (item >> 6) & 3; gla1_item(p, item, item + G, item + G < 1024, h != hprev, pre, lds); hprev = h; } }
    xcd_barrier(xb);
    for (int rep = 0; rep < REP_P3; ++rep) phase_scan_combine(p);
    xcd_barrier(xb);
    for (int rep = 0; rep < REP_P4; ++rep) { G3Pre pre; if (bid < 1024) gla3_fetch(p, bid, pre);
        for (int item = bid; item < 1024; item += G) gla3_item(p, item, item + G, item + G < 1024, pre, lds); }
    xcd_barrier(xb);
    for (int rep = 0; rep < REP_P5; ++rep) {
    { unsigned char* ws = opaque(p.ws); pg8::DenseProb S; S.init(ws + WS_YATT, ws + WS_W_A, NTOK, 1024, 512, G, bid);
      EpiGate<0> E; E.gate = (const bf16_t*)(ws + WS_SA); E.t1 = nullptr; E.out = (bf16_t*)(ws + WS_T1);
      pg8::gemm_phase(lds3, S, E); }
    { unsigned char* ws = opaque(p.ws); pg8::DenseProb S; S.init(ws + WS_YGLA, ws + WS_W_G, NTOK, 1024, 1024, G, bid);
      EpiGate<1> E; E.gate = (const bf16_t*)(ws + WS_SG); E.t1 = (const bf16_t*)(ws + WS_T1); E.out = (bf16_t*)(ws + WS_MERGED);
      pg8::gemm_phase(lds3, S, E); }
    }
    xcd_barrier(xb);
    for (int rep = 0; rep < REP_P6; ++rep) { unsigned char* ws = opaque(p.ws); pg8::DenseProb S; S.init(ws + WS_MERGED, ws + WS_W_MIX, NTOK, 1024, 1024, G, bid);
      EpiResid E; E.x = p.x; E.h = (bf16_t*)(ws + WS_H);
      pg8::gemm_phase(lds3, S, E); }
    xcd_barrier(xb);
    for (int rep = 0; rep < REP_P7; ++rep) for (int grp = bid; grp < 256; grp += G) route_group(p, grp, lds);
    xcd_barrier(xb);
    for (int rep = 0; rep < REP_P8; ++rep) for (int grp = bid; grp < 256; grp += G) dispatch_group(p, grp, lds);
    if (bid == 0) { unsigned char* ws = opaque(p.ws); dispatch_tables(p, -1, lds); const int* T = (const int*)(lds + DP_TOT); int* TE = (int*)(ws + WS_TILEE);
        if (tid_() < 32) { const int e = tid_(); for (int t = T[32 + e]; t < T[32 + e] + ((T[e] + 255) >> 8); ++t) TE[16 + t] = e; }
        if (tid_() == 0) TE[0] = T[96];
        for (int e = 0; e < 32; ++e) { const int nt_ = (T[e] + 255) >> 8; int* ro = (int*)(ws + WS_XPAD) + T[32 + e] * 256; for (int r = T[e] + tid_(); r < nt_ * 256; r += 512) ro[r] = 0; } }
    xcd_barrier(xb);
    for (int rep = 0; rep < REP_P9; ++rep) { unsigned char* ws = opaque(p.ws); const int* TE = (const int*)(ws + WS_TILEE);
      pg8::MoeProbT<true> S; S.A = (const char*)(ws + WS_HN); S.rowoff = (const int*)(ws + WS_XPAD); S.Bt = (const char*)(ws + WS_W_GU); S.K = 512  ; S.nN = 8; S.T = TE[0]; S.G = G; S.c = bid; S.estride = (size_t)2048 * 1024; S.tile_e = TE + 16;
      EpiAct E; E.bgu = p.e_b_gu; E.tile_e = TE + 16; E.act = ws + WS_ACT;
      pg8::gemm_phase(lds3, S, E); }
    xcd_barrier(xb);
    for (int rep = 0; rep < REP_P10; ++rep) { unsigned char* ws = opaque(p.ws); const int* TE = (const int*)(ws + WS_TILEE);
      pg8::MoeProbT<false> S; S.rowoff = nullptr; S.A = (const char*)(ws + WS_ACT); S.Bt = (const char*)(ws + WS_W_D); S.K = 512  ; S.nN = 4; S.T = TE[0]; S.G = G; S.c = bid; S.estride = (size_t)1024 * 1024; S.tile_e = TE + 16;
      EpiDown E; E.bd = p.e_b_d; E.tile_e = TE + 16; E.y = ws + WS_YPAD;
      pg8::gemm_phase(lds3, S, E); }
    xcd_barrier(xb);
    for (int rep = 0; rep < REP_P11; ++rep) phase_combine(p);
}

extern "C" void kernel_launch(void* const* d_in, const int* in_sizes, int n_in, void* d_out, int out_size, void* d_ws, size_t ws_size, hipStream_t stream) {
    static int grid = 0;
    if (grid == 0) {
        if (n_in != 17 || ws_size < WS_END) { fprintf(stderr, "kernel_launch: expected 17 inputs and >= %zu bytes of workspace (got %d, %zu); nothing launched\n", (size_t)WS_END, n_in, ws_size); grid = -1; return; }
        int dev = 0, cus = 0, per_cu = 0;
        if (hipGetDevice(&dev) != hipSuccess || hipDeviceGetAttribute(&cus, hipDeviceAttributeMultiprocessorCount, dev) != hipSuccess) { fprintf(stderr, "kernel_launch: device query failed\n"); grid = -1; return; }
        if (hipFuncSetAttribute((const void*)mega_fwd, hipFuncAttributeMaxDynamicSharedMemorySize, LDS_BYTES) != hipSuccess) { fprintf(stderr, "kernel_launch: hipFuncSetAttribute failed\n"); grid = -1; return; }
        if (hipOccupancyMaxActiveBlocksPerMultiprocessor(&per_cu, (const void*)mega_fwd, 512, LDS_BYTES) != hipSuccess || per_cu < 1) { fprintf(stderr, "kernel_launch: occupancy query failed (%d)\n", per_cu); grid = -1; return; }
        grid = cus;
    }
    if (grid < 0) return;
    Params p{};
    p.x = (const float*)d_in[0]; p.norm_mix_g = (const float*)d_in[1]; p.w_in = (const float*)d_in[2]; p.gla_gate_up = (const float*)d_in[3]; p.gla_gate_bias = (const float*)d_in[4]; p.gla_norm_g = (const float*)d_in[5];
    p.w_branch_gla = (const float*)d_in[6]; p.w_branch_att = (const float*)d_in[7]; p.w_mix_out = (const float*)d_in[8]; p.norm_ffn_g = (const float*)d_in[9]; p.router_w = (const float*)d_in[10]; p.router_b = (const float*)d_in[11];
    p.e_w_gu = (const float*)d_in[12]; p.e_b_gu = (const float*)d_in[13]; p.e_w_d = (const float*)d_in[14]; p.e_b_d = (const float*)d_in[15]; p.norm_final_g = (const float*)d_in[16];
    p.out = (float*)d_out; p.ws = (unsigned char*)d_ws;
    if (hipMemsetAsync((char*)d_ws + WS_BAR, 0, 3456 * 4, stream) != hipSuccess) { fprintf(stderr, "kernel_launch: memset of the barrier words failed\n"); return; }
    void* args[] = {&p};
    hipError_t e = hipLaunchCooperativeKernel((const void*)mega_fwd, dim3(grid), dim3(512), args, LDS_BYTES, stream);
    if (e != hipSuccess) fprintf(stderr, "kernel_launch: cooperative launch failed: %s (grid %d)\n", hipGetErrorString(e), grid);
}
```

```cpp
#include <hip/hip_runtime.h>
#include <hip/hip_cooperative_groups.h>
#include <cstdio>
#include <cstdint>
namespace cg = cooperative_groups;
#ifndef REP_P0
#define REP_P0 1
#define REP_P1 1
#define REP_ATT 1
#define REP_GLA1 1
#define REP_P3 1
#define REP_P4 1
#define REP_P5 1
#define REP_P6 1
#define REP_P7 1
#define REP_P8 1
#define REP_P9 1
#define REP_P10 1
#define REP_P11 1
#endif

#define LDS3 __attribute__((address_space(3)))
typedef unsigned short bf16_t;
typedef short bf16x8 __attribute__((ext_vector_type(8)));
typedef short s16x4 __attribute__((ext_vector_type(4)));
typedef short v4i16_t __attribute__((ext_vector_type(4)));
typedef float f32x4 __attribute__((ext_vector_type(4)));
typedef float f32x2 __attribute__((ext_vector_type(2)));
typedef float f32x16 __attribute__((ext_vector_type(16)));
typedef unsigned u32x4 __attribute__((ext_vector_type(4)));
typedef unsigned u32x2 __attribute__((ext_vector_type(2)));
typedef int i32x8 __attribute__((ext_vector_type(8)));
typedef int i32x4 __attribute__((ext_vector_type(4)));

constexpr int NTOK = 16384, DM = 1024, SEQ = 4096, NB = 4;
constexpr int INW = 9744, INWP = 9984;
constexpr int NEXP = 32, TOPK = 4, FF = 1024;
constexpr int MAXT = 288;
constexpr float EPS = 1e-5f;
constexpr float QSCALE = 0.125f * 1.4426950408889634f;
constexpr float LN2 = 0.6931471805599453f;

constexpr size_t al256(size_t x) { return (x + 255) & ~(size_t)255; }
constexpr size_t WS_W_IN = 0;
constexpr size_t WS_W_G = WS_W_IN + (size_t)INWP * 1024 * 2;
constexpr size_t WS_W_A = WS_W_G + (size_t)1024 * 1024 * 2;
constexpr size_t WS_W_MIX = WS_W_A + (size_t)1024 * 512 * 2;
constexpr size_t WS_W_GU = WS_W_MIX + (size_t)1024 * 1024 * 2;
constexpr size_t WS_W_D = WS_W_GU + (size_t)NEXP * 2048 * 1024;
constexpr size_t WS_ROPE_C = WS_W_D + (size_t)NEXP * 1024 * 1024;
constexpr size_t WS_ROPE_S = WS_ROPE_C + (size_t)SEQ * 8 * 4;
constexpr size_t WS_RWG = WS_ROPE_S + (size_t)SEQ * 8 * 4;
constexpr size_t WS_H = WS_RWG + (size_t)1024 * 32 * 4;
constexpr size_t WS_HN = WS_H + (size_t)NTOK * 1024 * 4;
constexpr size_t WS_TOPE = WS_HN + (size_t)NTOK * 1024;
constexpr size_t WS_TOPG = WS_TOPE + (size_t)NTOK * 4 * 4;
constexpr size_t WS_TOPP = WS_TOPG + (size_t)NTOK * 4 * 4;
constexpr size_t WS_SLOT = WS_TOPP + (size_t)NTOK * 4 * 4;
constexpr size_t WS_CNT = WS_SLOT + (size_t)NTOK * 4 * 4;
constexpr size_t WS_TILEE = WS_CNT + (size_t)256 * 32 * 4;
constexpr size_t WS_REGB = al256(WS_TILEE + (size_t)(MAXT + 32) * 4);
constexpr size_t WS_XN = WS_REGB;
constexpr size_t WS_GQ = WS_XN + (size_t)NTOK * 1024 * 2;
constexpr size_t WS_GK = WS_GQ + (size_t)NTOK * 512 * 2;
constexpr size_t WS_GV = WS_GK + (size_t)NTOK * 512 * 2;
constexpr size_t WS_GR = WS_GV + (size_t)NTOK * 1024 * 2;
constexpr size_t WS_SG = WS_GR + (size_t)NTOK * 1024 * 2;
constexpr size_t WS_SA = WS_SG + (size_t)NTOK * 1024 * 2;
constexpr size_t WS_AQ = WS_SA + (size_t)NTOK * 1024 * 2;
constexpr size_t WS_AK = WS_AQ + (size_t)NTOK * 1536 * 2;
constexpr size_t WS_AV = WS_AK + (size_t)NTOK * 1536 * 2;
constexpr size_t WS_GLR = WS_AV + (size_t)NTOK * 1536 * 2;
constexpr size_t WS_OATT = WS_GLR + (size_t)NTOK * 16 * 4;
constexpr size_t WS_LSE = WS_OATT + (size_t)3 * NTOK * 512 * 2;
constexpr size_t WS_QE = WS_LSE + (size_t)3 * NTOK * 8 * 4;
constexpr size_t WS_OINTRA = WS_QE + (size_t)NTOK * 512 * 2;
constexpr size_t WS_U = WS_OINTRA + (size_t)NTOK * 1024 * 2;
constexpr size_t WS_DEC = WS_U + (size_t)1024 * 128 * 256 * 2;
constexpr size_t WS_XN8 = WS_DEC + (size_t)1024 * 128 * 4;
constexpr size_t WS_WIN8 = WS_XN8 + (size_t)NTOK * 1024;
constexpr size_t WS_REGB_END = WS_WIN8 + (size_t)INWP * 1024;
constexpr size_t WS_PREV = WS_AQ;
constexpr size_t WS_YGLA = WS_AV;
constexpr size_t WS_YATT = WS_XN;
constexpr size_t WS_T1 = WS_GQ;
constexpr size_t WS_MERGED = WS_GV;
constexpr size_t PADROWS = (size_t)MAXT * 256;
constexpr size_t WS_XPAD = WS_REGB;
constexpr size_t WS_ACT = WS_XPAD + PADROWS * 1024;
constexpr size_t WS_YPAD = WS_ACT + PADROWS * 1024;
constexpr size_t WS_PAD_END = WS_YPAD + PADROWS * 1024;
constexpr size_t WS_BAR = al256(WS_REGB_END > WS_PAD_END ? WS_REGB_END : WS_PAD_END);
constexpr size_t WS_END = WS_BAR + 3456 * 4;
static_assert(WS_PAD_END <= WS_REGB_END + (1u << 30), "map");

constexpr int LDS_XB = 147456;
constexpr int LDS_TAB_OFF = 147456 + 16;
constexpr int LDS_BYTES = 147456 + 16 + 1024;

struct Params {
    const float *x, *norm_mix_g, *w_in, *gla_gate_up, *gla_gate_bias, *gla_norm_g, *w_branch_gla, *w_branch_att, *w_mix_out, *norm_ffn_g,
        *router_w, *router_b, *e_w_gu, *e_b_gu, *e_w_d, *e_b_d, *norm_final_g;
    float* out;
    unsigned char* ws;
};

__device__ __forceinline__ int tid_() { int t = threadIdx.x; asm volatile("" : "+v"(t)); return t; }
__device__ __forceinline__ unsigned char* opaque(unsigned char* q) { return q; }
__device__ __forceinline__ unsigned cvt_pk_bf16(float lo, float hi) { unsigned r; asm volatile("v_cvt_pk_bf16_f32 %0, %1, %2" : "=v"(r) : "v"(lo), "v"(hi)); return r; }
__device__ __forceinline__ float bf_lo(unsigned w) { return __uint_as_float(w << 16); }
__device__ __forceinline__ float bf_hi(unsigned w) { return __uint_as_float(w & 0xffff0000u); }
__device__ __forceinline__ float bf2f(bf16_t b) { return __uint_as_float(((unsigned)b) << 16); }
__device__ __forceinline__ u32x4 pack8(const float* v) { u32x4 w; w.x = cvt_pk_bf16(v[0], v[1]); w.y = cvt_pk_bf16(v[2], v[3]); w.z = cvt_pk_bf16(v[4], v[5]); w.w = cvt_pk_bf16(v[6], v[7]); return w; }
__device__ __forceinline__ void unpack8(u32x4 w, float* v) { v[0] = bf_lo(w.x); v[1] = bf_hi(w.x); v[2] = bf_lo(w.y); v[3] = bf_hi(w.y); v[4] = bf_lo(w.z); v[5] = bf_hi(w.z); v[6] = bf_lo(w.w); v[7] = bf_hi(w.w); }
__device__ __forceinline__ float sigmoidf_(float v) { return __builtin_amdgcn_rcpf(1.0f + __builtin_amdgcn_exp2f(v * -1.4426950408889634f)); }
__device__ __forceinline__ float wave_sum(float v) { v += __shfl_xor(v, 32); v += __shfl_xor(v, 16); v += __shfl_xor(v, 8); v += __shfl_xor(v, 4); v += __shfl_xor(v, 2); v += __shfl_xor(v, 1); return v; }
__device__ __forceinline__ s16x4 tr16(const LDS3 char* p) { return __builtin_bit_cast(s16x4, __builtin_amdgcn_ds_read_tr16_b64_v4i16((LDS3 v4i16_t*)p)); }
__device__ __forceinline__ bf16x8 cat8(s16x4 a, s16x4 b) { return (bf16x8){a[0], a[1], a[2], a[3], b[0], b[1], b[2], b[3]}; }
__device__ __forceinline__ int crow(int r, int hi) { return (r & 3) + 8 * (r >> 2) + 4 * hi; }
__device__ __forceinline__ void st_nt(void* p, u32x4 v) { __builtin_nontemporal_store(v, (u32x4*)p); }
__device__ __forceinline__ int pk4_fp8(float a, float b, float c, float d) { int w = __builtin_amdgcn_cvt_pk_fp8_f32(a, b, 0, false); return __builtin_amdgcn_cvt_pk_fp8_f32(c, d, w, true); }
__device__ __forceinline__ f32x4 bf4_to_f32(u32x2 w) { f32x4 r; r[0] = bf_lo(w.x); r[1] = bf_hi(w.x); r[2] = bf_lo(w.y); r[3] = bf_hi(w.y); return r; }
#define MFMA32(a, b, c) __builtin_amdgcn_mfma_f32_32x32x16_bf16(a, b, c, 0, 0, 0)

namespace pg8 {
constexpr int BM = 256, BK = 64, HALF = 128, HTB = HALF * BK * 2, STAGE_BYTES = 8 * HTB, NXCD = 8, WGM = 8;
constexpr bool GEMM_ALIGN_EPI = true;
constexpr bool GEMM_SP2 = true;
__host__ __device__ __forceinline__ int lds_byte(int r, int c) { const int st = (r >> 4) * 2 + (c >> 5), rr = r & 15, cc = c & 31, ob = rr * 64 + cc * 2; return st * 1024 + (ob ^ (((ob >> 9) & 1) << 5)); }
__host__ __device__ __forceinline__ void stage_rc(int b, int& R, int& C) { const int st = b / 1024, sb = b % 1024, swz = sb ^ (((sb >> 9) & 1) << 5); R = (st >> 1) * 16 + swz / 64; C = (st & 1) * 32 + (swz % 64) / 2; }
__host__ __device__ __forceinline__ int perm32(int rho) { const int n = rho >> 4, i = rho & 15; return 8 * (i >> 2) + 4 * n + (i & 3); }
struct Unit { int pm, pn; };

#ifndef SENSMASK
#define SENSMASK ((0xFFFull << 0) | (1ull << 38))
#endif
constexpr int sens_count() { int c = 0; for (int t = 0; t < 39; ++t) c += (int)((SENSMASK >> t) & 1ull); return c; }
__device__ __forceinline__ int subset_tile(int sub, int k) {
    int seen = 0, res = 0;
#pragma unroll
    for (int t = 0; t < 39; ++t) { const bool in = (((SENSMASK >> t) & 1ull) != 0ull) == (sub == 1); if (in) { if (seen == k) res = t; ++seen; } }
    return res; }
template <int SUBSET> struct DenseProbT {
    const char* A; const char* Bt; int K; int nM, nN, nwg, G, c;
    __device__ void init(const void* A_, const void* Bt_, int M, int N, int K_, int G_, int c_) { A = (const char*)A_; Bt = (const char*)Bt_; K = K_; nM = M / BM; nN = N / BM; nwg = nM * nN; G = G_; c = c_; }
    __device__ __forceinline__ bool next(int i, Unit& u) const {
        const long L = (long)i * G + c; if (L >= nwg) return false;
        int wgid = (int)L; { const int q = nwg / NXCD, r = nwg % NXCD, xcd = wgid % NXCD, off = wgid / NXCD; wgid = (xcd < r ? xcd * (q + 1) : r * (q + 1) + (xcd - r) * q) + off; }
        const int nig = WGM * nN, gid = wgid / nig, fm = gid * WGM, gsz = (nM - fm) < WGM ? (nM - fm) : WGM;
        u.pm = fm + ((wgid % nig) % gsz); int pn = (wgid % nig) / gsz;
        if (SUBSET != 0) pn = subset_tile(SUBSET, pn);
        u.pn = pn; return true;
    }
    __device__ __forceinline__ const char* a_ptr(const Unit& u) const { return A + (size_t)u.pm * BM * K * 2; }
    __device__ __forceinline__ const char* b_ptr(const Unit& u) const { return Bt + (size_t)u.pn * BM * K * 2; }
    static constexpr bool GATHER = false;
    __device__ __forceinline__ const int* rows(const Unit&) const { return nullptr; }
};
typedef DenseProbT<0> DenseProb;
template <bool GATHER_> struct MoeProbT {
    static constexpr bool GATHER = GATHER_;
    const char* A; const char* Bt; int K; int nN, T, G, c; size_t estride; const int* tile_e; const int* rowoff;
    __device__ __forceinline__ bool next(int i, Unit& u) const { const long L = (long)i * G + c; if (L >= (long)T * nN) return false; u.pm = (int)(L / nN); u.pn = (int)(L % nN); return true; }
    __device__ __forceinline__ const char* a_ptr(const Unit& u) const { return GATHER ? A : A + (size_t)u.pm * BM * K * 2; }
    __device__ __forceinline__ const char* b_ptr(const Unit& u) const { return Bt + (size_t)tile_e[u.pm] * estride + (size_t)u.pn * BM * K * 2; }
    __device__ __forceinline__ const int* rows(const Unit& u) const { return rowoff + u.pm * BM; }
};

template <class Epi, class Prob>
__device__ __forceinline__ void gemm_phase(LDS3 unsigned char* lds, const Prob& S, const Epi& E) {
    const int tid = tid_(), wid = __builtin_amdgcn_readfirstlane(tid >> 6), lane = tid & 63, wr = wid >> 2, wc = wid & 3, fr = lane & 15, fq = lane >> 4;
    const int K = S.K, nt = K / BK;
    unsigned voffA[2], voffB[2]; int Rrow[2];
#pragma unroll
    for (int i = 0; i < 2; ++i) { int R, C; stage_rc(tid * 16 + i * 8192, R, C); const int Rb = Epi::PERM ? (2 * (R & ~31) + perm32(R & 31)) : R;
        voffA[i] = (unsigned)(R * K + C) * 2u; voffB[i] = (unsigned)(Rb * K + C) * 2u; Rrow[i] = R; if (Prob::GATHER) voffA[i] = (unsigned)C * 2u; }
    const size_t kstep = (size_t)(BK * 2);
    const size_t hstep = (size_t)HALF * K * 2;
    const size_t hstepB = Epi::PERM ? (size_t)32 * K * 2 : hstep;
    const unsigned ldsw = (unsigned)wid * 1024u;
    const int aoff = lds_byte(wr * 64 + fr, fq * 8), boff = lds_byte(wc * 32 + fr, fq * 8);
#define PG8_SA(b, h) (((b) * 2 + (h)) * HTB)
#define PG8_SB(b, h) ((4 + (b) * 2 + (h)) * HTB)
#define PG8_STAGE(bufoff, gbase, voff) do { _Pragma("unroll") for (int _i = 0; _i < 2; ++_i) \
        __builtin_amdgcn_global_load_lds((const unsigned*)((const char*)(gbase) + (voff)[_i]), (LDS3 unsigned*)(lds + (bufoff) + ldsw + _i * 8192), 16, 0, 0); } while (0)
#define PG8_LD8(ptr) __builtin_shufflevector(*(const LDS3 i32x4*)(ptr), *(const LDS3 i32x4*)((ptr) + 1024), 0, 1, 2, 3, 4, 5, 6, 7)
#define PG8_LO(x) __builtin_bit_cast(bf16x8, __builtin_shufflevector(x, x, 0, 1, 2, 3))
#define PG8_HI(x) __builtin_bit_cast(bf16x8, __builtin_shufflevector(x, x, 4, 5, 6, 7))
#define PG8_LDA(dst, b, h) do { _Pragma("unroll") for (int m = 0; m < 4; ++m) dst[m] = PG8_LD8(lds + PG8_SA(b, h) + aoff + m * 2048); } while (0)
#define PG8_LDB(dst, b, h) do { _Pragma("unroll") for (int n = 0; n < 2; ++n) dst[n] = PG8_LD8(lds + PG8_SB(b, h) + boff + n * 2048); } while (0)
#define PG8_MMA(ai, bj, At, Bt) do { __builtin_amdgcn_s_setprio(1); _Pragma("unroll") for (int m = 0; m < 4; ++m) _Pragma("unroll") for (int n = 0; n < 2; ++n) { \
        if constexpr (Epi::FP8) asm volatile("v_mfma_scale_f32_16x16x128_f8f6f4 %0, %1, %2, %0, %3, %4 op_sel_hi:[0,0,0]" : "+v"(acc[ai][bj][m][n]) : "v"(Bt[n]), "v"(At[m]), "v"(sc_w), "v"(sc_1)); \
        else { acc[ai][bj][m][n] = __builtin_amdgcn_mfma_f32_16x16x32_bf16(PG8_LO(Bt[n]), PG8_LO(At[m]), acc[ai][bj][m][n], 0, 0, 0); acc[ai][bj][m][n] = __builtin_amdgcn_mfma_f32_16x16x32_bf16(PG8_HI(Bt[n]), PG8_HI(At[m]), acc[ai][bj][m][n], 0, 0, 0); } } __builtin_amdgcn_s_setprio(0); } while (0)
#define PG8_WAIT_V(n) asm volatile("s_waitcnt vmcnt(" #n ")" ::: "memory")
#define PG8_WAIT_L(n) asm volatile("s_waitcnt lgkmcnt(" #n ")" ::: "memory")
#define PG8_BAR __builtin_amdgcn_s_barrier()
#define PG8_SCHED __builtin_amdgcn_sched_barrier(0)
    Unit cur, nxt; int ui = 0;
    if (!S.next(0, cur)) return;
    f32x4 acc[2][2][4][2];
#pragma unroll
    for (int a = 0; a < 2; ++a)
#pragma unroll
        for (int b = 0; b < 2; ++b)
#pragma unroll
            for (int m = 0; m < 4; ++m)
#pragma unroll
                for (int n = 0; n < 2; ++n) acc[a][b][m][n] = (f32x4){0.f, 0.f, 0.f, 0.f};
    i32x8 At[4], B0[2], B1[2];
    int sc_w = 0x7A7A7A7A  , sc_1 = 0x7F7F7F7F; asm volatile("" : "+v"(sc_w), "+v"(sc_1));
    const char* cA = S.a_ptr(cur); const char* cB = S.b_ptr(cur);
    unsigned vAc[2][2], vAn[2][2];
    LDS3 int* rtab = (LDS3 int*)(lds + LDS_TAB_OFF);
    if constexpr (Prob::GATHER) { const int* rw = S.rows(cur);
#pragma unroll
        for (int h = 0; h < 2; ++h)
#pragma unroll
            for (int i = 0; i < 2; ++i) vAc[h][i] = (unsigned)rw[h * HALF + Rrow[i]] + voffA[i];
    } else {
#pragma unroll
        for (int h = 0; h < 2; ++h)
#pragma unroll
            for (int i = 0; i < 2; ++i) vAc[h][i] = voffA[i] + (unsigned)(h * hstep);
    }
#pragma unroll
    for (int h = 0; h < 2; ++h)
#pragma unroll
        for (int i = 0; i < 2; ++i) vAn[h][i] = vAc[h][i];
    if constexpr (GEMM_SP2) {
        PG8_STAGE(PG8_SB(0, 0), cB, voffB); PG8_STAGE(PG8_SB(0, 1), cB + hstepB, voffB); PG8_STAGE(PG8_SA(0, 0), cA, vAc[0]); PG8_STAGE(PG8_SA(0, 1), cA, vAc[1]);
        if (wr == 1) PG8_BAR;
        PG8_WAIT_V(2); PG8_BAR;
        PG8_STAGE(PG8_SB(1, 0), cB + kstep, voffB); PG8_STAGE(PG8_SA(1, 0), cA + kstep, vAc[0]); PG8_STAGE(PG8_SB(1, 1), cB + hstepB + kstep, voffB);
        PG8_WAIT_V(6); PG8_BAR;
    } else {
    PG8_STAGE(PG8_SB(0, 0), cB, voffB); PG8_STAGE(PG8_SA(0, 0), cA, vAc[0]); PG8_STAGE(PG8_SB(0, 1), cB + hstepB, voffB); PG8_STAGE(PG8_SA(0, 1), cA, vAc[1]);
    if (wr == 1) PG8_BAR;
    PG8_WAIT_V(4); PG8_BAR;
    PG8_STAGE(PG8_SB(1, 0), cB + kstep, voffB); PG8_STAGE(PG8_SA(1, 0), cA + kstep, vAc[0]); PG8_STAGE(PG8_SB(1, 1), cB + hstepB + kstep, voffB);
    PG8_WAIT_V(6); PG8_BAR;
    }
    for (;;) {
        const bool has_next = S.next(ui + 1, nxt);
        const char* nA = has_next ? S.a_ptr(nxt) : cA; const char* nB = has_next ? S.b_ptr(nxt) : cB;
        if constexpr (Prob::GATHER) { if (has_next && wid < 4) __builtin_amdgcn_global_load_lds((const unsigned*)(S.rows(nxt) + wid * 64 + lane), (LDS3 unsigned*)(lds + LDS_TAB_OFF + wid * 256), 4, 0, 0); }
        for (int t = 0; t < nt; t += 2) {
            const bool last = (t == nt - 2);
            const char* a1 = cA + (size_t)(t + 1) * kstep;
            const char* a2 = last ? nA : cA + (size_t)(t + 2) * kstep; const char* b2 = last ? nB : cB + (size_t)(t + 2) * kstep;
            const char* a3 = a2 + kstep; const char* b3 = b2 + kstep;
            if constexpr (Prob::GATHER) { if (last && has_next) {
#pragma unroll
                for (int h = 0; h < 2; ++h)
#pragma unroll
                    for (int i = 0; i < 2; ++i) vAn[h][i] = (unsigned)rtab[h * HALF + Rrow[i]] + voffA[i]; } }
            unsigned vS[2][2];
#pragma unroll
            for (int h = 0; h < 2; ++h)
#pragma unroll
                for (int i = 0; i < 2; ++i) vS[h][i] = last ? vAn[h][i] : vAc[h][i];
            if constexpr (GEMM_SP2) {
            PG8_LDB(B0, 0, 0); PG8_LDB(B1, 0, 1); PG8_SCHED; PG8_LDA(At, 0, 0); PG8_STAGE(PG8_SA(1, 1), a1, vAc[1]);
            PG8_WAIT_V(8); PG8_WAIT_L(0); PG8_BAR; PG8_MMA(0, 0, At, B0); PG8_MMA(0, 1, At, B1); PG8_BAR; PG8_SCHED;
            PG8_LDA(At, 0, 1); PG8_STAGE(PG8_SB(0, 0), b2, voffB); PG8_STAGE(PG8_SB(0, 1), b2 + hstepB, voffB); PG8_STAGE(PG8_SA(0, 0), a2, vS[0]);
            PG8_WAIT_V(8); PG8_WAIT_L(0); PG8_BAR; PG8_MMA(1, 0, At, B0); PG8_MMA(1, 1, At, B1); PG8_BAR; PG8_SCHED;
            PG8_LDB(B0, 1, 0); PG8_LDB(B1, 1, 1); PG8_SCHED; PG8_LDA(At, 1, 0); PG8_STAGE(PG8_SA(0, 1), a2, vS[1]);
            PG8_WAIT_V(8); PG8_WAIT_L(0); PG8_BAR; PG8_MMA(0, 0, At, B0); PG8_MMA(0, 1, At, B1); PG8_BAR; PG8_SCHED;
            PG8_LDA(At, 1, 1); PG8_STAGE(PG8_SB(1, 0), b3, voffB); PG8_STAGE(PG8_SB(1, 1), b3 + hstepB, voffB); PG8_STAGE(PG8_SA(1, 0), a3, vS[0]);
            PG8_WAIT_V(8); PG8_WAIT_L(0); PG8_BAR; PG8_MMA(1, 0, At, B0); PG8_MMA(1, 1, At, B1); PG8_BAR; PG8_SCHED;
            } else {
            PG8_LDB(B0, 0, 0); PG8_SCHED; PG8_LDA(At, 0, 0); PG8_STAGE(PG8_SA(1, 1), a1, vAc[1]);
            PG8_WAIT_L(8); PG8_BAR; PG8_WAIT_L(0); PG8_MMA(0, 0, At, B0); PG8_BAR; PG8_SCHED;
            PG8_LDB(B1, 0, 1); PG8_STAGE(PG8_SB(0, 0), b2, voffB);
            PG8_BAR; PG8_WAIT_L(0); PG8_MMA(0, 1, At, B1); PG8_BAR;
            PG8_LDA(At, 0, 1); PG8_STAGE(PG8_SA(0, 0), a2, vS[0]);
            PG8_BAR; PG8_WAIT_L(0); PG8_MMA(1, 0, At, B0); PG8_BAR; PG8_SCHED;
            PG8_STAGE(PG8_SB(0, 1), b2 + hstepB, voffB);
            PG8_WAIT_V(6); PG8_BAR; PG8_MMA(1, 1, At, B1); PG8_BAR;
            PG8_LDB(B0, 1, 0); PG8_SCHED; PG8_LDA(At, 1, 0); PG8_STAGE(PG8_SA(0, 1), a2, vS[1]);
            PG8_WAIT_L(8); PG8_BAR; PG8_WAIT_L(0); PG8_MMA(0, 0, At, B0); PG8_BAR; PG8_SCHED;
            PG8_LDB(B1, 1, 1); PG8_STAGE(PG8_SB(1, 0), b3, voffB);
            PG8_BAR; PG8_WAIT_L(0); PG8_MMA(0, 1, At, B1); PG8_BAR;
            PG8_LDA(At, 1, 1); PG8_STAGE(PG8_SA(1, 0), a3, vS[0]);
            PG8_BAR; PG8_WAIT_L(0); PG8_MMA(1, 0, At, B0); PG8_BAR; PG8_SCHED;
            PG8_STAGE(PG8_SB(1, 1), b3 + hstepB, voffB);
            PG8_WAIT_V(6); PG8_BAR; PG8_MMA(1, 1, At, B1); PG8_BAR;
            }
        }
        if constexpr (GEMM_ALIGN_EPI) { if (wr == 0) PG8_BAR; }
        if constexpr (Epi::FP8) asm volatile("s_nop 15\n\ts_nop 15" ::: "memory");
        E(acc, cur, wr, wc, fr, fq);
        if (!has_next) break;
#pragma unroll
        for (int a = 0; a < 2; ++a)
#pragma unroll
            for (int b = 0; b < 2; ++b)
#pragma unroll
                for (int m = 0; m < 4; ++m)
#pragma unroll
                    for (int n = 0; n < 2; ++n) acc[a][b][m][n] = (f32x4){0.f, 0.f, 0.f, 0.f};
        if constexpr (Epi::FP8) asm volatile("s_nop 7" ::: "memory");
        cur = nxt; cA = nA; cB = nB; ++ui;
#pragma unroll
        for (int h = 0; h < 2; ++h)
#pragma unroll
            for (int i = 0; i < 2; ++i) vAc[h][i] = vAn[h][i];
        if constexpr (GEMM_ALIGN_EPI) { if (wr == 1) PG8_BAR; }
    }
    PG8_WAIT_V(0);
    if constexpr (!GEMM_ALIGN_EPI) { if (wr == 0) PG8_BAR; }
    PG8_BAR;
#undef PG8_SA
#undef PG8_SB
#undef PG8_STAGE
#undef PG8_LDA
#undef PG8_LDB
#undef PG8_MMA
#undef PG8_LD8
#undef PG8_LO
#undef PG8_HI
#undef PG8_WAIT_V
#undef PG8_WAIT_L
#undef PG8_BAR
#undef PG8_SCHED
}
}
using pg8::Unit;

extern __shared__ __attribute__((aligned(16))) char smem[];
__device__ __forceinline__ char* smem_base() { return smem; }

constexpr int EPI_LDS = 131072;
__device__ __forceinline__ char* epi_slot(int wr, int wc) { return smem_base() + EPI_LDS + (wr * 4 + wc) * 2048; }
__device__ __forceinline__ void slot_put(char* slot, int fr, int fq, u32x4 w0, u32x4 w1) {
    *(u32x4*)(slot + fr * 128 + (((fq) ^ (fr & 7)) << 4)) = w0; *(u32x4*)(slot + fr * 128 + (((4 + fq) ^ (fr & 7)) << 4)) = w1; }
__device__ __forceinline__ u32x4 slot_get(const char* slot, int half, int lane) { const int row = half * 8 + (lane >> 3), ch = lane & 7; return *(const u32x4*)(slot + row * 128 + ((ch ^ (row & 7)) << 4)); }

#define EPI_ROWS(ai, m) for (int ai = 0; ai < 2; ++ai) _Pragma("unroll") for (int m = 0; m < 4; ++m)

template <bool F8_> struct EpiProjT {
    static constexpr bool PERM = true, FP8 = F8_;
    unsigned char* ws;
    __device__ __forceinline__ void operator()(const f32x4 (&acc)[2][2][4][2], const Unit& u, int wr, int wc, int fr, int fq) const {
        const int pn = u.pn; const int lane = fq * 16 + fr; char* slot = epi_slot(wr, wc);
        const int rowq = u.pm * 256 + wr * 64 + (lane >> 3);
        if (pn < 12 || (pn >= 30 && pn < 38)) {
            size_t boff; int ld, col0, act;
            if (pn < 2) { boff = WS_GQ; ld = 512; col0 = pn * 256; act = 0; }
            else if (pn < 4) { boff = WS_GK; ld = 512; col0 = (pn - 2) * 256; act = 0; }
            else if (pn < 8) { boff = WS_GV; ld = 1024; col0 = (pn - 4) * 256; act = 0; }
            else if (pn < 12) { boff = WS_GR; ld = 1024; col0 = (pn - 8) * 256; act = 1; }
            else if (pn < 34) { boff = WS_SG; ld = 1024; col0 = (pn - 30) * 256; act = 2; }
            else { boff = WS_SA; ld = 1024; col0 = (pn - 34) * 256; act = 2; }
            bf16_t* base = (bf16_t*)(ws + boff) + col0 + wc * 64 + (lane & 7) * 8;
#pragma unroll
            EPI_ROWS(ai, m) { u32x4 w[2];
#pragma unroll
                for (int bj = 0; bj < 2; ++bj) { float v[8];
#pragma unroll
                    for (int j = 0; j < 4; ++j) { v[j] = acc[ai][bj][m][0][j]; v[4 + j] = acc[ai][bj][m][1][j]; }
                    if (act == 1) {
#pragma unroll
                        for (int j = 0; j < 8; ++j) v[j] = v[j] * sigmoidf_(v[j]); }
                    if (act == 2) {
#pragma unroll
                        for (int j = 0; j < 8; ++j) v[j] = sigmoidf_(v[j]); }
                    w[bj] = pack8(v); }
                slot_put(slot, fr, fq, w[0], w[1]);
#pragma unroll
                for (int half = 0; half < 2; ++half) st_nt(base + (size_t)(rowq + ai * 128 + m * 16 + half * 8) * ld, slot_get(slot, half, lane)); }
        } else if (pn < 30) {
            const int which = (pn - 12) / 6, t6 = (pn - 12) % 6, sh = (t6 >> 1) * 2, dmask = (1 << sh) - 1, NL = SEQ >> sh;
            bf16_t* base = (bf16_t*)(ws + WS_AQ + (size_t)which * ((size_t)NTOK * 1536 * 2)) + (lane & 7) * 8;
            const bool rot = (which < 2) && (fq < 2);
            f32x4 frev;
#pragma unroll
            for (int q = 0; q < 4; ++q) frev[q] = rot ? __builtin_amdgcn_exp2f(-(float)(4 * fq + q) * (0.125f * 18.931568569324174f)) * 0.15915494309189535f : 0.f;
            const float sc = which == 0 ? QSCALE : 1.0f;
            const int head = t6 * 4 + wc;
#pragma unroll
            EPI_ROWS(ai, m) { const int s = (u.pm * 256 + wr * 64 + fr + ai * 128 + m * 16) & (SEQ - 1);
                f32x4 cs, sn;
#pragma unroll
                for (int q = 0; q < 4; ++q) { const float rev = __builtin_amdgcn_fractf((float)s * frev[q]); cs[q] = __builtin_amdgcn_cosf(rev); sn[q] = __builtin_amdgcn_sinf(rev); }
                u32x4 w[2];
#pragma unroll
                for (int bj = 0; bj < 2; ++bj) { float v[8];
#pragma unroll
                    for (int j = 0; j < 4; ++j) { v[j] = acc[ai][bj][m][0][j]; v[4 + j] = acc[ai][bj][m][1][j]; }
                    if (bj == 0) { const float a0 = v[0] * cs[0] - v[1] * sn[0], a1 = v[1] * cs[0] + v[0] * sn[0], a2 = v[2] * cs[1] - v[3] * sn[1], a3 = v[3] * cs[1] + v[2] * sn[1];
                      const float a4 = v[4] * cs[2] - v[5] * sn[2], a5 = v[5] * cs[2] + v[4] * sn[2], a6 = v[6] * cs[3] - v[7] * sn[3], a7 = v[7] * cs[3] + v[6] * sn[3];
                      v[0] = a0; v[1] = a1; v[2] = a2; v[3] = a3; v[4] = a4; v[5] = a5; v[6] = a6; v[7] = a7; }
#pragma unroll
                    for (int j = 0; j < 8; ++j) v[j] *= sc;
                    w[bj] = pack8(v); }
                slot_put(slot, fr, fq, w[0], w[1]);
#pragma unroll
                for (int half = 0; half < 2; ++half) { const int row = rowq + ai * 128 + m * 16 + half * 8, b = row >> 12, s2 = row & (SEQ - 1), r = s2 & dmask, n = s2 >> sh;
                    st_nt(base + ((size_t)(b * 24 + head) * SEQ + (size_t)r * NL + n) * 64, slot_get(slot, half, lane)); } }
        } else {
            const int row0 = u.pm * 256 + wr * 64 + fr;
            if (wc == 0 && fq < 2) { float* glr = (float*)(ws + WS_GLR);
#pragma unroll
                EPI_ROWS(ai, m) { float* rowp = glr + (size_t)(row0 + ai * 128 + m * 16) * 16 + 8 * fq; *(f32x4*)rowp = acc[ai][0][m][0]; *(f32x4*)(rowp + 4) = acc[ai][0][m][1]; } }
        }
    }
};

template <int MODE> struct EpiGate {
    static constexpr bool PERM = true, FP8 = false;
    const bf16_t* gate; const bf16_t* t1; bf16_t* out;
    __device__ __forceinline__ void operator()(const f32x4 (&acc)[2][2][4][2], const Unit& u, int wr, int wc, int fr, int fq) const {
        const int lane = fq * 16 + fr; char* slot = epi_slot(wr, wc);
        const size_t off0 = (size_t)(u.pm * 256 + wr * 64 + (lane >> 3)) * 1024 + u.pn * 256 + wc * 64 + (lane & 7) * 8;
#pragma unroll
        for (int ai = 0; ai < 2; ++ai) { u32x4 gw[4][2], tw[4][2];
#pragma unroll
            for (int m = 0; m < 4; ++m)
#pragma unroll
                for (int half = 0; half < 2; ++half) { const size_t off = off0 + (size_t)(ai * 128 + m * 16 + half * 8) * 1024; gw[m][half] = *(const u32x4*)(gate + off); if (MODE == 1) tw[m][half] = *(const u32x4*)(t1 + off); }
#pragma unroll
            for (int m = 0; m < 4; ++m) { u32x4 w[2];
#pragma unroll
                for (int bj = 0; bj < 2; ++bj) { float v[8];
#pragma unroll
                    for (int j = 0; j < 4; ++j) { v[j] = acc[ai][bj][m][0][j]; v[4 + j] = acc[ai][bj][m][1][j]; }
                    w[bj] = pack8(v); }
                slot_put(slot, fr, fq, w[0], w[1]);
#pragma unroll
                for (int half = 0; half < 2; ++half) { float a[8], g[8]; unpack8(slot_get(slot, half, lane), a); unpack8(gw[m][half], g);
#pragma unroll
                    for (int j = 0; j < 8; ++j) a[j] *= g[j];
                    if (MODE == 1) { float t[8]; unpack8(tw[m][half], t);
#pragma unroll
                        for (int j = 0; j < 8; ++j) a[j] += t[j]; }
                    *(u32x4*)(out + off0 + (size_t)(ai * 128 + m * 16 + half * 8) * 1024) = pack8(a); } } }
    }
};

struct EpiResid {
    static constexpr bool PERM = false, FP8 = false;
    const float* x; bf16_t* h;
    __device__ __forceinline__ void operator()(const f32x4 (&acc)[2][2][4][2], const Unit& u, int wr, int wc, int fr, int fq) const {
        const int lane = fq * 16 + fr; char* slot = epi_slot(wr, wc);
        const size_t off0 = (size_t)(u.pm * 256 + wr * 64 + (lane >> 3)) * 1024 + u.pn * 256 + wc * 32 + (lane & 7) * 4;
#pragma unroll
        for (int ai = 0; ai < 2; ++ai)
#pragma unroll
            for (int bj = 0; bj < 2; ++bj) { f32x4 xv[4][2];
#pragma unroll
                for (int m = 0; m < 4; ++m)
#pragma unroll
                    for (int half = 0; half < 2; ++half) xv[m][half] = *(const f32x4*)(x + off0 + (size_t)(ai * 128 + m * 16 + half * 8) * 1024 + bj * 128);
#pragma unroll
                for (int m = 0; m < 4; ++m) { slot_put(slot, fr, fq, __builtin_bit_cast(u32x4, acc[ai][bj][m][0]), __builtin_bit_cast(u32x4, acc[ai][bj][m][1]));
#pragma unroll
                    for (int half = 0; half < 2; ++half) { const f32x4 a = __builtin_bit_cast(f32x4, slot_get(slot, half, lane));
                        const f32x4 r = a + xv[m][half]; u32x2 w2; w2.x = cvt_pk_bf16(r[0], r[1]); w2.y = cvt_pk_bf16(r[2], r[3]);
                        *(u32x2*)(h + off0 + (size_t)(ai * 128 + m * 16 + half * 8) * 1024 + bj * 128) = w2; } } }
    }
};

struct EpiAct {
    static constexpr bool PERM = true, FP8 = true;
    const float* bgu; const int* tile_e; unsigned char* act;
    __device__ __forceinline__ void operator()(const f32x4 (&acc)[2][2][4][2], const Unit& u, int wr, int wc, int fr, int fq) const {
        const int e = tile_e[u.pm]; const int row0 = u.pm * 256 + wr * 64 + fr; const int j0 = u.pn * 128 + wc * 32 + 8 * fq;
        float bg[8], bu[8];
        { const float* bp = bgu + (size_t)e * 2048 + 2 * j0;
#pragma unroll
          for (int q = 0; q < 4; ++q) { const f32x4 t = *(const f32x4*)(bp + 4 * q); bg[2 * q] = t[0]; bu[2 * q] = t[1]; bg[2 * q + 1] = t[2]; bu[2 * q + 1] = t[3]; } }
#pragma unroll
        EPI_ROWS(ai, m) { float v[8];
#pragma unroll
            for (int j = 0; j < 8; ++j) { const float gt = acc[ai][0][m][j >> 2][j & 3] + bg[j], up = acc[ai][1][m][j >> 2][j & 3] + bu[j];
                const float g = fminf(gt, 7.0f), uu = fminf(fmaxf(up, -7.0f), 7.0f); v[j] = (uu + 1.0f) * (g * sigmoidf_(1.702f * g)); }
            u32x2 w8; w8.x = (unsigned)pk4_fp8(v[0], v[1], v[2], v[3]); w8.y = (unsigned)pk4_fp8(v[4], v[5], v[6], v[7]);
            *(u32x2*)(act + (size_t)(row0 + ai * 128 + m * 16) * 1024 + j0) = w8; }
    }
};

struct EpiDown {
    static constexpr bool PERM = true, FP8 = true;
    const float* bd; const int* tile_e; unsigned char* y;
    __device__ __forceinline__ void operator()(const f32x4 (&acc)[2][2][4][2], const Unit& u, int wr, int wc, int fr, int fq) const {
        const int e = tile_e[u.pm]; const int lane = fq * 16 + fr; char* slot = epi_slot(wr, wc); const int col0 = u.pn * 256 + wc * 64 + 8 * fq;
        f32x4 b[2][2];
#pragma unroll
        for (int bj = 0; bj < 2; ++bj)
#pragma unroll
            for (int n = 0; n < 2; ++n) b[bj][n] = *(const f32x4*)(bd + (size_t)e * 1024 + col0 + bj * 32 + 4 * n);
        unsigned char* base = y + (size_t)(u.pm * 256 + wr * 64 + (lane >> 2)) * 1024 + u.pn * 256 + wc * 64 + (lane & 3) * 16;
#pragma unroll
        EPI_ROWS(ai, m) { u32x2 w[2];
#pragma unroll
            for (int bj = 0; bj < 2; ++bj) { const f32x4 v0 = acc[ai][bj][m][0] + b[bj][0], v1 = acc[ai][bj][m][1] + b[bj][1];
                w[bj].x = (unsigned)pk4_fp8(v0[0], v0[1], v0[2], v0[3]); w[bj].y = (unsigned)pk4_fp8(v1[0], v1[1], v1[2], v1[3]); }
            *(u32x2*)(slot + fr * 64 + 8 * fq) = w[0]; *(u32x2*)(slot + fr * 64 + 32 + 8 * fq) = w[1];
            const u32x4 o = *(const u32x4*)(slot + (lane >> 2) * 64 + (lane & 3) * 16);
            *(u32x4*)(base + (size_t)(ai * 128 + m * 16) * 1024) = o; }
    }
};

__device__ __forceinline__ int win_colmap(int n) {
    if (n < 3072) return n;
    if (n < 7680) { const int off = n - 3072, which = off / 1536, hcol = off % 1536, head = hcol >> 6, p = hcol & 63;
        int dim = p; if (which < 2 && p < 16) dim = (p & 1) ? (p >> 1) + 8 : (p >> 1);
        return 3088 + which * 1536 + head * 64 + dim; }
    if (n < 9728) return 7696 + (n - 7680);
    if (n < 9744) return 3072 + (n - 9728);
    return -1;
}
__device__ __forceinline__ int gu_colmap(int n) { const int t = n >> 8, w = n & 255, wc = w >> 6, bj = (w >> 5) & 1, rho = w & 31; return 2 * (128 * t + 32 * wc + rho) + bj; }

__device__ __forceinline__ void transpose_tile(const float* src, int ld_src, bf16_t* dst, int K, int n0, int k0, int scol, char* lds) {
    const int t = tid_(), nl = t & 127, kq = t >> 7;
#pragma unroll
    for (int cc = 0; cc < 4; ++cc) { const int c = kq * 4 + cc; float v[8];
#pragma unroll
        for (int j = 0; j < 8; ++j) v[j] = scol >= 0 ? src[(size_t)(k0 + c * 8 + j) * ld_src + scol] : 0.f;
        *(u32x4*)(lds + nl * 256 + ((c ^ (nl & 15)) << 4)) = pack8(v); }
    __syncthreads();
#pragma unroll
    for (int pass = 0; pass < 4; ++pass) { const int idx = t + 512 * pass, n2 = idx >> 4, c2 = idx & 15;
        *(u32x4*)(dst + (size_t)(n0 + n2) * K + k0 + c2 * 8) = *(const u32x4*)(lds + n2 * 256 + ((c2 ^ (n2 & 15)) << 4)); }
    __syncthreads();
}

__device__ __forceinline__ void transpose_tile8(const float* src, int ld_src, unsigned char* dst, int K, int n0, int k0, int scol, float scale, char* lds) {
    const int t = tid_(), nl = t & 127, kq = t >> 7;
#pragma unroll
    for (int cc = 0; cc < 4; ++cc) { const int c = kq * 4 + cc; float v[16];
#pragma unroll
        for (int j = 0; j < 16; ++j) v[j] = scol >= 0 ? src[(size_t)(k0 + c * 16 + j) * ld_src + scol] * scale : 0.f;
        u32x4 w; w.x = (unsigned)pk4_fp8(v[0], v[1], v[2], v[3]); w.y = (unsigned)pk4_fp8(v[4], v[5], v[6], v[7]); w.z = (unsigned)pk4_fp8(v[8], v[9], v[10], v[11]); w.w = (unsigned)pk4_fp8(v[12], v[13], v[14], v[15]);
        *(u32x4*)(lds + nl * 256 + ((c ^ (nl & 15)) << 4)) = w; }
    __syncthreads();
#pragma unroll
    for (int pass = 0; pass < 4; ++pass) { const int idx = t + 512 * pass, n2 = idx >> 4, c2 = idx & 15;
        *(u32x4*)(dst + (size_t)(n0 + n2) * K + k0 + c2 * 16) = *(const u32x4*)(lds + n2 * 256 + ((c2 ^ (n2 & 15)) << 4)); }
    __syncthreads();
}

template <int MAP> __device__ __forceinline__ int tile_rowmap(int o) {
    if (MAP == 1) { const int d = o & 63; const int pp = d < 16 ? (d < 8 ? 2 * d : 2 * (d - 8) + 1) : d; return (o & 64) + pp; }
    if (MAP == 2) { const int wcl = o >> 6, w = o & 63; return 64 * wcl + 32 * (w & 1) + (w >> 1); }
    return o;
}
template <int MAP, bool F8> __device__ __forceinline__ void transpose_fast(const float* src  , int ld_src, unsigned char* dst, int Kb  , int n0, int k0, float scale, char* lds) {
    constexpr int KPT = F8 ? 16 : 8;
    const int t = tid_(), ng = t & 31, kg = t >> 5;
    f32x4 v[KPT];
#pragma unroll
    for (int j = 0; j < KPT; ++j) v[j] = *(const f32x4*)(src + (size_t)(k0 + kg * KPT + j) * ld_src + 4 * ng);
#pragma unroll
    for (int i = 0; i < 4; ++i) { const int row = tile_rowmap<MAP>(4 * ng + i); u32x4 w;
        if (F8) { w.x = (unsigned)pk4_fp8(v[0][i] * scale, v[1][i] * scale, v[2][i] * scale, v[3][i] * scale); w.y = (unsigned)pk4_fp8(v[4][i] * scale, v[5][i] * scale, v[6][i] * scale, v[7][i] * scale);
                  w.z = (unsigned)pk4_fp8(v[8 % KPT][i] * scale, v[9 % KPT][i] * scale, v[10 % KPT][i] * scale, v[11 % KPT][i] * scale); w.w = (unsigned)pk4_fp8(v[12 % KPT][i] * scale, v[13 % KPT][i] * scale, v[14 % KPT][i] * scale, v[15 % KPT][i] * scale); }
        else { w.x = cvt_pk_bf16(v[0][i], v[1][i]); w.y = cvt_pk_bf16(v[2][i], v[3][i]); w.z = cvt_pk_bf16(v[4][i], v[5][i]); w.w = cvt_pk_bf16(v[6][i], v[7][i]); }
        *(u32x4*)(lds + row * 256 + ((kg ^ (row & 15)) << 4)) = w; }
    __syncthreads();
#pragma unroll
    for (int pass = 0; pass < 4; ++pass) { const int idx = t + 512 * pass, n2 = idx >> 4, c2 = idx & 15;
        *(u32x4*)(dst + (size_t)(n0 + n2) * Kb + (size_t)k0 * (F8 ? 1 : 2) + c2 * 16) = *(const u32x4*)(lds + n2 * 256 + ((c2 ^ (n2 & 15)) << 4)); }
    __syncthreads();
}

constexpr int N_EXPERT_TILES_P0 = 1024;
__device__ __forceinline__ void expert_convert(const Params& p, char* lds, int first, int stride, int lo, int hi);
__device__ __forceinline__ void phase_prologue(const Params& p, char* lds) {
    unsigned char* ws = opaque(p.ws);
    const int tid = tid_(), lane = tid & 63, wid = tid >> 6, G = gridDim.x, bid = blockIdx.x;
    { bf16_t* xn = (bf16_t*)(ws + WS_XN); unsigned char* xn8 = ws + WS_XN8;
      for (int row = bid * 8 + wid; row < NTOK; row += G * 8) { const float* xr = p.x + (size_t)row * 1024; f32x4 v[4]; float ss = 0.f;
#pragma unroll
          for (int i = 0; i < 4; ++i) { v[i] = *(const f32x4*)(xr + i * 256 + lane * 4); ss += v[i][0] * v[i][0] + v[i][1] * v[i][1] + v[i][2] * v[i][2] + v[i][3] * v[i][3]; }
          ss = wave_sum(ss); const float rs = rsqrtf(ss * (1.0f / 1024.0f) + EPS);
#pragma unroll
          for (int i = 0; i < 4; ++i) { const f32x4 g = *(const f32x4*)(p.norm_mix_g + i * 256 + lane * 4); const float y0 = v[i][0] * rs * g[0], y1 = v[i][1] * rs * g[1], y2 = v[i][2] * rs * g[2], y3 = v[i][3] * rs * g[3];
              u32x2 w; w.x = cvt_pk_bf16(y0, y1); w.y = cvt_pk_bf16(y2, y3);
              *(u32x2*)(xn + (size_t)row * 1024 + i * 256 + lane * 4) = w; *(unsigned*)(xn8 + (size_t)row * 1024 + i * 256 + lane * 4) = (unsigned)pk4_fp8(y0, y1, y2, y3); } } }
    { float* rwg = (float*)(ws + WS_RWG);
      for (int i = bid * 512 + tid; i < 1024 * 32; i += G * 512) rwg[i] = p.router_w[i] * p.norm_ffn_g[i >> 5]; }
    { constexpr int T0 = 78 * 8, T1 = T0 + 64, T2 = T1 + 32, T3 = T2 + 64, T4 = T3 + 32 * 64, T5 = T4 + 32 * 32;
      const int nl = tid & 127;
      for (int tile = bid; tile < T3; tile += G) {
          if (tile < T0) { const int nt_ = tile >> 3, kt = tile & 7; const int t256 = nt_ >> 1; const bool sens = ((SENSMASK >> t256) & 1ull) != 0ull;
              bf16_t* d = (bf16_t*)(ws + WS_W_IN); unsigned char* d16 = ws + WS_W_IN; unsigned char* d8 = ws + WS_WIN8;
              const float* srcg = nt_ < 24 ? p.w_in + nt_ * 128 : (nt_ < 60 ? p.w_in + 3088 + (nt_ - 24) * 128 : p.w_in + 7696 + (nt_ - 60) * 128); const bool rotmap = nt_ >= 24 && nt_ < 48;
              if (sens) {
                  if (nt_ >= 76) transpose_tile(p.w_in, INW, d, 1024, nt_ * 128, kt * 128, win_colmap(nt_ * 128 + nl), lds);
                  else if (rotmap) transpose_fast<1, false>(srcg, INW, d16, 2048, nt_ * 128, kt * 128, 1.f, lds);
                  else transpose_fast<0, false>(srcg, INW, d16, 2048, nt_ * 128, kt * 128, 1.f, lds);
              } else if (kt < 4) {
                  if (nt_ >= 76) transpose_tile8(p.w_in, INW, d8, 1024, nt_ * 128, kt * 256, win_colmap(nt_ * 128 + nl), 32.f, lds);
                  else if (rotmap) transpose_fast<1, true>(srcg, INW, d8, 1024, nt_ * 128, kt * 256, 32.f, lds);
                  else transpose_fast<0, true>(srcg, INW, d8, 1024, nt_ * 128, kt * 256, 32.f, lds);
              } }
          else if (tile < T1) { const int q = tile - T0, nt_ = q >> 3, kt = q & 7; transpose_fast<0, false>(p.w_branch_gla + nt_ * 128, 1024, ws + WS_W_G, 2048, nt_ * 128, kt * 128, 1.f, lds); }
          else if (tile < T2) { const int q = tile - T1, nt_ = q >> 2, kt = q & 3; transpose_fast<0, false>(p.w_branch_att + nt_ * 128, 1024, ws + WS_W_A, 1024, nt_ * 128, kt * 128, 1.f, lds); }
          else if (tile < T3) { const int q = tile - T2, nt_ = q >> 3, kt = q & 7; transpose_fast<0, false>(p.w_mix_out + nt_ * 128, 1024, ws + WS_W_MIX, 2048, nt_ * 128, kt * 128, 1.f, lds); }
      } }
    expert_convert(p, lds, bid, G, 0, N_EXPERT_TILES_P0);
}

constexpr int N_EXPERT_TILES = 32 * 64 + 32 * 32;
__device__ __forceinline__ void expert_convert(const Params& p, char* lds, int first, int stride, int lo, int hi) {
    unsigned char* ws = opaque(p.ws);
    for (int q0 = lo + first; q0 < hi; q0 += stride) {
        if (q0 < 32 * 64) { const int q = q0, e = q >> 6, r = q & 63, nt_ = r >> 2, kt = r & 3;
            transpose_fast<2, true>(p.e_w_gu + (size_t)e * 1024 * 2048 + nt_ * 128, 2048, ws + WS_W_GU + (size_t)e * 2048 * 1024, 1024, nt_ * 128, kt * 256, 32.0f, lds); }
        else { const int q = q0 - 32 * 64, e = q >> 5, r = q & 31, nt_ = r >> 2, kt = r & 3;
            transpose_fast<0, true>(p.e_w_d + (size_t)e * 1024 * 1024 + nt_ * 128, 1024, ws + WS_W_D + (size_t)e * 1024 * 1024, 1024, nt_ * 128, kt * 256, 32.0f, lds); }
    }
}

constexpr int AT_KCS = 385 * 16;
constexpr int AT_VH = 385 * 64;
constexpr int AT_K = 0, AT_V = 8 * AT_KCS, AT_WL = AT_V + 2 * AT_VH, AT_STG = AT_WL + 8 * 128, AT_END = AT_STG + 8 * 4096;
static_assert(AT_END <= LDS_BYTES, "attention LDS");
struct AttnPre { u32x4 k[6], v[6]; bf16x8 q[4]; };
__device__ __forceinline__ void attn_fetch(const Params& p, int item, AttnPre& r) {
    unsigned char* ws = opaque(p.ws); const int tid = tid_();
    const int jj = item & 15, bh = item >> 4, head = bh % 24, g = head >> 3, sh = 2 * g, NL = SEQ >> sh, ppr = 16 >> sh; const int rr_ = jj / ppr, j = jj % ppr;
    const size_t hb = ((size_t)bh * SEQ + (size_t)rr_ * NL) * 64; const bf16_t* Kg = (const bf16_t*)(ws + WS_AK) + hb; const bf16_t* Vg = (const bf16_t*)(ws + WS_AV) + hb; const int kn0 = 256 * j - 128;
    { const int lane = tid & 63, r32 = lane & 31, hi = lane >> 5, w = tid >> 6; const bf16_t* Q = (const bf16_t*)(ws + WS_AQ) + hb;
#pragma unroll
      for (int d0 = 0; d0 < 4; ++d0) r.q[d0] = *(const bf16x8*)(Q + (size_t)(256 * j + 32 * w + r32) * 64 + d0 * 16 + hi * 8); }
#pragma unroll
    for (int i = 0; i < 6; ++i) { const int idx = tid + 512 * i, key = idx >> 3, c = idx & 7;
        if (kn0 + key >= 0) { r.k[i] = *(const u32x4*)(Kg + (ptrdiff_t)(kn0 + key) * 64 + c * 8); r.v[i] = *(const u32x4*)(Vg + (ptrdiff_t)(kn0 + key) * 64 + c * 8); } }
}
__device__ __forceinline__ void attn_item(const Params& p, int item, int nitem, bool has_next, AttnPre& pre, char* lds) {
    unsigned char* ws = opaque(p.ws);
    const int tid = tid_(), lane = tid & 63, r32 = lane & 31, hi = lane >> 5; const int w = __builtin_amdgcn_readfirstlane(tid >> 6);
    const int jj = item & 15, bh = item >> 4, head = bh % 24, b = bh / 24, g = head >> 3, sh = 2 * g, d = 1 << sh, NL = SEQ >> sh, ppr = 16 >> sh;
    const int r = jj / ppr, j = jj % ppr;
    const size_t hb = ((size_t)bh * SEQ + (size_t)r * NL) * 64;
    const bf16_t* Q = (const bf16_t*)(ws + WS_AQ) + hb;
    const int kn0 = 256 * j - 128;
    bf16x8 qf[4];
#pragma unroll
    for (int d0 = 0; d0 < 4; ++d0) qf[d0] = pre.q[d0];
#pragma unroll
    for (int i = 0; i < 6; ++i) { const int idx = tid + 512 * i, key = idx >> 3, c = idx & 7;
        if (kn0 + key >= 0) { *(u32x4*)(lds + AT_K + c * AT_KCS + key * 16) = pre.k[i]; *(u32x4*)(lds + AT_V + (c >> 2) * AT_VH + key * 64 + (c & 3) * 16) = pre.v[i]; } }
    __syncthreads();
    if (has_next) attn_fetch(p, nitem, pre);
    const LDS3 char* l3 = (const LDS3 char*)lds;
    f32x16 s[5]; const int ktmin = (j == 0) ? 4 : 0;
#pragma unroll
    for (int t5 = 0; t5 < 5; ++t5) { const int kt = w + t5;
        if (kt >= ktmin) { f32x16 a = {};
#pragma unroll
            for (int d0 = 0; d0 < 4; ++d0) { const bf16x8 kf = *(const LDS3 bf16x8*)(l3 + AT_K + (2 * d0 + hi) * AT_KCS + (kt * 32 + r32) * 16); a = MFMA32(kf, qf[d0], a); }
            s[t5] = a; }
        else {
#pragma unroll
            for (int rr = 0; rr < 16; ++rr) s[t5][rr] = -1e30f; } }
#pragma unroll
    for (int rr = 0; rr < 16; ++rr) { const int c = crow(rr, hi); if (c < r32) s[0][rr] = -1e30f; if (c > r32) s[4][rr] = -1e30f; }
    float mx = -1e30f;
#pragma unroll
    for (int t5 = 0; t5 < 5; ++t5)
#pragma unroll
        for (int rr = 0; rr < 16; ++rr) mx = fmaxf(mx, s[t5][rr]);
    mx = fmaxf(mx, __shfl_xor(mx, 32));
    float l = 0.f;
#pragma unroll
    for (int t5 = 0; t5 < 5; ++t5)
#pragma unroll
        for (int rr = 0; rr < 16; ++rr) { const float e = __builtin_amdgcn_exp2f(s[t5][rr] - mx); s[t5][rr] = e; l += e; }
    l += __shfl_xor(l, 32);
    f32x16 o[2]; o[0] = f32x16{}; o[1] = f32x16{};
    const int blk = (lane >> 4) & 1, q4 = (lane & 15) >> 2, p4 = lane & 3;
#pragma unroll
    for (int t5 = 0; t5 < 5; ++t5) { const int kt = w + t5;
        if (kt >= ktmin) {
#pragma unroll
            for (int ss = 0; ss < 2; ++ss) { float pv[8];
#pragma unroll
                for (int q = 0; q < 8; ++q) pv[q] = s[t5][8 * ss + q];
                const bf16x8 pa = __builtin_bit_cast(bf16x8, pack8(pv));
#pragma unroll
                for (int dh = 0; dh < 2; ++dh) { const LDS3 char* vp = l3 + AT_V + dh * AT_VH + (kt * 32 + 16 * ss + 4 * hi + q4) * 64 + (16 * blk + 4 * p4) * 2;
                    const bf16x8 vf = cat8(tr16(vp), tr16(vp + 8 * 64)); o[dh] = MFMA32(pa, vf, o[dh]); } } } }
    const int n_q = 256 * j + 32 * w + r32; const int tok = b * SEQ + n_q * d + r;
    if (hi == 0) { ((float*)(ws + WS_LSE))[((size_t)g * NTOK + tok) * 8 + (head & 7)] = (mx + __builtin_amdgcn_logf(l)) * LN2;
        ((float*)(lds + AT_WL))[w * 32 + r32] = __builtin_amdgcn_rcpf(l); }
    bf16_t* stg = (bf16_t*)(lds + AT_STG) + w * 2048;
#pragma unroll
    for (int rr = 0; rr < 16; ++rr) { const int qr = crow(rr, hi); const float rl = ((const float*)(lds + AT_WL))[w * 32 + qr];
#pragma unroll
        for (int dh = 0; dh < 2; ++dh) stg[qr * 64 + dh * 32 + r32] = (bf16_t)(cvt_pk_bf16(o[dh][rr] * rl, 0.f) & 0xffffu); }
    bf16_t* og = (bf16_t*)(ws + WS_OATT) + (size_t)g * NTOK * 512;
#pragma unroll
    for (int i = 0; i < 4; ++i) { const int idx = i * 64 + lane, row = idx >> 3, ch = idx & 7; const int tk = b * SEQ + (256 * j + 32 * w + row) * d + r;
        *(u32x4*)(og + (size_t)tk * 512 + (head & 7) * 64 + ch * 8) = *(const u32x4*)(stg + row * 64 + ch * 8); }
    __syncthreads();
}

constexpr int G1_BB = 0;
constexpr int G1_QE = G1_BB + 64 * 128 * 4;
constexpr int G1_KE = G1_QE + 64 * 272;
constexpr int G1_KD = G1_KE + 64 * 272;
constexpr int G1_V = G1_KD + 64 * 320;
constexpr int G1_GLR = G1_V + 64 * 576;
constexpr int G1_GUP = G1_GLR + 64 * 16 * 4;
constexpr int G1_SEG = G1_GUP + 16 * 128 * 4;
constexpr int G1_BIAS = G1_SEG + 4 * 128 * 4;
constexpr int G1_END = G1_BIAS + 128 * 4;
constexpr int G1_SU = 0;
constexpr int G1_SO = 128 * 528;
static_assert(G1_SO + 64 * 528 <= G1_GLR, "gla1 staging");
static_assert(G1_END <= LDS_BYTES, "gla1 LDS");
__device__ __forceinline__ float logsigmoidf_(float z) { return fminf(z, 0.f) - log1pf(__expf(-fabsf(z))); }
struct G1Pre { u32x4 q[2], k[2], v[4]; float glr[2]; };
__device__ __forceinline__ void gla1_fetch(const Params& p, int item, G1Pre& r) {
    unsigned char* ws = opaque(p.ws); const int tid = tid_();
    const int n = item & 63, bh = item >> 6, h = bh & 3, b = bh >> 2; const int tok0 = b * SEQ + n * 64;
    const bf16_t* gq = (const bf16_t*)(ws + WS_GQ); const bf16_t* gk = (const bf16_t*)(ws + WS_GK); const bf16_t* gv = (const bf16_t*)(ws + WS_GV);
#pragma unroll
    for (int pp = 0; pp < 2; ++pp) { const int idx = tid + 512 * pp, i = idx >> 4, c = idx & 15; const size_t go = (size_t)(tok0 + i) * 512 + h * 128 + c * 8; r.q[pp] = *(const u32x4*)(gq + go); r.k[pp] = *(const u32x4*)(gk + go);
        r.glr[pp] = ((const float*)(ws + WS_GLR))[(size_t)tok0 * 16 + idx]; }
#pragma unroll
    for (int pp = 0; pp < 4; ++pp) { const int idx = tid + 512 * pp, jv = idx >> 5, c = idx & 31; r.v[pp] = *(const u32x4*)(gv + (size_t)(tok0 + jv) * 1024 + h * 256 + c * 8); }
}
__device__ __forceinline__ void gla1_head_operands(const Params& p, int h, char* lds) {
    const int tid = tid_(); float* GUP = (float*)(lds + G1_GUP); float* BIAS = (float*)(lds + G1_BIAS);
    for (int i = tid; i < 16 * 128; i += 512) GUP[i] = p.gla_gate_up[(i >> 7) * 512 + h * 128 + (i & 127)];
    if (tid < 128) BIAS[tid] = p.gla_gate_bias[h * 128 + tid];
}
__device__ __forceinline__ void gla1_item(const Params& p, int item, int nitem, bool has_next, bool reload_head, G1Pre& pre, char* lds) {
    unsigned char* ws = opaque(p.ws);
    const int tid = tid_(), lane = tid & 63, r32 = lane & 31, hi = lane >> 5; const int w = __builtin_amdgcn_readfirstlane(tid >> 6);
    const int n = item & 63, bh = item >> 6, h = bh & 3, b = bh >> 2; const int tok0 = b * SEQ + n * 64;
    float* BB = (float*)(lds + G1_BB); float* GLRs = (float*)(lds + G1_GLR); float* GUP = (float*)(lds + G1_GUP); float* SEGs = (float*)(lds + G1_SEG); float* BIAS = (float*)(lds + G1_BIAS);
    u32x4 qraw[2], kraw[2], vraw[4];
#pragma unroll
    for (int pp = 0; pp < 2; ++pp) { qraw[pp] = pre.q[pp]; kraw[pp] = pre.k[pp]; GLRs[tid + 512 * pp] = pre.glr[pp]; }
#pragma unroll
    for (int pp = 0; pp < 4; ++pp) vraw[pp] = pre.v[pp];
    if (reload_head) gla1_head_operands(p, h, lds);
    __syncthreads();
    if (has_next) gla1_fetch(p, nitem, pre);
    { const int d = tid & 127, seg = tid >> 7; float gu[16];
#pragma unroll
      for (int r = 0; r < 16; ++r) gu[r] = GUP[r * 128 + d];
      const float bias = BIAS[d]; float run = 0.f;
#pragma unroll 4
      for (int ii = 0; ii < 16; ++ii) { const int i = seg * 16 + ii; float z = bias;
#pragma unroll
          for (int r4 = 0; r4 < 4; ++r4) { const f32x4 gl = *(const f32x4*)(GLRs + i * 16 + r4 * 4); z += gl[0] * gu[r4 * 4] + gl[1] * gu[r4 * 4 + 1] + gl[2] * gu[r4 * 4 + 2] + gl[3] * gu[r4 * 4 + 3]; }
          run += logsigmoidf_(z) * (1.0f / 16.0f); BB[i * 128 + d] = run; }
      SEGs[seg * 128 + d] = run;
      __syncthreads();
      float off = 0.f; for (int s2 = 0; s2 < seg; ++s2) off += SEGs[s2 * 128 + d];
      if (seg > 0) { for (int ii = 0; ii < 16; ++ii) BB[(seg * 16 + ii) * 128 + d] += off; }
      __syncthreads(); }
    { const bf16_t* gq = (const bf16_t*)(ws + WS_GQ); const bf16_t* gk = (const bf16_t*)(ws + WS_GK); const bf16_t* gv = (const bf16_t*)(ws + WS_GV); bf16_t* qeg = (bf16_t*)(ws + WS_QE);
#pragma unroll
      for (int pp = 0; pp < 2; ++pp) { const int idx = tid + 512 * pp, i = idx >> 4, c = idx & 15, d0 = c * 8; const size_t go = (size_t)(tok0 + i) * 512 + h * 128 + d0;
          float q[8], k[8], qe[8], ke[8], kd[8]; unpack8(qraw[pp], q); unpack8(kraw[pp], k);
#pragma unroll
          for (int j = 0; j < 8; ++j) { const float bb = BB[i * 128 + d0 + j], bl = BB[63 * 128 + d0 + j]; qe[j] = q[j] * __expf(bb) * 0.08838834764831845f; ke[j] = k[j] * __expf(-bb); kd[j] = k[j] * __expf(bl - bb); }
          const u32x4 qw = pack8(qe); *(u32x4*)(lds + G1_QE + i * 272 + c * 16) = qw; *(u32x4*)(qeg + go) = qw;
          *(u32x4*)(lds + G1_KE + i * 272 + c * 16) = pack8(ke); *(u32x4*)(lds + G1_KD + i * 320 + c * 16) = pack8(kd); }
#pragma unroll
      for (int pp = 0; pp < 4; ++pp) { const int idx = tid + 512 * pp, jv = idx >> 5, c = idx & 31; *(u32x4*)(lds + G1_V + jv * 576 + c * 16) = vraw[pp]; }
      if (tid < 128) ((float*)(ws + WS_DEC))[(size_t)item * 128 + tid] = __expf(BB[63 * 128 + tid]);
      __syncthreads(); }
    const LDS3 char* l3 = (const LDS3 char*)lds; const int blk = (lane >> 4) & 1, q4 = (lane & 15) >> 2, p4 = lane & 3;
    {
      const int it = w & 1, vq = w >> 1; f32x16 oi[2]; oi[0] = f32x16{}; oi[1] = f32x16{};
#pragma unroll
      for (int jt = 0; jt < 2; ++jt) { if (jt <= it) { f32x16 x = {};
#pragma unroll
          for (int s = 0; s < 8; ++s) { const bf16x8 a = *(const LDS3 bf16x8*)(l3 + G1_KE + (jt * 32 + r32) * 272 + (16 * s + 8 * hi) * 2), bq = *(const LDS3 bf16x8*)(l3 + G1_QE + (it * 32 + r32) * 272 + (16 * s + 8 * hi) * 2); x = MFMA32(a, bq, x); }
          if (jt == it) {
#pragma unroll
              for (int rr = 0; rr < 16; ++rr) if (crow(rr, hi) > r32) x[rr] = 0.f; }
#pragma unroll
          for (int ss = 0; ss < 2; ++ss) { float xv[8];
#pragma unroll
              for (int q = 0; q < 8; ++q) xv[q] = x[8 * ss + q];
              const bf16x8 xa = __builtin_bit_cast(bf16x8, pack8(xv));
#pragma unroll
              for (int vi = 0; vi < 2; ++vi) { const int vt = 2 * vq + vi; const LDS3 char* vp = l3 + G1_V + (jt * 32 + 16 * ss + 4 * hi + q4) * 576 + (vt * 32 + 16 * blk + 4 * p4) * 2;
                  const bf16x8 vf = cat8(tr16(vp), tr16(vp + 8 * 576)); oi[vi] = MFMA32(xa, vf, oi[vi]); } } } }
      const int dt = w & 3, vg = w >> 2; f32x16 uu[4]; uu[0] = f32x16{}; uu[1] = f32x16{}; uu[2] = f32x16{}; uu[3] = f32x16{};
#pragma unroll
      for (int ks = 0; ks < 4; ++ks) { const LDS3 char* ap = l3 + G1_KD + (16 * ks + 8 * hi + q4) * 320 + (dt * 32 + 16 * blk + 4 * p4) * 2; const bf16x8 a = cat8(tr16(ap), tr16(ap + 4 * 320));
#pragma unroll
          for (int vi = 0; vi < 4; ++vi) { const int vt = 4 * vg + vi; const LDS3 char* vp = l3 + G1_V + (16 * ks + 8 * hi + q4) * 576 + (vt * 32 + 16 * blk + 4 * p4) * 2; const bf16x8 vf = cat8(tr16(vp), tr16(vp + 4 * 576)); uu[vi] = MFMA32(a, vf, uu[vi]); } }
      __syncthreads();
      bf16_t* SU = (bf16_t*)(lds + G1_SU); bf16_t* SO = (bf16_t*)(lds + G1_SO);
#pragma unroll
      for (int vi = 0; vi < 4; ++vi)
#pragma unroll
          for (int rr = 0; rr < 16; ++rr) SU[(dt * 32 + crow(rr, hi)) * 264 + (4 * vg + vi) * 32 + r32] = (bf16_t)(cvt_pk_bf16(uu[vi][rr], 0.f) & 0xffffu);
#pragma unroll
      for (int vi = 0; vi < 2; ++vi)
#pragma unroll
          for (int rr = 0; rr < 16; ++rr) SO[(it * 32 + crow(rr, hi)) * 264 + (2 * vq + vi) * 32 + r32] = (bf16_t)(cvt_pk_bf16(oi[vi][rr], 0.f) & 0xffffu);
      __syncthreads();
      bf16_t* ug = (bf16_t*)(ws + WS_U) + (size_t)item * 128 * 256; bf16_t* og = (bf16_t*)(ws + WS_OINTRA);
#pragma unroll
      for (int pp = 0; pp < 8; ++pp) { const int idx = tid + 512 * pp, row = idx >> 5, c = idx & 31; *(u32x4*)(ug + (size_t)row * 256 + c * 8) = *(const u32x4*)(SU + row * 264 + c * 8); }
#pragma unroll
      for (int pp = 0; pp < 4; ++pp) { const int idx = tid + 512 * pp, row = idx >> 5, c = idx & 31; *(u32x4*)(og + (size_t)(tok0 + row) * 1024 + h * 256 + c * 8) = *(const u32x4*)(SO + row * 264 + c * 8); } }
    __syncthreads();
}

__device__ __forceinline__ void phase_scan_combine(const Params& p) {
    unsigned char* ws = opaque(p.ws); const int G = gridDim.x;
    { const bf16_t* U = (const bf16_t*)(ws + WS_U); bf16_t* PV = (bf16_t*)(ws + WS_PREV); const float* DEC = (const float*)(ws + WS_DEC);
      for (int idx = blockIdx.x * 512 + tid_(); idx < 16 * 128 * 64; idx += G * 512) { const int bh = idx >> 13, rem = idx & 8191, d = rem >> 6, vq = rem & 63;
          float st[4] = {0.f, 0.f, 0.f, 0.f}; const size_t e0 = ((size_t)bh * 64 * 128 + d) * 256 + vq * 4;
#pragma unroll 8
          for (int n = 0; n < 64; ++n) { const size_t e = e0 + (size_t)n * 128 * 256; const u32x2 uw = *(const u32x2*)(U + e); const float dc = DEC[(size_t)(bh * 64 + n) * 128 + d];
              u32x2 pw; pw.x = cvt_pk_bf16(st[0], st[1]); pw.y = cvt_pk_bf16(st[2], st[3]); *(u32x2*)(PV + e) = pw;
              st[0] = dc * st[0] + bf_lo(uw.x); st[1] = dc * st[1] + bf_hi(uw.x); st[2] = dc * st[2] + bf_lo(uw.y); st[3] = dc * st[3] + bf_hi(uw.y); } } }
    { const bf16_t* OG = (const bf16_t*)(ws + WS_OATT); const float* LSE = (const float*)(ws + WS_LSE); bf16_t* YA = (bf16_t*)(ws + WS_YATT);
#pragma unroll 2
      for (int idx = blockIdx.x * 512 + tid_(); idx < NTOK * 64; idx += G * 512) { const int tok = idx >> 6, jc = idx & 63, jh = jc >> 3;
          const float l0 = LSE[(size_t)tok * 8 + jh], l1 = LSE[((size_t)NTOK + tok) * 8 + jh], l2 = LSE[((size_t)2 * NTOK + tok) * 8 + jh];
          const float m = fmaxf(l0, fmaxf(l1, l2)); float a0 = __expf(l0 - m), a1 = __expf(l1 - m), a2 = __expf(l2 - m); const float inv = __builtin_amdgcn_rcpf(a0 + a1 + a2); a0 *= inv; a1 *= inv; a2 *= inv;
          float o0[8], o1[8], o2[8], y[8]; const size_t off = (size_t)tok * 512 + jc * 8;
          unpack8(*(const u32x4*)(OG + off), o0); unpack8(*(const u32x4*)(OG + (size_t)NTOK * 512 + off), o1); unpack8(*(const u32x4*)(OG + (size_t)2 * NTOK * 512 + off), o2);
#pragma unroll
          for (int q = 0; q < 8; ++q) y[q] = a0 * o0[q] + a1 * o1[q] + a2 * o2[q];
          *(u32x4*)(YA + off) = pack8(y); } }
}

constexpr int G3_PREV = 0;
constexpr int G3_SS = G3_PREV + 128 * 576;
constexpr int G3_OI = G3_SS + 8 * 32 * 4;
constexpr int G3_GR = G3_OI + 64 * 528;
constexpr int G3_END = G3_GR + 64 * 528;
static_assert(G3_END <= LDS_XB, "gla3 LDS");
struct G3Pre { u32x4 pv[8], oi[4], gr[4]; };
__device__ __forceinline__ void gla3_fetch(const Params& p, int item, G3Pre& r) {
    unsigned char* ws = opaque(p.ws); const int tid = tid_();
    const int n = item & 63, bh = item >> 6, h = bh & 3, b = bh >> 2; const int tok0 = b * SEQ + n * 64;
    const bf16_t* PV = (const bf16_t*)(ws + WS_PREV) + (size_t)item * 128 * 256;
#pragma unroll
    for (int pp = 0; pp < 8; ++pp) { const int idx = tid + 512 * pp, d = idx >> 5, c = idx & 31; r.pv[pp] = *(const u32x4*)(PV + (size_t)d * 256 + c * 8); }
#pragma unroll
    for (int pp = 0; pp < 4; ++pp) { const int idx = tid + 512 * pp, row = idx >> 5, c = idx & 31; const size_t go = (size_t)(tok0 + row) * 1024 + h * 256 + c * 8;
        r.oi[pp] = *(const u32x4*)((const bf16_t*)(ws + WS_OINTRA) + go); r.gr[pp] = *(const u32x4*)((const bf16_t*)(ws + WS_GR) + go); }
}
__device__ __forceinline__ void gla3_item(const Params& p, int item, int nitem, bool has_next, G3Pre& pre, char* lds) {
    unsigned char* ws = opaque(p.ws);
    const int tid = tid_(), lane = tid & 63, r32 = lane & 31, hi = lane >> 5; const int w = __builtin_amdgcn_readfirstlane(tid >> 6);
    const int n = item & 63, bh = item >> 6, h = bh & 3, b = bh >> 2; const int tok0 = b * SEQ + n * 64;
    bf16_t* SOI = (bf16_t*)(lds + G3_OI); bf16_t* SGR = (bf16_t*)(lds + G3_GR);
#pragma unroll
    for (int pp = 0; pp < 8; ++pp) { const int idx = tid + 512 * pp, d = idx >> 5, c = idx & 31; *(u32x4*)(lds + G3_PREV + d * 576 + c * 16) = pre.pv[pp]; }
#pragma unroll
    for (int pp = 0; pp < 4; ++pp) { const int idx = tid + 512 * pp, row = idx >> 5, c = idx & 31; *(u32x4*)(SOI + row * 264 + c * 8) = pre.oi[pp]; *(u32x4*)(SGR + row * 264 + c * 8) = pre.gr[pp]; }
    const int it = w & 1, vq = w >> 1; const bf16_t* qeg = (const bf16_t*)(ws + WS_QE) + (size_t)(tok0 + it * 32 + r32) * 512 + h * 128;
    bf16x8 qa[8];
#pragma unroll
    for (int s = 0; s < 8; ++s) qa[s] = *(const bf16x8*)(qeg + 16 * s + 8 * hi);
    __syncthreads();
    if (has_next) gla3_fetch(p, nitem, pre);
    const LDS3 char* l3 = (const LDS3 char*)lds; const int blk = (lane >> 4) & 1, q4 = (lane & 15) >> 2, p4 = lane & 3;
    f32x16 o[2];
#pragma unroll
    for (int vi = 0; vi < 2; ++vi)
#pragma unroll
        for (int rr = 0; rr < 16; ++rr) o[vi][rr] = bf2f(SOI[(it * 32 + crow(rr, hi)) * 264 + (2 * vq + vi) * 32 + r32]);
#pragma unroll
    for (int s = 0; s < 8; ++s)
#pragma unroll
        for (int vi = 0; vi < 2; ++vi) { const int vt = 2 * vq + vi; const LDS3 char* pp_ = l3 + G3_PREV + (16 * s + 8 * hi + q4) * 576 + (vt * 32 + 16 * blk + 4 * p4) * 2; const bf16x8 pf = cat8(tr16(pp_), tr16(pp_ + 4 * 576)); o[vi] = MFMA32(qa[s], pf, o[vi]); }
    float* SS = (float*)(lds + G3_SS);
#pragma unroll
    for (int rr = 0; rr < 16; ++rr) { float q = o[0][rr] * o[0][rr] + o[1][rr] * o[1][rr]; q += __shfl_xor(q, 16); q += __shfl_xor(q, 8); q += __shfl_xor(q, 4); q += __shfl_xor(q, 2); q += __shfl_xor(q, 1);
        if (r32 == 0) SS[w * 32 + crow(rr, hi)] = q; }
    __syncthreads();
    float ng[2]; ng[0] = p.gla_norm_g[(2 * vq) * 32 + r32]; ng[1] = p.gla_norm_g[(2 * vq + 1) * 32 + r32];
#pragma unroll
    for (int rr = 0; rr < 16; ++rr) { const int row = crow(rr, hi); const float tot = SS[(it + 0) * 32 + row] + SS[(it + 2) * 32 + row] + SS[(it + 4) * 32 + row] + SS[(it + 6) * 32 + row];
        const float rs = rsqrtf(tot * (1.0f / 256.0f) + EPS);
#pragma unroll
        for (int vi = 0; vi < 2; ++vi) { const int li = (it * 32 + row) * 264 + (2 * vq + vi) * 32 + r32; const float y = o[vi][rr] * rs * ng[vi] * bf2f(SGR[li]); SOI[li] = (bf16_t)(cvt_pk_bf16(y, 0.f) & 0xffffu); } }
    __syncthreads();
    bf16_t* yg = (bf16_t*)(ws + WS_YGLA);
#pragma unroll
    for (int pp = 0; pp < 4; ++pp) { const int idx = tid + 512 * pp, row = idx >> 5, c = idx & 31; *(u32x4*)(yg + (size_t)(tok0 + row) * 1024 + h * 256 + c * 8) = *(const u32x4*)(SOI + row * 264 + c * 8); }
    __syncthreads();
}

constexpr int RT_RSTD = 0;
constexpr int RT_LOG = 256;
constexpr int RT_CNT = RT_LOG + 64 * 32 * 4;
__device__ __forceinline__ void route_group(const Params& p, int grp, char* lds) {
    unsigned char* ws = opaque(p.ws); const int tid = tid_(), lane = tid & 63; const int w = __builtin_amdgcn_readfirstlane(tid >> 6);
    const bf16_t* H = (const bf16_t*)(ws + WS_H); const float* RWG = (const float*)(ws + WS_RWG);
    float* RSTD = (float*)(lds + RT_RSTD); float* LOGS = (float*)(lds + RT_LOG); int* LCNT = (int*)(lds + RT_CNT);
    const int tok0 = grp * 64;
    if (tid < 32) LCNT[tid] = 0;
    if (w < 4) { const int tl = lane & 15, kq = lane >> 4; const bf16_t* hr = H + (size_t)(tok0 + w * 16 + tl) * 1024 + kq * 256; const float* br = RWG + (size_t)(kq * 256) * 32 + tl;
        f32x4 a0 = {0.f, 0.f, 0.f, 0.f}, a1 = {0.f, 0.f, 0.f, 0.f}; float ss = 0.f;
#pragma unroll 4
        for (int m4 = 0; m4 < 64; ++m4) { const f32x4 hv = bf4_to_f32(*(const u32x2*)(hr + m4 * 4));
#pragma unroll
            for (int q = 0; q < 4; ++q) { const float b0 = br[(size_t)(m4 * 4 + q) * 32], b1 = br[(size_t)(m4 * 4 + q) * 32 + 16];
                a0 = __builtin_amdgcn_mfma_f32_16x16x4f32(hv[q], b0, a0, 0, 0, 0); a1 = __builtin_amdgcn_mfma_f32_16x16x4f32(hv[q], b1, a1, 0, 0, 0); ss += hv[q] * hv[q]; } }
        ss += __shfl_xor(ss, 16); ss += __shfl_xor(ss, 32);
        const float rs = rsqrtf(ss * (1.0f / 1024.0f) + EPS);
        if (kq == 0) RSTD[w * 16 + tl] = rs;
#pragma unroll
        for (int rg = 0; rg < 4; ++rg) { const int t = w * 16 + 4 * kq + rg; LOGS[t * 32 + tl] = a0[rg]; LOGS[t * 32 + 16 + tl] = a1[rg]; } }
    __syncthreads();
    if (tid < 64) { const int tok = tok0 + tid; const float rs = RSTD[tid]; float lg[32];
#pragma unroll
        for (int e = 0; e < 32; ++e) lg[e] = LOGS[tid * 32 + e] * rs + p.router_b[e];
        int be[4]; float bv[4];
#pragma unroll
        for (int k = 0; k < 4; ++k) { float best = -3.0e38f; int bi = 0;
#pragma unroll
            for (int e = 0; e < 32; ++e) { const bool tk = lg[e] > best; best = tk ? lg[e] : best; bi = tk ? e : bi; }
            be[k] = bi; bv[k] = best;
#pragma unroll
            for (int e = 0; e < 32; ++e) lg[e] = (e == bi) ? -3.0e38f : lg[e]; }
        const float e1 = __expf(bv[1] - bv[0]), e2 = __expf(bv[2] - bv[0]), e3 = __expf(bv[3] - bv[0]); const float inv = 1.0f / (1.0f + e1 + e2 + e3);
        const float gt[4] = {inv, e1 * inv, e2 * inv, e3 * inv};
#pragma unroll
        for (int k = 0; k < 4; ++k) { const int pos = atomicAdd(&LCNT[be[k]], 1);
            ((int*)(ws + WS_TOPE))[tok * 4 + k] = be[k]; ((float*)(ws + WS_TOPG))[tok * 4 + k] = gt[k]; ((int*)(ws + WS_TOPP))[tok * 4 + k] = pos; } }
    { unsigned char* HN = ws + WS_HN;
#pragma unroll 2
      for (int i = 0; i < 8; ++i) { const int idx = tid + 512 * i, t = idx >> 6, c = idx & 63; const float rs = RSTD[t]; const size_t off = (size_t)(tok0 + t) * 1024 + c * 16; u32x4 wv;
#pragma unroll
          for (int q = 0; q < 4; ++q) { const f32x4 h0 = bf4_to_f32(*(const u32x2*)(H + off + 4 * q)), g0 = *(const f32x4*)(p.norm_ffn_g + c * 16 + 4 * q); wv[q] = (unsigned)pk4_fp8(h0[0] * rs * g0[0], h0[1] * rs * g0[1], h0[2] * rs * g0[2], h0[3] * rs * g0[3]); }
          *(u32x4*)(HN + off) = wv; } }
    __syncthreads();
    if (tid < 32) ((int*)(ws + WS_CNT))[grp * 32 + tid] = LCNT[tid];
    __syncthreads();
}

constexpr int DP_TOT = 0;
constexpr int DP_PART = 512;
__device__ __forceinline__ void dispatch_tables(const Params& p, int grp, char* lds) {
    unsigned char* ws = opaque(p.ws); const int tid = tid_(); const int* CNT = (const int*)(ws + WS_CNT); int* T = (int*)(lds + DP_TOT); int* PART = (int*)(lds + DP_PART);
    { const int e = tid & 31, part = tid >> 5; int tot = 0, pre = 0;
      for (int g2 = part * 16; g2 < part * 16 + 16; ++g2) { const int c = CNT[g2 * 32 + e]; tot += c; if (g2 < grp) pre += c; }
      PART[part * 32 + e] = tot; PART[512 + part * 32 + e] = pre; }
    __syncthreads();
    if (tid < 32) { int tot = 0, pre = 0; for (int q = 0; q < 16; ++q) { tot += PART[q * 32 + tid]; pre += PART[512 + q * 32 + tid]; } T[tid] = tot; T[64 + tid] = pre; }
    __syncthreads();
    if (tid == 0) { int base = 0; for (int e = 0; e < 32; ++e) { T[32 + e] = base; base += (T[e] + 255) >> 8; } T[96] = base; }
    __syncthreads();
}
__device__ __forceinline__ void dispatch_group(const Params& p, int grp, char* lds) {
    unsigned char* ws = opaque(p.ws); const int tid = tid_();
    dispatch_tables(p, grp, lds);
    const int* T = (const int*)(lds + DP_TOT); int* DEST = (int*)(lds + DP_PART + 4096);
    if (tid < 256) { const int tok = grp * 64 + (tid >> 2); const int e = ((const int*)(ws + WS_TOPE))[tok * 4 + (tid & 3)], lp = ((const int*)(ws + WS_TOPP))[tok * 4 + (tid & 3)];
        const int dest = T[32 + e] * 256 + T[64 + e] + lp; DEST[tid] = dest; ((int*)(ws + WS_SLOT))[tok * 4 + (tid & 3)] = dest; }
    __syncthreads();
    if (tid < 256) ((int*)(ws + WS_XPAD))[DEST[tid]] = (grp * 64 + (tid >> 2)) * 1024;
    __syncthreads();
}

__device__ __forceinline__ void phase_combine(const Params& p) {
    unsigned char* ws = opaque(p.ws); const int tid = tid_(), lane = tid & 63, wid = tid >> 6, G = gridDim.x;
    const bf16_t* H = (const bf16_t*)(ws + WS_H); const unsigned char* YP = ws + WS_YPAD;
    for (int tok = blockIdx.x * 8 + wid; tok < NTOK; tok += G * 8) {
        int sl[4]; float gt[4];
#pragma unroll
        for (int k = 0; k < 4; ++k) { sl[k] = ((const int*)(ws + WS_SLOT))[tok * 4 + k]; gt[k] = ((const float*)(ws + WS_TOPG))[tok * 4 + k]; }
        f32x4 v[4]; float ss = 0.f;
#pragma unroll
        for (int i = 0; i < 4; ++i) { const int col = i * 256 + lane * 4; v[i] = bf4_to_f32(*(const u32x2*)(H + (size_t)tok * 1024 + col));
#pragma unroll
            for (int k = 0; k < 4; ++k) { const unsigned yw = *(const unsigned*)(YP + (size_t)sl[k] * 1024 + col); const f32x2 lo = __builtin_amdgcn_cvt_pk_f32_fp8((int)yw, false), hi2 = __builtin_amdgcn_cvt_pk_f32_fp8((int)yw, true); v[i][0] += gt[k] * lo[0]; v[i][1] += gt[k] * lo[1]; v[i][2] += gt[k] * hi2[0]; v[i][3] += gt[k] * hi2[1]; }
            ss += v[i][0] * v[i][0] + v[i][1] * v[i][1] + v[i][2] * v[i][2] + v[i][3] * v[i][3]; }
        ss = wave_sum(ss); const float rs = rsqrtf(ss * (1.0f / 1024.0f) + EPS);
#pragma unroll
        for (int i = 0; i < 4; ++i) { const int col = i * 256 + lane * 4; const f32x4 g = *(const f32x4*)(p.norm_final_g + col); f32x4 o; o[0] = v[i][0] * rs * g[0]; o[1] = v[i][1] * rs * g[1]; o[2] = v[i][2] * rs * g[2]; o[3] = v[i][3] * rs * g[3];
            *(f32x4*)(p.out + (size_t)tok * 1024 + col) = o; } }
}


#define XB_TMO      128
#define XB_XCNT(j)  (256  + 64 * (j))
#define XB_XSUB(j)  (1280 + 64 * (j))
#define XB_XGEN(j)  (2304 + 64 * (j))
#define XB_TOP      3328
#define XB_TOPGEN   3392
#define XCD_BAR_WORDS 3456
#define XB_SPIN_CAP (1u << 18)
__device__ __forceinline__ unsigned xb_ld(unsigned* p)              { return __hip_atomic_load(p, __ATOMIC_RELAXED, __HIP_MEMORY_SCOPE_AGENT); }
__device__ __forceinline__ unsigned xb_add(unsigned* p, unsigned v) { return __hip_atomic_fetch_add(p, v, __ATOMIC_RELAXED, __HIP_MEMORY_SCOPE_AGENT); }
__device__ __forceinline__ unsigned xb_xcc_id() { return (unsigned)__builtin_amdgcn_s_getreg((3 << 11) | 20) & 0xFu; }
#define XB_SPIN(cond, bar) do { unsigned _sp = 0; while (cond) { __builtin_amdgcn_s_sleep(1); \
    if ((++_sp & 255u) == 0u) { if (xb_ld(&(bar)[XB_TMO])) break; if (_sp > XB_SPIN_CAP) { atomicAdd(&(bar)[XB_TMO], 1u); break; } } } } while (0)
struct XcdBarrier { unsigned* bar; unsigned x; volatile LDS3 unsigned* st; };
__device__ __forceinline__ XcdBarrier xcd_barrier_post(unsigned* bar, volatile LDS3 unsigned* st) {
    XcdBarrier b; b.bar = bar; b.x = xb_xcc_id(); b.st = st;
    if (tid_() == 0) (void)xb_add(&bar[XB_XCNT(b.x)], 1u);
    return b;
}
__device__ __forceinline__ void xcd_barrier_complete(unsigned* bar, unsigned x, unsigned& nloc, unsigned& nx) {
    const unsigned G = gridDim.x * gridDim.y * gridDim.z;
    unsigned sum, cnt, mine, sp = 0u;
    for (;;) {
        sum = 0u; cnt = 0u; mine = 0u;
#pragma unroll
        for (unsigned j = 0; j < 16; ++j) { const unsigned c = xb_ld(&bar[XB_XCNT(j)]); sum += c; cnt += (c > 0u) ? 1u : 0u; mine = (j == x) ? c : mine; }
        if (sum == G) break;
        __builtin_amdgcn_s_sleep(1);
        if ((++sp & 255u) == 0u) { if (xb_ld(&bar[XB_TMO])) break; if (sp > XB_SPIN_CAP) { atomicAdd(&bar[XB_TMO], 1u); break; } }
    }
    nloc = mine > 0u ? mine : 1u; nx = cnt > 0u ? cnt : 1u;
}
__device__ __forceinline__ void xcd_barrier(const XcdBarrier& b) {
    asm volatile("s_waitcnt vmcnt(0)" ::: "memory");
    __syncthreads();
    if (tid_() == 0) {
        unsigned* bar = b.bar;
        __builtin_amdgcn_s_waitcnt(0);
        unsigned nloc = b.st[0], nx = b.st[1];
        if (nloc == 0u) { xcd_barrier_complete(bar, b.x, nloc, nx); b.st[0] = nloc; b.st[1] = nx; }
        const unsigned old = xb_add(&bar[XB_XSUB(b.x)], 1u);
        const unsigned gen = old / nloc;
        if (old + 1u == (gen + 1u) * nloc) {
            __builtin_amdgcn_fence(__ATOMIC_RELEASE, "agent");
            asm volatile("s_waitcnt vmcnt(0)" ::: "memory");
            const unsigned og = xb_add(&bar[XB_TOP], 1u);
            const unsigned tg = og / nx;
            if (og + 1u == (tg + 1u) * nx) xb_add(&bar[XB_TOPGEN], 1u);
            else XB_SPIN(xb_ld(&bar[XB_TOPGEN]) == tg, bar);
            __builtin_amdgcn_fence(__ATOMIC_ACQUIRE, "agent");
            xb_add(&bar[XB_XGEN(b.x)], 1u);
            asm volatile("s_waitcnt vmcnt(0)" ::: "memory");
        } else {
            XB_SPIN(xb_ld(&bar[XB_XGEN(b.x)]) == gen, bar);
            __builtin_amdgcn_fence(__ATOMIC_ACQUIRE, "agent");
            asm volatile("s_waitcnt vmcnt(0)" ::: "memory");
        }
    }
    __syncthreads();
}

__global__ void __launch_bounds__(512, 2) mega_fwd(Params p) {
    cg::grid_group grid = cg::this_grid();
    char* lds = smem; LDS3 unsigned char* lds3 = (LDS3 unsigned char*)smem;
    const int G = gridDim.x, bid = blockIdx.x;
    if (tid_() < 4) ((volatile LDS3 unsigned*)(lds3 + LDS_XB))[tid_()] = 0u;
    __syncthreads();
    const XcdBarrier xb = xcd_barrier_post((unsigned*)(p.ws + WS_BAR), (volatile LDS3 unsigned*)(lds3 + LDS_XB));
    for (int rep = 0; rep < REP_P0; ++rep) phase_prologue(p, lds);
    if (p.ws == nullptr) grid.sync();
    xcd_barrier(xb);
    for (int rep = 0; rep < REP_P1; ++rep) { const int nconv = (G >= 64) ? (G * 3) / 16 : 0, ngemm = G - nconv;
      if (bid >= ngemm) { expert_convert(p, lds, bid - ngemm, nconv, N_EXPERT_TILES_P0, N_EXPERT_TILES); }
      else { unsigned char* ws = opaque(p.ws);
        { pg8::DenseProbT<1> S; S.init(ws + WS_XN, ws + WS_W_IN, NTOK, pg8::sens_count() * 256, 1024, ngemm, bid);
          EpiProjT<false> E; E.ws = ws; pg8::gemm_phase(lds3, S, E); }
        { pg8::DenseProbT<2> S; S.init(ws + WS_XN8, ws + WS_WIN8, NTOK, (39 - pg8::sens_count()) * 256, 512  , ngemm, bid);
          EpiProjT<true> E; E.ws = ws; pg8::gemm_phase(lds3, S, E); } }
      if (nconv == 0) expert_convert(p, lds, bid, G, N_EXPERT_TILES_P0, N_EXPERT_TILES); }
    xcd_barrier(xb);
    for (int rep = 0; rep < REP_ATT; ++rep) { AttnPre pre; if (bid < 4 * 24 * 16) attn_fetch(p, bid, pre);
        for (int item = bid; item < 4 * 24 * 16; item += G) attn_item(p, item, item + G, item + G < 4 * 24 * 16, pre, lds); }
    for (int rep = 0; rep < REP_GLA1; ++rep) { G1Pre pre; if (bid < 1024) gla1_fetch(p, bid, pre); int hprev = -1;
        for (int item = bid; item < 1024; item += G) { const int h = (item >> 6) & 3; gla1_item(p, item, item + G, item + G < 1024, h != hprev, pre, lds); hprev = h; } }
    xcd_barrier(xb);
    for (int rep = 0; rep < REP_P3; ++rep) phase_scan_combine(p);
    xcd_barrier(xb);
    for (int rep = 0; rep < REP_P4; ++rep) { G3Pre pre; if (bid < 1024) gla3_fetch(p, bid, pre);
        for (int item = bid; item < 1024; item += G) gla3_item(p, item, item + G, item + G < 1024, pre, lds); }
    xcd_barrier(xb);
    for (int rep = 0; rep < REP_P5; ++rep) {
    { unsigned char* ws = opaque(p.ws); pg8::DenseProb S; S.init(ws + WS_YATT, ws + WS_W_A, NTOK, 1024, 512, G, bid);
      EpiGate<0> E; E.gate = (const bf16_t*)(ws + WS_SA); E.t1 = nullptr; E.out = (bf16_t*)(ws + WS_T1);
      pg8::gemm_phase(lds3, S, E); }
    { unsigned char* ws = opaque(p.ws); pg8::DenseProb S; S.init(ws + WS_YGLA, ws + WS_W_G, NTOK, 1024, 1024, G, bid);
      EpiGate<1> E; E.gate = (const bf16_t*)(ws + WS_SG); E.t1 = (const bf16_t*)(ws + WS_T1); E.out = (bf16_t*)(ws + WS_MERGED);
      pg8::gemm_phase(lds3, S, E); }
    }
    xcd_barrier(xb);
    for (int rep = 0; rep < REP_P6; ++rep) { unsigned char* ws = opaque(p.ws); pg8::DenseProb S; S.init(ws + WS_MERGED, ws + WS_W_MIX, NTOK, 1024, 1024, G, bid);
      EpiResid E; E.x = p.x; E.h = (bf16_t*)(ws + WS_H);
      pg8::gemm_phase(lds3, S, E); }
    xcd_barrier(xb);
    for (int rep = 0; rep < REP_P7; ++rep) for (int grp = bid; grp < 256; grp += G) route_group(p, grp, lds);
    xcd_barrier(xb);
    for (int rep = 0; rep < REP_P8; ++rep) for (int grp = bid; grp < 256; grp += G) dispatch_group(p, grp, lds);
    if (bid == 0) { unsigned char* ws = opaque(p.ws); dispatch_tables(p, -1, lds); const int* T = (const int*)(lds + DP_TOT); int* TE = (int*)(ws + WS_TILEE);
        if (tid_() < 32) { const int e = tid_(); for (int t = T[32 + e]; t < T[32 + e] + ((T[e] + 255) >> 8); ++t) TE[16 + t] = e; }
        if (tid_() == 0) TE[0] = T[96];
        for (int e = 0; e < 32; ++e) { const int nt_ = (T[e] + 255) >> 8; int* ro = (int*)(ws + WS_XPAD) + T[32 + e] * 256; for (int r = T[e] + tid_(); r < nt_ * 256; r += 512) ro[r] = 0; } }
    xcd_barrier(xb);
    for (int rep = 0; rep < REP_P9; ++rep) { unsigned char* ws = opaque(p.ws); const int* TE = (const int*)(ws + WS_TILEE);
      pg8::MoeProbT<true> S; S.A = (const char*)(ws + WS_HN); S.rowoff = (const int*)(ws + WS_XPAD); S.Bt = (const char*)(ws + WS_W_GU); S.K = 512  ; S.nN = 8; S.T = TE[0]; S.G = G; S.c = bid; S.estride = (size_t)2048 * 1024; S.tile_e = TE + 16;
      EpiAct E; E.bgu = p.e_b_gu; E.tile_e = TE + 16; E.act = ws + WS_ACT;
      pg8::gemm_phase(lds3, S, E); }
    xcd_barrier(xb);
    for (int rep = 0; rep < REP_P10; ++rep) { unsigned char* ws = opaque(p.ws); const int* TE = (const int*)(ws + WS_TILEE);
      pg8::MoeProbT<false> S; S.rowoff = nullptr; S.A = (const char*)(ws + WS_ACT); S.Bt = (const char*)(ws + WS_W_D); S.K = 512  ; S.nN = 4; S.T = TE[0]; S.G = G; S.c = bid; S.estride = (size_t)1024 * 1024; S.tile_e = TE + 16;
      EpiDown E; E.bd = p.e_b_d; E.tile_e = TE + 16; E.y = ws + WS_YPAD;
      pg8::gemm_phase(lds3, S, E); }
    xcd_barrier(xb);
    for (int rep = 0; rep < REP_P11; ++rep) phase_combine(p);
}

extern "C" void kernel_launch(void* const* d_in, const int* in_sizes, int n_in, void* d_out, int out_size, void* d_ws, size_t ws_size, hipStream_t stream) {
    static int grid = 0;
    if (grid == 0) {
        if (n_in != 17 || ws_size < WS_END) { fprintf(stderr, "kernel_launch: expected 17 inputs and >= %zu bytes of workspace (got %d, %zu); nothing launched\n", (size_t)WS_END, n_in, ws_size); grid = -1; return; }
        int dev = 0, cus = 0, per_cu = 0;
        if (hipGetDevice(&dev) != hipSuccess || hipDeviceGetAttribute(&cus, hipDeviceAttributeMultiprocessorCount, dev) != hipSuccess) { fprintf(stderr, "kernel_launch: device query failed\n"); grid = -1; return; }
        if (hipFuncSetAttribute((const void*)mega_fwd, hipFuncAttributeMaxDynamicSharedMemorySize, LDS_BYTES) != hipSuccess) { fprintf(stderr, "kernel_launch: hipFuncSetAttribute failed\n"); grid = -1; return; }
        if (hipOccupancyMaxActiveBlocksPerMultiprocessor(&per_cu, (const void*)mega_fwd, 512, LDS_BYTES) != hipSuccess || per_cu < 1) { fprintf(stderr, "kernel_launch: occupancy query failed (%d)\n", per_cu); grid = -1; return; }
        grid = cus;
    }
    if (grid < 0) return;
    Params p{};
    p.x = (const float*)d_in[0]; p.norm_mix_g = (const float*)d_in[1]; p.w_in = (const float*)d_in[2]; p.gla_gate_up = (const float*)d_in[3]; p.gla_gate_bias = (const float*)d_in[4]; p.gla_norm_g = (const float*)d_in[5];
    p.w_branch_gla = (const float*)d_in[6]; p.w_branch_att = (const float*)d_in[7]; p.w_mix_out = (const float*)d_in[8]; p.norm_ffn_g = (const float*)d_in[9]; p.router_w = (const float*)d_in[10]; p.router_b = (const float*)d_in[11];
    p.e_w_gu = (const float*)d_in[12]; p.e_b_gu = (const float*)d_in[13]; p.e_w_d = (const float*)d_in[14]; p.e_b_d = (const float*)d_in[15]; p.norm_final_g = (const float*)d_in[16];
    p.out = (float*)d_out; p.ws = (unsigned char*)d_ws;
    if (hipMemsetAsync((char*)d_ws + WS_BAR, 0, 3456 * 4, stream) != hipSuccess) { fprintf(stderr, "kernel_launch: memset of the barrier words failed\n"); return; }
    void* args[] = {&p};
    hipError_t e = hipLaunchCooperativeKernel((const void*)mega_fwd, dim3(grid), dim3(512), args, LDS_BYTES, stream);
    if (e != hipSuccess) fprintf(stderr, "kernel_launch: cooperative launch failed: %s (grid %d)\n", hipGetErrorString(e), grid);
}
```

```cpp
#include <hip/hip_runtime.h>
#include <hip/hip_cooperative_groups.h>
#include <cstdio>
#include <cstdint>
namespace cg = cooperative_groups;
#ifndef REP_P0
#define REP_P0 1
#define REP_P1 1
#define REP_ATT 1
#define REP_GLA1 1
#define REP_P3 1
#define REP_P4 1
#define REP_P5 1
#define REP_P6 1
#define REP_P7 1
#define REP_P8 1
#define REP_P9 1
#define REP_P10 1
#define REP_P11 1
#endif

#define LDS3 __attribute__((address_space(3)))
typedef unsigned short bf16_t;
typedef short bf16x8 __attribute__((ext_vector_type(8)));
typedef short s16x4 __attribute__((ext_vector_type(4)));
typedef short v4i16_t __attribute__((ext_vector_type(4)));
typedef float f32x4 __attribute__((ext_vector_type(4)));
typedef float f32x2 __attribute__((ext_vector_type(2)));
typedef float f32x16 __attribute__((ext_vector_type(16)));
typedef unsigned u32x4 __attribute__((ext_vector_type(4)));
typedef unsigned u32x2 __attribute__((ext_vector_type(2)));
typedef int i32x8 __attribute__((ext_vector_type(8)));
typedef int i32x4 __attribute__((ext_vector_type(4)));

constexpr int NTOK = 16384, DM = 1024, SEQ = 4096, NB = 4;
constexpr int INW = 9744, INWP = 9984;
constexpr int NEXP = 32, TOPK = 4, FF = 1024;
constexpr int MAXT = 288;
constexpr float EPS = 1e-5f;
constexpr float QSCALE = 0.125f * 1.4426950408889634f;
constexpr float LN2 = 0.6931471805599453f;

constexpr size_t al256(size_t x) { return (x + 255) & ~(size_t)255; }
constexpr size_t WS_W_IN = 0;
constexpr size_t WS_W_G = WS_W_IN + (size_t)INWP * 1024 * 2;
constexpr size_t WS_W_A = WS_W_G + (size_t)1024 * 1024 * 2;
constexpr size_t WS_W_MIX = WS_W_A + (size_t)1024 * 512 * 2;
constexpr size_t WS_W_GU = WS_W_MIX + (size_t)1024 * 1024 * 2;
constexpr size_t WS_W_D = WS_W_GU + (size_t)NEXP * 2048 * 1024;
constexpr size_t WS_ROPE_C = WS_W_D + (size_t)NEXP * 1024 * 1024;
constexpr size_t WS_ROPE_S = WS_ROPE_C + (size_t)SEQ * 8 * 4;
constexpr size_t WS_RWG = WS_ROPE_S + (size_t)SEQ * 8 * 4;
constexpr size_t WS_H = WS_RWG + (size_t)1024 * 32 * 4;
constexpr size_t WS_HN = WS_H + (size_t)NTOK * 1024 * 4;
constexpr size_t WS_TOPE = WS_HN + (size_t)NTOK * 1024;
constexpr size_t WS_TOPG = WS_TOPE + (size_t)NTOK * 4 * 4;
constexpr size_t WS_TOPP = WS_TOPG + (size_t)NTOK * 4 * 4;
constexpr size_t WS_SLOT = WS_TOPP + (size_t)NTOK * 4 * 4;
constexpr size_t WS_CNT = WS_SLOT + (size_t)NTOK * 4 * 4;
constexpr size_t WS_TILEE = WS_CNT + (size_t)256 * 32 * 4;
constexpr size_t WS_REGB = al256(WS_TILEE + (size_t)(MAXT + 32) * 4);
constexpr size_t WS_XN = WS_REGB;
constexpr size_t WS_GQ = WS_XN + (size_t)NTOK * 1024 * 2;
constexpr size_t WS_GK = WS_GQ + (size_t)NTOK * 512 * 2;
constexpr size_t WS_GV = WS_GK + (size_t)NTOK * 512 * 2;
constexpr size_t WS_GR = WS_GV + (size_t)NTOK * 1024 * 2;
constexpr size_t WS_SG = WS_GR + (size_t)NTOK * 1024 * 2;
constexpr size_t WS_SA = WS_SG + (size_t)NTOK * 1024 * 2;
constexpr size_t WS_AQ = WS_SA + (size_t)NTOK * 1024 * 2;
constexpr size_t WS_AK = WS_AQ + (size_t)NTOK * 1536 * 2;
constexpr size_t WS_AV = WS_AK + (size_t)NTOK * 1536 * 2;
constexpr size_t WS_GLR = WS_AV + (size_t)NTOK * 1536 * 2;
constexpr size_t WS_OATT = WS_GLR + (size_t)NTOK * 16 * 4;
constexpr size_t WS_LSE = WS_OATT + (size_t)3 * NTOK * 512 * 2;
constexpr size_t WS_QE = WS_LSE + (size_t)3 * NTOK * 8 * 4;
constexpr size_t WS_OINTRA = WS_QE + (size_t)NTOK * 512 * 2;
constexpr size_t WS_U = WS_OINTRA + (size_t)NTOK * 1024 * 2;
constexpr size_t WS_DEC = WS_U + (size_t)1024 * 128 * 256 * 2;
constexpr size_t WS_XN8 = WS_DEC + (size_t)1024 * 128 * 4;
constexpr size_t WS_WIN8 = WS_XN8 + (size_t)NTOK * 1024;
constexpr size_t WS_REGB_END = WS_WIN8 + (size_t)INWP * 1024;
constexpr size_t WS_PREV = WS_AQ;
constexpr size_t WS_YGLA = WS_AV;
constexpr size_t WS_YATT = WS_XN;
constexpr size_t WS_T1 = WS_GQ;
constexpr size_t WS_MERGED = WS_GV;
constexpr size_t PADROWS = (size_t)MAXT * 256;
constexpr size_t WS_XPAD = WS_REGB;
constexpr size_t WS_ACT = WS_XPAD + PADROWS * 1024;
constexpr size_t WS_YPAD = WS_ACT + PADROWS * 1024;
constexpr size_t WS_PAD_END = WS_YPAD + PADROWS * 1024;
constexpr size_t WS_BAR = al256(WS_REGB_END > WS_PAD_END ? WS_REGB_END : WS_PAD_END);
constexpr size_t WS_END = WS_BAR + 3456 * 4;
static_assert(WS_PAD_END <= WS_REGB_END + (1u << 30), "map");

constexpr int LDS_XB = 147456;
constexpr int LDS_TAB_OFF = 147456 + 16;
constexpr int LDS_BYTES = 147456 + 16 + 1024;

struct Params {
    const float *x, *norm_mix_g, *w_in, *gla_gate_up, *gla_gate_bias, *gla_norm_g, *w_branch_gla, *w_branch_att, *w_mix_out, *norm_ffn_g,
        *router_w, *router_b, *e_w_gu, *e_b_gu, *e_w_d, *e_b_d, *norm_final_g;
    float* out;
    unsigned char* ws;
};

__device__ __forceinline__ int tid_() { int t = threadIdx.x; asm volatile("" : "+v"(t)); return t; }
__device__ __forceinline__ unsigned char* opaque(unsigned char* q) { return q; }
__device__ __forceinline__ unsigned cvt_pk_bf16(float lo, float hi) { unsigned r; asm volatile("v_cvt_pk_bf16_f32 %0, %1, %2" : "=v"(r) : "v"(lo), "v"(hi)); return r; }
__device__ __forceinline__ float bf_lo(unsigned w) { return __uint_as_float(w << 16); }
__device__ __forceinline__ float bf_hi(unsigned w) { return __uint_as_float(w & 0xffff0000u); }
__device__ __forceinline__ float bf2f(bf16_t b) { return __uint_as_float(((unsigned)b) << 16); }
__device__ __forceinline__ u32x4 pack8(const float* v) { u32x4 w; w.x = cvt_pk_bf16(v[0], v[1]); w.y = cvt_pk_bf16(v[2], v[3]); w.z = cvt_pk_bf16(v[4], v[5]); w.w = cvt_pk_bf16(v[6], v[7]); return w; }
__device__ __forceinline__ void unpack8(u32x4 w, float* v) { v[0] = bf_lo(w.x); v[1] = bf_hi(w.x); v[2] = bf_lo(w.y); v[3] = bf_hi(w.y); v[4] = bf_lo(w.z); v[5] = bf_hi(w.z); v[6] = bf_lo(w.w); v[7] = bf_hi(w.w); }
__device__ __forceinline__ float sigmoidf_(float v) { return __builtin_amdgcn_rcpf(1.0f + __builtin_amdgcn_exp2f(v * -1.4426950408889634f)); }
__device__ __forceinline__ float wave_sum(float v) { v += __shfl_xor(v, 32); v += __shfl_xor(v, 16); v += __shfl_xor(v, 8); v += __shfl_xor(v, 4); v += __shfl_xor(v, 2); v += __shfl_xor(v, 1); return v; }
__device__ __forceinline__ s16x4 tr16(const LDS3 char* p) { return __builtin_bit_cast(s16x4, __builtin_amdgcn_ds_read_tr16_b64_v4i16((LDS3 v4i16_t*)p)); }
__device__ __forceinline__ bf16x8 cat8(s16x4 a, s16x4 b) { return (bf16x8){a[0], a[1], a[2], a[3], b[0], b[1], b[2], b[3]}; }
__device__ __forceinline__ int crow(int r, int hi) { return (r & 3) + 8 * (r >> 2) + 4 * hi; }
__device__ __forceinline__ void st_nt(void* p, u32x4 v) { __builtin_nontemporal_store(v, (u32x4*)p); }
__device__ __forceinline__ int pk4_fp8(float a, float b, float c, float d) { int w = __builtin_amdgcn_cvt_pk_fp8_f32(a, b, 0, false); return __builtin_amdgcn_cvt_pk_fp8_f32(c, d, w, true); }
__device__ __forceinline__ f32x4 bf4_to_f32(u32x2 w) { f32x4 r; r[0] = bf_lo(w.x); r[1] = bf_hi(w.x); r[2] = bf_lo(w.y); r[3] = bf_hi(w.y); return r; }
#define MFMA32(a, b, c) __builtin_amdgcn_mfma_f32_32x32x16_bf16(a, b, c, 0, 0, 0)

namespace pg8 {
constexpr int BM = 256, BK = 64, HALF = 128, HTB = HALF * BK * 2, STAGE_BYTES = 8 * HTB, NXCD = 8, WGM = 8;
constexpr bool GEMM_ALIGN_EPI = true;
constexpr bool GEMM_SP2 = true;
__host__ __device__ __forceinline__ int lds_byte(int r, int c) { const int st = (r >> 4) * 2 + (c >> 5), rr = r & 15, cc = c & 31, ob = rr * 64 + cc * 2; return st * 1024 + (ob ^ (((ob >> 9) & 1) << 5)); }
__host__ __device__ __forceinline__ void stage_rc(int b, int& R, int& C) { const int st = b / 1024, sb = b % 1024, swz = sb ^ (((sb >> 9) & 1) << 5); R = (st >> 1) * 16 + swz / 64; C = (st & 1) * 32 + (swz % 64) / 2; }
__host__ __device__ __forceinline__ int perm32(int rho) { const int n = rho >> 4, i = rho & 15; return 8 * (i >> 2) + 4 * n + (i & 3); }
struct Unit { int pm, pn; };

#ifndef SENSMASK
#define SENSMASK ((0xFFFull << 0) | (1ull << 38))
#endif
constexpr int sens_count() { int c = 0; for (int t = 0; t < 39; ++t) c += (int)((SENSMASK >> t) & 1ull); return c; }
__device__ __forceinline__ int subset_tile(int sub, int k) {
    int seen = 0, res = 0;
#pragma unroll
    for (int t = 0; t < 39; ++t) { const bool in = (((SENSMASK >> t) & 1ull) != 0ull) == (sub == 1); if (in) { if (seen == k) res = t; ++seen; } }
    return res; }
template <int SUBSET> struct DenseProbT {
    const char* A; const char* Bt; int K; int nM, nN, nwg, G, c;
    __device__ void init(const void* A_, const void* Bt_, int M, int N, int K_, int G_, int c_) { A = (const char*)A_; Bt = (const char*)Bt_; K = K_; nM = M / BM; nN = N / BM; nwg = nM * nN; G = G_; c = c_; }
    __device__ __forceinline__ bool next(int i, Unit& u) const {
        const long L = (long)i * G + c; if (L >= nwg) return false;
        int wgid = (int)L; { const int q = nwg / NXCD, r = nwg % NXCD, xcd = wgid % NXCD, off = wgid / NXCD; wgid = (xcd < r ? xcd * (q + 1) : r * (q + 1) + (xcd - r) * q) + off; }
        const int nig = WGM * nN, gid = wgid / nig, fm = gid * WGM, gsz = (nM - fm) < WGM ? (nM - fm) : WGM;
        u.pm = fm + ((wgid % nig) % gsz); int pn = (wgid % nig) / gsz;
        if (SUBSET != 0) pn = subset_tile(SUBSET, pn);
        u.pn = pn; return true;
    }
    __device__ __forceinline__ const char* a_ptr(const Unit& u) const { return A + (size_t)u.pm * BM * K * 2; }
    __device__ __forceinline__ const char* b_ptr(const Unit& u) const { return Bt + (size_t)u.pn * BM * K * 2; }
    static constexpr bool GATHER = false;
    __device__ __forceinline__ const int* rows(const Unit&) const { return nullptr; }
};
typedef DenseProbT<0> DenseProb;
template <bool GATHER_> struct MoeProbT {
    static constexpr bool GATHER = GATHER_;
    const char* A; const char* Bt; int K; int nN, T, G, c; size_t estride; const int* tile_e; const int* rowoff;
    __device__ __forceinline__ bool next(int i, Unit& u) const { const long L = (long)i * G + c; if (L >= (long)T * nN) return false; u.pm = (int)(L / nN); u.pn = (int)(L % nN); return true; }
    __device__ __forceinline__ const char* a_ptr(const Unit& u) const { return GATHER ? A : A + (size_t)u.pm * BM * K * 2; }
    __device__ __forceinline__ const char* b_ptr(const Unit& u) const { return Bt + (size_t)tile_e[u.pm] * estride + (size_t)u.pn * BM * K * 2; }
    __device__ __forceinline__ const int* rows(const Unit& u) const { return rowoff + u.pm * BM; }
};

template <class Epi, class Prob>
__device__ __forceinline__ void gemm_phase(LDS3 unsigned char* lds, const Prob& S, const Epi& E) {
    const int tid = tid_(), wid = __builtin_amdgcn_readfirstlane(tid >> 6), lane = tid & 63, wr = wid >> 2, wc = wid & 3, fr = lane & 15, fq = lane >> 4;
    const int K = S.K, nt = K / BK;
    unsigned voffA[2], voffB[2]; int Rrow[2];
#pragma unroll
    for (int i = 0; i < 2; ++i) { int R, C; stage_rc(tid * 16 + i * 8192, R, C); const int Rb = Epi::PERM ? (2 * (R & ~31) + perm32(R & 31)) : R;
        voffA[i] = (unsigned)(R * K + C) * 2u; voffB[i] = (unsigned)(Rb * K + C) * 2u; Rrow[i] = R; if (Prob::GATHER) voffA[i] = (unsigned)C * 2u; }
    const size_t kstep = (size_t)(BK * 2);
    const size_t hstep = (size_t)HALF * K * 2;
    const size_t hstepB = Epi::PERM ? (size_t)32 * K * 2 : hstep;
    const unsigned ldsw = (unsigned)wid * 1024u;
    const int aoff = lds_byte(wr * 64 + fr, fq * 8), boff = lds_byte(wc * 32 + fr, fq * 8);
#define PG8_SA(b, h) (((b) * 2 + (h)) * HTB)
#define PG8_SB(b, h) ((4 + (b) * 2 + (h)) * HTB)
#define PG8_STAGE(bufoff, gbase, voff) do { _Pragma("unroll") for (int _i = 0; _i < 2; ++_i) \
        __builtin_amdgcn_global_load_lds((const unsigned*)((const char*)(gbase) + (voff)[_i]), (LDS3 unsigned*)(lds + (bufoff) + ldsw + _i * 8192), 16, 0, 0); } while (0)
#define PG8_LD8(ptr) __builtin_shufflevector(*(const LDS3 i32x4*)(ptr), *(const LDS3 i32x4*)((ptr) + 1024), 0, 1, 2, 3, 4, 5, 6, 7)
#define PG8_LO(x) __builtin_bit_cast(bf16x8, __builtin_shufflevector(x, x, 0, 1, 2, 3))
#define PG8_HI(x) __builtin_bit_cast(bf16x8, __builtin_shufflevector(x, x, 4, 5, 6, 7))
#define PG8_LDA(dst, b, h) do { _Pragma("unroll") for (int m = 0; m < 4; ++m) dst[m] = PG8_LD8(lds + PG8_SA(b, h) + aoff + m * 2048); } while (0)
#define PG8_LDB(dst, b, h) do { _Pragma("unroll") for (int n = 0; n < 2; ++n) dst[n] = PG8_LD8(lds + PG8_SB(b, h) + boff + n * 2048); } while (0)
#define PG8_MMA(ai, bj, At, Bt) do { __builtin_amdgcn_s_setprio(1); _Pragma("unroll") for (int m = 0; m < 4; ++m) _Pragma("unroll") for (int n = 0; n < 2; ++n) { \
        if constexpr (Epi::FP8) asm volatile("v_mfma_scale_f32_16x16x128_f8f6f4 %0, %1, %2, %0, %3, %4 op_sel_hi:[0,0,0]" : "+v"(acc[ai][bj][m][n]) : "v"(Bt[n]), "v"(At[m]), "v"(sc_w), "v"(sc_1)); \
        else { acc[ai][bj][m][n] = __builtin_amdgcn_mfma_f32_16x16x32_bf16(PG8_LO(Bt[n]), PG8_LO(At[m]), acc[ai][bj][m][n], 0, 0, 0); acc[ai][bj][m][n] = __builtin_amdgcn_mfma_f32_16x16x32_bf16(PG8_HI(Bt[n]), PG8_HI(At[m]), acc[ai][bj][m][n], 0, 0, 0); } } __builtin_amdgcn_s_setprio(0); } while (0)
#define PG8_WAIT_V(n) asm volatile("s_waitcnt vmcnt(" #n ")" ::: "memory")
#define PG8_WAIT_L(n) asm volatile("s_waitcnt lgkmcnt(" #n ")" ::: "memory")
#define PG8_BAR __builtin_amdgcn_s_barrier()
#define PG8_SCHED __builtin_amdgcn_sched_barrier(0)
    Unit cur, nxt; int ui = 0;
    if (!S.next(0, cur)) return;
    f32x4 acc[2][2][4][2];
#pragma unroll
    for (int a = 0; a < 2; ++a)
#pragma unroll
        for (int b = 0; b < 2; ++b)
#pragma unroll
            for (int m = 0; m < 4; ++m)
#pragma unroll
                for (int n = 0; n < 2; ++n) acc[a][b][m][n] = (f32x4){0.f, 0.f, 0.f, 0.f};
    i32x8 At[4], B0[2], B1[2];
    int sc_w = 0x7A7A7A7A  , sc_1 = 0x7F7F7F7F; asm volatile("" : "+v"(sc_w), "+v"(sc_1));
    const char* cA = S.a_ptr(cur); const char* cB = S.b_ptr(cur);
    unsigned vAc[2][2], vAn[2][2];
    LDS3 int* rtab = (LDS3 int*)(lds + LDS_TAB_OFF);
    if constexpr (Prob::GATHER) { const int* rw = S.rows(cur);
#pragma unroll
        for (int h = 0; h < 2; ++h)
#pragma unroll
            for (int i = 0; i < 2; ++i) vAc[h][i] = (unsigned)rw[h * HALF + Rrow[i]] + voffA[i];
    } else {
#pragma unroll
        for (int h = 0; h < 2; ++h)
#pragma unroll
            for (int i = 0; i < 2; ++i) vAc[h][i] = voffA[i] + (unsigned)(h * hstep);
    }
#pragma unroll
    for (int h = 0; h < 2; ++h)
#pragma unroll
        for (int i = 0; i < 2; ++i) vAn[h][i] = vAc[h][i];
    if constexpr (GEMM_SP2) {
        PG8_STAGE(PG8_SB(0, 0), cB, voffB); PG8_STAGE(PG8_SB(0, 1), cB + hstepB, voffB); PG8_STAGE(PG8_SA(0, 0), cA, vAc[0]); PG8_STAGE(PG8_SA(0, 1), cA, vAc[1]);
        if (wr == 1) PG8_BAR;
        PG8_WAIT_V(2); PG8_BAR;
        PG8_STAGE(PG8_SB(1, 0), cB + kstep, voffB); PG8_STAGE(PG8_SA(1, 0), cA + kstep, vAc[0]); PG8_STAGE(PG8_SB(1, 1), cB + hstepB + kstep, voffB);
        PG8_WAIT_V(6); PG8_BAR;
    } else {
    PG8_STAGE(PG8_SB(0, 0), cB, voffB); PG8_STAGE(PG8_SA(0, 0), cA, vAc[0]); PG8_STAGE(PG8_SB(0, 1), cB + hstepB, voffB); PG8_STAGE(PG8_SA(0, 1), cA, vAc[1]);
    if (wr == 1) PG8_BAR;
    PG8_WAIT_V(4); PG8_BAR;
    PG8_STAGE(PG8_SB(1, 0), cB + kstep, voffB); PG8_STAGE(PG8_SA(1, 0), cA + kstep, vAc[0]); PG8_STAGE(PG8_SB(1, 1), cB + hstepB + kstep, voffB);
    PG8_WAIT_V(6); PG8_BAR;
    }
    for (;;) {
        const bool has_next = S.next(ui + 1, nxt);
        const char* nA = has_next ? S.a_ptr(nxt) : cA; const char* nB = has_next ? S.b_ptr(nxt) : cB;
        if constexpr (Prob::GATHER) { if (has_next && wid < 4) __builtin_amdgcn_global_load_lds((const unsigned*)(S.rows(nxt) + wid * 64 + lane), (LDS3 unsigned*)(lds + LDS_TAB_OFF + wid * 256), 4, 0, 0); }
        for (int t = 0; t < nt; t += 2) {
            const bool last = (t == nt - 2);
            const char* a1 = cA + (size_t)(t + 1) * kstep;
            const char* a2 = last ? nA : cA + (size_t)(t + 2) * kstep; const char* b2 = last ? nB : cB + (size_t)(t + 2) * kstep;
            const char* a3 = a2 + kstep; const char* b3 = b2 + kstep;
            if constexpr (Prob::GATHER) { if (last && has_next) {
#pragma unroll
                for (int h = 0; h < 2; ++h)
#pragma unroll
                    for (int i = 0; i < 2; ++i) vAn[h][i] = (unsigned)rtab[h * HALF + Rrow[i]] + voffA[i]; } }
            unsigned vS[2][2];
#pragma unroll
            for (int h = 0; h < 2; ++h)
#pragma unroll
                for (int i = 0; i < 2; ++i) vS[h][i] = last ? vAn[h][i] : vAc[h][i];
            if constexpr (GEMM_SP2) {
            PG8_LDB(B0, 0, 0); PG8_LDB(B1, 0, 1); PG8_SCHED; PG8_LDA(At, 0, 0); PG8_STAGE(PG8_SA(1, 1), a1, vAc[1]);
            PG8_WAIT_V(8); PG8_WAIT_L(0); PG8_BAR; PG8_MMA(0, 0, At, B0); PG8_MMA(0, 1, At, B1); PG8_BAR; PG8_SCHED;
            PG8_LDA(At, 0, 1); PG8_STAGE(PG8_SB(0, 0), b2, voffB); PG8_STAGE(PG8_SB(0, 1), b2 + hstepB, voffB); PG8_STAGE(PG8_SA(0, 0), a2, vS[0]);
            PG8_WAIT_V(8); PG8_WAIT_L(0); PG8_BAR; PG8_MMA(1, 0, At, B0); PG8_MMA(1, 1, At, B1); PG8_BAR; PG8_SCHED;
            PG8_LDB(B0, 1, 0); PG8_LDB(B1, 1, 1); PG8_SCHED; PG8_LDA(At, 1, 0); PG8_STAGE(PG8_SA(0, 1), a2, vS[1]);
            PG8_WAIT_V(8); PG8_WAIT_L(0); PG8_BAR; PG8_MMA(0, 0, At, B0); PG8_MMA(0, 1, At, B1); PG8_BAR; PG8_SCHED;
            PG8_LDA(At, 1, 1); PG8_STAGE(PG8_SB(1, 0), b3, voffB); PG8_STAGE(PG8_SB(1, 1), b3 + hstepB, voffB); PG8_STAGE(PG8_SA(1, 0), a3, vS[0]);
            PG8_WAIT_V(8); PG8_WAIT_L(0); PG8_BAR; PG8_MMA(1, 0, At, B0); PG8_MMA(1, 1, At, B1); PG8_BAR; PG8_SCHED;
            } else {
            PG8_LDB(B0, 0, 0); PG8_SCHED; PG8_LDA(At, 0, 0); PG8_STAGE(PG8_SA(1, 1), a1, vAc[1]);
            PG8_WAIT_L(8); PG8_BAR; PG8_WAIT_L(0); PG8_MMA(0, 0, At, B0); PG8_BAR; PG8_SCHED;
            PG8_LDB(B1, 0, 1); PG8_STAGE(PG8_SB(0, 0), b2, voffB);
            PG8_BAR; PG8_WAIT_L(0); PG8_MMA(0, 1, At, B1); PG8_BAR;
            PG8_LDA(At, 0, 1); PG8_STAGE(PG8_SA(0, 0), a2, vS[0]);
            PG8_BAR; PG8_WAIT_L(0); PG8_MMA(1, 0, At, B0); PG8_BAR; PG8_SCHED;
            PG8_STAGE(PG8_SB(0, 1), b2 + hstepB, voffB);
            PG8_WAIT_V(6); PG8_BAR; PG8_MMA(1, 1, At, B1); PG8_BAR;
            PG8_LDB(B0, 1, 0); PG8_SCHED; PG8_LDA(At, 1, 0); PG8_STAGE(PG8_SA(0, 1), a2, vS[1]);
            PG8_WAIT_L(8); PG8_BAR; PG8_WAIT_L(0); PG8_MMA(0, 0, At, B0); PG8_BAR; PG8_SCHED;
            PG8_LDB(B1, 1, 1); PG8_STAGE(PG8_SB(1, 0), b3, voffB);
            PG8_BAR; PG8_WAIT_L(0); PG8_MMA(0, 1, At, B1); PG8_BAR;
            PG8_LDA(At, 1, 1); PG8_STAGE(PG8_SA(1, 0), a3, vS[0]);
            PG8_BAR; PG8_WAIT_L(0); PG8_MMA(1, 0, At, B0); PG8_BAR; PG8_SCHED;
            PG8_STAGE(PG8_SB(1, 1), b3 + hstepB, voffB);
            PG8_WAIT_V(6); PG8_BAR; PG8_MMA(1, 1, At, B1); PG8_BAR;
            }
        }
        if constexpr (GEMM_ALIGN_EPI) { if (wr == 0) PG8_BAR; }
        if constexpr (Epi::FP8) asm volatile("s_nop 15\n\ts_nop 15" ::: "memory");
        E(acc, cur, wr, wc, fr, fq);
        if (!has_next) break;
#pragma unroll
        for (int a = 0; a < 2; ++a)
#pragma unroll
            for (int b = 0; b < 2; ++b)
#pragma unroll
                for (int m = 0; m < 4; ++m)
#pragma unroll
                    for (int n = 0; n < 2; ++n) acc[a][b][m][n] = (f32x4){0.f, 0.f, 0.f, 0.f};
        if constexpr (Epi::FP8) asm volatile("s_nop 7" ::: "memory");
        cur = nxt; cA = nA; cB = nB; ++ui;
#pragma unroll
        for (int h = 0; h < 2; ++h)
#pragma unroll
            for (int i = 0; i < 2; ++i) vAc[h][i] = vAn[h][i];
        if constexpr (GEMM_ALIGN_EPI) { if (wr == 1) PG8_BAR; }
    }
    PG8_WAIT_V(0);
    if constexpr (!GEMM_ALIGN_EPI) { if (wr == 0) PG8_BAR; }
    PG8_BAR;
#undef PG8_SA
#undef PG8_SB
#undef PG8_STAGE
#undef PG8_LDA
#undef PG8_LDB
#undef PG8_MMA
#undef PG8_LD8
#undef PG8_LO
#undef PG8_HI
#undef PG8_WAIT_V
#undef PG8_WAIT_L
#undef PG8_BAR
#undef PG8_SCHED
}
}
using pg8::Unit;

extern __shared__ __attribute__((aligned(16))) char smem[];
__device__ __forceinline__ char* smem_base() { return smem; }

constexpr int EPI_LDS = 131072;
__device__ __forceinline__ char* epi_slot(int wr, int wc) { return smem_base() + EPI_LDS + (wr * 4 + wc) * 2048; }
__device__ __forceinline__ void slot_put(char* slot, int fr, int fq, u32x4 w0, u32x4 w1) {
    *(u32x4*)(slot + fr * 128 + (((fq) ^ (fr & 7)) << 4)) = w0; *(u32x4*)(slot + fr * 128 + (((4 + fq) ^ (fr & 7)) << 4)) = w1; }
__device__ __forceinline__ u32x4 slot_get(const char* slot, int half, int lane) { const int row = half * 8 + (lane >> 3), ch = lane & 7; return *(const u32x4*)(slot + row * 128 + ((ch ^ (row & 7)) << 4)); }

#define EPI_ROWS(ai, m) for (int ai = 0; ai < 2; ++ai) _Pragma("unroll") for (int m = 0; m < 4; ++m)

template <bool F8_> struct EpiProjT {
    static constexpr bool PERM = true, FP8 = F8_;
    unsigned char* ws;
    __device__ __forceinline__ void operator()(const f32x4 (&acc)[2][2][4][2], const Unit& u, int wr, int wc, int fr, int fq) const {
        const int pn = u.pn; const int lane = fq * 16 + fr; char* slot = epi_slot(wr, wc);
        const int rowq = u.pm * 256 + wr * 64 + (lane >> 3);
        if (pn < 12 || (pn >= 30 && pn < 38)) {
            size_t boff; int ld, col0, act;
            if (pn < 2) { boff = WS_GQ; ld = 512; col0 = pn * 256; act = 0; }
            else if (pn < 4) { boff = WS_GK; ld = 512; col0 = (pn - 2) * 256; act = 0; }
            else if (pn < 8) { boff = WS_GV; ld = 1024; col0 = (pn - 4) * 256; act = 0; }
            else if (pn < 12) { boff = WS_GR; ld = 1024; col0 = (pn - 8) * 256; act = 1; }
            else if (pn < 34) { boff = WS_SG; ld = 1024; col0 = (pn - 30) * 256; act = 2; }
            else { boff = WS_SA; ld = 1024; col0 = (pn - 34) * 256; act = 2; }
            bf16_t* base = (bf16_t*)(ws + boff) + col0 + wc * 64 + (lane & 7) * 8;
#pragma unroll
            EPI_ROWS(ai, m) { u32x4 w[2];
#pragma unroll
                for (int bj = 0; bj < 2; ++bj) { float v[8];
#pragma unroll
                    for (int j = 0; j < 4; ++j) { v[j] = acc[ai][bj][m][0][j]; v[4 + j] = acc[ai][bj][m][1][j]; }
                    if (act == 1) {
#pragma unroll
                        for (int j = 0; j < 8; ++j) v[j] = v[j] * sigmoidf_(v[j]); }
                    if (act == 2) {
#pragma unroll
                        for (int j = 0; j < 8; ++j) v[j] = sigmoidf_(v[j]); }
                    w[bj] = pack8(v); }
                slot_put(slot, fr, fq, w[0], w[1]);
#pragma unroll
                for (int half = 0; half < 2; ++half) st_nt(base + (size_t)(rowq + ai * 128 + m * 16 + half * 8) * ld, slot_get(slot, half, lane)); }
        } else if (pn < 30) {
            const int which = (pn - 12) / 6, t6 = (pn - 12) % 6, sh = (t6 >> 1) * 2, dmask = (1 << sh) - 1, NL = SEQ >> sh;
            unsigned char* base = ws + WS_AQ + (size_t)which * ((size_t)NTOK * 1536 * 2) + (lane & 3) * 16;
            const bool rot = (which < 2) && (fq < 2);
            f32x4 frev;
#pragma unroll
            for (int q = 0; q < 4; ++q) frev[q] = rot ? __builtin_amdgcn_exp2f(-(float)(4 * fq + q) * (0.125f * 18.931568569324174f)) * 0.15915494309189535f : 0.f;
            const int head = t6 * 4 + wc;
            const int rowq4 = u.pm * 256 + wr * 64 + (lane >> 2);
#pragma unroll
            EPI_ROWS(ai, m) { const int s = (u.pm * 256 + wr * 64 + fr + ai * 128 + m * 16) & (SEQ - 1);
                f32x4 cs, sn;
#pragma unroll
                for (int q = 0; q < 4; ++q) { const float rev = __builtin_amdgcn_fractf((float)s * frev[q]); cs[q] = __builtin_amdgcn_cosf(rev); sn[q] = __builtin_amdgcn_sinf(rev); }
#pragma unroll
                for (int bj = 0; bj < 2; ++bj) { float v[8];
#pragma unroll
                    for (int j = 0; j < 4; ++j) { v[j] = acc[ai][bj][m][0][j]; v[4 + j] = acc[ai][bj][m][1][j]; }
                    if (bj == 0) { const float a0 = v[0] * cs[0] - v[1] * sn[0], a1 = v[1] * cs[0] + v[0] * sn[0], a2 = v[2] * cs[1] - v[3] * sn[1], a3 = v[3] * cs[1] + v[2] * sn[1];
                      const float a4 = v[4] * cs[2] - v[5] * sn[2], a5 = v[5] * cs[2] + v[4] * sn[2], a6 = v[6] * cs[3] - v[7] * sn[3], a7 = v[7] * cs[3] + v[6] * sn[3];
                      v[0] = a0; v[1] = a1; v[2] = a2; v[3] = a3; v[4] = a4; v[5] = a5; v[6] = a6; v[7] = a7; }
                    u32x2 w8; w8.x = (unsigned)pk4_fp8(v[0], v[1], v[2], v[3]); w8.y = (unsigned)pk4_fp8(v[4], v[5], v[6], v[7]);
                    *(u32x2*)(slot + fr * 64 + bj * 32 + 8 * fq) = w8; }
                const u32x4 o = *(const u32x4*)(slot + (lane >> 2) * 64 + (lane & 3) * 16);
                const int row = rowq4 + ai * 128 + m * 16, b = row >> 12, s2 = row & (SEQ - 1), r = s2 & dmask, n = s2 >> sh;
                st_nt(base + ((size_t)(b * 24 + head) * SEQ + (size_t)r * NL + n) * 64, o); }
        } else {
            const int row0 = u.pm * 256 + wr * 64 + fr;
            if (wc == 0 && fq < 2) { float* glr = (float*)(ws + WS_GLR);
#pragma unroll
                EPI_ROWS(ai, m) { float* rowp = glr + (size_t)(row0 + ai * 128 + m * 16) * 16 + 8 * fq; *(f32x4*)rowp = acc[ai][0][m][0]; *(f32x4*)(rowp + 4) = acc[ai][0][m][1]; } }
        }
    }
};

template <int MODE> struct EpiGate {
    static constexpr bool PERM = true, FP8 = false;
    const bf16_t* gate; const bf16_t* t1; bf16_t* out;
    __device__ __forceinline__ void operator()(const f32x4 (&acc)[2][2][4][2], const Unit& u, int wr, int wc, int fr, int fq) const {
        const int lane = fq * 16 + fr; char* slot = epi_slot(wr, wc);
        const size_t off0 = (size_t)(u.pm * 256 + wr * 64 + (lane >> 3)) * 1024 + u.pn * 256 + wc * 64 + (lane & 7) * 8;
#pragma unroll
        for (int ai = 0; ai < 2; ++ai) { u32x4 gw[4][2], tw[4][2];
#pragma unroll
            for (int m = 0; m < 4; ++m)
#pragma unroll
                for (int half = 0; half < 2; ++half) { const size_t off = off0 + (size_t)(ai * 128 + m * 16 + half * 8) * 1024; gw[m][half] = *(const u32x4*)(gate + off); if (MODE == 1) tw[m][half] = *(const u32x4*)(t1 + off); }
#pragma unroll
            for (int m = 0; m < 4; ++m) { u32x4 w[2];
#pragma unroll
                for (int bj = 0; bj < 2; ++bj) { float v[8];
#pragma unroll
                    for (int j = 0; j < 4; ++j) { v[j] = acc[ai][bj][m][0][j]; v[4 + j] = acc[ai][bj][m][1][j]; }
                    w[bj] = pack8(v); }
                slot_put(slot, fr, fq, w[0], w[1]);
#pragma unroll
                for (int half = 0; half < 2; ++half) { float a[8], g[8]; unpack8(slot_get(slot, half, lane), a); unpack8(gw[m][half], g);
#pragma unroll
                    for (int j = 0; j < 8; ++j) a[j] *= g[j];
                    if (MODE == 1) { float t[8]; unpack8(tw[m][half], t);
#pragma unroll
                        for (int j = 0; j < 8; ++j) a[j] += t[j]; }
                    *(u32x4*)(out + off0 + (size_t)(ai * 128 + m * 16 + half * 8) * 1024) = pack8(a); } } }
    }
};

struct EpiResid {
    static constexpr bool PERM = false, FP8 = false;
    const float* x; bf16_t* h;
    __device__ __forceinline__ void operator()(const f32x4 (&acc)[2][2][4][2], const Unit& u, int wr, int wc, int fr, int fq) const {
        const int lane = fq * 16 + fr; char* slot = epi_slot(wr, wc);
        const size_t off0 = (size_t)(u.pm * 256 + wr * 64 + (lane >> 3)) * 1024 + u.pn * 256 + wc * 32 + (lane & 7) * 4;
#pragma unroll
        for (int ai = 0; ai < 2; ++ai)
#pragma unroll
            for (int bj = 0; bj < 2; ++bj) { f32x4 xv[4][2];
#pragma unroll
                for (int m = 0; m < 4; ++m)
#pragma unroll
                    for (int half = 0; half < 2; ++half) xv[m][half] = *(const f32x4*)(x + off0 + (size_t)(ai * 128 + m * 16 + half * 8) * 1024 + bj * 128);
#pragma unroll
                for (int m = 0; m < 4; ++m) { slot_put(slot, fr, fq, __builtin_bit_cast(u32x4, acc[ai][bj][m][0]), __builtin_bit_cast(u32x4, acc[ai][bj][m][1]));
#pragma unroll
                    for (int half = 0; half < 2; ++half) { const f32x4 a = __builtin_bit_cast(f32x4, slot_get(slot, half, lane));
                        const f32x4 r = a + xv[m][half]; u32x2 w2; w2.x = cvt_pk_bf16(r[0], r[1]); w2.y = cvt_pk_bf16(r[2], r[3]);
                        *(u32x2*)(h + off0 + (size_t)(ai * 128 + m * 16 + half * 8) * 1024 + bj * 128) = w2; } } }
    }
};

struct EpiAct {
    static constexpr bool PERM = true, FP8 = true;
    const float* bgu; const int* tile_e; unsigned char* act;
    __device__ __forceinline__ void operator()(const f32x4 (&acc)[2][2][4][2], const Unit& u, int wr, int wc, int fr, int fq) const {
        const int e = tile_e[u.pm]; const int row0 = u.pm * 256 + wr * 64 + fr; const int j0 = u.pn * 128 + wc * 32 + 8 * fq;
        float bg[8], bu[8];
        { const float* bp = bgu + (size_t)e * 2048 + 2 * j0;
#pragma unroll
          for (int q = 0; q < 4; ++q) { const f32x4 t = *(const f32x4*)(bp + 4 * q); bg[2 * q] = t[0]; bu[2 * q] = t[1]; bg[2 * q + 1] = t[2]; bu[2 * q + 1] = t[3]; } }
#pragma unroll
        EPI_ROWS(ai, m) { float v[8];
#pragma unroll
            for (int j = 0; j < 8; ++j) { const float gt = acc[ai][0][m][j >> 2][j & 3] + bg[j], up = acc[ai][1][m][j >> 2][j & 3] + bu[j];
                const float g = fminf(gt, 7.0f), uu = fminf(fmaxf(up, -7.0f), 7.0f); v[j] = (uu + 1.0f) * (g * sigmoidf_(1.702f * g)); }
            u32x2 w8; w8.x = (unsigned)pk4_fp8(v[0], v[1], v[2], v[3]); w8.y = (unsigned)pk4_fp8(v[4], v[5], v[6], v[7]);
            *(u32x2*)(act + (size_t)(row0 + ai * 128 + m * 16) * 1024 + j0) = w8; }
    }
};

struct EpiDown {
    static constexpr bool PERM = true, FP8 = true;
    const float* bd; const int* tile_e; unsigned char* y;
    __device__ __forceinline__ void operator()(const f32x4 (&acc)[2][2][4][2], const Unit& u, int wr, int wc, int fr, int fq) const {
        const int e = tile_e[u.pm]; const int lane = fq * 16 + fr; char* slot = epi_slot(wr, wc); const int col0 = u.pn * 256 + wc * 64 + 8 * fq;
        f32x4 b[2][2];
#pragma unroll
        for (int bj = 0; bj < 2; ++bj)
#pragma unroll
            for (int n = 0; n < 2; ++n) b[bj][n] = *(const f32x4*)(bd + (size_t)e * 1024 + col0 + bj * 32 + 4 * n);
        unsigned char* base = y + (size_t)(u.pm * 256 + wr * 64 + (lane >> 2)) * 1024 + u.pn * 256 + wc * 64 + (lane & 3) * 16;
#pragma unroll
        EPI_ROWS(ai, m) { u32x2 w[2];
#pragma unroll
            for (int bj = 0; bj < 2; ++bj) { const f32x4 v0 = acc[ai][bj][m][0] + b[bj][0], v1 = acc[ai][bj][m][1] + b[bj][1];
                w[bj].x = (unsigned)pk4_fp8(v0[0], v0[1], v0[2], v0[3]); w[bj].y = (unsigned)pk4_fp8(v1[0], v1[1], v1[2], v1[3]); }
            *(u32x2*)(slot + fr * 64 + 8 * fq) = w[0]; *(u32x2*)(slot + fr * 64 + 32 + 8 * fq) = w[1];
            const u32x4 o = *(const u32x4*)(slot + (lane >> 2) * 64 + (lane & 3) * 16);
            *(u32x4*)(base + (size_t)(ai * 128 + m * 16) * 1024) = o; }
    }
};

__device__ __forceinline__ int win_colmap(int n) {
    if (n < 3072) return n;
    if (n < 7680) { const int off = n - 3072, which = off / 1536, hcol = off % 1536, head = hcol >> 6, p = hcol & 63;
        int dim = p; if (which < 2 && p < 16) dim = (p & 1) ? (p >> 1) + 8 : (p >> 1);
        return 3088 + which * 1536 + head * 64 + dim; }
    if (n < 9728) return 7696 + (n - 7680);
    if (n < 9744) return 3072 + (n - 9728);
    return -1;
}
__device__ __forceinline__ int gu_colmap(int n) { const int t = n >> 8, w = n & 255, wc = w >> 6, bj = (w >> 5) & 1, rho = w & 31; return 2 * (128 * t + 32 * wc + rho) + bj; }

__device__ __forceinline__ void transpose_tile(const float* src, int ld_src, bf16_t* dst, int K, int n0, int k0, int scol, char* lds) {
    const int t = tid_(), nl = t & 127, kq = t >> 7;
#pragma unroll
    for (int cc = 0; cc < 4; ++cc) { const int c = kq * 4 + cc; float v[8];
#pragma unroll
        for (int j = 0; j < 8; ++j) v[j] = scol >= 0 ? src[(size_t)(k0 + c * 8 + j) * ld_src + scol] : 0.f;
        *(u32x4*)(lds + nl * 256 + ((c ^ (nl & 15)) << 4)) = pack8(v); }
    __syncthreads();
#pragma unroll
    for (int pass = 0; pass < 4; ++pass) { const int idx = t + 512 * pass, n2 = idx >> 4, c2 = idx & 15;
        *(u32x4*)(dst + (size_t)(n0 + n2) * K + k0 + c2 * 8) = *(const u32x4*)(lds + n2 * 256 + ((c2 ^ (n2 & 15)) << 4)); }
    __syncthreads();
}

__device__ __forceinline__ void transpose_tile8(const float* src, int ld_src, unsigned char* dst, int K, int n0, int k0, int scol, float scale, char* lds) {
    const int t = tid_(), nl = t & 127, kq = t >> 7;
#pragma unroll
    for (int cc = 0; cc < 4; ++cc) { const int c = kq * 4 + cc; float v[16];
#pragma unroll
        for (int j = 0; j < 16; ++j) v[j] = scol >= 0 ? src[(size_t)(k0 + c * 16 + j) * ld_src + scol] * scale : 0.f;
        u32x4 w; w.x = (unsigned)pk4_fp8(v[0], v[1], v[2], v[3]); w.y = (unsigned)pk4_fp8(v[4], v[5], v[6], v[7]); w.z = (unsigned)pk4_fp8(v[8], v[9], v[10], v[11]); w.w = (unsigned)pk4_fp8(v[12], v[13], v[14], v[15]);
        *(u32x4*)(lds + nl * 256 + ((c ^ (nl & 15)) << 4)) = w; }
    __syncthreads();
#pragma unroll
    for (int pass = 0; pass < 4; ++pass) { const int idx = t + 512 * pass, n2 = idx >> 4, c2 = idx & 15;
        *(u32x4*)(dst + (size_t)(n0 + n2) * K + k0 + c2 * 16) = *(const u32x4*)(lds + n2 * 256 + ((c2 ^ (n2 & 15)) << 4)); }
    __syncthreads();
}

template <int MAP> __device__ __forceinline__ int tile_rowmap(int o) {
    if (MAP == 1) { const int d = o & 63; const int pp = d < 16 ? (d < 8 ? 2 * d : 2 * (d - 8) + 1) : d; return (o & 64) + pp; }
    if (MAP == 2) { const int wcl = o >> 6, w = o & 63; return 64 * wcl + 32 * (w & 1) + (w >> 1); }
    return o;
}
template <int MAP, bool F8> __device__ __forceinline__ void transpose_fast(const float* src  , int ld_src, unsigned char* dst, int Kb  , int n0, int k0, float scale, char* lds) {
    constexpr int KPT = F8 ? 16 : 8;
    const int t = tid_(), ng = t & 31, kg = t >> 5;
    f32x4 v[KPT];
#pragma unroll
    for (int j = 0; j < KPT; ++j) v[j] = *(const f32x4*)(src + (size_t)(k0 + kg * KPT + j) * ld_src + 4 * ng);
#pragma unroll
    for (int i = 0; i < 4; ++i) { const int row = tile_rowmap<MAP>(4 * ng + i); u32x4 w;
        if (F8) { w.x = (unsigned)pk4_fp8(v[0][i] * scale, v[1][i] * scale, v[2][i] * scale, v[3][i] * scale); w.y = (unsigned)pk4_fp8(v[4][i] * scale, v[5][i] * scale, v[6][i] * scale, v[7][i] * scale);
                  w.z = (unsigned)pk4_fp8(v[8 % KPT][i] * scale, v[9 % KPT][i] * scale, v[10 % KPT][i] * scale, v[11 % KPT][i] * scale); w.w = (unsigned)pk4_fp8(v[12 % KPT][i] * scale, v[13 % KPT][i] * scale, v[14 % KPT][i] * scale, v[15 % KPT][i] * scale); }
        else { w.x = cvt_pk_bf16(v[0][i], v[1][i]); w.y = cvt_pk_bf16(v[2][i], v[3][i]); w.z = cvt_pk_bf16(v[4][i], v[5][i]); w.w = cvt_pk_bf16(v[6][i], v[7][i]); }
        *(u32x4*)(lds + row * 256 + ((kg ^ (row & 15)) << 4)) = w; }
    __syncthreads();
#pragma unroll
    for (int pass = 0; pass < 4; ++pass) { const int idx = t + 512 * pass, n2 = idx >> 4, c2 = idx & 15;
        *(u32x4*)(dst + (size_t)(n0 + n2) * Kb + (size_t)k0 * (F8 ? 1 : 2) + c2 * 16) = *(const u32x4*)(lds + n2 * 256 + ((c2 ^ (n2 & 15)) << 4)); }
    __syncthreads();
}

constexpr int N_EXPERT_TILES_P0 = 1024;
__device__ __forceinline__ void expert_convert(const Params& p, char* lds, int first, int stride, int lo, int hi);
__device__ __forceinline__ void phase_prologue(const Params& p, char* lds) {
    unsigned char* ws = opaque(p.ws);
    const int tid = tid_(), lane = tid & 63, wid = tid >> 6, G = gridDim.x, bid = blockIdx.x;
    { bf16_t* xn = (bf16_t*)(ws + WS_XN); unsigned char* xn8 = ws + WS_XN8;
      for (int row = bid * 8 + wid; row < NTOK; row += G * 8) { const float* xr = p.x + (size_t)row * 1024; f32x4 v[4]; float ss = 0.f;
#pragma unroll
          for (int i = 0; i < 4; ++i) { v[i] = *(const f32x4*)(xr + i * 256 + lane * 4); ss += v[i][0] * v[i][0] + v[i][1] * v[i][1] + v[i][2] * v[i][2] + v[i][3] * v[i][3]; }
          ss = wave_sum(ss); const float rs = rsqrtf(ss * (1.0f / 1024.0f) + EPS);
#pragma unroll
          for (int i = 0; i < 4; ++i) { const f32x4 g = *(const f32x4*)(p.norm_mix_g + i * 256 + lane * 4); const float y0 = v[i][0] * rs * g[0], y1 = v[i][1] * rs * g[1], y2 = v[i][2] * rs * g[2], y3 = v[i][3] * rs * g[3];
              u32x2 w; w.x = cvt_pk_bf16(y0, y1); w.y = cvt_pk_bf16(y2, y3);
              *(u32x2*)(xn + (size_t)row * 1024 + i * 256 + lane * 4) = w; *(unsigned*)(xn8 + (size_t)row * 1024 + i * 256 + lane * 4) = (unsigned)pk4_fp8(y0, y1, y2, y3); } } }
    { float* rwg = (float*)(ws + WS_RWG);
      for (int i = bid * 512 + tid; i < 1024 * 32; i += G * 512) rwg[i] = p.router_w[i] * p.norm_ffn_g[i >> 5]; }
    { constexpr int T0 = 78 * 8, T1 = T0 + 64, T2 = T1 + 32, T3 = T2 + 64, T4 = T3 + 32 * 64, T5 = T4 + 32 * 32;
      const int nl = tid & 127;
      for (int tile = bid; tile < T3; tile += G) {
          if (tile < T0) { const int nt_ = tile >> 3, kt = tile & 7; const int t256 = nt_ >> 1; const bool sens = ((SENSMASK >> t256) & 1ull) != 0ull;
              bf16_t* d = (bf16_t*)(ws + WS_W_IN); unsigned char* d16 = ws + WS_W_IN; unsigned char* d8 = ws + WS_WIN8;
              const float* srcg = nt_ < 24 ? p.w_in + nt_ * 128 : (nt_ < 60 ? p.w_in + 3088 + (nt_ - 24) * 128 : p.w_in + 7696 + (nt_ - 60) * 128); const bool rotmap = nt_ >= 24 && nt_ < 48;
              if (sens) {
                  if (nt_ >= 76) transpose_tile(p.w_in, INW, d, 1024, nt_ * 128, kt * 128, win_colmap(nt_ * 128 + nl), lds);
                  else if (rotmap) transpose_fast<1, false>(srcg, INW, d16, 2048, nt_ * 128, kt * 128, 1.f, lds);
                  else transpose_fast<0, false>(srcg, INW, d16, 2048, nt_ * 128, kt * 128, 1.f, lds);
              } else if (kt < 4) {
                  if (nt_ >= 76) transpose_tile8(p.w_in, INW, d8, 1024, nt_ * 128, kt * 256, win_colmap(nt_ * 128 + nl), 32.f, lds);
                  else if (rotmap) transpose_fast<1, true>(srcg, INW, d8, 1024, nt_ * 128, kt * 256, 32.f, lds);
                  else transpose_fast<0, true>(srcg, INW, d8, 1024, nt_ * 128, kt * 256, 32.f, lds);
              } }
          else if (tile < T1) { const int q = tile - T0, nt_ = q >> 3, kt = q & 7; transpose_fast<0, false>(p.w_branch_gla + nt_ * 128, 1024, ws + WS_W_G, 2048, nt_ * 128, kt * 128, 1.f, lds); }
          else if (tile < T2) { const int q = tile - T1, nt_ = q >> 2, kt = q & 3; transpose_fast<0, false>(p.w_branch_att + nt_ * 128, 1024, ws + WS_W_A, 1024, nt_ * 128, kt * 128, 1.f, lds); }
          else if (tile < T3) { const int q = tile - T2, nt_ = q >> 3, kt = q & 7; transpose_fast<0, false>(p.w_mix_out + nt_ * 128, 1024, ws + WS_W_MIX, 2048, nt_ * 128, kt * 128, 1.f, lds); }
      } }
    expert_convert(p, lds, bid, G, 0, N_EXPERT_TILES_P0);
}

constexpr int N_EXPERT_TILES = 32 * 64 + 32 * 32;
__device__ __forceinline__ void expert_convert(const Params& p, char* lds, int first, int stride, int lo, int hi) {
    unsigned char* ws = opaque(p.ws);
    for (int q0 = lo + first; q0 < hi; q0 += stride) {
        if (q0 < 32 * 64) { const int q = q0, e = q >> 6, r = q & 63, nt_ = r >> 2, kt = r & 3;
            transpose_fast<2, true>(p.e_w_gu + (size_t)e * 1024 * 2048 + nt_ * 128, 2048, ws + WS_W_GU + (size_t)e * 2048 * 1024, 1024, nt_ * 128, kt * 256, 32.0f, lds); }
        else { const int q = q0 - 32 * 64, e = q >> 5, r = q & 31, nt_ = r >> 2, kt = r & 3;
            transpose_fast<0, true>(p.e_w_d + (size_t)e * 1024 * 1024 + nt_ * 128, 1024, ws + WS_W_D + (size_t)e * 1024 * 1024, 1024, nt_ * 128, kt * 256, 32.0f, lds); }
    }
}

constexpr int AT_KCS = 385 * 16;
constexpr int AT_VH = 385 * 64;
constexpr int AT_K = 0, AT_V = 8 * AT_KCS, AT_WL = AT_V + 2 * AT_VH, AT_STG = AT_WL + 8 * 128, AT_END = AT_STG + 8 * 4096;
static_assert(AT_END <= LDS_BYTES, "attention LDS");
struct AttnPre { u32x4 k[3], v[3]; u32x2 q[4]; };
__device__ __forceinline__ void attn_fetch(const Params& p, int item, AttnPre& r) {
    unsigned char* ws = opaque(p.ws); const int tid = tid_();
    const int jj = item & 15, bh = item >> 4, head = bh % 24, g = head >> 3, sh = 2 * g, NL = SEQ >> sh, ppr = 16 >> sh; const int rr_ = jj / ppr, j = jj % ppr;
    const size_t hb = ((size_t)bh * SEQ + (size_t)rr_ * NL) * 64; const unsigned char* Kg = ws + WS_AK + hb; const unsigned char* Vg = ws + WS_AV + hb; const int kn0 = 256 * j - 128;
    { const int lane = tid & 63, r32 = lane & 31, hi = lane >> 5, w = tid >> 6; const unsigned char* Q = ws + WS_AQ + hb;
#pragma unroll
      for (int d0 = 0; d0 < 4; ++d0) r.q[d0] = *(const u32x2*)(Q + (size_t)(256 * j + 32 * w + r32) * 64 + d0 * 16 + hi * 8); }
#pragma unroll
    for (int i = 0; i < 3; ++i) { const int idx = tid + 512 * i, key = idx >> 2, c = idx & 3;
        if (kn0 + key >= 0) { r.k[i] = *(const u32x4*)(Kg + (ptrdiff_t)(kn0 + key) * 64 + c * 16); r.v[i] = *(const u32x4*)(Vg + (ptrdiff_t)(kn0 + key) * 64 + c * 16); } }
}
__device__ __forceinline__ u32x4 fp8x8_to_bf16(unsigned lo, unsigned hi_, float sc) {
    const f32x2 a = __builtin_amdgcn_cvt_pk_f32_fp8((int)lo, false), b = __builtin_amdgcn_cvt_pk_f32_fp8((int)lo, true), c = __builtin_amdgcn_cvt_pk_f32_fp8((int)hi_, false), d = __builtin_amdgcn_cvt_pk_f32_fp8((int)hi_, true);
    u32x4 w; w.x = cvt_pk_bf16(a[0] * sc, a[1] * sc); w.y = cvt_pk_bf16(b[0] * sc, b[1] * sc); w.z = cvt_pk_bf16(c[0] * sc, c[1] * sc); w.w = cvt_pk_bf16(d[0] * sc, d[1] * sc); return w; }
__device__ __forceinline__ void attn_item(const Params& p, int item, int nitem, bool has_next, AttnPre& pre, char* lds) {
    unsigned char* ws = opaque(p.ws);
    const int tid = tid_(), lane = tid & 63, r32 = lane & 31, hi = lane >> 5; const int w = __builtin_amdgcn_readfirstlane(tid >> 6);
    const int jj = item & 15, bh = item >> 4, head = bh % 24, b = bh / 24, g = head >> 3, sh = 2 * g, d = 1 << sh, NL = SEQ >> sh, ppr = 16 >> sh;
    const int r = jj / ppr, j = jj % ppr;
    const size_t hb = ((size_t)bh * SEQ + (size_t)r * NL) * 64;
    const bf16_t* Q = (const bf16_t*)(ws + WS_AQ) + hb;
    const int kn0 = 256 * j - 128;
    bf16x8 qf[4];
#pragma unroll
    for (int d0 = 0; d0 < 4; ++d0) qf[d0] = __builtin_bit_cast(bf16x8, fp8x8_to_bf16(pre.q[d0].x, pre.q[d0].y, QSCALE));
#pragma unroll
    for (int i = 0; i < 3; ++i) { const int idx = tid + 512 * i, key = idx >> 2, c4 = idx & 3;
        if (kn0 + key >= 0) {
#pragma unroll
            for (int hh = 0; hh < 2; ++hh) { const int c = 2 * c4 + hh;
                *(u32x4*)(lds + AT_K + c * AT_KCS + key * 16) = fp8x8_to_bf16(hh ? pre.k[i].z : pre.k[i].x, hh ? pre.k[i].w : pre.k[i].y, 1.0f);
                *(u32x4*)(lds + AT_V + (c >> 2) * AT_VH + key * 64 + (c & 3) * 16) = fp8x8_to_bf16(hh ? pre.v[i].z : pre.v[i].x, hh ? pre.v[i].w : pre.v[i].y, 1.0f); } } }
    __syncthreads();
    if (has_next) attn_fetch(p, nitem, pre);
    const LDS3 char* l3 = (const LDS3 char*)lds;
    f32x16 s[5]; const int ktmin = (j == 0) ? 4 : 0;
#pragma unroll
    for (int t5 = 0; t5 < 5; ++t5) { const int kt = w + t5;
        if (kt >= ktmin) { f32x16 a = {};
#pragma unroll
            for (int d0 = 0; d0 < 4; ++d0) { const bf16x8 kf = *(const LDS3 bf16x8*)(l3 + AT_K + (2 * d0 + hi) * AT_KCS + (kt * 32 + r32) * 16); a = MFMA32(kf, qf[d0], a); }
            s[t5] = a; }
        else {
#pragma unroll
            for (int rr = 0; rr < 16; ++rr) s[t5][rr] = -1e30f; } }
#pragma unroll
    for (int rr = 0; rr < 16; ++rr) { const int c = crow(rr, hi); if (c < r32) s[0][rr] = -1e30f; if (c > r32) s[4][rr] = -1e30f; }
    float mx = -1e30f;
#pragma unroll
    for (int t5 = 0; t5 < 5; ++t5)
#pragma unroll
        for (int rr = 0; rr < 16; ++rr) mx = fmaxf(mx, s[t5][rr]);
    mx = fmaxf(mx, __shfl_xor(mx, 32));
    float l = 0.f;
#pragma unroll
    for (int t5 = 0; t5 < 5; ++t5)
#pragma unroll
        for (int rr = 0; rr < 16; ++rr) { const float e = __builtin_amdgcn_exp2f(s[t5][rr] - mx); s[t5][rr] = e; l += e; }
    l += __shfl_xor(l, 32);
    f32x16 o[2]; o[0] = f32x16{}; o[1] = f32x16{};
    const int blk = (lane >> 4) & 1, q4 = (lane & 15) >> 2, p4 = lane & 3;
#pragma unroll
    for (int t5 = 0; t5 < 5; ++t5) { const int kt = w + t5;
        if (kt >= ktmin) {
#pragma unroll
            for (int ss = 0; ss < 2; ++ss) { float pv[8];
#pragma unroll
                for (int q = 0; q < 8; ++q) pv[q] = s[t5][8 * ss + q];
                const bf16x8 pa = __builtin_bit_cast(bf16x8, pack8(pv));
#pragma unroll
                for (int dh = 0; dh < 2; ++dh) { const LDS3 char* vp = l3 + AT_V + dh * AT_VH + (kt * 32 + 16 * ss + 4 * hi + q4) * 64 + (16 * blk + 4 * p4) * 2;
                    const bf16x8 vf = cat8(tr16(vp), tr16(vp + 8 * 64)); o[dh] = MFMA32(pa, vf, o[dh]); } } } }
    const int n_q = 256 * j + 32 * w + r32; const int tok = b * SEQ + n_q * d + r;
    if (hi == 0) { ((float*)(ws + WS_LSE))[((size_t)g * NTOK + tok) * 8 + (head & 7)] = (mx + __builtin_amdgcn_logf(l)) * LN2;
        ((float*)(lds + AT_WL))[w * 32 + r32] = __builtin_amdgcn_rcpf(l); }
    bf16_t* stg = (bf16_t*)(lds + AT_STG) + w * 2048;
#pragma unroll
    for (int rr = 0; rr < 16; ++rr) { const int qr = crow(rr, hi); const float rl = ((const float*)(lds + AT_WL))[w * 32 + qr];
#pragma unroll
        for (int dh = 0; dh < 2; ++dh) stg[qr * 64 + dh * 32 + r32] = (bf16_t)(cvt_pk_bf16(o[dh][rr] * rl, 0.f) & 0xffffu); }
    bf16_t* og = (bf16_t*)(ws + WS_OATT) + (size_t)g * NTOK * 512;
#pragma unroll
    for (int i = 0; i < 4; ++i) { const int idx = i * 64 + lane, row = idx >> 3, ch = idx & 7; const int tk = b * SEQ + (256 * j + 32 * w + row) * d + r;
        *(u32x4*)(og + (size_t)tk * 512 + (head & 7) * 64 + ch * 8) = *(const u32x4*)(stg + row * 64 + ch * 8); }
    __syncthreads();
}

constexpr int G1_BB = 0;
constexpr int G1_QE = G1_BB + 64 * 128 * 4;
constexpr int G1_KE = G1_QE + 64 * 272;
constexpr int G1_KD = G1_KE + 64 * 272;
constexpr int G1_V = G1_KD + 64 * 320;
constexpr int G1_GLR = G1_V + 64 * 576;
constexpr int G1_GUP = G1_GLR + 64 * 16 * 4;
constexpr int G1_SEG = G1_GUP + 16 * 128 * 4;
constexpr int G1_BIAS = G1_SEG + 4 * 128 * 4;
constexpr int G1_END = G1_BIAS + 128 * 4;
constexpr int G1_SU = 0;
constexpr int G1_SO = 128 * 528;
static_assert(G1_SO + 64 * 528 <= G1_GLR, "gla1 staging");
static_assert(G1_END <= LDS_BYTES, "gla1 LDS");
__device__ __forceinline__ float logsigmoidf_(float z) { return fminf(z, 0.f) - log1pf(__expf(-fabsf(z))); }
struct G1Pre { u32x4 q[2], k[2], v[4]; float glr[2]; };
__device__ __forceinline__ void gla1_fetch(const Params& p, int item, G1Pre& r) {
    unsigned char* ws = opaque(p.ws); const int tid = tid_();
    const int n = item & 63, bh = item >> 6, h = bh & 3, b = bh >> 2; const int tok0 = b * SEQ + n * 64;
    const bf16_t* gq = (const bf16_t*)(ws + WS_GQ); const bf16_t* gk = (const bf16_t*)(ws + WS_GK); const bf16_t* gv = (const bf16_t*)(ws + WS_GV);
#pragma unroll
    for (int pp = 0; pp < 2; ++pp) { const int idx = tid + 512 * pp, i = idx >> 4, c = idx & 15; const size_t go = (size_t)(tok0 + i) * 512 + h * 128 + c * 8; r.q[pp] = *(const u32x4*)(gq + go); r.k[pp] = *(const u32x4*)(gk + go);
        r.glr[pp] = ((const float*)(ws + WS_GLR))[(size_t)tok0 * 16 + idx]; }
#pragma unroll
    for (int pp = 0; pp < 4; ++pp) { const int idx = tid + 512 * pp, jv = idx >> 5, c = idx & 31; r.v[pp] = *(const u32x4*)(gv + (size_t)(tok0 + jv) * 1024 + h * 256 + c * 8); }
}
__device__ __forceinline__ void gla1_head_operands(const Params& p, int h, char* lds) {
    const int tid = tid_(); float* GUP = (float*)(lds + G1_GUP); float* BIAS = (float*)(lds + G1_BIAS);
    for (int i = tid; i < 16 * 128; i += 512) GUP[i] = p.gla_gate_up[(i >> 7) * 512 + h * 128 + (i & 127)];
    if (tid < 128) BIAS[tid] = p.gla_gate_bias[h * 128 + tid];
}
__device__ __forceinline__ void gla1_item(const Params& p, int item, int nitem, bool has_next, bool reload_head, G1Pre& pre, char* lds) {
    unsigned char* ws = opaque(p.ws);
    const int tid = tid_(), lane = tid & 63, r32 = lane & 31, hi = lane >> 5; const int w = __builtin_amdgcn_readfirstlane(tid >> 6);
    const int n = item & 63, bh = item >> 6, h = bh & 3, b = bh >> 2; const int tok0 = b * SEQ + n * 64;
    float* BB = (float*)(lds + G1_BB); float* GLRs = (float*)(lds + G1_GLR); float* GUP = (float*)(lds + G1_GUP); float* SEGs = (float*)(lds + G1_SEG); float* BIAS = (float*)(lds + G1_BIAS);
    u32x4 qraw[2], kraw[2], vraw[4];
#pragma unroll
    for (int pp = 0; pp < 2; ++pp) { qraw[pp] = pre.q[pp]; kraw[pp] = pre.k[pp]; GLRs[tid + 512 * pp] = pre.glr[pp]; }
#pragma unroll
    for (int pp = 0; pp < 4; ++pp) vraw[pp] = pre.v[pp];
    if (reload_head) gla1_head_operands(p, h, lds);
    __syncthreads();
    if (has_next) gla1_fetch(p, nitem, pre);
    { const int d = tid & 127, seg = tid >> 7; float gu[16];
#pragma unroll
      for (int r = 0; r < 16; ++r) gu[r] = GUP[r * 128 + d];
      const float bias = BIAS[d]; float run = 0.f;
#pragma unroll 4
      for (int ii = 0; ii < 16; ++ii) { const int i = seg * 16 + ii; float z = bias;
#pragma unroll
          for (int r4 = 0; r4 < 4; ++r4) { const f32x4 gl = *(const f32x4*)(GLRs + i * 16 + r4 * 4); z += gl[0] * gu[r4 * 4] + gl[1] * gu[r4 * 4 + 1] + gl[2] * gu[r4 * 4 + 2] + gl[3] * gu[r4 * 4 + 3]; }
          run += logsigmoidf_(z) * (1.0f / 16.0f); BB[i * 128 + d] = run; }
      SEGs[seg * 128 + d] = run;
      __syncthreads();
      float off = 0.f; for (int s2 = 0; s2 < seg; ++s2) off += SEGs[s2 * 128 + d];
      if (seg > 0) { for (int ii = 0; ii < 16; ++ii) BB[(seg * 16 + ii) * 128 + d] += off; }
      __syncthreads(); }
    { const bf16_t* gq = (const bf16_t*)(ws + WS_GQ); const bf16_t* gk = (const bf16_t*)(ws + WS_GK); const bf16_t* gv = (const bf16_t*)(ws + WS_GV); bf16_t* qeg = (bf16_t*)(ws + WS_QE);
#pragma unroll
      for (int pp = 0; pp < 2; ++pp) { const int idx = tid + 512 * pp, i = idx >> 4, c = idx & 15, d0 = c * 8; const size_t go = (size_t)(tok0 + i) * 512 + h * 128 + d0;
          float q[8], k[8], qe[8], ke[8], kd[8]; unpack8(qraw[pp], q); unpack8(kraw[pp], k);
#pragma unroll
          for (int j = 0; j < 8; ++j) { const float bb = BB[i * 128 + d0 + j], bl = BB[63 * 128 + d0 + j]; qe[j] = q[j] * __expf(bb) * 0.08838834764831845f; ke[j] = k[j] * __expf(-bb); kd[j] = k[j] * __expf(bl - bb); }
          const u32x4 qw = pack8(qe); *(u32x4*)(lds + G1_QE + i * 272 + c * 16) = qw; *(u32x4*)(qeg + go) = qw;
          *(u32x4*)(lds + G1_KE + i * 272 + c * 16) = pack8(ke); *(u32x4*)(lds + G1_KD + i * 320 + c * 16) = pack8(kd); }
#pragma unroll
      for (int pp = 0; pp < 4; ++pp) { const int idx = tid + 512 * pp, jv = idx >> 5, c = idx & 31; *(u32x4*)(lds + G1_V + jv * 576 + c * 16) = vraw[pp]; }
      if (tid < 128) ((float*)(ws + WS_DEC))[(size_t)item * 128 + tid] = __expf(BB[63 * 128 + tid]);
      __syncthreads(); }
    const LDS3 char* l3 = (const LDS3 char*)lds; const int blk = (lane >> 4) & 1, q4 = (lane & 15) >> 2, p4 = lane & 3;
    {
      const int it = w & 1, vq = w >> 1; f32x16 oi[2]; oi[0] = f32x16{}; oi[1] = f32x16{};
#pragma unroll
      for (int jt = 0; jt < 2; ++jt) { if (jt <= it) { f32x16 x = {};
#pragma unroll
          for (int s = 0; s < 8; ++s) { const bf16x8 a = *(const LDS3 bf16x8*)(l3 + G1_KE + (jt * 32 + r32) * 272 + (16 * s + 8 * hi) * 2), bq = *(const LDS3 bf16x8*)(l3 + G1_QE + (it * 32 + r32) * 272 + (16 * s + 8 * hi) * 2); x = MFMA32(a, bq, x); }
          if (jt == it) {
#pragma unroll
              for (int rr = 0; rr < 16; ++rr) if (crow(rr, hi) > r32) x[rr] = 0.f; }
#pragma unroll
          for (int ss = 0; ss < 2; ++ss) { float xv[8];
#pragma unroll
              for (int q = 0; q < 8; ++q) xv[q] = x[8 * ss + q];
              const bf16x8 xa = __builtin_bit_cast(bf16x8, pack8(xv));
#pragma unroll
              for (int vi = 0; vi < 2; ++vi) { const int vt = 2 * vq + vi; const LDS3 char* vp = l3 + G1_V + (jt * 32 + 16 * ss + 4 * hi + q4) * 576 + (vt * 32 + 16 * blk + 4 * p4) * 2;
                  const bf16x8 vf = cat8(tr16(vp), tr16(vp + 8 * 576)); oi[vi] = MFMA32(xa, vf, oi[vi]); } } } }
      const int dt = w & 3, vg = w >> 2; f32x16 uu[4]; uu[0] = f32x16{}; uu[1] = f32x16{}; uu[2] = f32x16{}; uu[3] = f32x16{};
#pragma unroll
      for (int ks = 0; ks < 4; ++ks) { const LDS3 char* ap = l3 + G1_KD + (16 * ks + 8 * hi + q4) * 320 + (dt * 32 + 16 * blk + 4 * p4) * 2; const bf16x8 a = cat8(tr16(ap), tr16(ap + 4 * 320));
#pragma unroll
          for (int vi = 0; vi < 4; ++vi) { const int vt = 4 * vg + vi; const LDS3 char* vp = l3 + G1_V + (16 * ks + 8 * hi + q4) * 576 + (vt * 32 + 16 * blk + 4 * p4) * 2; const bf16x8 vf = cat8(tr16(vp), tr16(vp + 4 * 576)); uu[vi] = MFMA32(a, vf, uu[vi]); } }
      __syncthreads();
      bf16_t* SU = (bf16_t*)(lds + G1_SU); bf16_t* SO = (bf16_t*)(lds + G1_SO);
#pragma unroll
      for (int vi = 0; vi < 4; ++vi)
#pragma unroll
          for (int rr = 0; rr < 16; ++rr) SU[(dt * 32 + crow(rr, hi)) * 264 + (4 * vg + vi) * 32 + r32] = (bf16_t)(cvt_pk_bf16(uu[vi][rr], 0.f) & 0xffffu);
#pragma unroll
      for (int vi = 0; vi < 2; ++vi)
#pragma unroll
          for (int rr = 0; rr < 16; ++rr) SO[(it * 32 + crow(rr, hi)) * 264 + (2 * vq + vi) * 32 + r32] = (bf16_t)(cvt_pk_bf16(oi[vi][rr], 0.f) & 0xffffu);
      __syncthreads();
      bf16_t* ug = (bf16_t*)(ws + WS_U) + (size_t)item * 128 * 256; bf16_t* og = (bf16_t*)(ws + WS_OINTRA);
#pragma unroll
      for (int pp = 0; pp < 8; ++pp) { const int idx = tid + 512 * pp, row = idx >> 5, c = idx & 31; *(u32x4*)(ug + (size_t)row * 256 + c * 8) = *(const u32x4*)(SU + row * 264 + c * 8); }
#pragma unroll
      for (int pp = 0; pp < 4; ++pp) { const int idx = tid + 512 * pp, row = idx >> 5, c = idx & 31; *(u32x4*)(og + (size_t)(tok0 + row) * 1024 + h * 256 + c * 8) = *(const u32x4*)(SO + row * 264 + c * 8); } }
    __syncthreads();
}

__device__ __forceinline__ void phase_scan_combine(const Params& p) {
    unsigned char* ws = opaque(p.ws); const int G = gridDim.x;
    { const bf16_t* U = (const bf16_t*)(ws + WS_U); bf16_t* PV = (bf16_t*)(ws + WS_PREV); const float* DEC = (const float*)(ws + WS_DEC);
      for (int idx = blockIdx.x * 512 + tid_(); idx < 16 * 128 * 64; idx += G * 512) { const int bh = idx >> 13, rem = idx & 8191, d = rem >> 6, vq = rem & 63;
          float st[4] = {0.f, 0.f, 0.f, 0.f}; const size_t e0 = ((size_t)bh * 64 * 128 + d) * 256 + vq * 4;
#pragma unroll 8
          for (int n = 0; n < 64; ++n) { const size_t e = e0 + (size_t)n * 128 * 256; const u32x2 uw = *(const u32x2*)(U + e); const float dc = DEC[(size_t)(bh * 64 + n) * 128 + d];
              u32x2 pw; pw.x = cvt_pk_bf16(st[0], st[1]); pw.y = cvt_pk_bf16(st[2], st[3]); *(u32x2*)(PV + e) = pw;
              st[0] = dc * st[0] + bf_lo(uw.x); st[1] = dc * st[1] + bf_hi(uw.x); st[2] = dc * st[2] + bf_lo(uw.y); st[3] = dc * st[3] + bf_hi(uw.y); } } }
    { const bf16_t* OG = (const bf16_t*)(ws + WS_OATT); const float* LSE = (const float*)(ws + WS_LSE); bf16_t* YA = (bf16_t*)(ws + WS_YATT);
#pragma unroll 2
      for (int idx = blockIdx.x * 512 + tid_(); idx < NTOK * 64; idx += G * 512) { const int tok = idx >> 6, jc = idx & 63, jh = jc >> 3;
          const float l0 = LSE[(size_t)tok * 8 + jh], l1 = LSE[((size_t)NTOK + tok) * 8 + jh], l2 = LSE[((size_t)2 * NTOK + tok) * 8 + jh];
          const float m = fmaxf(l0, fmaxf(l1, l2)); float a0 = __expf(l0 - m), a1 = __expf(l1 - m), a2 = __expf(l2 - m); const float inv = __builtin_amdgcn_rcpf(a0 + a1 + a2); a0 *= inv; a1 *= inv; a2 *= inv;
          float o0[8], o1[8], o2[8], y[8]; const size_t off = (size_t)tok * 512 + jc * 8;
          unpack8(*(const u32x4*)(OG + off), o0); unpack8(*(const u32x4*)(OG + (size_t)NTOK * 512 + off), o1); unpack8(*(const u32x4*)(OG + (size_t)2 * NTOK * 512 + off), o2);
#pragma unroll
          for (int q = 0; q < 8; ++q) y[q] = a0 * o0[q] + a1 * o1[q] + a2 * o2[q];
          *(u32x4*)(YA + off) = pack8(y); } }
}

constexpr int G3_PREV = 0;
constexpr int G3_SS = G3_PREV + 128 * 576;
constexpr int G3_OI = G3_SS + 8 * 32 * 4;
constexpr int G3_GR = G3_OI + 64 * 528;
constexpr int G3_END = G3_GR + 64 * 528;
static_assert(G3_END <= LDS_XB, "gla3 LDS");
struct G3Pre { u32x4 pv[8], oi[4], gr[4]; };
__device__ __forceinline__ void gla3_fetch(const Params& p, int item, G3Pre& r) {
    unsigned char* ws = opaque(p.ws); const int tid = tid_();
    const int n = item & 63, bh = item >> 6, h = bh & 3, b = bh >> 2; const int tok0 = b * SEQ + n * 64;
    const bf16_t* PV = (const bf16_t*)(ws + WS_PREV) + (size_t)item * 128 * 256;
#pragma unroll
    for (int pp = 0; pp < 8; ++pp) { const int idx = tid + 512 * pp, d = idx >> 5, c = idx & 31; r.pv[pp] = *(const u32x4*)(PV + (size_t)d * 256 + c * 8); }
#pragma unroll
    for (int pp = 0; pp < 4; ++pp) { const int idx = tid + 512 * pp, row = idx >> 5, c = idx & 31; const size_t go = (size_t)(tok0 + row) * 1024 + h * 256 + c * 8;
        r.oi[pp] = *(const u32x4*)((const bf16_t*)(ws + WS_OINTRA) + go); r.gr[pp] = *(const u32x4*)((const bf16_t*)(ws + WS_GR) + go); }
}
__device__ __forceinline__ void gla3_item(const Params& p, int item, int nitem, bool has_next, G3Pre& pre, char* lds) {
    unsigned char* ws = opaque(p.ws);
    const int tid = tid_(), lane = tid & 63, r32 = lane & 31, hi = lane >> 5; const int w = __builtin_amdgcn_readfirstlane(tid >> 6);
    const int n = item & 63, bh = item >> 6, h = bh & 3, b = bh >> 2; const int tok0 = b * SEQ + n * 64;
    bf16_t* SOI = (bf16_t*)(lds + G3_OI); bf16_t* SGR = (bf16_t*)(lds + G3_GR);
#pragma unroll
    for (int pp = 0; pp < 8; ++pp) { const int idx = tid + 512 * pp, d = idx >> 5, c = idx & 31; *(u32x4*)(lds + G3_PREV + d * 576 + c * 16) = pre.pv[pp]; }
#pragma unroll
    for (int pp = 0; pp < 4; ++pp) { const int idx = tid + 512 * pp, row = idx >> 5, c = idx & 31; *(u32x4*)(SOI + row * 264 + c * 8) = pre.oi[pp]; *(u32x4*)(SGR + row * 264 + c * 8) = pre.gr[pp]; }
    const int it = w & 1, vq = w >> 1; const bf16_t* qeg = (const bf16_t*)(ws + WS_QE) + (size_t)(tok0 + it * 32 + r32) * 512 + h * 128;
    bf16x8 qa[8];
#pragma unroll
    for (int s = 0; s < 8; ++s) qa[s] = *(const bf16x8*)(qeg + 16 * s + 8 * hi);
    __syncthreads();
    if (has_next) gla3_fetch(p, nitem, pre);
    const LDS3 char* l3 = (const LDS3 char*)lds; const int blk = (lane >> 4) & 1, q4 = (lane & 15) >> 2, p4 = lane & 3;
    f32x16 o[2];
#pragma unroll
    for (int vi = 0; vi < 2; ++vi)
#pragma unroll
        for (int rr = 0; rr < 16; ++rr) o[vi][rr] = bf2f(SOI[(it * 32 + crow(rr, hi)) * 264 + (2 * vq + vi) * 32 + r32]);
#pragma unroll
    for (int s = 0; s < 8; ++s)
#pragma unroll
        for (int vi = 0; vi < 2; ++vi) { const int vt = 2 * vq + vi; const LDS3 char* pp_ = l3 + G3_PREV + (16 * s + 8 * hi + q4) * 576 + (vt * 32 + 16 * blk + 4 * p4) * 2; const bf16x8 pf = cat8(tr16(pp_), tr16(pp_ + 4 * 576)); o[vi] = MFMA32(qa[s], pf, o[vi]); }
    float* SS = (float*)(lds + G3_SS);
#pragma unroll
    for (int rr = 0; rr < 16; ++rr) { float q = o[0][rr] * o[0][rr] + o[1][rr] * o[1][rr]; q += __shfl_xor(q, 16); q += __shfl_xor(q, 8); q += __shfl_xor(q, 4); q += __shfl_xor(q, 2); q += __shfl_xor(q, 1);
        if (r32 == 0) SS[w * 32 + crow(rr, hi)] = q; }
    __syncthreads();
    float ng[2]; ng[0] = p.gla_norm_g[(2 * vq) * 32 + r32]; ng[1] = p.gla_norm_g[(2 * vq + 1) * 32 + r32];
#pragma unroll
    for (int rr = 0; rr < 16; ++rr) { const int row = crow(rr, hi); const float tot = SS[(it + 0) * 32 + row] + SS[(it + 2) * 32 + row] + SS[(it + 4) * 32 + row] + SS[(it + 6) * 32 + row];
        const float rs = rsqrtf(tot * (1.0f / 256.0f) + EPS);
#pragma unroll
        for (int vi = 0; vi < 2; ++vi) { const int li = (it * 32 + row) * 264 + (2 * vq + vi) * 32 + r32; const float y = o[vi][rr] * rs * ng[vi] * bf2f(SGR[li]); SOI[li] = (bf16_t)(cvt_pk_bf16(y, 0.f) & 0xffffu); } }
    __syncthreads();
    bf16_t* yg = (bf16_t*)(ws + WS_YGLA);
#pragma unroll
    for (int pp = 0; pp < 4; ++pp) { const int idx = tid + 512 * pp, row = idx >> 5, c = idx & 31; *(u32x4*)(yg + (size_t)(tok0 + row) * 1024 + h * 256 + c * 8) = *(const u32x4*)(SOI + row * 264 + c * 8); }
    __syncthreads();
}

constexpr int RT_RSTD = 0;
constexpr int RT_LOG = 256;
constexpr int RT_CNT = RT_LOG + 64 * 32 * 4;
__device__ __forceinline__ void route_group(const Params& p, int grp, char* lds) {
    unsigned char* ws = opaque(p.ws); const int tid = tid_(), lane = tid & 63; const int w = __builtin_amdgcn_readfirstlane(tid >> 6);
    const bf16_t* H = (const bf16_t*)(ws + WS_H); const float* RWG = (const float*)(ws + WS_RWG);
    float* RSTD = (float*)(lds + RT_RSTD); float* LOGS = (float*)(lds + RT_LOG); int* LCNT = (int*)(lds + RT_CNT);
    const int tok0 = grp * 64;
    if (tid < 32) LCNT[tid] = 0;
    if (w < 4) { const int tl = lane & 15, kq = lane >> 4; const bf16_t* hr = H + (size_t)(tok0 + w * 16 + tl) * 1024 + kq * 256; const float* br = RWG + (size_t)(kq * 256) * 32 + tl;
        f32x4 a0 = {0.f, 0.f, 0.f, 0.f}, a1 = {0.f, 0.f, 0.f, 0.f}; float ss = 0.f;
#pragma unroll 4
        for (int m4 = 0; m4 < 64; ++m4) { const f32x4 hv = bf4_to_f32(*(const u32x2*)(hr + m4 * 4));
#pragma unroll
            for (int q = 0; q < 4; ++q) { const float b0 = br[(size_t)(m4 * 4 + q) * 32], b1 = br[(size_t)(m4 * 4 + q) * 32 + 16];
                a0 = __builtin_amdgcn_mfma_f32_16x16x4f32(hv[q], b0, a0, 0, 0, 0); a1 = __builtin_amdgcn_mfma_f32_16x16x4f32(hv[q], b1, a1, 0, 0, 0); ss += hv[q] * hv[q]; } }
        ss += __shfl_xor(ss, 16); ss += __shfl_xor(ss, 32);
        const float rs = rsqrtf(ss * (1.0f / 1024.0f) + EPS);
        if (kq == 0) RSTD[w * 16 + tl] = rs;
#pragma unroll
        for (int rg = 0; rg < 4; ++rg) { const int t = w * 16 + 4 * kq + rg; LOGS[t * 32 + tl] = a0[rg]; LOGS[t * 32 + 16 + tl] = a1[rg]; } }
    __syncthreads();
    if (tid < 64) { const int tok = tok0 + tid; const float rs = RSTD[tid]; float lg[32];
#pragma unroll
        for (int e = 0; e < 32; ++e) lg[e] = LOGS[tid * 32 + e] * rs + p.router_b[e];
        int be[4]; float bv[4];
#pragma unroll
        for (int k = 0; k < 4; ++k) { float best = -3.0e38f; int bi = 0;
#pragma unroll
            for (int e = 0; e < 32; ++e) { const bool tk = lg[e] > best; best = tk ? lg[e] : best; bi = tk ? e : bi; }
            be[k] = bi; bv[k] = best;
#pragma unroll
            for (int e = 0; e < 32; ++e) lg[e] = (e == bi) ? -3.0e38f : lg[e]; }
        const float e1 = __expf(bv[1] - bv[0]), e2 = __expf(bv[2] - bv[0]), e3 = __expf(bv[3] - bv[0]); const float inv = 1.0f / (1.0f + e1 + e2 + e3);
        const float gt[4] = {inv, e1 * inv, e2 * inv, e3 * inv};
#pragma unroll
        for (int k = 0; k < 4; ++k) { const int pos = atomicAdd(&LCNT[be[k]], 1);
            ((int*)(ws + WS_TOPE))[tok * 4 + k] = be[k]; ((float*)(ws + WS_TOPG))[tok * 4 + k] = gt[k]; ((int*)(ws + WS_TOPP))[tok * 4 + k] = pos; } }
    { unsigned char* HN = ws + WS_HN;
#pragma unroll 2
      for (int i = 0; i < 8; ++i) { const int idx = tid + 512 * i, t = idx >> 6, c = idx & 63; const float rs = RSTD[t]; const size_t off = (size_t)(tok0 + t) * 1024 + c * 16; u32x4 wv;
#pragma unroll
          for (int q = 0; q < 4; ++q) { const f32x4 h0 = bf4_to_f32(*(const u32x2*)(H + off + 4 * q)), g0 = *(const f32x4*)(p.norm_ffn_g + c * 16 + 4 * q); wv[q] = (unsigned)pk4_fp8(h0[0] * rs * g0[0], h0[1] * rs * g0[1], h0[2] * rs * g0[2], h0[3] * rs * g0[3]); }
          *(u32x4*)(HN + off) = wv; } }
    __syncthreads();
    if (tid < 32) ((int*)(ws + WS_CNT))[grp * 32 + tid] = LCNT[tid];
    __syncthreads();
}

constexpr int DP_TOT = 0;
constexpr int DP_PART = 512;
__device__ __forceinline__ void dispatch_tables(const Params& p, int grp, char* lds) {
    unsigned char* ws = opaque(p.ws); const int tid = tid_(); const int* CNT = (const int*)(ws + WS_CNT); int* T = (int*)(lds + DP_TOT); int* PART = (int*)(lds + DP_PART);
    { const int e = tid & 31, part = tid >> 5; int tot = 0, pre = 0;
      for (int g2 = part * 16; g2 < part * 16 + 16; ++g2) { const int c = CNT[g2 * 32 + e]; tot += c; if (g2 < grp) pre += c; }
      PART[part * 32 + e] = tot; PART[512 + part * 32 + e] = pre; }
    __syncthreads();
    if (tid < 32) { int tot = 0, pre = 0; for (int q = 0; q < 16; ++q) { tot += PART[q * 32 + tid]; pre += PART[512 + q * 32 + tid]; } T[tid] = tot; T[64 + tid] = pre; }
    __syncthreads();
    if (tid == 0) { int base = 0; for (int e = 0; e < 32; ++e) { T[32 + e] = base; base += (T[e] + 255) >> 8; } T[96] = base; }
    __syncthreads();
}
__device__ __forceinline__ void dispatch_group(const Params& p, int grp, char* lds) {
    unsigned char* ws = opaque(p.ws); const int tid = tid_();
    dispatch_tables(p, grp, lds);
    const int* T = (const int*)(lds + DP_TOT); int* DEST = (int*)(lds + DP_PART + 4096);
    if (tid < 256) { const int tok = grp * 64 + (tid >> 2); const int e = ((const int*)(ws + WS_TOPE))[tok * 4 + (tid & 3)], lp = ((const int*)(ws + WS_TOPP))[tok * 4 + (tid & 3)];
        const int dest = T[32 + e] * 256 + T[64 + e] + lp; DEST[tid] = dest; ((int*)(ws + WS_SLOT))[tok * 4 + (tid & 3)] = dest; }
    __syncthreads();
    if (tid < 256) ((int*)(ws + WS_XPAD))[DEST[tid]] = (grp * 64 + (tid >> 2)) * 1024;
    __syncthreads();
}

__device__ __forceinline__ void phase_combine(const Params& p) {
    unsigned char* ws = opaque(p.ws); const int tid = tid_(), lane = tid & 63, wid = tid >> 6, G = gridDim.x;
    const bf16_t* H = (const bf16_t*)(ws + WS_H); const unsigned char* YP = ws + WS_YPAD;
    for (int tok = blockIdx.x * 8 + wid; tok < NTOK; tok += G * 8) {
        int sl[4]; float gt[4];
#pragma unroll
        for (int k = 0; k < 4; ++k) { sl[k] = ((const int*)(ws + WS_SLOT))[tok * 4 + k]; gt[k] = ((const float*)(ws + WS_TOPG))[tok * 4 + k]; }
        f32x4 v[4]; float ss = 0.f;
#pragma unroll
        for (int i = 0; i < 4; ++i) { const int col = i * 256 + lane * 4; v[i] = bf4_to_f32(*(const u32x2*)(H + (size_t)tok * 1024 + col));
#pragma unroll
            for (int k = 0; k < 4; ++k) { const unsigned yw = *(const unsigned*)(YP + (size_t)sl[k] * 1024 + col); const f32x2 lo = __builtin_amdgcn_cvt_pk_f32_fp8((int)yw, false), hi2 = __builtin_amdgcn_cvt_pk_f32_fp8((int)yw, true); v[i][0] += gt[k] * lo[0]; v[i][1] += gt[k] * lo[1]; v[i][2] += gt[k] * hi2[0]; v[i][3] += gt[k] * hi2[1]; }
            ss += v[i][0] * v[i][0] + v[i][1] * v[i][1] + v[i][2] * v[i][2] + v[i][3] * v[i][3]; }
        ss = wave_sum(ss); const float rs = rsqrtf(ss * (1.0f / 1024.0f) + EPS);
#pragma unroll
        for (int i = 0; i < 4; ++i) { const int col = i * 256 + lane * 4; const f32x4 g = *(const f32x4*)(p.norm_final_g + col); f32x4 o; o[0] = v[i][0] * rs * g[0]; o[1] = v[i][1] * rs * g[1]; o[2] = v[i][2] * rs * g[2]; o[3] = v[i][3] * rs * g[3];
            *(f32x4*)(p.out + (size_t)tok * 1024 + col) = o; } }
}


#define XB_TMO      128
#define XB_XCNT(j)  (256  + 64 * (j))
#define XB_XSUB(j)  (1280 + 64 * (j))
#define XB_XGEN(j)  (2304 + 64 * (j))
#define XB_TOP      3328
#define XB_TOPGEN   3392
#define XCD_BAR_WORDS 3456
#define XB_SPIN_CAP (1u << 18)
__device__ __forceinline__ unsigned xb_ld(unsigned* p)              { return __hip_atomic_load(p, __ATOMIC_RELAXED, __HIP_MEMORY_SCOPE_AGENT); }
__device__ __forceinline__ unsigned xb_add(unsigned* p, unsigned v) { return __hip_atomic_fetch_add(p, v, __ATOMIC_RELAXED, __HIP_MEMORY_SCOPE_AGENT); }
__device__ __forceinline__ unsigned xb_xcc_id() { return (unsigned)__builtin_amdgcn_s_getreg((3 << 11) | 20) & 0xFu; }
#define XB_SPIN(cond, bar) do { unsigned _sp = 0; while (cond) { __builtin_amdgcn_s_sleep(1); \
    if ((++_sp & 255u) == 0u) { if (xb_ld(&(bar)[XB_TMO])) break; if (_sp > XB_SPIN_CAP) { atomicAdd(&(bar)[XB_TMO], 1u); break; } } } } while (0)
struct XcdBarrier { unsigned* bar; unsigned x; volatile LDS3 unsigned* st; };
__device__ __forceinline__ XcdBarrier xcd_barrier_post(unsigned* bar, volatile LDS3 unsigned* st) {
    XcdBarrier b; b.bar = bar; b.x = xb_xcc_id(); b.st = st;
    if (tid_() == 0) (void)xb_add(&bar[XB_XCNT(b.x)], 1u);
    return b;
}
__device__ __forceinline__ void xcd_barrier_complete(unsigned* bar, unsigned x, unsigned& nloc, unsigned& nx) {
    const unsigned G = gridDim.x * gridDim.y * gridDim.z;
    unsigned sum, cnt, mine, sp = 0u;
    for (;;) {
        sum = 0u; cnt = 0u; mine = 0u;
#pragma unroll
        for (unsigned j = 0; j < 16; ++j) { const unsigned c = xb_ld(&bar[XB_XCNT(j)]); sum += c; cnt += (c > 0u) ? 1u : 0u; mine = (j == x) ? c : mine; }
        if (sum == G) break;
        __builtin_amdgcn_s_sleep(1);
        if ((++sp & 255u) == 0u) { if (xb_ld(&bar[XB_TMO])) break; if (sp > XB_SPIN_CAP) { atomicAdd(&bar[XB_TMO], 1u); break; } }
    }
    nloc = mine > 0u ? mine : 1u; nx = cnt > 0u ? cnt : 1u;
}
__device__ __forceinline__ void xcd_barrier(const XcdBarrier& b) {
    asm volatile("s_waitcnt vmcnt(0)" ::: "memory");
    __syncthreads();
    if (tid_() == 0) {
        unsigned* bar = b.bar;
        __builtin_amdgcn_s_waitcnt(0);
        unsigned nloc = b.st[0], nx = b.st[1];
        if (nloc == 0u) { xcd_barrier_complete(bar, b.x, nloc, nx); b.st[0] = nloc; b.st[1] = nx; }
        const unsigned old = xb_add(&bar[XB_XSUB(b.x)], 1u);
        const unsigned gen = old / nloc;
        if (old + 1u == (gen + 1u) * nloc) {
            __builtin_amdgcn_fence(__ATOMIC_RELEASE, "agent");
            asm volatile("s_waitcnt vmcnt(0)" ::: "memory");
            const unsigned og = xb_add(&bar[XB_TOP], 1u);
            const unsigned tg = og / nx;
            if (og + 1u == (tg + 1u) * nx) xb_add(&bar[XB_TOPGEN], 1u);
            else XB_SPIN(xb_ld(&bar[XB_TOPGEN]) == tg, bar);
            __builtin_amdgcn_fence(__ATOMIC_ACQUIRE, "agent");
            xb_add(&bar[XB_XGEN(b.x)], 1u);
            asm volatile("s_waitcnt vmcnt(0)" ::: "memory");
        } else {
            XB_SPIN(xb_ld(&bar[XB_XGEN(b.x)]) == gen, bar);
            __builtin_amdgcn_fence(__ATOMIC_ACQUIRE, "agent");
            asm volatile("s_waitcnt vmcnt(0)" ::: "memory");
        }
    }
    __syncthreads();
}

__global__ void __launch_bounds__(512, 2) mega_fwd(Params p) {
    cg::grid_group grid = cg::this_grid();
    char* lds = smem; LDS3 unsigned char* lds3 = (LDS3 unsigned char*)smem;
    const int G = gridDim.x, bid = blockIdx.x;
    if (tid_() < 4) ((volatile LDS3 unsigned*)(lds3 + LDS_XB))[tid_()] = 0u;
    __syncthreads();
    const XcdBarrier xb = xcd_barrier_post((unsigned*)(p.ws + WS_BAR), (volatile LDS3 unsigned*)(lds3 + LDS_XB));
    for (int rep = 0; rep < REP_P0; ++rep) phase_prologue(p, lds);
    if (p.ws == nullptr) grid.sync();
    xcd_barrier(xb);
    for (int rep = 0; rep < REP_P1; ++rep) { const int nconv = (G >= 64) ? (G * 3) / 16 : 0, ngemm = G - nconv;
      if (bid >= ngemm) { expert_convert(p, lds, bid - ngemm, nconv, N_EXPERT_TILES_P0, N_EXPERT_TILES); }
      else { unsigned char* ws = opaque(p.ws);
        { pg8::DenseProbT<1> S; S.init(ws + WS_XN, ws + WS_W_IN, NTOK, pg8::sens_count() * 256, 1024, ngemm, bid);
          EpiProjT<false> E; E.ws = ws; pg8::gemm_phase(lds3, S, E); }
        { pg8::DenseProbT<2> S; S.init(ws + WS_XN8, ws + WS_WIN8, NTOK, (39 - pg8::sens_count()) * 256, 512  , ngemm, bid);
          EpiProjT<true> E; E.ws = ws; pg8::gemm_phase(lds3, S, E); } }
      if (nconv == 0) expert_convert(p, lds, bid, G, N_EXPERT_TILES_P0, N_EXPERT_TILES); }
    xcd_barrier(xb);
    for (int rep = 0; rep < REP_ATT; ++rep) { AttnPre pre; if (bid < 4 * 24 * 16) attn_fetch(p, bid, pre);
        for (int item = bid; item < 4 * 24 * 16; item += G) attn_item(p, item, item + G, item + G < 4 * 24 * 16, pre, lds); }
    for (int rep = 0; rep < REP_GLA1; ++rep) { G1Pre pre; if (bid < 1024) gla1_fetch(p, bid, pre); int hprev = -1;
        for (int item = bid; item < 1024; item += G) { const int h = (item >> 6) & 3; gla1_item(p, item, item + G, item + G < 1024, h != hprev, pre, lds); hprev = h; } }
    xcd_barrier(xb);
    for (int rep = 0; rep < REP_P3; ++rep) phase_scan_combine(p);
    xcd_barrier(xb);
    for (int rep = 0; rep < REP_P4; ++rep) { G3Pre pre; if (bid < 1024) gla3_fetch(p, bid, pre);
        for (int item = bid; item < 1024; item += G) gla3_item(p, item, item + G, item + G < 1024, pre, lds); }
    xcd_barrier(xb);
    for (int rep = 0; rep < REP_P5; ++rep) {
    { unsigned char* ws = opaque(p.ws); pg8::DenseProb S; S.init(ws + WS_YATT, ws + WS_W_A, NTOK, 1024, 512, G, bid);
      EpiGate<0> E; E.gate = (const bf16_t*)(ws + WS_SA); E.t1 = nullptr; E.out = (bf16_t*)(ws + WS_T1);
      pg8::gemm_phase(lds3, S, E); }
    { unsigned char* ws = opaque(p.ws); pg8::DenseProb S; S.init(ws + WS_YGLA, ws + WS_W_G, NTOK, 1024, 1024, G, bid);
      EpiGate<1> E; E.gate = (const bf16_t*)(ws + WS_SG); E.t1 = (const bf16_t*)(ws + WS_T1); E.out = (bf16_t*)(ws + WS_MERGED);
      pg8::gemm_phase(lds3, S, E); }
    }
    xcd_barrier(xb);
    for (int rep = 0; rep < REP_P6; ++rep) { unsigned char* ws = opaque(p.ws); pg8::DenseProb S; S.init(ws + WS_MERGED, ws + WS_W_MIX, NTOK, 1024, 1024, G, bid);
      EpiResid E; E.x = p.x; E.h = (bf16_t*)(ws + WS_H);
      pg8::gemm_phase(lds3, S, E); }
    xcd_barrier(xb);
    for (int rep = 0; rep < REP_P7; ++rep) for (int grp = bid; grp < 256; grp += G) route_group(p, grp, lds);
    xcd_barrier(xb);
    for (int rep = 0; rep < REP_P8; ++rep) for (int grp = bid; grp < 256; grp += G) dispatch_group(p, grp, lds);
    if (bid == 0) { unsigned char* ws = opaque(p.ws); dispatch_tables(p, -1, lds); const int* T = (const int*)(lds + DP_TOT); int* TE = (int*)(ws + WS_TILEE);
        if (tid_() < 32) { const int e = tid_(); for (int t = T[32 + e]; t < T[32 + e] + ((T[e] + 255) >> 8); ++t) TE[16 + t] = e; }
        if (tid_() == 0) TE[0] = T[96];
        for (int e = 0; e < 32; ++e) { const int nt_ = (T[e] + 255) >> 8; int* ro = (int*)(ws + WS_XPAD) + T[32 + e] * 256; for (int r = T[e] + tid_(); r < nt_ * 256; r += 512) ro[r] = 0; } }
    xcd_barrier(xb);
    for (int rep = 0; rep < REP_P9; ++rep) { unsigned char* ws = opaque(p.ws); const int* TE = (const int*)(ws + WS_TILEE);
      pg8::MoeProbT<true> S; S.A = (const char*)(ws + WS_HN); S.rowoff = (const int*)(ws + WS_XPAD); S.Bt = (const char*)(ws + WS_W_GU); S.K = 512  ; S.nN = 8; S.T = TE[0]; S.G = G; S.c = bid; S.estride = (size_t)2048 * 1024; S.tile_e = TE + 16;
      EpiAct E; E.bgu = p.e_b_gu; E.tile_e = TE + 16; E.act = ws + WS_ACT;
      pg8::gemm_phase(lds3, S, E); }
    xcd_barrier(xb);
    for (int rep = 0; rep < REP_P10; ++rep) { unsigned char* ws = opaque(p.ws); const int* TE = (const int*)(ws + WS_TILEE);
      pg8::MoeProbT<false> S; S.rowoff = nullptr; S.A = (const char*)(ws + WS_ACT); S.Bt = (const char*)(ws + WS_W_D); S.K = 512  ; S.nN = 4; S.T = TE[0]; S.G = G; S.c = bid; S.estride = (size_t)1024 * 1024; S.tile_e = TE + 16;
      EpiDown E; E.bd = p.e_b_d; E.tile_e = TE + 16; E.y = ws + WS_YPAD;
      pg8::gemm_phase(lds3, S, E); }
    xcd_barrier(xb);
    for (int rep = 0; rep < REP_P11; ++rep) phase_combine(p);
}

extern "C" void kernel_launch(void* const* d_in, const int* in_sizes, int n_in, void* d_out, int out_size, void* d_ws, size_t ws_size, hipStream_t stream) {
    static int grid = 0;
    if (grid == 0) {
        if (n_in != 17 || ws_size < WS_END) { fprintf(stderr, "kernel_launch: expected 17 inputs and >= %zu bytes of workspace (got %d, %zu); nothing launched\n", (size_t)WS_END, n_in, ws_size); grid = -1; return; }
        int dev = 0, cus = 0, per_cu = 0;
        if (hipGetDevice(&dev) != hipSuccess || hipDeviceGetAttribute(&cus, hipDeviceAttributeMultiprocessorCount, dev) != hipSuccess) { fprintf(stderr, "kernel_launch: device query failed\n"); grid = -1; return; }
        if (hipFuncSetAttribute((const void*)mega_fwd, hipFuncAttributeMaxDynamicSharedMemorySize, LDS_BYTES) != hipSuccess) { fprintf(stderr, "kernel_launch: hipFuncSetAttribute failed\n"); grid = -1; return; }
        if (hipOccupancyMaxActiveBlocksPerMultiprocessor(&per_cu, (const void*)mega_fwd, 512, LDS_BYTES) != hipSuccess || per_cu < 1) { fprintf(stderr, "kernel_launch: occupancy query failed (%d)\n", per_cu); grid = -1; return; }
        grid = cus;
    }
    if (grid < 0) return;
    Params p{};
    p.x = (const float*)d_in[0]; p.norm_mix_g = (const float*)d_in[1]; p.w_in = (const float*)d_in[2]; p.gla_gate_up = (const float*)d_in[3]; p.gla_gate_bias = (const float*)d_in[4]; p.gla_norm_g = (const float*)d_in[5];
    p.w_branch_gla = (const float*)d_in[6]; p.w_branch_att = (const float*)d_in[7]; p.w_mix_out = (const float*)d_in[8]; p.norm_ffn_g = (const float*)d_in[9]; p.router_w = (const float*)d_in[10]; p.router_b = (const float*)d_in[11];
    p.e_w_gu = (const float*)d_in[12]; p.e_b_gu = (const float*)d_in[13]; p.e_w_d = (const float*)d_in[14]; p.e_b_d = (const float*)d_in[15]; p.norm_final_g = (const float*)d_in[16];
    p.out = (float*)d_out; p.ws = (unsigned char*)d_ws;
    if (hipMemsetAsync((char*)d_ws + WS_BAR, 0, 3456 * 4, stream) != hipSuccess) { fprintf(stderr, "kernel_launch: memset of the barrier words failed\n"); return; }
    void* args[] = {&p};
    hipError_t e = hipLaunchCooperativeKernel((const void*)mega_fwd, dim3(grid), dim3(512), args, LDS_BYTES, stream);
    if (e != hipSuccess) fprintf(stderr, "kernel_launch: cooperative launch failed: %s (grid %d)\n", hipGetErrorString(e), grid);
}
```

```cpp
#include <hip/hip_runtime.h>
#include <hip/hip_cooperative_groups.h>
#include <cstdio>
#include <cstdint>
namespace cg = cooperative_groups;
#ifndef REP_P0
#define REP_P0 1
#define REP_P1 1
#define REP_ATT 1
#define REP_GLA1 1
#define REP_P3 1
#define REP_P4 1
#define REP_P5 1
#define REP_P6 1
#define REP_P7 1
#define REP_P8 1
#define REP_P9 1
#define REP_P10 1
#define REP_P11 1
#endif

#define LDS3 __attribute__((address_space(3)))
typedef unsigned short bf16_t;
typedef short bf16x8 __attribute__((ext_vector_type(8)));
typedef short s16x4 __attribute__((ext_vector_type(4)));
typedef short v4i16_t __attribute__((ext_vector_type(4)));
typedef float f32x4 __attribute__((ext_vector_type(4)));
typedef float f32x2 __attribute__((ext_vector_type(2)));
typedef float f32x16 __attribute__((ext_vector_type(16)));
typedef unsigned u32x4 __attribute__((ext_vector_type(4)));
typedef unsigned u32x2 __attribute__((ext_vector_type(2)));
typedef int i32x8 __attribute__((ext_vector_type(8)));
typedef int i32x4 __attribute__((ext_vector_type(4)));

constexpr int NTOK = 16384, DM = 1024, SEQ = 4096, NB = 4;
constexpr int INW = 9744, INWP = 9984;
constexpr int NEXP = 32, TOPK = 4, FF = 1024;
constexpr int MAXT = 288;
constexpr float EPS = 1e-5f;
constexpr float QSCALE = 0.125f * 1.4426950408889634f;
constexpr float LN2 = 0.6931471805599453f;

constexpr size_t al256(size_t x) { return (x + 255) & ~(size_t)255; }
constexpr size_t WS_W_IN = 0;
constexpr size_t WS_W_G = WS_W_IN + (size_t)INWP * 1024 * 2;
constexpr size_t WS_W_A = WS_W_G + (size_t)1024 * 1024 * 2;
constexpr size_t WS_W_MIX = WS_W_A + (size_t)1024 * 512 * 2;
constexpr size_t WS_W_GU = WS_W_MIX + (size_t)1024 * 1024 * 2;
constexpr size_t WS_W_D = WS_W_GU + (size_t)NEXP * 2048 * 1024;
constexpr size_t WS_ROPE_C = WS_W_D + (size_t)NEXP * 1024 * 1024;
constexpr size_t WS_ROPE_S = WS_ROPE_C + (size_t)SEQ * 8 * 4;
constexpr size_t WS_RWG = WS_ROPE_S + (size_t)SEQ * 8 * 4;
constexpr size_t WS_H = WS_RWG + (size_t)1024 * 32 * 4;
constexpr size_t WS_HN = WS_H + (size_t)NTOK * 1024 * 4;
constexpr size_t WS_TOPE = WS_HN + (size_t)NTOK * 1024;
constexpr size_t WS_TOPG = WS_TOPE + (size_t)NTOK * 4 * 4;
constexpr size_t WS_TOPP = WS_TOPG + (size_t)NTOK * 4 * 4;
constexpr size_t WS_SLOT = WS_TOPP + (size_t)NTOK * 4 * 4;
constexpr size_t WS_CNT = WS_SLOT + (size_t)NTOK * 4 * 4;
constexpr size_t WS_TILEE = WS_CNT + (size_t)256 * 32 * 4;
constexpr size_t WS_REGB = al256(WS_TILEE + (size_t)(MAXT + 32) * 4);
constexpr size_t WS_XN = WS_REGB;
constexpr size_t WS_GQ = WS_XN + (size_t)NTOK * 1024 * 2;
constexpr size_t WS_GK = WS_GQ + (size_t)NTOK * 512 * 2;
constexpr size_t WS_GV = WS_GK + (size_t)NTOK * 512 * 2;
constexpr size_t WS_GR = WS_GV + (size_t)NTOK * 1024 * 2;
constexpr size_t WS_SG = WS_GR + (size_t)NTOK * 1024 * 2;
constexpr size_t WS_SA = WS_SG + (size_t)NTOK * 1024 * 2;
constexpr size_t WS_AQ = WS_SA + (size_t)NTOK * 1024 * 2;
constexpr size_t WS_AK = WS_AQ + (size_t)NTOK * 1536 * 2;
constexpr size_t WS_AV = WS_AK + (size_t)NTOK * 1536 * 2;
constexpr size_t WS_GLR = WS_AV + (size_t)NTOK * 1536 * 2;
constexpr size_t WS_OATT = WS_GLR + (size_t)NTOK * 16 * 4;
constexpr size_t WS_LSE = WS_OATT + (size_t)3 * NTOK * 512 * 2;
constexpr size_t WS_QE = WS_LSE + (size_t)3 * NTOK * 8 * 4;
constexpr size_t WS_OINTRA = WS_QE + (size_t)NTOK * 512 * 2;
constexpr size_t WS_U = WS_OINTRA + (size_t)NTOK * 1024 * 2;
constexpr size_t WS_DEC = WS_U + (size_t)1024 * 128 * 256 * 2;
constexpr size_t WS_XN8 = WS_DEC + (size_t)1024 * 128 * 4;
constexpr size_t WS_WIN8 = WS_XN8 + (size_t)NTOK * 1024;
constexpr size_t WS_REGB_END = WS_WIN8 + (size_t)INWP * 1024;
constexpr size_t WS_PREV = WS_AQ;
constexpr size_t WS_YGLA = WS_AV;
constexpr size_t WS_YATT = WS_XN;
constexpr size_t WS_T1 = WS_GQ;
constexpr size_t WS_MERGED = WS_GV;
constexpr size_t PADROWS = (size_t)MAXT * 256;
constexpr size_t WS_XPAD = WS_REGB;
constexpr size_t WS_ACT = WS_XPAD + PADROWS * 1024;
constexpr size_t WS_YPAD = WS_ACT + PADROWS * 1024;
constexpr size_t WS_PAD_END = WS_YPAD + PADROWS * 1024;
constexpr size_t WS_BAR = al256(WS_REGB_END > WS_PAD_END ? WS_REGB_END : WS_PAD_END);
constexpr size_t WS_END = WS_BAR + 3456 * 4;
static_assert(WS_PAD_END <= WS_REGB_END + (1u << 30), "map");

constexpr int LDS_XB = 147456;
constexpr int LDS_TAB_OFF = 147456 + 16;
constexpr int LDS_BYTES = 147456 + 16 + 1024;

struct Params {
    const float *x, *norm_mix_g, *w_in, *gla_gate_up, *gla_gate_bias, *gla_norm_g, *w_branch_gla, *w_branch_att, *w_mix_out, *norm_ffn_g,
        *router_w, *router_b, *e_w_gu, *e_b_gu, *e_w_d, *e_b_d, *norm_final_g;
    float* out;
    unsigned char* ws;
};

__device__ __forceinline__ int tid_() { int t = threadIdx.x; asm volatile("" : "+v"(t)); return t; }
__device__ __forceinline__ unsigned char* opaque(unsigned char* q) { return q; }
__device__ __forceinline__ unsigned cvt_pk_bf16(float lo, float hi) { unsigned r; asm volatile("v_cvt_pk_bf16_f32 %0, %1, %2" : "=v"(r) : "v"(lo), "v"(hi)); return r; }
__device__ __forceinline__ float bf_lo(unsigned w) { return __uint_as_float(w << 16); }
__device__ __forceinline__ float bf_hi(unsigned w) { return __uint_as_float(w & 0xffff0000u); }
__device__ __forceinline__ float bf2f(bf16_t b) { return __uint_as_float(((unsigned)b) << 16); }
__device__ __forceinline__ u32x4 pack8(const float* v) { u32x4 w; w.x = cvt_pk_bf16(v[0], v[1]); w.y = cvt_pk_bf16(v[2], v[3]); w.z = cvt_pk_bf16(v[4], v[5]); w.w = cvt_pk_bf16(v[6], v[7]); return w; }
__device__ __forceinline__ void unpack8(u32x4 w, float* v) { v[0] = bf_lo(w.x); v[1] = bf_hi(w.x); v[2] = bf_lo(w.y); v[3] = bf_hi(w.y); v[4] = bf_lo(w.z); v[5] = bf_hi(w.z); v[6] = bf_lo(w.w); v[7] = bf_hi(w.w); }
__device__ __forceinline__ float sigmoidf_(float v) { return __builtin_amdgcn_rcpf(1.0f + __builtin_amdgcn_exp2f(v * -1.4426950408889634f)); }
__device__ __forceinline__ float wave_sum(float v) { v += __shfl_xor(v, 32); v += __shfl_xor(v, 16); v += __shfl_xor(v, 8); v += __shfl_xor(v, 4); v += __shfl_xor(v, 2); v += __shfl_xor(v, 1); return v; }
__device__ __forceinline__ s16x4 tr16(const LDS3 char* p) { return __builtin_bit_cast(s16x4, __builtin_amdgcn_ds_read_tr16_b64_v4i16((LDS3 v4i16_t*)p)); }
__device__ __forceinline__ bf16x8 cat8(s16x4 a, s16x4 b) { return (bf16x8){a[0], a[1], a[2], a[3], b[0], b[1], b[2], b[3]}; }
__device__ __forceinline__ int crow(int r, int hi) { return (r & 3) + 8 * (r >> 2) + 4 * hi; }
__device__ __forceinline__ void st_nt(void* p, u32x4 v) { __builtin_nontemporal_store(v, (u32x4*)p); }
__device__ __forceinline__ int pk4_fp8(float a, float b, float c, float d) { int w = __builtin_amdgcn_cvt_pk_fp8_f32(a, b, 0, false); return __builtin_amdgcn_cvt_pk_fp8_f32(c, d, w, true); }
__device__ __forceinline__ f32x4 bf4_to_f32(u32x2 w) { f32x4 r; r[0] = bf_lo(w.x); r[1] = bf_hi(w.x); r[2] = bf_lo(w.y); r[3] = bf_hi(w.y); return r; }
#define MFMA32(a, b, c) __builtin_amdgcn_mfma_f32_32x32x16_bf16(a, b, c, 0, 0, 0)

namespace pg8 {
constexpr int BM = 256, BK = 64, HALF = 128, HTB = HALF * BK * 2, STAGE_BYTES = 8 * HTB, NXCD = 8, WGM = 8;
constexpr bool GEMM_ALIGN_EPI = true;
constexpr bool GEMM_SP2 = true;
__host__ __device__ __forceinline__ int lds_byte(int r, int c) { const int st = (r >> 4) * 2 + (c >> 5), rr = r & 15, cc = c & 31, ob = rr * 64 + cc * 2; return st * 1024 + (ob ^ (((ob >> 9) & 1) << 5)); }
__host__ __device__ __forceinline__ void stage_rc(int b, int& R, int& C) { const int st = b / 1024, sb = b % 1024, swz = sb ^ (((sb >> 9) & 1) << 5); R = (st >> 1) * 16 + swz / 64; C = (st & 1) * 32 + (swz % 64) / 2; }
__host__ __device__ __forceinline__ int perm32(int rho) { const int n = rho >> 4, i = rho & 15; return 8 * (i >> 2) + 4 * n + (i & 3); }
struct Unit { int pm, pn; };

#ifndef SENSMASK
#define SENSMASK ((0xFFFull << 0) | (1ull << 38))
#endif
constexpr int sens_count() { int c = 0; for (int t = 0; t < 39; ++t) c += (int)((SENSMASK >> t) & 1ull); return c; }
__device__ __forceinline__ int subset_tile(int sub, int k) {
    int seen = 0, res = 0;
#pragma unroll
    for (int t = 0; t < 39; ++t) { const bool in = (((SENSMASK >> t) & 1ull) != 0ull) == (sub == 1); if (in) { if (seen == k) res = t; ++seen; } }
    return res; }
template <int SUBSET> struct DenseProbT {
    const char* A; const char* Bt; int K; int nM, nN, nwg, G, c;
    __device__ void init(const void* A_, const void* Bt_, int M, int N, int K_, int G_, int c_) { A = (const char*)A_; Bt = (const char*)Bt_; K = K_; nM = M / BM; nN = N / BM; nwg = nM * nN; G = G_; c = c_; }
    __device__ __forceinline__ bool next(int i, Unit& u) const {
        const long L = (long)i * G + c; if (L >= nwg) return false;
        int wgid = (int)L; { const int q = nwg / NXCD, r = nwg % NXCD, xcd = wgid % NXCD, off = wgid / NXCD; wgid = (xcd < r ? xcd * (q + 1) : r * (q + 1) + (xcd - r) * q) + off; }
        const int nig = WGM * nN, gid = wgid / nig, fm = gid * WGM, gsz = (nM - fm) < WGM ? (nM - fm) : WGM;
        u.pm = fm + ((wgid % nig) % gsz); int pn = (wgid % nig) / gsz;
        if (SUBSET != 0) pn = subset_tile(SUBSET, pn);
        u.pn = pn; return true;
    }
    __device__ __forceinline__ const char* a_ptr(const Unit& u) const { return A + (size_t)u.pm * BM * K * 2; }
    __device__ __forceinline__ const char* b_ptr(const Unit& u) const { return Bt + (size_t)u.pn * BM * K * 2; }
    static constexpr bool GATHER = false;
    __device__ __forceinline__ const int* rows(const Unit&) const { return nullptr; }
};
typedef DenseProbT<0> DenseProb;
template <bool GATHER_> struct MoeProbT {
    static constexpr bool GATHER = GATHER_;
    const char* A; const char* Bt; int K; int nN, T, G, c; size_t estride; const int* tile_e; const int* rowoff;
    __device__ __forceinline__ bool next(int i, Unit& u) const {
        if ((G % (8 * nN)) == 0) { const int tpx = G / (8 * nN), tpr = 8 * tpx, x = c & 7, slot = c >> 3; const int tile = i * tpr + x * tpx + slot / nN; if (tile >= T) return false; u.pm = tile; u.pn = slot % nN; return true; }
        const long L = (long)i * G + c; if (L >= (long)T * nN) return false; u.pm = (int)(L / nN); u.pn = (int)(L % nN); return true; }
    __device__ __forceinline__ const char* a_ptr(const Unit& u) const { return GATHER ? A : A + (size_t)u.pm * BM * K * 2; }
    __device__ __forceinline__ const char* b_ptr(const Unit& u) const { return Bt + (size_t)tile_e[u.pm] * estride + (size_t)u.pn * BM * K * 2; }
    __device__ __forceinline__ const int* rows(const Unit& u) const { return rowoff + u.pm * BM; }
};

template <class Epi, class Prob>
__device__ __forceinline__ void gemm_phase(LDS3 unsigned char* lds, const Prob& S, const Epi& E) {
    const int tid = tid_(), wid = __builtin_amdgcn_readfirstlane(tid >> 6), lane = tid & 63, wr = wid >> 2, wc = wid & 3, fr = lane & 15, fq = lane >> 4;
    const int K = S.K, nt = K / BK;
    unsigned voffA[2], voffB[2]; int Rrow[2];
#pragma unroll
    for (int i = 0; i < 2; ++i) { int R, C; stage_rc(tid * 16 + i * 8192, R, C); const int Rb = Epi::PERM ? (2 * (R & ~31) + perm32(R & 31)) : R;
        voffA[i] = (unsigned)(R * K + C) * 2u; voffB[i] = (unsigned)(Rb * K + C) * 2u; Rrow[i] = R; if (Prob::GATHER) voffA[i] = (unsigned)C * 2u; }
    const size_t kstep = (size_t)(BK * 2);
    const size_t hstep = (size_t)HALF * K * 2;
    const size_t hstepB = Epi::PERM ? (size_t)32 * K * 2 : hstep;
    const unsigned ldsw = (unsigned)wid * 1024u;
    const int aoff = lds_byte(wr * 64 + fr, fq * 8), boff = lds_byte(wc * 32 + fr, fq * 8);
#define PG8_SA(b, h) (((b) * 2 + (h)) * HTB)
#define PG8_SB(b, h) ((4 + (b) * 2 + (h)) * HTB)
#define PG8_STAGE(bufoff, gbase, voff) do { _Pragma("unroll") for (int _i = 0; _i < 2; ++_i) \
        __builtin_amdgcn_global_load_lds((const unsigned*)((const char*)(gbase) + (voff)[_i]), (LDS3 unsigned*)(lds + (bufoff) + ldsw + _i * 8192), 16, 0, 0); } while (0)
#define PG8_LD8(ptr) __builtin_shufflevector(*(const LDS3 i32x4*)(ptr), *(const LDS3 i32x4*)((ptr) + 1024), 0, 1, 2, 3, 4, 5, 6, 7)
#define PG8_LO(x) __builtin_bit_cast(bf16x8, __builtin_shufflevector(x, x, 0, 1, 2, 3))
#define PG8_HI(x) __builtin_bit_cast(bf16x8, __builtin_shufflevector(x, x, 4, 5, 6, 7))
#define PG8_LDA(dst, b, h) do { _Pragma("unroll") for (int m = 0; m < 4; ++m) dst[m] = PG8_LD8(lds + PG8_SA(b, h) + aoff + m * 2048); } while (0)
#define PG8_LDB(dst, b, h) do { _Pragma("unroll") for (int n = 0; n < 2; ++n) dst[n] = PG8_LD8(lds + PG8_SB(b, h) + boff + n * 2048); } while (0)
#define PG8_MMA(ai, bj, At, Bt) do { __builtin_amdgcn_s_setprio(1); _Pragma("unroll") for (int m = 0; m < 4; ++m) _Pragma("unroll") for (int n = 0; n < 2; ++n) { \
        if constexpr (Epi::FP8) asm volatile("v_mfma_scale_f32_16x16x128_f8f6f4 %0, %1, %2, %0, %3, %4 op_sel_hi:[0,0,0]" : "+v"(acc[ai][bj][m][n]) : "v"(Bt[n]), "v"(At[m]), "v"(sc_w), "v"(sc_1)); \
        else { acc[ai][bj][m][n] = __builtin_amdgcn_mfma_f32_16x16x32_bf16(PG8_LO(Bt[n]), PG8_LO(At[m]), acc[ai][bj][m][n], 0, 0, 0); acc[ai][bj][m][n] = __builtin_amdgcn_mfma_f32_16x16x32_bf16(PG8_HI(Bt[n]), PG8_HI(At[m]), acc[ai][bj][m][n], 0, 0, 0); } } __builtin_amdgcn_s_setprio(0); } while (0)
#define PG8_WAIT_V(n) asm volatile("s_waitcnt vmcnt(" #n ")" ::: "memory")
#define PG8_WAIT_L(n) asm volatile("s_waitcnt lgkmcnt(" #n ")" ::: "memory")
#define PG8_BAR __builtin_amdgcn_s_barrier()
#define PG8_SCHED __builtin_amdgcn_sched_barrier(0)
    Unit cur, nxt; int ui = 0;
    if (!S.next(0, cur)) return;
    f32x4 acc[2][2][4][2];
#pragma unroll
    for (int a = 0; a < 2; ++a)
#pragma unroll
        for (int b = 0; b < 2; ++b)
#pragma unroll
            for (int m = 0; m < 4; ++m)
#pragma unroll
                for (int n = 0; n < 2; ++n) acc[a][b][m][n] = (f32x4){0.f, 0.f, 0.f, 0.f};
    i32x8 At[4], B0[2], B1[2];
    int sc_w = 0x7A7A7A7A  , sc_1 = 0x7F7F7F7F; asm volatile("" : "+v"(sc_w), "+v"(sc_1));
    const char* cA = S.a_ptr(cur); const char* cB = S.b_ptr(cur);
    unsigned vAc[2][2], vAn[2][2];
    LDS3 int* rtab = (LDS3 int*)(lds + LDS_TAB_OFF);
    if constexpr (Prob::GATHER) { const int* rw = S.rows(cur);
#pragma unroll
        for (int h = 0; h < 2; ++h)
#pragma unroll
            for (int i = 0; i < 2; ++i) vAc[h][i] = (unsigned)rw[h * HALF + Rrow[i]] + voffA[i];
    } else {
#pragma unroll
        for (int h = 0; h < 2; ++h)
#pragma unroll
            for (int i = 0; i < 2; ++i) vAc[h][i] = voffA[i] + (unsigned)(h * hstep);
    }
#pragma unroll
    for (int h = 0; h < 2; ++h)
#pragma unroll
        for (int i = 0; i < 2; ++i) vAn[h][i] = vAc[h][i];
    if constexpr (GEMM_SP2) {
        PG8_STAGE(PG8_SB(0, 0), cB, voffB); PG8_STAGE(PG8_SB(0, 1), cB + hstepB, voffB); PG8_STAGE(PG8_SA(0, 0), cA, vAc[0]); PG8_STAGE(PG8_SA(0, 1), cA, vAc[1]);
        if (wr == 1) PG8_BAR;
        PG8_WAIT_V(2); PG8_BAR;
        PG8_STAGE(PG8_SB(1, 0), cB + kstep, voffB); PG8_STAGE(PG8_SA(1, 0), cA + kstep, vAc[0]); PG8_STAGE(PG8_SB(1, 1), cB + hstepB + kstep, voffB);
        PG8_WAIT_V(6); PG8_BAR;
    } else {
    PG8_STAGE(PG8_SB(0, 0), cB, voffB); PG8_STAGE(PG8_SA(0, 0), cA, vAc[0]); PG8_STAGE(PG8_SB(0, 1), cB + hstepB, voffB); PG8_STAGE(PG8_SA(0, 1), cA, vAc[1]);
    if (wr == 1) PG8_BAR;
    PG8_WAIT_V(4); PG8_BAR;
    PG8_STAGE(PG8_SB(1, 0), cB + kstep, voffB); PG8_STAGE(PG8_SA(1, 0), cA + kstep, vAc[0]); PG8_STAGE(PG8_SB(1, 1), cB + hstepB + kstep, voffB);
    PG8_WAIT_V(6); PG8_BAR;
    }
    for (;;) {
        const bool has_next = S.next(ui + 1, nxt);
        const char* nA = has_next ? S.a_ptr(nxt) : cA; const char* nB = has_next ? S.b_ptr(nxt) : cB;
        if constexpr (Prob::GATHER) { if (has_next && wid < 4) __builtin_amdgcn_global_load_lds((const unsigned*)(S.rows(nxt) + wid * 64 + lane), (LDS3 unsigned*)(lds + LDS_TAB_OFF + wid * 256), 4, 0, 0); }
        for (int t = 0; t < nt; t += 2) {
            const bool last = (t == nt - 2);
            const char* a1 = cA + (size_t)(t + 1) * kstep;
            const char* a2 = last ? nA : cA + (size_t)(t + 2) * kstep; const char* b2 = last ? nB : cB + (size_t)(t + 2) * kstep;
            const char* a3 = a2 + kstep; const char* b3 = b2 + kstep;
            if constexpr (Prob::GATHER) { if (last && has_next) {
#pragma unroll
                for (int h = 0; h < 2; ++h)
#pragma unroll
                    for (int i = 0; i < 2; ++i) vAn[h][i] = (unsigned)rtab[h * HALF + Rrow[i]] + voffA[i]; } }
            unsigned vS[2][2];
#pragma unroll
            for (int h = 0; h < 2; ++h)
#pragma unroll
                for (int i = 0; i < 2; ++i) vS[h][i] = last ? vAn[h][i] : vAc[h][i];
            if constexpr (GEMM_SP2) {
            PG8_LDB(B0, 0, 0); PG8_LDB(B1, 0, 1); PG8_SCHED; PG8_LDA(At, 0, 0); PG8_STAGE(PG8_SA(1, 1), a1, vAc[1]);
            PG8_WAIT_V(8); PG8_WAIT_L(0); PG8_BAR; PG8_MMA(0, 0, At, B0); PG8_MMA(0, 1, At, B1); PG8_BAR; PG8_SCHED;
            PG8_LDA(At, 0, 1); PG8_STAGE(PG8_SB(0, 0), b2, voffB); PG8_STAGE(PG8_SB(0, 1), b2 + hstepB, voffB); PG8_STAGE(PG8_SA(0, 0), a2, vS[0]);
            PG8_WAIT_V(8); PG8_WAIT_L(0); PG8_BAR; PG8_MMA(1, 0, At, B0); PG8_MMA(1, 1, At, B1); PG8_BAR; PG8_SCHED;
            PG8_LDB(B0, 1, 0); PG8_LDB(B1, 1, 1); PG8_SCHED; PG8_LDA(At, 1, 0); PG8_STAGE(PG8_SA(0, 1), a2, vS[1]);
            PG8_WAIT_V(8); PG8_WAIT_L(0); PG8_BAR; PG8_MMA(0, 0, At, B0); PG8_MMA(0, 1, At, B1); PG8_BAR; PG8_SCHED;
            PG8_LDA(At, 1, 1); PG8_STAGE(PG8_SB(1, 0), b3, voffB); PG8_STAGE(PG8_SB(1, 1), b3 + hstepB, voffB); PG8_STAGE(PG8_SA(1, 0), a3, vS[0]);
            PG8_WAIT_V(8); PG8_WAIT_L(0); PG8_BAR; PG8_MMA(1, 0, At, B0); PG8_MMA(1, 1, At, B1); PG8_BAR; PG8_SCHED;
            } else {
            PG8_LDB(B0, 0, 0); PG8_SCHED; PG8_LDA(At, 0, 0); PG8_STAGE(PG8_SA(1, 1), a1, vAc[1]);
            PG8_WAIT_L(8); PG8_BAR; PG8_WAIT_L(0); PG8_MMA(0, 0, At, B0); PG8_BAR; PG8_SCHED;
            PG8_LDB(B1, 0, 1); PG8_STAGE(PG8_SB(0, 0), b2, voffB);
            PG8_BAR; PG8_WAIT_L(0); PG8_MMA(0, 1, At, B1); PG8_BAR;
            PG8_LDA(At, 0, 1); PG8_STAGE(PG8_SA(0, 0), a2, vS[0]);
            PG8_BAR; PG8_WAIT_L(0); PG8_MMA(1, 0, At, B0); PG8_BAR; PG8_SCHED;
            PG8_STAGE(PG8_SB(0, 1), b2 + hstepB, voffB);
            PG8_WAIT_V(6); PG8_BAR; PG8_MMA(1, 1, At, B1); PG8_BAR;
            PG8_LDB(B0, 1, 0); PG8_SCHED; PG8_LDA(At, 1, 0); PG8_STAGE(PG8_SA(0, 1), a2, vS[1]);
            PG8_WAIT_L(8); PG8_BAR; PG8_WAIT_L(0); PG8_MMA(0, 0, At, B0); PG8_BAR; PG8_SCHED;
            PG8_LDB(B1, 1, 1); PG8_STAGE(PG8_SB(1, 0), b3, voffB);
            PG8_BAR; PG8_WAIT_L(0); PG8_MMA(0, 1, At, B1); PG8_BAR;
            PG8_LDA(At, 1, 1); PG8_STAGE(PG8_SA(1, 0), a3, vS[0]);
            PG8_BAR; PG8_WAIT_L(0); PG8_MMA(1, 0, At, B0); PG8_BAR; PG8_SCHED;
            PG8_STAGE(PG8_SB(1, 1), b3 + hstepB, voffB);
            PG8_WAIT_V(6); PG8_BAR; PG8_MMA(1, 1, At, B1); PG8_BAR;
            }
        }
        if constexpr (GEMM_ALIGN_EPI) { if (wr == 0) PG8_BAR; }
        if constexpr (Epi::FP8) asm volatile("s_nop 15\n\ts_nop 15" ::: "memory");
        E(acc, cur, wr, wc, fr, fq);
        if (!has_next) break;
#pragma unroll
        for (int a = 0; a < 2; ++a)
#pragma unroll
            for (int b = 0; b < 2; ++b)
#pragma unroll
                for (int m = 0; m < 4; ++m)
#pragma unroll
                    for (int n = 0; n < 2; ++n) acc[a][b][m][n] = (f32x4){0.f, 0.f, 0.f, 0.f};
        if constexpr (Epi::FP8) asm volatile("s_nop 7" ::: "memory");
        cur = nxt; cA = nA; cB = nB; ++ui;
#pragma unroll
        for (int h = 0; h < 2; ++h)
#pragma unroll
            for (int i = 0; i < 2; ++i) vAc[h][i] = vAn[h][i];
        if constexpr (GEMM_ALIGN_EPI) { if (wr == 1) PG8_BAR; }
    }
    PG8_WAIT_V(0);
    if constexpr (!GEMM_ALIGN_EPI) { if (wr == 0) PG8_BAR; }
    PG8_BAR;
#undef PG8_SA
#undef PG8_SB
#undef PG8_STAGE
#undef PG8_LDA
#undef PG8_LDB
#undef PG8_MMA
#undef PG8_LD8
#undef PG8_LO
#undef PG8_HI
#undef PG8_WAIT_V
#undef PG8_WAIT_L
#undef PG8_BAR
#undef PG8_SCHED
}
}
using pg8::Unit;

extern __shared__ __attribute__((aligned(16))) char smem[];
__device__ __forceinline__ char* smem_base() { return smem; }

constexpr int EPI_LDS = 131072;
__device__ __forceinline__ char* epi_slot(int wr, int wc) { return smem_base() + EPI_LDS + (wr * 4 + wc) * 2048; }
__device__ __forceinline__ void slot_put(char* slot, int fr, int fq, u32x4 w0, u32x4 w1) {
    *(u32x4*)(slot + fr * 128 + (((fq) ^ (fr & 7)) << 4)) = w0; *(u32x4*)(slot + fr * 128 + (((4 + fq) ^ (fr & 7)) << 4)) = w1; }
__device__ __forceinline__ u32x4 slot_get(const char* slot, int half, int lane) { const int row = half * 8 + (lane >> 3), ch = lane & 7; return *(const u32x4*)(slot + row * 128 + ((ch ^ (row & 7)) << 4)); }

#define EPI_ROWS(ai, m) for (int ai = 0; ai < 2; ++ai) _Pragma("unroll") for (int m = 0; m < 4; ++m)

template <bool F8_> struct EpiProjT {
    static constexpr bool PERM = true, FP8 = F8_;
    unsigned char* ws;
    __device__ __forceinline__ void operator()(const f32x4 (&acc)[2][2][4][2], const Unit& u, int wr, int wc, int fr, int fq) const {
        const int pn = u.pn; const int lane = fq * 16 + fr; char* slot = epi_slot(wr, wc);
        const int rowq = u.pm * 256 + wr * 64 + (lane >> 3);
        if (pn < 12 || (pn >= 30 && pn < 38)) {
            size_t boff; int ld, col0, act;
            if (pn < 2) { boff = WS_GQ; ld = 512; col0 = pn * 256; act = 0; }
            else if (pn < 4) { boff = WS_GK; ld = 512; col0 = (pn - 2) * 256; act = 0; }
            else if (pn < 8) { boff = WS_GV; ld = 1024; col0 = (pn - 4) * 256; act = 0; }
            else if (pn < 12) { boff = WS_GR; ld = 1024; col0 = (pn - 8) * 256; act = 1; }
            else if (pn < 34) { boff = WS_SG; ld = 1024; col0 = (pn - 30) * 256; act = 2; }
            else { boff = WS_SA; ld = 1024; col0 = (pn - 34) * 256; act = 2; }
            bf16_t* base = (bf16_t*)(ws + boff) + col0 + wc * 64 + (lane & 7) * 8;
#pragma unroll
            EPI_ROWS(ai, m) { u32x4 w[2];
#pragma unroll
                for (int bj = 0; bj < 2; ++bj) { float v[8];
#pragma unroll
                    for (int j = 0; j < 4; ++j) { v[j] = acc[ai][bj][m][0][j]; v[4 + j] = acc[ai][bj][m][1][j]; }
                    if (act == 1) {
#pragma unroll
                        for (int j = 0; j < 8; ++j) v[j] = v[j] * sigmoidf_(v[j]); }
                    if (act == 2) {
#pragma unroll
                        for (int j = 0; j < 8; ++j) v[j] = sigmoidf_(v[j]); }
                    w[bj] = pack8(v); }
                slot_put(slot, fr, fq, w[0], w[1]);
#pragma unroll
                for (int half = 0; half < 2; ++half) st_nt(base + (size_t)(rowq + ai * 128 + m * 16 + half * 8) * ld, slot_get(slot, half, lane)); }
        } else if (pn < 30) {
            const int which = (pn - 12) / 6, t6 = (pn - 12) % 6, sh = (t6 >> 1) * 2, dmask = (1 << sh) - 1, NL = SEQ >> sh;
            unsigned char* base = ws + WS_AQ + (size_t)which * ((size_t)NTOK * 1536 * 2) + (lane & 3) * 16;
            const bool rot = (which < 2) && (fq < 2);
            f32x4 frev;
#pragma unroll
            for (int q = 0; q < 4; ++q) frev[q] = rot ? __builtin_amdgcn_exp2f(-(float)(4 * fq + q) * (0.125f * 18.931568569324174f)) * 0.15915494309189535f : 0.f;
            const int head = t6 * 4 + wc;
            const int rowq4 = u.pm * 256 + wr * 64 + (lane >> 2);
#pragma unroll
            EPI_ROWS(ai, m) { const int s = (u.pm * 256 + wr * 64 + fr + ai * 128 + m * 16) & (SEQ - 1);
                f32x4 cs, sn;
#pragma unroll
                for (int q = 0; q < 4; ++q) { const float rev = __builtin_amdgcn_fractf((float)s * frev[q]); cs[q] = __builtin_amdgcn_cosf(rev); sn[q] = __builtin_amdgcn_sinf(rev); }
#pragma unroll
                for (int bj = 0; bj < 2; ++bj) { float v[8];
#pragma unroll
                    for (int j = 0; j < 4; ++j) { v[j] = acc[ai][bj][m][0][j]; v[4 + j] = acc[ai][bj][m][1][j]; }
                    if (bj == 0) { const float a0 = v[0] * cs[0] - v[1] * sn[0], a1 = v[1] * cs[0] + v[0] * sn[0], a2 = v[2] * cs[1] - v[3] * sn[1], a3 = v[3] * cs[1] + v[2] * sn[1];
                      const float a4 = v[4] * cs[2] - v[5] * sn[2], a5 = v[5] * cs[2] + v[4] * sn[2], a6 = v[6] * cs[3] - v[7] * sn[3], a7 = v[7] * cs[3] + v[6] * sn[3];
                      v[0] = a0; v[1] = a1; v[2] = a2; v[3] = a3; v[4] = a4; v[5] = a5; v[6] = a6; v[7] = a7; }
                    u32x2 w8; w8.x = (unsigned)pk4_fp8(v[0], v[1], v[2], v[3]); w8.y = (unsigned)pk4_fp8(v[4], v[5], v[6], v[7]);
                    *(u32x2*)(slot + fr * 64 + bj * 32 + 8 * fq) = w8; }
                const u32x4 o = *(const u32x4*)(slot + (lane >> 2) * 64 + (lane & 3) * 16);
                const int row = rowq4 + ai * 128 + m * 16, b = row >> 12, s2 = row & (SEQ - 1), r = s2 & dmask, n = s2 >> sh;
                st_nt(base + ((size_t)(b * 24 + head) * SEQ + (size_t)r * NL + n) * 64, o); }
        } else {
            const int row0 = u.pm * 256 + wr * 64 + fr;
            if (wc == 0 && fq < 2) { float* glr = (float*)(ws + WS_GLR);
#pragma unroll
                EPI_ROWS(ai, m) { float* rowp = glr + (size_t)(row0 + ai * 128 + m * 16) * 16 + 8 * fq; *(f32x4*)rowp = acc[ai][0][m][0]; *(f32x4*)(rowp + 4) = acc[ai][0][m][1]; } }
        }
    }
};

template <int MODE> struct EpiGate {
    static constexpr bool PERM = true, FP8 = false;
    const bf16_t* gate; const bf16_t* t1; bf16_t* out;
    __device__ __forceinline__ void operator()(const f32x4 (&acc)[2][2][4][2], const Unit& u, int wr, int wc, int fr, int fq) const {
        const int lane = fq * 16 + fr; char* slot = epi_slot(wr, wc);
        const size_t off0 = (size_t)(u.pm * 256 + wr * 64 + (lane >> 3)) * 1024 + u.pn * 256 + wc * 64 + (lane & 7) * 8;
#pragma unroll
        for (int ai = 0; ai < 2; ++ai) { u32x4 gw[4][2], tw[4][2];
#pragma unroll
            for (int m = 0; m < 4; ++m)
#pragma unroll
                for (int half = 0; half < 2; ++half) { const size_t off = off0 + (size_t)(ai * 128 + m * 16 + half * 8) * 1024; gw[m][half] = *(const u32x4*)(gate + off); if (MODE == 1) tw[m][half] = *(const u32x4*)(t1 + off); }
#pragma unroll
            for (int m = 0; m < 4; ++m) { u32x4 w[2];
#pragma unroll
                for (int bj = 0; bj < 2; ++bj) { float v[8];
#pragma unroll
                    for (int j = 0; j < 4; ++j) { v[j] = acc[ai][bj][m][0][j]; v[4 + j] = acc[ai][bj][m][1][j]; }
                    w[bj] = pack8(v); }
                slot_put(slot, fr, fq, w[0], w[1]);
#pragma unroll
                for (int half = 0; half < 2; ++half) { float a[8], g[8]; unpack8(slot_get(slot, half, lane), a); unpack8(gw[m][half], g);
#pragma unroll
                    for (int j = 0; j < 8; ++j) a[j] *= g[j];
                    if (MODE == 1) { float t[8]; unpack8(tw[m][half], t);
#pragma unroll
                        for (int j = 0; j < 8; ++j) a[j] += t[j]; }
                    *(u32x4*)(out + off0 + (size_t)(ai * 128 + m * 16 + half * 8) * 1024) = pack8(a); } } }
    }
};

struct EpiResid {
    static constexpr bool PERM = false, FP8 = false;
    const float* x; bf16_t* h;
    __device__ __forceinline__ void operator()(const f32x4 (&acc)[2][2][4][2], const Unit& u, int wr, int wc, int fr, int fq) const {
        const int lane = fq * 16 + fr; char* slot = epi_slot(wr, wc);
        const size_t off0 = (size_t)(u.pm * 256 + wr * 64 + (lane >> 3)) * 1024 + u.pn * 256 + wc * 32 + (lane & 7) * 4;
#pragma unroll
        for (int ai = 0; ai < 2; ++ai)
#pragma unroll
            for (int bj = 0; bj < 2; ++bj) { f32x4 xv[4][2];
#pragma unroll
                for (int m = 0; m < 4; ++m)
#pragma unroll
                    for (int half = 0; half < 2; ++half) xv[m][half] = *(const f32x4*)(x + off0 + (size_t)(ai * 128 + m * 16 + half * 8) * 1024 + bj * 128);
#pragma unroll
                for (int m = 0; m < 4; ++m) { slot_put(slot, fr, fq, __builtin_bit_cast(u32x4, acc[ai][bj][m][0]), __builtin_bit_cast(u32x4, acc[ai][bj][m][1]));
#pragma unroll
                    for (int half = 0; half < 2; ++half) { const f32x4 a = __builtin_bit_cast(f32x4, slot_get(slot, half, lane));
                        const f32x4 r = a + xv[m][half]; u32x2 w2; w2.x = cvt_pk_bf16(r[0], r[1]); w2.y = cvt_pk_bf16(r[2], r[3]);
                        *(u32x2*)(h + off0 + (size_t)(ai * 128 + m * 16 + half * 8) * 1024 + bj * 128) = w2; } } }
    }
};

struct EpiAct {
    static constexpr bool PERM = true, FP8 = true;
    const float* bgu; const int* tile_e; unsigned char* act;
    __device__ __forceinline__ void operator()(const f32x4 (&acc)[2][2][4][2], const Unit& u, int wr, int wc, int fr, int fq) const {
        const int e = tile_e[u.pm]; const int row0 = u.pm * 256 + wr * 64 + fr; const int j0 = u.pn * 128 + wc * 32 + 8 * fq;
        float bg[8], bu[8];
        { const float* bp = bgu + (size_t)e * 2048 + 2 * j0;
#pragma unroll
          for (int q = 0; q < 4; ++q) { const f32x4 t = *(const f32x4*)(bp + 4 * q); bg[2 * q] = t[0]; bu[2 * q] = t[1]; bg[2 * q + 1] = t[2]; bu[2 * q + 1] = t[3]; } }
#pragma unroll
        EPI_ROWS(ai, m) { float v[8];
#pragma unroll
            for (int j = 0; j < 8; ++j) { const float gt = acc[ai][0][m][j >> 2][j & 3] + bg[j], up = acc[ai][1][m][j >> 2][j & 3] + bu[j];
                const float g = fminf(gt, 7.0f), uu = fminf(fmaxf(up, -7.0f), 7.0f); v[j] = (uu + 1.0f) * (g * sigmoidf_(1.702f * g)); }
            u32x2 w8; w8.x = (unsigned)pk4_fp8(v[0], v[1], v[2], v[3]); w8.y = (unsigned)pk4_fp8(v[4], v[5], v[6], v[7]);
            *(u32x2*)(act + (size_t)(row0 + ai * 128 + m * 16) * 1024 + j0) = w8; }
    }
};

struct EpiDown {
    static constexpr bool PERM = true, FP8 = true;
    const float* bd; const int* tile_e; unsigned char* y;
    __device__ __forceinline__ void operator()(const f32x4 (&acc)[2][2][4][2], const Unit& u, int wr, int wc, int fr, int fq) const {
        const int e = tile_e[u.pm]; const int lane = fq * 16 + fr; char* slot = epi_slot(wr, wc); const int col0 = u.pn * 256 + wc * 64 + 8 * fq;
        f32x4 b[2][2];
#pragma unroll
        for (int bj = 0; bj < 2; ++bj)
#pragma unroll
            for (int n = 0; n < 2; ++n) b[bj][n] = *(const f32x4*)(bd + (size_t)e * 1024 + col0 + bj * 32 + 4 * n);
        unsigned char* base = y + (size_t)(u.pm * 256 + wr * 64 + (lane >> 2)) * 1024 + u.pn * 256 + wc * 64 + (lane & 3) * 16;
#pragma unroll
        EPI_ROWS(ai, m) { u32x2 w[2];
#pragma unroll
            for (int bj = 0; bj < 2; ++bj) { const f32x4 v0 = acc[ai][bj][m][0] + b[bj][0], v1 = acc[ai][bj][m][1] + b[bj][1];
                w[bj].x = (unsigned)pk4_fp8(v0[0], v0[1], v0[2], v0[3]); w[bj].y = (unsigned)pk4_fp8(v1[0], v1[1], v1[2], v1[3]); }
            *(u32x2*)(slot + fr * 64 + 8 * fq) = w[0]; *(u32x2*)(slot + fr * 64 + 32 + 8 * fq) = w[1];
            const u32x4 o = *(const u32x4*)(slot + (lane >> 2) * 64 + (lane & 3) * 16);
            *(u32x4*)(base + (size_t)(ai * 128 + m * 16) * 1024) = o; }
    }
};

__device__ __forceinline__ int win_colmap(int n) {
    if (n < 3072) return n;
    if (n < 7680) { const int off = n - 3072, which = off / 1536, hcol = off % 1536, head = hcol >> 6, p = hcol & 63;
        int dim = p; if (which < 2 && p < 16) dim = (p & 1) ? (p >> 1) + 8 : (p >> 1);
        return 3088 + which * 1536 + head * 64 + dim; }
    if (n < 9728) return 7696 + (n - 7680);
    if (n < 9744) return 3072 + (n - 9728);
    return -1;
}
__device__ __forceinline__ int gu_colmap(int n) { const int t = n >> 8, w = n & 255, wc = w >> 6, bj = (w >> 5) & 1, rho = w & 31; return 2 * (128 * t + 32 * wc + rho) + bj; }

__device__ __forceinline__ void transpose_tile(const float* src, int ld_src, bf16_t* dst, int K, int n0, int k0, int scol, char* lds) {
    const int t = tid_(), nl = t & 127, kq = t >> 7;
#pragma unroll
    for (int cc = 0; cc < 4; ++cc) { const int c = kq * 4 + cc; float v[8];
#pragma unroll
        for (int j = 0; j < 8; ++j) v[j] = scol >= 0 ? src[(size_t)(k0 + c * 8 + j) * ld_src + scol] : 0.f;
        *(u32x4*)(lds + nl * 256 + ((c ^ (nl & 15)) << 4)) = pack8(v); }
    __syncthreads();
#pragma unroll
    for (int pass = 0; pass < 4; ++pass) { const int idx = t + 512 * pass, n2 = idx >> 4, c2 = idx & 15;
        *(u32x4*)(dst + (size_t)(n0 + n2) * K + k0 + c2 * 8) = *(const u32x4*)(lds + n2 * 256 + ((c2 ^ (n2 & 15)) << 4)); }
    __syncthreads();
}

__device__ __forceinline__ void transpose_tile8(const float* src, int ld_src, unsigned char* dst, int K, int n0, int k0, int scol, float scale, char* lds) {
    const int t = tid_(), nl = t & 127, kq = t >> 7;
#pragma unroll
    for (int cc = 0; cc < 4; ++cc) { const int c = kq * 4 + cc; float v[16];
#pragma unroll
        for (int j = 0; j < 16; ++j) v[j] = scol >= 0 ? src[(size_t)(k0 + c * 16 + j) * ld_src + scol] * scale : 0.f;
        u32x4 w; w.x = (unsigned)pk4_fp8(v[0], v[1], v[2], v[3]); w.y = (unsigned)pk4_fp8(v[4], v[5], v[6], v[7]); w.z = (unsigned)pk4_fp8(v[8], v[9], v[10], v[11]); w.w = (unsigned)pk4_fp8(v[12], v[13], v[14], v[15]);
        *(u32x4*)(lds + nl * 256 + ((c ^ (nl & 15)) << 4)) = w; }
    __syncthreads();
#pragma unroll
    for (int pass = 0; pass < 4; ++pass) { const int idx = t + 512 * pass, n2 = idx >> 4, c2 = idx & 15;
        *(u32x4*)(dst + (size_t)(n0 + n2) * K + k0 + c2 * 16) = *(const u32x4*)(lds + n2 * 256 + ((c2 ^ (n2 & 15)) << 4)); }
    __syncthreads();
}

template <int MAP> __device__ __forceinline__ int tile_rowmap(int o) {
    if (MAP == 1) { const int d = o & 63; const int pp = d < 16 ? (d < 8 ? 2 * d : 2 * (d - 8) + 1) : d; return (o & 64) + pp; }
    if (MAP == 2) { const int wcl = o >> 6, w = o & 63; return 64 * wcl + 32 * (w & 1) + (w >> 1); }
    return o;
}
template <int MAP, bool F8> __device__ __forceinline__ void transpose_fast(const float* src  , int ld_src, unsigned char* dst, int Kb  , int n0, int k0, float scale, char* lds) {
    constexpr int KPT = F8 ? 16 : 8;
    const int t = tid_(), ng = t & 31, kg = t >> 5;
    f32x4 v[KPT];
#pragma unroll
    for (int j = 0; j < KPT; ++j) v[j] = *(const f32x4*)(src + (size_t)(k0 + kg * KPT + j) * ld_src + 4 * ng);
#pragma unroll
    for (int i = 0; i < 4; ++i) { const int row = tile_rowmap<MAP>(4 * ng + i); u32x4 w;
        if (F8) { w.x = (unsigned)pk4_fp8(v[0][i] * scale, v[1][i] * scale, v[2][i] * scale, v[3][i] * scale); w.y = (unsigned)pk4_fp8(v[4][i] * scale, v[5][i] * scale, v[6][i] * scale, v[7][i] * scale);
                  w.z = (unsigned)pk4_fp8(v[8 % KPT][i] * scale, v[9 % KPT][i] * scale, v[10 % KPT][i] * scale, v[11 % KPT][i] * scale); w.w = (unsigned)pk4_fp8(v[12 % KPT][i] * scale, v[13 % KPT][i] * scale, v[14 % KPT][i] * scale, v[15 % KPT][i] * scale); }
        else { w.x = cvt_pk_bf16(v[0][i], v[1][i]); w.y = cvt_pk_bf16(v[2][i], v[3][i]); w.z = cvt_pk_bf16(v[4][i], v[5][i]); w.w = cvt_pk_bf16(v[6][i], v[7][i]); }
        *(u32x4*)(lds + row * 256 + ((kg ^ (row & 15)) << 4)) = w; }
    __syncthreads();
#pragma unroll
    for (int pass = 0; pass < 4; ++pass) { const int idx = t + 512 * pass, n2 = idx >> 4, c2 = idx & 15;
        *(u32x4*)(dst + (size_t)(n0 + n2) * Kb + (size_t)k0 * (F8 ? 1 : 2) + c2 * 16) = *(const u32x4*)(lds + n2 * 256 + ((c2 ^ (n2 & 15)) << 4)); }
    __syncthreads();
}

constexpr int N_EXPERT_TILES_P0 = 1024;
__device__ __forceinline__ void expert_convert(const Params& p, char* lds, int first, int stride, int lo, int hi);
__device__ __forceinline__ void phase_prologue(const Params& p, char* lds) {
    unsigned char* ws = opaque(p.ws);
    const int tid = tid_(), lane = tid & 63, wid = tid >> 6, G = gridDim.x, bid = blockIdx.x;
    { bf16_t* xn = (bf16_t*)(ws + WS_XN); unsigned char* xn8 = ws + WS_XN8;
      for (int row = bid * 8 + wid; row < NTOK; row += G * 8) { const float* xr = p.x + (size_t)row * 1024; f32x4 v[4]; float ss = 0.f;
#pragma unroll
          for (int i = 0; i < 4; ++i) { v[i] = *(const f32x4*)(xr + i * 256 + lane * 4); ss += v[i][0] * v[i][0] + v[i][1] * v[i][1] + v[i][2] * v[i][2] + v[i][3] * v[i][3]; }
          ss = wave_sum(ss); const float rs = rsqrtf(ss * (1.0f / 1024.0f) + EPS);
#pragma unroll
          for (int i = 0; i < 4; ++i) { const f32x4 g = *(const f32x4*)(p.norm_mix_g + i * 256 + lane * 4); const float y0 = v[i][0] * rs * g[0], y1 = v[i][1] * rs * g[1], y2 = v[i][2] * rs * g[2], y3 = v[i][3] * rs * g[3];
              u32x2 w; w.x = cvt_pk_bf16(y0, y1); w.y = cvt_pk_bf16(y2, y3);
              *(u32x2*)(xn + (size_t)row * 1024 + i * 256 + lane * 4) = w; *(unsigned*)(xn8 + (size_t)row * 1024 + i * 256 + lane * 4) = (unsigned)pk4_fp8(y0, y1, y2, y3); } } }
    { float* rwg = (float*)(ws + WS_RWG);
      for (int i = bid * 512 + tid; i < 1024 * 32; i += G * 512) rwg[i] = p.router_w[i] * p.norm_ffn_g[i >> 5]; }
    { constexpr int T0 = 78 * 8, T1 = T0 + 64, T2 = T1 + 32, T3 = T2 + 64, T4 = T3 + 32 * 64, T5 = T4 + 32 * 32;
      const int nl = tid & 127;
      for (int tile = bid; tile < T3; tile += G) {
          if (tile < T0) { const int nt_ = tile >> 3, kt = tile & 7; const int t256 = nt_ >> 1; const bool sens = ((SENSMASK >> t256) & 1ull) != 0ull;
              bf16_t* d = (bf16_t*)(ws + WS_W_IN); unsigned char* d16 = ws + WS_W_IN; unsigned char* d8 = ws + WS_WIN8;
              const float* srcg = nt_ < 24 ? p.w_in + nt_ * 128 : (nt_ < 60 ? p.w_in + 3088 + (nt_ - 24) * 128 : p.w_in + 7696 + (nt_ - 60) * 128); const bool rotmap = nt_ >= 24 && nt_ < 48;
              if (sens) {
                  if (nt_ >= 76) transpose_tile(p.w_in, INW, d, 1024, nt_ * 128, kt * 128, win_colmap(nt_ * 128 + nl), lds);
                  else if (rotmap) transpose_fast<1, false>(srcg, INW, d16, 2048, nt_ * 128, kt * 128, 1.f, lds);
                  else transpose_fast<0, false>(srcg, INW, d16, 2048, nt_ * 128, kt * 128, 1.f, lds);
              } else if (kt < 4) {
                  if (nt_ >= 76) transpose_tile8(p.w_in, INW, d8, 1024, nt_ * 128, kt * 256, win_colmap(nt_ * 128 + nl), 32.f, lds);
                  else if (rotmap) transpose_fast<1, true>(srcg, INW, d8, 1024, nt_ * 128, kt * 256, 32.f, lds);
                  else transpose_fast<0, true>(srcg, INW, d8, 1024, nt_ * 128, kt * 256, 32.f, lds);
              } }
          else if (tile < T1) { const int q = tile - T0, nt_ = q >> 3, kt = q & 7; transpose_fast<0, false>(p.w_branch_gla + nt_ * 128, 1024, ws + WS_W_G, 2048, nt_ * 128, kt * 128, 1.f, lds); }
          else if (tile < T2) { const int q = tile - T1, nt_ = q >> 2, kt = q & 3; transpose_fast<0, false>(p.w_branch_att + nt_ * 128, 1024, ws + WS_W_A, 1024, nt_ * 128, kt * 128, 1.f, lds); }
          else if (tile < T3) { const int q = tile - T2, nt_ = q >> 3, kt = q & 7; transpose_fast<0, false>(p.w_mix_out + nt_ * 128, 1024, ws + WS_W_MIX, 2048, nt_ * 128, kt * 128, 1.f, lds); }
      } }
    expert_convert(p, lds, bid, G, 0, N_EXPERT_TILES_P0);
}

constexpr int N_EXPERT_TILES = 32 * 64 + 32 * 32;
__device__ __forceinline__ void expert_convert(const Params& p, char* lds, int first, int stride, int lo, int hi) {
    unsigned char* ws = opaque(p.ws);
    for (int q0 = lo + first; q0 < hi; q0 += stride) {
        if (q0 < 32 * 64) { const int q = q0, e = q >> 6, r = q & 63, nt_ = r >> 2, kt = r & 3;
            transpose_fast<2, true>(p.e_w_gu + (size_t)e * 1024 * 2048 + nt_ * 128, 2048, ws + WS_W_GU + (size_t)e * 2048 * 1024, 1024, nt_ * 128, kt * 256, 32.0f, lds); }
        else { const int q = q0 - 32 * 64, e = q >> 5, r = q & 31, nt_ = r >> 2, kt = r & 3;
            transpose_fast<0, true>(p.e_w_d + (size_t)e * 1024 * 1024 + nt_ * 128, 1024, ws + WS_W_D + (size_t)e * 1024 * 1024, 1024, nt_ * 128, kt * 256, 32.0f, lds); }
    }
}

constexpr int AT_KCS = 385 * 16;
constexpr int AT_VH = 385 * 64;
constexpr int AT_K = 0, AT_V = 8 * AT_KCS, AT_WL = AT_V + 2 * AT_VH, AT_STG = AT_WL + 8 * 128, AT_END = AT_STG + 8 * 4096;
static_assert(AT_END <= LDS_BYTES, "attention LDS");
struct AttnPre { u32x4 k[3], v[3]; u32x2 q[4]; };
__device__ __forceinline__ void attn_fetch(const Params& p, int item, AttnPre& r) {
    unsigned char* ws = opaque(p.ws); const int tid = tid_();
    const int jj = item & 15, bh = item >> 4, head = bh % 24, g = head >> 3, sh = 2 * g, NL = SEQ >> sh, ppr = 16 >> sh; const int rr_ = jj / ppr, j = jj % ppr;
    const size_t hb = ((size_t)bh * SEQ + (size_t)rr_ * NL) * 64; const unsigned char* Kg = ws + WS_AK + hb; const unsigned char* Vg = ws + WS_AV + hb; const int kn0 = 256 * j - 128;
    { const int lane = tid & 63, r32 = lane & 31, hi = lane >> 5, w = tid >> 6; const unsigned char* Q = ws + WS_AQ + hb;
#pragma unroll
      for (int d0 = 0; d0 < 4; ++d0) r.q[d0] = *(const u32x2*)(Q + (size_t)(256 * j + 32 * w + r32) * 64 + d0 * 16 + hi * 8); }
#pragma unroll
    for (int i = 0; i < 3; ++i) { const int idx = tid + 512 * i, key = idx >> 2, c = idx & 3;
        if (kn0 + key >= 0) { r.k[i] = *(const u32x4*)(Kg + (ptrdiff_t)(kn0 + key) * 64 + c * 16); r.v[i] = *(const u32x4*)(Vg + (ptrdiff_t)(kn0 + key) * 64 + c * 16); } }
}
__device__ __forceinline__ u32x4 fp8x8_to_bf16(unsigned lo, unsigned hi_, float sc) {
    const f32x2 a = __builtin_amdgcn_cvt_pk_f32_fp8((int)lo, false), b = __builtin_amdgcn_cvt_pk_f32_fp8((int)lo, true), c = __builtin_amdgcn_cvt_pk_f32_fp8((int)hi_, false), d = __builtin_amdgcn_cvt_pk_f32_fp8((int)hi_, true);
    u32x4 w; w.x = cvt_pk_bf16(a[0] * sc, a[1] * sc); w.y = cvt_pk_bf16(b[0] * sc, b[1] * sc); w.z = cvt_pk_bf16(c[0] * sc, c[1] * sc); w.w = cvt_pk_bf16(d[0] * sc, d[1] * sc); return w; }
__device__ __forceinline__ void attn_item(const Params& p, int item, int nitem, bool has_next, AttnPre& pre, char* lds) {
    unsigned char* ws = opaque(p.ws);
    const int tid = tid_(), lane = tid & 63, r32 = lane & 31, hi = lane >> 5; const int w = __builtin_amdgcn_readfirstlane(tid >> 6);
    const int jj = item & 15, bh = item >> 4, head = bh % 24, b = bh / 24, g = head >> 3, sh = 2 * g, d = 1 << sh, NL = SEQ >> sh, ppr = 16 >> sh;
    const int r = jj / ppr, j = jj % ppr;
    const size_t hb = ((size_t)bh * SEQ + (size_t)r * NL) * 64;
    const bf16_t* Q = (const bf16_t*)(ws + WS_AQ) + hb;
    const int kn0 = 256 * j - 128;
    bf16x8 qf[4];
#pragma unroll
    for (int d0 = 0; d0 < 4; ++d0) qf[d0] = __builtin_bit_cast(bf16x8, fp8x8_to_bf16(pre.q[d0].x, pre.q[d0].y, QSCALE));
#pragma unroll
    for (int i = 0; i < 3; ++i) { const int idx = tid + 512 * i, key = idx >> 2, c4 = idx & 3;
        if (kn0 + key >= 0) {
#pragma unroll
            for (int hh = 0; hh < 2; ++hh) { const int c = 2 * c4 + hh;
                *(u32x4*)(lds + AT_K + c * AT_KCS + key * 16) = fp8x8_to_bf16(hh ? pre.k[i].z : pre.k[i].x, hh ? pre.k[i].w : pre.k[i].y, 1.0f);
                *(u32x4*)(lds + AT_V + (c >> 2) * AT_VH + key * 64 + (c & 3) * 16) = fp8x8_to_bf16(hh ? pre.v[i].z : pre.v[i].x, hh ? pre.v[i].w : pre.v[i].y, 1.0f); } } }
    __syncthreads();
    if (has_next) attn_fetch(p, nitem, pre);
    const LDS3 char* l3 = (const LDS3 char*)lds;
    f32x16 s[5]; const int ktmin = (j == 0) ? 4 : 0;
#pragma unroll
    for (int t5 = 0; t5 < 5; ++t5) { const int kt = w + t5;
        if (kt >= ktmin) { f32x16 a = {};
#pragma unroll
            for (int d0 = 0; d0 < 4; ++d0) { const bf16x8 kf = *(const LDS3 bf16x8*)(l3 + AT_K + (2 * d0 + hi) * AT_KCS + (kt * 32 + r32) * 16); a = MFMA32(kf, qf[d0], a); }
            s[t5] = a; }
        else {
#pragma unroll
            for (int rr = 0; rr < 16; ++rr) s[t5][rr] = -1e30f; } }
#pragma unroll
    for (int rr = 0; rr < 16; ++rr) { const int c = crow(rr, hi); if (c < r32) s[0][rr] = -1e30f; if (c > r32) s[4][rr] = -1e30f; }
    float mx = -1e30f;
#pragma unroll
    for (int t5 = 0; t5 < 5; ++t5)
#pragma unroll
        for (int rr = 0; rr < 16; ++rr) mx = fmaxf(mx, s[t5][rr]);
    mx = fmaxf(mx, __shfl_xor(mx, 32));
    float l = 0.f;
#pragma unroll
    for (int t5 = 0; t5 < 5; ++t5)
#pragma unroll
        for (int rr = 0; rr < 16; ++rr) { const float e = __builtin_amdgcn_exp2f(s[t5][rr] - mx); s[t5][rr] = e; l += e; }
    l += __shfl_xor(l, 32);
    f32x16 o[2]; o[0] = f32x16{}; o[1] = f32x16{};
    const int blk = (lane >> 4) & 1, q4 = (lane & 15) >> 2, p4 = lane & 3;
#pragma unroll
    for (int t5 = 0; t5 < 5; ++t5) { const int kt = w + t5;
        if (kt >= ktmin) {
#pragma unroll
            for (int ss = 0; ss < 2; ++ss) { float pv[8];
#pragma unroll
                for (int q = 0; q < 8; ++q) pv[q] = s[t5][8 * ss + q];
                const bf16x8 pa = __builtin_bit_cast(bf16x8, pack8(pv));
#pragma unroll
                for (int dh = 0; dh < 2; ++dh) { const LDS3 char* vp = l3 + AT_V + dh * AT_VH + (kt * 32 + 16 * ss + 4 * hi + q4) * 64 + (16 * blk + 4 * p4) * 2;
                    const bf16x8 vf = cat8(tr16(vp), tr16(vp + 8 * 64)); o[dh] = MFMA32(pa, vf, o[dh]); } } } }
    const int n_q = 256 * j + 32 * w + r32; const int tok = b * SEQ + n_q * d + r;
    if (hi == 0) { ((float*)(ws + WS_LSE))[((size_t)g * NTOK + tok) * 8 + (head & 7)] = (mx + __builtin_amdgcn_logf(l)) * LN2;
        ((float*)(lds + AT_WL))[w * 32 + r32] = __builtin_amdgcn_rcpf(l); }
    bf16_t* stg = (bf16_t*)(lds + AT_STG) + w * 2048;
#pragma unroll
    for (int rr = 0; rr < 16; ++rr) { const int qr = crow(rr, hi); const float rl = ((const float*)(lds + AT_WL))[w * 32 + qr];
#pragma unroll
        for (int dh = 0; dh < 2; ++dh) stg[qr * 64 + dh * 32 + r32] = (bf16_t)(cvt_pk_bf16(o[dh][rr] * rl, 0.f) & 0xffffu); }
    bf16_t* og = (bf16_t*)(ws + WS_OATT) + (size_t)g * NTOK * 512;
#pragma unroll
    for (int i = 0; i < 4; ++i) { const int idx = i * 64 + lane, row = idx >> 3, ch = idx & 7; const int tk = b * SEQ + (256 * j + 32 * w + row) * d + r;
        *(u32x4*)(og + (size_t)tk * 512 + (head & 7) * 64 + ch * 8) = *(const u32x4*)(stg + row * 64 + ch * 8); }
    __syncthreads();
}

constexpr int G1_BB = 0;
constexpr int G1_QE = G1_BB + 64 * 128 * 4;
constexpr int G1_KE = G1_QE + 64 * 272;
constexpr int G1_KD = G1_KE + 64 * 272;
constexpr int G1_V = G1_KD + 64 * 320;
constexpr int G1_GLR = G1_V + 64 * 576;
constexpr int G1_GUP = G1_GLR + 64 * 16 * 4;
constexpr int G1_SEG = G1_GUP + 16 * 128 * 4;
constexpr int G1_BIAS = G1_SEG + 4 * 128 * 4;
constexpr int G1_END = G1_BIAS + 128 * 4;
constexpr int G1_SU = 0;
constexpr int G1_SO = 128 * 528;
static_assert(G1_SO + 64 * 528 <= G1_GLR, "gla1 staging");
static_assert(G1_END <= LDS_BYTES, "gla1 LDS");
__device__ __forceinline__ float logsigmoidf_(float z) { return fminf(z, 0.f) - log1pf(__expf(-fabsf(z))); }
struct G1Pre { u32x4 q[2], k[2], v[4]; float glr[2]; };
__device__ __forceinline__ void gla1_fetch(const Params& p, int item, G1Pre& r) {
    unsigned char* ws = opaque(p.ws); const int tid = tid_();
    const int n = item & 63, bh = item >> 6, h = bh & 3, b = bh >> 2; const int tok0 = b * SEQ + n * 64;
    const bf16_t* gq = (const bf16_t*)(ws + WS_GQ); const bf16_t* gk = (const bf16_t*)(ws + WS_GK); const bf16_t* gv = (const bf16_t*)(ws + WS_GV);
#pragma unroll
    for (int pp = 0; pp < 2; ++pp) { const int idx = tid + 512 * pp, i = idx >> 4, c = idx & 15; const size_t go = (size_t)(tok0 + i) * 512 + h * 128 + c * 8; r.q[pp] = *(const u32x4*)(gq + go); r.k[pp] = *(const u32x4*)(gk + go);
        r.glr[pp] = ((const float*)(ws + WS_GLR))[(size_t)tok0 * 16 + idx]; }
#pragma unroll
    for (int pp = 0; pp < 4; ++pp) { const int idx = tid + 512 * pp, jv = idx >> 5, c = idx & 31; r.v[pp] = *(const u32x4*)(gv + (size_t)(tok0 + jv) * 1024 + h * 256 + c * 8); }
}
__device__ __forceinline__ void gla1_head_operands(const Params& p, int h, char* lds) {
    const int tid = tid_(); float* GUP = (float*)(lds + G1_GUP); float* BIAS = (float*)(lds + G1_BIAS);
    for (int i = tid; i < 16 * 128; i += 512) GUP[i] = p.gla_gate_up[(i >> 7) * 512 + h * 128 + (i & 127)];
    if (tid < 128) BIAS[tid] = p.gla_gate_bias[h * 128 + tid];
}
__device__ __forceinline__ void gla1_item(const Params& p, int item, int nitem, bool has_next, bool reload_head, G1Pre& pre, char* lds) {
    unsigned char* ws = opaque(p.ws);
    const int tid = tid_(), lane = tid & 63, r32 = lane & 31, hi = lane >> 5; const int w = __builtin_amdgcn_readfirstlane(tid >> 6);
    const int n = item & 63, bh = item >> 6, h = bh & 3, b = bh >> 2; const int tok0 = b * SEQ + n * 64;
    float* BB = (float*)(lds + G1_BB); float* GLRs = (float*)(lds + G1_GLR); float* GUP = (float*)(lds + G1_GUP); float* SEGs = (float*)(lds + G1_SEG); float* BIAS = (float*)(lds + G1_BIAS);
    u32x4 qraw[2], kraw[2], vraw[4];
#pragma unroll
    for (int pp = 0; pp < 2; ++pp) { qraw[pp] = pre.q[pp]; kraw[pp] = pre.k[pp]; GLRs[tid + 512 * pp] = pre.glr[pp]; }
#pragma unroll
    for (int pp = 0; pp < 4; ++pp) vraw[pp] = pre.v[pp];
    if (reload_head) gla1_head_operands(p, h, lds);
    __syncthreads();
    if (has_next) gla1_fetch(p, nitem, pre);
    { const int d = tid & 127, seg = tid >> 7; float gu[16];
#pragma unroll
      for (int r = 0; r < 16; ++r) gu[r] = GUP[r * 128 + d];
      const float bias = BIAS[d]; float run = 0.f;
#pragma unroll 4
      for (int ii = 0; ii < 16; ++ii) { const int i = seg * 16 + ii; float z = bias;
#pragma unroll
          for (int r4 = 0; r4 < 4; ++r4) { const f32x4 gl = *(const f32x4*)(GLRs + i * 16 + r4 * 4); z += gl[0] * gu[r4 * 4] + gl[1] * gu[r4 * 4 + 1] + gl[2] * gu[r4 * 4 + 2] + gl[3] * gu[r4 * 4 + 3]; }
          run += logsigmoidf_(z) * (1.0f / 16.0f); BB[i * 128 + d] = run; }
      SEGs[seg * 128 + d] = run;
      __syncthreads();
      float off = 0.f; for (int s2 = 0; s2 < seg; ++s2) off += SEGs[s2 * 128 + d];
      if (seg > 0) { for (int ii = 0; ii < 16; ++ii) BB[(seg * 16 + ii) * 128 + d] += off; }
      __syncthreads(); }
    { const bf16_t* gq = (const bf16_t*)(ws + WS_GQ); const bf16_t* gk = (const bf16_t*)(ws + WS_GK); const bf16_t* gv = (const bf16_t*)(ws + WS_GV); bf16_t* qeg = (bf16_t*)(ws + WS_QE);
#pragma unroll
      for (int pp = 0; pp < 2; ++pp) { const int idx = tid + 512 * pp, i = idx >> 4, c = idx & 15, d0 = c * 8; const size_t go = (size_t)(tok0 + i) * 512 + h * 128 + d0;
          float q[8], k[8], qe[8], ke[8], kd[8]; unpack8(qraw[pp], q); unpack8(kraw[pp], k);
#pragma unroll
          for (int j = 0; j < 8; ++j) { const float bb = BB[i * 128 + d0 + j], bl = BB[63 * 128 + d0 + j]; qe[j] = q[j] * __expf(bb) * 0.08838834764831845f; ke[j] = k[j] * __expf(-bb); kd[j] = k[j] * __expf(bl - bb); }
          const u32x4 qw = pack8(qe); *(u32x4*)(lds + G1_QE + i * 272 + c * 16) = qw; *(u32x4*)(qeg + go) = qw;
          *(u32x4*)(lds + G1_KE + i * 272 + c * 16) = pack8(ke); *(u32x4*)(lds + G1_KD + i * 320 + c * 16) = pack8(kd); }
#pragma unroll
      for (int pp = 0; pp < 4; ++pp) { const int idx = tid + 512 * pp, jv = idx >> 5, c = idx & 31; *(u32x4*)(lds + G1_V + jv * 576 + c * 16) = vraw[pp]; }
      if (tid < 128) ((float*)(ws + WS_DEC))[(size_t)item * 128 + tid] = __expf(BB[63 * 128 + tid]);
      __syncthreads(); }
    const LDS3 char* l3 = (const LDS3 char*)lds; const int blk = (lane >> 4) & 1, q4 = (lane & 15) >> 2, p4 = lane & 3;
    {
      const int it = w & 1, vq = w >> 1; f32x16 oi[2]; oi[0] = f32x16{}; oi[1] = f32x16{};
#pragma unroll
      for (int jt = 0; jt < 2; ++jt) { if (jt <= it) { f32x16 x = {};
#pragma unroll
          for (int s = 0; s < 8; ++s) { const bf16x8 a = *(const LDS3 bf16x8*)(l3 + G1_KE + (jt * 32 + r32) * 272 + (16 * s + 8 * hi) * 2), bq = *(const LDS3 bf16x8*)(l3 + G1_QE + (it * 32 + r32) * 272 + (16 * s + 8 * hi) * 2); x = MFMA32(a, bq, x); }
          if (jt == it) {
#pragma unroll
              for (int rr = 0; rr < 16; ++rr) if (crow(rr, hi) > r32) x[rr] = 0.f; }
#pragma unroll
          for (int ss = 0; ss < 2; ++ss) { float xv[8];
#pragma unroll
              for (int q = 0; q < 8; ++q) xv[q] = x[8 * ss + q];
              const bf16x8 xa = __builtin_bit_cast(bf16x8, pack8(xv));
#pragma unroll
              for (int vi = 0; vi < 2; ++vi) { const int vt = 2 * vq + vi; const LDS3 char* vp = l3 + G1_V + (jt * 32 + 16 * ss + 4 * hi + q4) * 576 + (vt * 32 + 16 * blk + 4 * p4) * 2;
                  const bf16x8 vf = cat8(tr16(vp), tr16(vp + 8 * 576)); oi[vi] = MFMA32(xa, vf, oi[vi]); } } } }
      const int dt = w & 3, vg = w >> 2; f32x16 uu[4]; uu[0] = f32x16{}; uu[1] = f32x16{}; uu[2] = f32x16{}; uu[3] = f32x16{};
#pragma unroll
      for (int ks = 0; ks < 4; ++ks) { const LDS3 char* ap = l3 + G1_KD + (16 * ks + 8 * hi + q4) * 320 + (dt * 32 + 16 * blk + 4 * p4) * 2; const bf16x8 a = cat8(tr16(ap), tr16(ap + 4 * 320));
#pragma unroll
          for (int vi = 0; vi < 4; ++vi) { const int vt = 4 * vg + vi; const LDS3 char* vp = l3 + G1_V + (16 * ks + 8 * hi + q4) * 576 + (vt * 32 + 16 * blk + 4 * p4) * 2; const bf16x8 vf = cat8(tr16(vp), tr16(vp + 4 * 576)); uu[vi] = MFMA32(a, vf, uu[vi]); } }
      __syncthreads();
      bf16_t* SU = (bf16_t*)(lds + G1_SU); bf16_t* SO = (bf16_t*)(lds + G1_SO);
#pragma unroll
      for (int vi = 0; vi < 4; ++vi)
#pragma unroll
          for (int rr = 0; rr < 16; ++rr) SU[(dt * 32 + crow(rr, hi)) * 264 + (4 * vg + vi) * 32 + r32] = (bf16_t)(cvt_pk_bf16(uu[vi][rr], 0.f) & 0xffffu);
#pragma unroll
      for (int vi = 0; vi < 2; ++vi)
#pragma unroll
          for (int rr = 0; rr < 16; ++rr) SO[(it * 32 + crow(rr, hi)) * 264 + (2 * vq + vi) * 32 + r32] = (bf16_t)(cvt_pk_bf16(oi[vi][rr], 0.f) & 0xffffu);
      __syncthreads();
      bf16_t* ug = (bf16_t*)(ws + WS_U) + (size_t)item * 128 * 256; bf16_t* og = (bf16_t*)(ws + WS_OINTRA);
#pragma unroll
      for (int pp = 0; pp < 8; ++pp) { const int idx = tid + 512 * pp, row = idx >> 5, c = idx & 31; *(u32x4*)(ug + (size_t)row * 256 + c * 8) = *(const u32x4*)(SU + row * 264 + c * 8); }
#pragma unroll
      for (int pp = 0; pp < 4; ++pp) { const int idx = tid + 512 * pp, row = idx >> 5, c = idx & 31; *(u32x4*)(og + (size_t)(tok0 + row) * 1024 + h * 256 + c * 8) = *(const u32x4*)(SO + row * 264 + c * 8); } }
    __syncthreads();
}

__device__ __forceinline__ void phase_scan_combine(const Params& p) {
    unsigned char* ws = opaque(p.ws); const int G = gridDim.x;
    { const bf16_t* U = (const bf16_t*)(ws + WS_U); bf16_t* PV = (bf16_t*)(ws + WS_PREV); const float* DEC = (const float*)(ws + WS_DEC);
      for (int idx = blockIdx.x * 512 + tid_(); idx < 16 * 128 * 64; idx += G * 512) { const int bh = idx >> 13, rem = idx & 8191, d = rem >> 6, vq = rem & 63;
          float st[4] = {0.f, 0.f, 0.f, 0.f}; const size_t e0 = ((size_t)bh * 64 * 128 + d) * 256 + vq * 4;
#pragma unroll 8
          for (int n = 0; n < 64; ++n) { const size_t e = e0 + (size_t)n * 128 * 256; const u32x2 uw = *(const u32x2*)(U + e); const float dc = DEC[(size_t)(bh * 64 + n) * 128 + d];
              u32x2 pw; pw.x = cvt_pk_bf16(st[0], st[1]); pw.y = cvt_pk_bf16(st[2], st[3]); *(u32x2*)(PV + e) = pw;
              st[0] = dc * st[0] + bf_lo(uw.x); st[1] = dc * st[1] + bf_hi(uw.x); st[2] = dc * st[2] + bf_lo(uw.y); st[3] = dc * st[3] + bf_hi(uw.y); } } }
    { const bf16_t* OG = (const bf16_t*)(ws + WS_OATT); const float* LSE = (const float*)(ws + WS_LSE); bf16_t* YA = (bf16_t*)(ws + WS_YATT);
#pragma unroll 2
      for (int idx = blockIdx.x * 512 + tid_(); idx < NTOK * 64; idx += G * 512) { const int tok = idx >> 6, jc = idx & 63, jh = jc >> 3;
          const float l0 = LSE[(size_t)tok * 8 + jh], l1 = LSE[((size_t)NTOK + tok) * 8 + jh], l2 = LSE[((size_t)2 * NTOK + tok) * 8 + jh];
          const float m = fmaxf(l0, fmaxf(l1, l2)); float a0 = __expf(l0 - m), a1 = __expf(l1 - m), a2 = __expf(l2 - m); const float inv = __builtin_amdgcn_rcpf(a0 + a1 + a2); a0 *= inv; a1 *= inv; a2 *= inv;
          float o0[8], o1[8], o2[8], y[8]; const size_t off = (size_t)tok * 512 + jc * 8;
          unpack8(*(const u32x4*)(OG + off), o0); unpack8(*(const u32x4*)(OG + (size_t)NTOK * 512 + off), o1); unpack8(*(const u32x4*)(OG + (size_t)2 * NTOK * 512 + off), o2);
#pragma unroll
          for (int q = 0; q < 8; ++q) y[q] = a0 * o0[q] + a1 * o1[q] + a2 * o2[q];
          *(u32x4*)(YA + off) = pack8(y); } }
}

constexpr int G3_PREV = 0;
constexpr int G3_SS = G3_PREV + 128 * 576;
constexpr int G3_OI = G3_SS + 8 * 32 * 4;
constexpr int G3_GR = G3_OI + 64 * 528;
constexpr int G3_END = G3_GR + 64 * 528;
static_assert(G3_END <= LDS_XB, "gla3 LDS");
struct G3Pre { u32x4 pv[8], oi[4], gr[4]; };
__device__ __forceinline__ void gla3_fetch(const Params& p, int item, G3Pre& r) {
    unsigned char* ws = opaque(p.ws); const int tid = tid_();
    const int n = item & 63, bh = item >> 6, h = bh & 3, b = bh >> 2; const int tok0 = b * SEQ + n * 64;
    const bf16_t* PV = (const bf16_t*)(ws + WS_PREV) + (size_t)item * 128 * 256;
#pragma unroll
    for (int pp = 0; pp < 8; ++pp) { const int idx = tid + 512 * pp, d = idx >> 5, c = idx & 31; r.pv[pp] = *(const u32x4*)(PV + (size_t)d * 256 + c * 8); }
#pragma unroll
    for (int pp = 0; pp < 4; ++pp) { const int idx = tid + 512 * pp, row = idx >> 5, c = idx & 31; const size_t go = (size_t)(tok0 + row) * 1024 + h * 256 + c * 8;
        r.oi[pp] = *(const u32x4*)((const bf16_t*)(ws + WS_OINTRA) + go); r.gr[pp] = *(const u32x4*)((const bf16_t*)(ws + WS_GR) + go); }
}
__device__ __forceinline__ void gla3_item(const Params& p, int item, int nitem, bool has_next, G3Pre& pre, char* lds) {
    unsigned char* ws = opaque(p.ws);
    const int tid = tid_(), lane = tid & 63, r32 = lane & 31, hi = lane >> 5; const int w = __builtin_amdgcn_readfirstlane(tid >> 6);
    const int n = item & 63, bh = item >> 6, h = bh & 3, b = bh >> 2; const int tok0 = b * SEQ + n * 64;
    bf16_t* SOI = (bf16_t*)(lds + G3_OI); bf16_t* SGR = (bf16_t*)(lds + G3_GR);
#pragma unroll
    for (int pp = 0; pp < 8; ++pp) { const int idx = tid + 512 * pp, d = idx >> 5, c = idx & 31; *(u32x4*)(lds + G3_PREV + d * 576 + c * 16) = pre.pv[pp]; }
#pragma unroll
    for (int pp = 0; pp < 4; ++pp) { const int idx = tid + 512 * pp, row = idx >> 5, c = idx & 31; *(u32x4*)(SOI + row * 264 + c * 8) = pre.oi[pp]; *(u32x4*)(SGR + row * 264 + c * 8) = pre.gr[pp]; }
    const int it = w & 1, vq = w >> 1; const bf16_t* qeg = (const bf16_t*)(ws + WS_QE) + (size_t)(tok0 + it * 32 + r32) * 512 + h * 128;
    bf16x8 qa[8];
#pragma unroll
    for (int s = 0; s < 8; ++s) qa[s] = *(const bf16x8*)(qeg + 16 * s + 8 * hi);
    __syncthreads();
    if (has_next) gla3_fetch(p, nitem, pre);
    const LDS3 char* l3 = (const LDS3 char*)lds; const int blk = (lane >> 4) & 1, q4 = (lane & 15) >> 2, p4 = lane & 3;
    f32x16 o[2];
#pragma unroll
    for (int vi = 0; vi < 2; ++vi)
#pragma unroll
        for (int rr = 0; rr < 16; ++rr) o[vi][rr] = bf2f(SOI[(it * 32 + crow(rr, hi)) * 264 + (2 * vq + vi) * 32 + r32]);
#pragma unroll
    for (int s = 0; s < 8; ++s)
#pragma unroll
        for (int vi = 0; vi < 2; ++vi) { const int vt = 2 * vq + vi; const LDS3 char* pp_ = l3 + G3_PREV + (16 * s + 8 * hi + q4) * 576 + (vt * 32 + 16 * blk + 4 * p4) * 2; const bf16x8 pf = cat8(tr16(pp_), tr16(pp_ + 4 * 576)); o[vi] = MFMA32(qa[s], pf, o[vi]); }
    float* SS = (float*)(lds + G3_SS);
#pragma unroll
    for (int rr = 0; rr < 16; ++rr) { float q = o[0][rr] * o[0][rr] + o[1][rr] * o[1][rr]; q += __shfl_xor(q, 16); q += __shfl_xor(q, 8); q += __shfl_xor(q, 4); q += __shfl_xor(q, 2); q += __shfl_xor(q, 1);
        if (r32 == 0) SS[w * 32 + crow(rr, hi)] = q; }
    __syncthreads();
    float ng[2]; ng[0] = p.gla_norm_g[(2 * vq) * 32 + r32]; ng[1] = p.gla_norm_g[(2 * vq + 1) * 32 + r32];
#pragma unroll
    for (int rr = 0; rr < 16; ++rr) { const int row = crow(rr, hi); const float tot = SS[(it + 0) * 32 + row] + SS[(it + 2) * 32 + row] + SS[(it + 4) * 32 + row] + SS[(it + 6) * 32 + row];
        const float rs = rsqrtf(tot * (1.0f / 256.0f) + EPS);
#pragma unroll
        for (int vi = 0; vi < 2; ++vi) { const int li = (it * 32 + row) * 264 + (2 * vq + vi) * 32 + r32; const float y = o[vi][rr] * rs * ng[vi] * bf2f(SGR[li]); SOI[li] = (bf16_t)(cvt_pk_bf16(y, 0.f) & 0xffffu); } }
    __syncthreads();
    bf16_t* yg = (bf16_t*)(ws + WS_YGLA);
#pragma unroll
    for (int pp = 0; pp < 4; ++pp) { const int idx = tid + 512 * pp, row = idx >> 5, c = idx & 31; *(u32x4*)(yg + (size_t)(tok0 + row) * 1024 + h * 256 + c * 8) = *(const u32x4*)(SOI + row * 264 + c * 8); }
    __syncthreads();
}

constexpr int RT_RSTD = 0;
constexpr int RT_LOG = 256;
constexpr int RT_CNT = RT_LOG + 64 * 32 * 4;
__device__ __forceinline__ void route_group(const Params& p, int grp, char* lds) {
    unsigned char* ws = opaque(p.ws); const int tid = tid_(), lane = tid & 63; const int w = __builtin_amdgcn_readfirstlane(tid >> 6);
    const bf16_t* H = (const bf16_t*)(ws + WS_H); const float* RWG = (const float*)(ws + WS_RWG);
    float* RSTD = (float*)(lds + RT_RSTD); float* LOGS = (float*)(lds + RT_LOG); int* LCNT = (int*)(lds + RT_CNT);
    const int tok0 = grp * 64;
    if (tid < 32) LCNT[tid] = 0;
    if (w < 4) { const int tl = lane & 15, kq = lane >> 4; const bf16_t* hr = H + (size_t)(tok0 + w * 16 + tl) * 1024 + kq * 256; const float* br = RWG + (size_t)(kq * 256) * 32 + tl;
        f32x4 a0 = {0.f, 0.f, 0.f, 0.f}, a1 = {0.f, 0.f, 0.f, 0.f}; float ss = 0.f;
#pragma unroll 4
        for (int m4 = 0; m4 < 64; ++m4) { const f32x4 hv = bf4_to_f32(*(const u32x2*)(hr + m4 * 4));
#pragma unroll
            for (int q = 0; q < 4; ++q) { const float b0 = br[(size_t)(m4 * 4 + q) * 32], b1 = br[(size_t)(m4 * 4 + q) * 32 + 16];
                a0 = __builtin_amdgcn_mfma_f32_16x16x4f32(hv[q], b0, a0, 0, 0, 0); a1 = __builtin_amdgcn_mfma_f32_16x16x4f32(hv[q], b1, a1, 0, 0, 0); ss += hv[q] * hv[q]; } }
        ss += __shfl_xor(ss, 16); ss += __shfl_xor(ss, 32);
        const float rs = rsqrtf(ss * (1.0f / 1024.0f) + EPS);
        if (kq == 0) RSTD[w * 16 + tl] = rs;
#pragma unroll
        for (int rg = 0; rg < 4; ++rg) { const int t = w * 16 + 4 * kq + rg; LOGS[t * 32 + tl] = a0[rg]; LOGS[t * 32 + 16 + tl] = a1[rg]; } }
    __syncthreads();
    if (tid < 64) { const int tok = tok0 + tid; const float rs = RSTD[tid]; float lg[32];
#pragma unroll
        for (int e = 0; e < 32; ++e) lg[e] = LOGS[tid * 32 + e] * rs + p.router_b[e];
        int be[4]; float bv[4];
#pragma unroll
        for (int k = 0; k < 4; ++k) { float best = -3.0e38f; int bi = 0;
#pragma unroll
            for (int e = 0; e < 32; ++e) { const bool tk = lg[e] > best; best = tk ? lg[e] : best; bi = tk ? e : bi; }
            be[k] = bi; bv[k] = best;
#pragma unroll
            for (int e = 0; e < 32; ++e) lg[e] = (e == bi) ? -3.0e38f : lg[e]; }
        const float e1 = __expf(bv[1] - bv[0]), e2 = __expf(bv[2] - bv[0]), e3 = __expf(bv[3] - bv[0]); const float inv = 1.0f / (1.0f + e1 + e2 + e3);
        const float gt[4] = {inv, e1 * inv, e2 * inv, e3 * inv};
#pragma unroll
        for (int k = 0; k < 4; ++k) { const int pos = atomicAdd(&LCNT[be[k]], 1);
            ((int*)(ws + WS_TOPE))[tok * 4 + k] = be[k]; ((float*)(ws + WS_TOPG))[tok * 4 + k] = gt[k]; ((int*)(ws + WS_TOPP))[tok * 4 + k] = pos; } }
    { unsigned char* HN = ws + WS_HN;
#pragma unroll 2
      for (int i = 0; i < 8; ++i) { const int idx = tid + 512 * i, t = idx >> 6, c = idx & 63; const float rs = RSTD[t]; const size_t off = (size_t)(tok0 + t) * 1024 + c * 16; u32x4 wv;
#pragma unroll
          for (int q = 0; q < 4; ++q) { const f32x4 h0 = bf4_to_f32(*(const u32x2*)(H + off + 4 * q)), g0 = *(const f32x4*)(p.norm_ffn_g + c * 16 + 4 * q); wv[q] = (unsigned)pk4_fp8(h0[0] * rs * g0[0], h0[1] * rs * g0[1], h0[2] * rs * g0[2], h0[3] * rs * g0[3]); }
          *(u32x4*)(HN + off) = wv; } }
    __syncthreads();
    if (tid < 32) ((int*)(ws + WS_CNT))[grp * 32 + tid] = LCNT[tid];
    __syncthreads();
}

constexpr int DP_TOT = 0;
constexpr int DP_PART = 512;
__device__ __forceinline__ void dispatch_tables(const Params& p, int grp, char* lds) {
    unsigned char* ws = opaque(p.ws); const int tid = tid_(); const int* CNT = (const int*)(ws + WS_CNT); int* T = (int*)(lds + DP_TOT); int* PART = (int*)(lds + DP_PART);
    { const int e = tid & 31, part = tid >> 5; int tot = 0, pre = 0;
      for (int g2 = part * 16; g2 < part * 16 + 16; ++g2) { const int c = CNT[g2 * 32 + e]; tot += c; if (g2 < grp) pre += c; }
      PART[part * 32 + e] = tot; PART[512 + part * 32 + e] = pre; }
    __syncthreads();
    if (tid < 32) { int tot = 0, pre = 0; for (int q = 0; q < 16; ++q) { tot += PART[q * 32 + tid]; pre += PART[512 + q * 32 + tid]; } T[tid] = tot; T[64 + tid] = pre; }
    __syncthreads();
    if (tid == 0) { int base = 0; for (int e = 0; e < 32; ++e) { T[32 + e] = base; base += (T[e] + 255) >> 8; } T[96] = base; }
    __syncthreads();
}
__device__ __forceinline__ void dispatch_group(const Params& p, int grp, char* lds) {
    unsigned char* ws = opaque(p.ws); const int tid = tid_();
    dispatch_tables(p, grp, lds);
    const int* T = (const int*)(lds + DP_TOT); int* DEST = (int*)(lds + DP_PART + 4096);
    if (tid < 256) { const int tok = grp * 64 + (tid >> 2); const int e = ((const int*)(ws + WS_TOPE))[tok * 4 + (tid & 3)], lp = ((const int*)(ws + WS_TOPP))[tok * 4 + (tid & 3)];
        const int dest = T[32 + e] * 256 + T[64 + e] + lp; DEST[tid] = dest; ((int*)(ws + WS_SLOT))[tok * 4 + (tid & 3)] = dest; }
    __syncthreads();
    if (tid < 256) ((int*)(ws + WS_XPAD))[DEST[tid]] = (grp * 64 + (tid >> 2)) * 1024;
    __syncthreads();
}

__device__ __forceinline__ void phase_combine(const Params& p) {
    unsigned char* ws = opaque(p.ws); const int tid = tid_(), lane = tid & 63, wid = tid >> 6, G = gridDim.x;
    const bf16_t* H = (const bf16_t*)(ws + WS_H); const unsigned char* YP = ws + WS_YPAD;
    for (int tok = blockIdx.x * 8 + wid; tok < NTOK; tok += G * 8) {
        int sl[4]; float gt[4];
#pragma unroll
        for (int k = 0; k < 4; ++k) { sl[k] = ((const int*)(ws + WS_SLOT))[tok * 4 + k]; gt[k] = ((const float*)(ws + WS_TOPG))[tok * 4 + k]; }
        f32x4 v[4]; float ss = 0.f;
#pragma unroll
        for (int i = 0; i < 4; ++i) { const int col = i * 256 + lane * 4; v[i] = bf4_to_f32(*(const u32x2*)(H + (size_t)tok * 1024 + col));
#pragma unroll
            for (int k = 0; k < 4; ++k) { const unsigned yw = *(const unsigned*)(YP + (size_t)sl[k] * 1024 + col); const f32x2 lo = __builtin_amdgcn_cvt_pk_f32_fp8((int)yw, false), hi2 = __builtin_amdgcn_cvt_pk_f32_fp8((int)yw, true); v[i][0] += gt[k] * lo[0]; v[i][1] += gt[k] * lo[1]; v[i][2] += gt[k] * hi2[0]; v[i][3] += gt[k] * hi2[1]; }
            ss += v[i][0] * v[i][0] + v[i][1] * v[i][1] + v[i][2] * v[i][2] + v[i][3] * v[i][3]; }
        ss = wave_sum(ss); const float rs = rsqrtf(ss * (1.0f / 1024.0f) + EPS);
#pragma unroll
        for (int i = 0; i < 4; ++i) { const int col = i * 256 + lane * 4; const f32x4 g = *(const f32x4*)(p.norm_final_g + col); f32x4 o; o[0] = v[i][0] * rs * g[0]; o[1] = v[i][1] * rs * g[1]; o[2] = v[i][2] * rs * g[2]; o[3] = v[i][3] * rs * g[3];
            *(f32x4*)(p.out + (size_t)tok * 1024 + col) = o; } }
}


#define XB_TMO      128
#define XB_XCNT(j)  (256  + 64 * (j))
#define XB_XSUB(j)  (1280 + 64 * (j))
#define XB_XGEN(j)  (2304 + 64 * (j))
#define XB_TOP      3328
#define XB_TOPGEN   3392
#define XCD_BAR_WORDS 3456
#define XB_SPIN_CAP (1u << 18)
__device__ __forceinline__ unsigned xb_ld(unsigned* p)              { return __hip_atomic_load(p, __ATOMIC_RELAXED, __HIP_MEMORY_SCOPE_AGENT); }
__device__ __forceinline__ unsigned xb_add(unsigned* p, unsigned v) { return __hip_atomic_fetch_add(p, v, __ATOMIC_RELAXED, __HIP_MEMORY_SCOPE_AGENT); }
__device__ __forceinline__ unsigned xb_xcc_id() { return (unsigned)__builtin_amdgcn_s_getreg((3 << 11) | 20) & 0xFu; }
#define XB_SPIN(cond, bar) do { unsigned _sp = 0; while (cond) { __builtin_amdgcn_s_sleep(1); \
    if ((++_sp & 255u) == 0u) { if (xb_ld(&(bar)[XB_TMO])) break; if (_sp > XB_SPIN_CAP) { atomicAdd(&(bar)[XB_TMO], 1u); break; } } } } while (0)
struct XcdBarrier { unsigned* bar; unsigned x; volatile LDS3 unsigned* st; };
__device__ __forceinline__ XcdBarrier xcd_barrier_post(unsigned* bar, volatile LDS3 unsigned* st) {
    XcdBarrier b; b.bar = bar; b.x = xb_xcc_id(); b.st = st;
    if (tid_() == 0) (void)xb_add(&bar[XB_XCNT(b.x)], 1u);
    return b;
}
__device__ __forceinline__ void xcd_barrier_complete(unsigned* bar, unsigned x, unsigned& nloc, unsigned& nx) {
    const unsigned G = gridDim.x * gridDim.y * gridDim.z;
    unsigned sum, cnt, mine, sp = 0u;
    for (;;) {
        sum = 0u; cnt = 0u; mine = 0u;
#pragma unroll
        for (unsigned j = 0; j < 16; ++j) { const unsigned c = xb_ld(&bar[XB_XCNT(j)]); sum += c; cnt += (c > 0u) ? 1u : 0u; mine = (j == x) ? c : mine; }
        if (sum == G) break;
        __builtin_amdgcn_s_sleep(1);
        if ((++sp & 255u) == 0u) { if (xb_ld(&bar[XB_TMO])) break; if (sp > XB_SPIN_CAP) { atomicAdd(&bar[XB_TMO], 1u); break; } }
    }
    nloc = mine > 0u ? mine : 1u; nx = cnt > 0u ? cnt : 1u;
}
__device__ __forceinline__ void xcd_barrier(const XcdBarrier& b) {
    asm volatile("s_waitcnt vmcnt(0)" ::: "memory");
    __syncthreads();
    if (tid_() == 0) {
        unsigned* bar = b.bar;
        __builtin_amdgcn_s_waitcnt(0);
        unsigned nloc = b.st[0], nx = b.st[1];
        if (nloc == 0u) { xcd_barrier_complete(bar, b.x, nloc, nx); b.st[0] = nloc; b.st[1] = nx; }
        const unsigned old = xb_add(&bar[XB_XSUB(b.x)], 1u);
        const unsigned gen = old / nloc;
        if (old + 1u == (gen + 1u) * nloc) {
            __builtin_amdgcn_fence(__ATOMIC_RELEASE, "agent");
            asm volatile("s_waitcnt vmcnt(0)" ::: "memory");
            const unsigned og = xb_add(&bar[XB_TOP], 1u);
            const unsigned tg = og / nx;
            if (og + 1u == (tg + 1u) * nx) xb_add(&bar[XB_TOPGEN], 1u);
            else XB_SPIN(xb_ld(&bar[XB_TOPGEN]) == tg, bar);
            __builtin_amdgcn_fence(__ATOMIC_ACQUIRE, "agent");
            xb_add(&bar[XB_XGEN(b.x)], 1u);
            asm volatile("s_waitcnt vmcnt(0)" ::: "memory");
        } else {
            XB_SPIN(xb_ld(&bar[XB_XGEN(b.x)]) == gen, bar);
            __builtin_amdgcn_fence(__ATOMIC_ACQUIRE, "agent");
            asm volatile("s_waitcnt vmcnt(0)" ::: "memory");
        }
    }
    __syncthreads();
}

__global__ void __launch_bounds__(512, 2) mega_fwd(Params p) {
    cg::grid_group grid = cg::this_grid();
    char* lds = smem; LDS3 unsigned char* lds3 = (LDS3 unsigned char*)smem;
    const int G = gridDim.x, bid = blockIdx.x;
    if (tid_() < 4) ((volatile LDS3 unsigned*)(lds3 + LDS_XB))[tid_()] = 0u;
    __syncthreads();
    const XcdBarrier xb = xcd_barrier_post((unsigned*)(p.ws + WS_BAR), (volatile LDS3 unsigned*)(lds3 + LDS_XB));
    for (int rep = 0; rep < REP_P0; ++rep) phase_prologue(p, lds);
    if (p.ws == nullptr) grid.sync();
    xcd_barrier(xb);
    for (int rep = 0; rep < REP_P1; ++rep) { const int nconv = (G >= 64) ? (G * 3) / 16 : 0, ngemm = G - nconv;
      if (bid >= ngemm) { expert_convert(p, lds, bid - ngemm, nconv, N_EXPERT_TILES_P0, N_EXPERT_TILES); }
      else { unsigned char* ws = opaque(p.ws);
        { pg8::DenseProbT<1> S; S.init(ws + WS_XN, ws + WS_W_IN, NTOK, pg8::sens_count() * 256, 1024, ngemm, bid);
          EpiProjT<false> E; E.ws = ws; pg8::gemm_phase(lds3, S, E); }
        { pg8::DenseProbT<2> S; S.init(ws + WS_XN8, ws + WS_WIN8, NTOK, (39 - pg8::sens_count()) * 256, 512  , ngemm, bid);
          EpiProjT<true> E; E.ws = ws; pg8::gemm_phase(lds3, S, E); } }
      if (nconv == 0) expert_convert(p, lds, bid, G, N_EXPERT_TILES_P0, N_EXPERT_TILES); }
    xcd_barrier(xb);
    {
      constexpr int NIT = 4 * 24 * 16; const bool xmap = (G == 256);
      auto amap = [&](int k) -> int { return xmap ? (((k * 16 + 2 * (bid & 7) + ((bid >> 3) >> 4)) << 4) + ((bid >> 3) & 15)) : (k * G + bid); };
      AttnPre pre; if (amap(0) < NIT) attn_fetch(p, amap(0), pre);
      for (int k = 0; amap(k) < NIT; ++k) attn_item(p, amap(k), amap(k + 1), amap(k + 1) < NIT, pre, lds); }
    for (int rep = 0; rep < REP_GLA1; ++rep) { G1Pre pre; if (bid < 1024) gla1_fetch(p, bid, pre); int hprev = -1;
        for (int item = bid; item < 1024; item += G) { const int h = (item >> 6) & 3; gla1_item(p, item, item + G, item + G < 1024, h != hprev, pre, lds); hprev = h; } }
    xcd_barrier(xb);
    for (int rep = 0; rep < REP_P3; ++rep) phase_scan_combine(p);
    xcd_barrier(xb);
    for (int rep = 0; rep < REP_P4; ++rep) { G3Pre pre; if (bid < 1024) gla3_fetch(p, bid, pre);
        for (int item = bid; item < 1024; item += G) gla3_item(p, item, item + G, item + G < 1024, pre, lds); }
    xcd_barrier(xb);
    for (int rep = 0; rep < REP_P5; ++rep) {
    { unsigned char* ws = opaque(p.ws); pg8::DenseProb S; S.init(ws + WS_YATT, ws + WS_W_A, NTOK, 1024, 512, G, bid);
      EpiGate<0> E; E.gate = (const bf16_t*)(ws + WS_SA); E.t1 = nullptr; E.out = (bf16_t*)(ws + WS_T1);
      pg8::gemm_phase(lds3, S, E); }
    { unsigned char* ws = opaque(p.ws); pg8::DenseProb S; S.init(ws + WS_YGLA, ws + WS_W_G, NTOK, 1024, 1024, G, bid);
      EpiGate<1> E; E.gate = (const bf16_t*)(ws + WS_SG); E.t1 = (const bf16_t*)(ws + WS_T1); E.out = (bf16_t*)(ws + WS_MERGED);
      pg8::gemm_phase(lds3, S, E); }
    }
    xcd_barrier(xb);
    for (int rep = 0; rep < REP_P6; ++rep) { unsigned char* ws = opaque(p.ws); pg8::DenseProb S; S.init(ws + WS_MERGED, ws + WS_W_MIX, NTOK, 1024, 1024, G, bid);
      EpiResid E; E.x = p.x; E.h = (bf16_t*)(ws + WS_H);
      pg8::gemm_phase(lds3, S, E); }
    xcd_barrier(xb);
    for (int rep = 0; rep < REP_P7; ++rep) for (int grp = bid; grp < 256; grp += G) route_group(p, grp, lds);
    xcd_barrier(xb);
    for (int rep = 0; rep < REP_P8; ++rep) for (int grp = bid; grp < 256; grp += G) dispatch_group(p, grp, lds);
    if (bid == 0) { unsigned char* ws = opaque(p.ws); dispatch_tables(p, -1, lds); const int* T = (const int*)(lds + DP_TOT); int* TE = (int*)(ws + WS_TILEE);
        if (tid_() < 32) { const int e = tid_(); for (int t = T[32 + e]; t < T[32 + e] + ((T[e] + 255) >> 8); ++t) TE[16 + t] = e; }
        if (tid_() == 0) TE[0] = T[96];
        for (int e = 0; e < 32; ++e) { const int nt_ = (T[e] + 255) >> 8; int* ro = (int*)(ws + WS_XPAD) + T[32 + e] * 256; for (int r = T[e] + tid_(); r < nt_ * 256; r += 512) ro[r] = 0; } }
    xcd_barrier(xb);
    for (int rep = 0; rep < REP_P9; ++rep) { unsigned char* ws = opaque(p.ws); const int* TE = (const int*)(ws + WS_TILEE);
      pg8::MoeProbT<true> S; S.A = (const char*)(ws + WS_HN); S.rowoff = (const int*)(ws + WS_XPAD); S.Bt = (const char*)(ws + WS_W_GU); S.K = 512  ; S.nN = 8; S.T = TE[0]; S.G = G; S.c = bid; S.estride = (size_t)2048 * 1024; S.tile_e = TE + 16;
      EpiAct E; E.bgu = p.e_b_gu; E.tile_e = TE + 16; E.act = ws + WS_ACT;
      pg8::gemm_phase(lds3, S, E); }
    xcd_barrier(xb);
    for (int rep = 0; rep < REP_P10; ++rep) { unsigned char* ws = opaque(p.ws); const int* TE = (const int*)(ws + WS_TILEE);
      pg8::MoeProbT<false> S; S.rowoff = nullptr; S.A = (const char*)(ws + WS_ACT); S.Bt = (const char*)(ws + WS_W_D); S.K = 512  ; S.nN = 4; S.T = TE[0]; S.G = G; S.c = bid; S.estride = (size_t)1024 * 1024; S.tile_e = TE + 16;
      EpiDown E; E.bd = p.e_b_d; E.tile_e = TE + 16; E.y = ws + WS_YPAD;
      pg8::gemm_phase(lds3, S, E); }
    xcd_barrier(xb);
    for (int rep = 0; rep < REP_P11; ++rep) phase_combine(p);
}

extern "C" void kernel_launch(void* const* d_in, const int* in_sizes, int n_in, void* d_out, int out_size, void* d_ws, size_t ws_size, hipStream_t stream) {
    static int grid = 0;
    if (grid == 0) {
        if (n_in != 17 || ws_size < WS_END) { fprintf(stderr, "kernel_launch: expected 17 inputs and >= %zu bytes of workspace (got %d, %zu); nothing launched\n", (size_t)WS_END, n_in, ws_size); grid = -1; return; }
        int dev = 0, cus = 0, per_cu = 0;
        if (hipGetDevice(&dev) != hipSuccess || hipDeviceGetAttribute(&cus, hipDeviceAttributeMultiprocessorCount, dev) != hipSuccess) { fprintf(stderr, "kernel_launch: device query failed\n"); grid = -1; return; }
        if (hipFuncSetAttribute((const void*)mega_fwd, hipFuncAttributeMaxDynamicSharedMemorySize, LDS_BYTES) != hipSuccess) { fprintf(stderr, "kernel_launch: hipFuncSetAttribute failed\n"); grid = -1; return; }
        if (hipOccupancyMaxActiveBlocksPerMultiprocessor(&per_cu, (const void*)mega_fwd, 512, LDS_BYTES) != hipSuccess || per_cu < 1) { fprintf(stderr, "kernel_launch: occupancy query failed (%d)\n", per_cu); grid = -1; return; }
        grid = cus;
    }
    if (grid < 0) return;
    Params p{};
    p.x = (const float*)d_in[0]; p.norm_mix_g = (const float*)d_in[1]; p.w_in = (const float*)d_in[2]; p.gla_gate_up = (const float*)d_in[3]; p.gla_gate_bias = (const float*)d_in[4]; p.gla_norm_g = (const float*)d_in[5];
    p.w_branch_gla = (const float*)d_in[6]; p.w_branch_att = (const float*)d_in[7]; p.w_mix_out = (const float*)d_in[8]; p.norm_ffn_g = (const float*)d_in[9]; p.router_w = (const float*)d_in[10]; p.router_b = (const float*)d_in[11];
    p.e_w_gu = (const float*)d_in[12]; p.e_b_gu = (const float*)d_in[13]; p.e_w_d = (const float*)d_in[14]; p.e_b_d = (const float*)d_in[15]; p.norm_final_g = (const float*)d_in[16];
    p.out = (float*)d_out; p.ws = (unsigned char*)d_ws;
    if (hipMemsetAsync((char*)d_ws + WS_BAR, 0, 3456 * 4, stream) != hipSuccess) { fprintf(stderr, "kernel_launch: memset of the barrier words failed\n"); return; }
    void* args[] = {&p};
    hipError_t e = hipLaunchCooperativeKernel((const void*)mega_fwd, dim3(grid), dim3(512), args, LDS_BYTES, stream);
    if (e != hipSuccess) fprintf(stderr, "kernel_launch: cooperative launch failed: %s (grid %d)\n", hipGetErrorString(e), grid);
}
```

```cpp
#include <hip/hip_runtime.h>
#include <hip/hip_cooperative_groups.h>
#include <cstdio>
#include <cstdint>
namespace cg = cooperative_groups;
#ifndef REP_P0
#define REP_P0 1
#define REP_P1 1
#define REP_ATT 1
#define REP_GLA1 1
#define REP_P3 1
#define REP_P4 1
#define REP_P5 1
#define REP_P6 1
#define REP_P7 1
#define REP_P8 1
#define REP_P9 1
#define REP_P10 1
#define REP_P11 1
#endif

#define LDS3 __attribute__((address_space(3)))
typedef unsigned short bf16_t;
typedef short bf16x8 __attribute__((ext_vector_type(8)));
typedef short s16x4 __attribute__((ext_vector_type(4)));
typedef short v4i16_t __attribute__((ext_vector_type(4)));
typedef float f32x4 __attribute__((ext_vector_type(4)));
typedef float f32x2 __attribute__((ext_vector_type(2)));
typedef float f32x16 __attribute__((ext_vector_type(16)));
typedef unsigned u32x4 __attribute__((ext_vector_type(4)));
typedef unsigned u32x2 __attribute__((ext_vector_type(2)));
typedef int i32x8 __attribute__((ext_vector_type(8)));
typedef int i32x4 __attribute__((ext_vector_type(4)));

constexpr int NTOK = 16384, DM = 1024, SEQ = 4096, NB = 4;
constexpr int INW = 9744, INWP = 9984;
constexpr int NEXP = 32, TOPK = 4, FF = 1024;
constexpr int MAXT = 288;
constexpr float EPS = 1e-5f;
constexpr float QSCALE = 0.125f * 1.4426950408889634f;
constexpr float LN2 = 0.6931471805599453f;

constexpr size_t al256(size_t x) { return (x + 255) & ~(size_t)255; }
constexpr size_t WS_W_IN = 0;
constexpr size_t WS_W_G = WS_W_IN + (size_t)INWP * 1024 * 2;
constexpr size_t WS_W_A = WS_W_G + (size_t)1024 * 1024 * 2;
constexpr size_t WS_W_MIX = WS_W_A + (size_t)1024 * 512 * 2;
constexpr size_t WS_W_GU = WS_W_MIX + (size_t)1024 * 1024 * 2;
constexpr size_t WS_W_D = WS_W_GU + (size_t)NEXP * 2048 * 1024;
constexpr size_t WS_ROPE_C = WS_W_D + (size_t)NEXP * 1024 * 1024;
constexpr size_t WS_ROPE_S = WS_ROPE_C + (size_t)SEQ * 8 * 4;
constexpr size_t WS_RWG = WS_ROPE_S + (size_t)SEQ * 8 * 4;
constexpr size_t WS_H = WS_RWG + (size_t)1024 * 32 * 4;
constexpr size_t WS_HN = WS_H + (size_t)NTOK * 1024 * 4;
constexpr size_t WS_TOPE = WS_HN + (size_t)NTOK * 1024;
constexpr size_t WS_TOPG = WS_TOPE + (size_t)NTOK * 4 * 4;
constexpr size_t WS_TOPP = WS_TOPG + (size_t)NTOK * 4 * 4;
constexpr size_t WS_SLOT = WS_TOPP + (size_t)NTOK * 4 * 4;
constexpr size_t WS_CNT = WS_SLOT + (size_t)NTOK * 4 * 4;
constexpr size_t WS_TILEE = WS_CNT + (size_t)256 * 32 * 4;
constexpr size_t WS_REGB = al256(WS_TILEE + (size_t)(MAXT + 32) * 4);
constexpr size_t WS_XN = WS_REGB;
constexpr size_t WS_GQ = WS_XN + (size_t)NTOK * 1024 * 2;
constexpr size_t WS_GK = WS_GQ + (size_t)NTOK * 512 * 2;
constexpr size_t WS_GV = WS_GK + (size_t)NTOK * 512 * 2;
constexpr size_t WS_GR = WS_GV + (size_t)NTOK * 1024 * 2;
constexpr size_t WS_SG = WS_GR + (size_t)NTOK * 1024 * 2;
constexpr size_t WS_SA = WS_SG + (size_t)NTOK * 1024 * 2;
constexpr size_t WS_AQ = WS_SA + (size_t)NTOK * 1024 * 2;
constexpr size_t WS_AK = WS_AQ + (size_t)NTOK * 1536 * 2;
constexpr size_t WS_AV = WS_AK + (size_t)NTOK * 1536 * 2;
constexpr size_t WS_GLR = WS_AV + (size_t)NTOK * 1536 * 2;
constexpr size_t WS_OATT = WS_GLR + (size_t)NTOK * 16 * 4;
constexpr size_t WS_LSE = WS_OATT + (size_t)3 * NTOK * 512 * 2;
constexpr size_t WS_QE = WS_LSE + (size_t)3 * NTOK * 8 * 4;
constexpr size_t WS_OINTRA = WS_QE + (size_t)NTOK * 512 * 2;
constexpr size_t WS_U = WS_OINTRA + (size_t)NTOK * 1024 * 2;
constexpr size_t WS_DEC = WS_U + (size_t)1024 * 128 * 256 * 2;
constexpr size_t WS_XN8 = WS_DEC + (size_t)1024 * 128 * 4;
constexpr size_t WS_WIN8 = WS_XN8 + (size_t)NTOK * 1024;
constexpr size_t WS_REGB_END = WS_WIN8 + (size_t)INWP * 1024;
constexpr size_t WS_PREV = WS_AQ;
constexpr size_t WS_YGLA = WS_AV;
constexpr size_t WS_YATT = WS_XN;
constexpr size_t WS_T1 = WS_GQ;
constexpr size_t WS_MERGED = WS_GV;
constexpr size_t PADROWS = (size_t)MAXT * 256;
constexpr size_t WS_XPAD = WS_REGB;
constexpr size_t WS_ACT = WS_XPAD + PADROWS * 1024;
constexpr size_t WS_YPAD = WS_ACT + PADROWS * 1024;
constexpr size_t WS_PAD_END = WS_YPAD + PADROWS * 1024;
constexpr size_t WS_BAR = al256(WS_REGB_END > WS_PAD_END ? WS_REGB_END : WS_PAD_END);
constexpr size_t WS_END = WS_BAR + 3456 * 4;
static_assert(WS_PAD_END <= WS_REGB_END + (1u << 30), "map");

constexpr int LDS_XB = 147456;
constexpr int LDS_TAB_OFF = 147456 + 16;
constexpr int LDS_BYTES = 147456 + 16 + 1024;

struct Params {
    const float *x, *norm_mix_g, *w_in, *gla_gate_up, *gla_gate_bias, *gla_norm_g, *w_branch_gla, *w_branch_att, *w_mix_out, *norm_ffn_g,
        *router_w, *router_b, *e_w_gu, *e_b_gu, *e_w_d, *e_b_d, *norm_final_g;
    float* out;
    unsigned char* ws;
};

__device__ __forceinline__ int tid_() { int t = threadIdx.x; asm volatile("" : "+v"(t)); return t; }
__device__ __forceinline__ unsigned char* opaque(unsigned char* q) { return q; }
__device__ __forceinline__ unsigned cvt_pk_bf16(float lo, float hi) { unsigned r; asm volatile("v_cvt_pk_bf16_f32 %0, %1, %2" : "=v"(r) : "v"(lo), "v"(hi)); return r; }
__device__ __forceinline__ float bf_lo(unsigned w) { return __uint_as_float(w << 16); }
__device__ __forceinline__ float bf_hi(unsigned w) { return __uint_as_float(w & 0xffff0000u); }
__device__ __forceinline__ float bf2f(bf16_t b) { return __uint_as_float(((unsigned)b) << 16); }
__device__ __forceinline__ u32x4 pack8(const float* v) { u32x4 w; w.x = cvt_pk_bf16(v[0], v[1]); w.y = cvt_pk_bf16(v[2], v[3]); w.z = cvt_pk_bf16(v[4], v[5]); w.w = cvt_pk_bf16(v[6], v[7]); return w; }
__device__ __forceinline__ void unpack8(u32x4 w, float* v) { v[0] = bf_lo(w.x); v[1] = bf_hi(w.x); v[2] = bf_lo(w.y); v[3] = bf_hi(w.y); v[4] = bf_lo(w.z); v[5] = bf_hi(w.z); v[6] = bf_lo(w.w); v[7] = bf_hi(w.w); }
__device__ __forceinline__ float sigmoidf_(float v) { return __builtin_amdgcn_rcpf(1.0f + __builtin_amdgcn_exp2f(v * -1.4426950408889634f)); }
__device__ __forceinline__ float wave_sum(float v) { v += __shfl_xor(v, 32); v += __shfl_xor(v, 16); v += __shfl_xor(v, 8); v += __shfl_xor(v, 4); v += __shfl_xor(v, 2); v += __shfl_xor(v, 1); return v; }
__device__ __forceinline__ s16x4 tr16(const LDS3 char* p) { return __builtin_bit_cast(s16x4, __builtin_amdgcn_ds_read_tr16_b64_v4i16((LDS3 v4i16_t*)p)); }
__device__ __forceinline__ bf16x8 cat8(s16x4 a, s16x4 b) { return (bf16x8){a[0], a[1], a[2], a[3], b[0], b[1], b[2], b[3]}; }
__device__ __forceinline__ int crow(int r, int hi) { return (r & 3) + 8 * (r >> 2) + 4 * hi; }
__device__ __forceinline__ void st_nt(void* p, u32x4 v) { __builtin_nontemporal_store(v, (u32x4*)p); }
__device__ __forceinline__ int pk4_fp8(float a, float b, float c, float d) { int w = __builtin_amdgcn_cvt_pk_fp8_f32(a, b, 0, false); return __builtin_amdgcn_cvt_pk_fp8_f32(c, d, w, true); }
__device__ __forceinline__ f32x4 bf4_to_f32(u32x2 w) { f32x4 r; r[0] = bf_lo(w.x); r[1] = bf_hi(w.x); r[2] = bf_lo(w.y); r[3] = bf_hi(w.y); return r; }
#define MFMA32(a, b, c) __builtin_amdgcn_mfma_f32_32x32x16_bf16(a, b, c, 0, 0, 0)

namespace pg8 {
constexpr int BM = 256, BK = 64, HALF = 128, HTB = HALF * BK * 2, STAGE_BYTES = 8 * HTB, NXCD = 8, WGM = 8;
constexpr bool GEMM_ALIGN_EPI = true;
constexpr bool GEMM_SP2 = true;
__host__ __device__ __forceinline__ int lds_byte(int r, int c) { const int st = (r >> 4) * 2 + (c >> 5), rr = r & 15, cc = c & 31, ob = rr * 64 + cc * 2; return st * 1024 + (ob ^ (((ob >> 9) & 1) << 5)); }
__host__ __device__ __forceinline__ void stage_rc(int b, int& R, int& C) { const int st = b / 1024, sb = b % 1024, swz = sb ^ (((sb >> 9) & 1) << 5); R = (st >> 1) * 16 + swz / 64; C = (st & 1) * 32 + (swz % 64) / 2; }
__host__ __device__ __forceinline__ int perm32(int rho) { const int n = rho >> 4, i = rho & 15; return 8 * (i >> 2) + 4 * n + (i & 3); }
struct Unit { int pm, pn; };

#ifndef SENSMASK
#define SENSMASK ((0xFFFull << 0) | (3ull << 30) | (1ull << 38))
#endif
constexpr int sens_count() { int c = 0; for (int t = 0; t < 39; ++t) c += (int)((SENSMASK >> t) & 1ull); return c; }
__device__ __forceinline__ int subset_tile(int sub, int k) {
    int seen = 0, res = 0;
#pragma unroll
    for (int t = 0; t < 39; ++t) { const bool in = (((SENSMASK >> t) & 1ull) != 0ull) == (sub == 1); if (in) { if (seen == k) res = t; ++seen; } }
    return res; }
template <int SUBSET> struct DenseProbT {
    const char* A; const char* Bt; int K; int nM, nN, nwg, G, c;
    __device__ void init(const void* A_, const void* Bt_, int M, int N, int K_, int G_, int c_) { A = (const char*)A_; Bt = (const char*)Bt_; K = K_; nM = M / BM; nN = N / BM; nwg = nM * nN; G = G_; c = c_; }
    __device__ __forceinline__ bool next(int i, Unit& u) const {
        const long L = (long)i * G + c; if (L >= nwg) return false;
        int wgid = (int)L; { const int q = nwg / NXCD, r = nwg % NXCD, xcd = wgid % NXCD, off = wgid / NXCD; wgid = (xcd < r ? xcd * (q + 1) : r * (q + 1) + (xcd - r) * q) + off; }
        const int nig = WGM * nN, gid = wgid / nig, fm = gid * WGM, gsz = (nM - fm) < WGM ? (nM - fm) : WGM;
        u.pm = fm + ((wgid % nig) % gsz); int pn = (wgid % nig) / gsz;
        if (SUBSET != 0) pn = subset_tile(SUBSET, pn);
        u.pn = pn; return true;
    }
    __device__ __forceinline__ const char* a_ptr(const Unit& u) const { return A + (size_t)u.pm * BM * K * 2; }
    __device__ __forceinline__ const char* b_ptr(const Unit& u) const { return Bt + (size_t)u.pn * BM * K * 2; }
    static constexpr bool GATHER = false;
    __device__ __forceinline__ const int* rows(const Unit&) const { return nullptr; }
};
typedef DenseProbT<0> DenseProb;
template <bool GATHER_> struct MoeProbT {
    static constexpr bool GATHER = GATHER_;
    const char* A; const char* Bt; int K; int nN, T, G, c; size_t estride; const int* tile_e; const int* rowoff;
    __device__ __forceinline__ bool next(int i, Unit& u) const {
        if ((G % (8 * nN)) == 0) { const int tpx = G / (8 * nN), tpr = 8 * tpx, x = c & 7, slot = c >> 3; const int tile = i * tpr + x * tpx + slot / nN; if (tile >= T) return false; u.pm = tile; u.pn = slot % nN; return true; }
        const long L = (long)i * G + c; if (L >= (long)T * nN) return false; u.pm = (int)(L / nN); u.pn = (int)(L % nN); return true; }
    __device__ __forceinline__ const char* a_ptr(const Unit& u) const { return GATHER ? A : A + (size_t)u.pm * BM * K * 2; }
    __device__ __forceinline__ const char* b_ptr(const Unit& u) const { return Bt + (size_t)tile_e[u.pm] * estride + (size_t)u.pn * BM * K * 2; }
    __device__ __forceinline__ const int* rows(const Unit& u) const { return rowoff + u.pm * BM; }
};

template <class Epi, class Prob>
__device__ __forceinline__ void gemm_phase(LDS3 unsigned char* lds, const Prob& S, const Epi& E) {
    const int tid = tid_(), wid = __builtin_amdgcn_readfirstlane(tid >> 6), lane = tid & 63, wr = wid >> 2, wc = wid & 3, fr = lane & 15, fq = lane >> 4;
    const int K = S.K, nt = K / BK;
    unsigned voffA[2], voffB[2]; int Rrow[2];
#pragma unroll
    for (int i = 0; i < 2; ++i) { int R, C; stage_rc(tid * 16 + i * 8192, R, C); const int Rb = Epi::PERM ? (2 * (R & ~31) + perm32(R & 31)) : R;
        voffA[i] = (unsigned)(R * K + C) * 2u; voffB[i] = (unsigned)(Rb * K + C) * 2u; Rrow[i] = R; if (Prob::GATHER) voffA[i] = (unsigned)C * 2u; }
    const size_t kstep = (size_t)(BK * 2);
    const size_t hstep = (size_t)HALF * K * 2;
    const size_t hstepB = Epi::PERM ? (size_t)32 * K * 2 : hstep;
    const unsigned ldsw = (unsigned)wid * 1024u;
    const int aoff = lds_byte(wr * 64 + fr, fq * 8), boff = lds_byte(wc * 32 + fr, fq * 8);
#define PG8_SA(b, h) (((b) * 2 + (h)) * HTB)
#define PG8_SB(b, h) ((4 + (b) * 2 + (h)) * HTB)
#define PG8_STAGE(bufoff, gbase, voff) do { _Pragma("unroll") for (int _i = 0; _i < 2; ++_i) \
        __builtin_amdgcn_global_load_lds((const unsigned*)((const char*)(gbase) + (voff)[_i]), (LDS3 unsigned*)(lds + (bufoff) + ldsw + _i * 8192), 16, 0, 0); } while (0)
#define PG8_LD8(ptr) __builtin_shufflevector(*(const LDS3 i32x4*)(ptr), *(const LDS3 i32x4*)((ptr) + 1024), 0, 1, 2, 3, 4, 5, 6, 7)
#define PG8_LO(x) __builtin_bit_cast(bf16x8, __builtin_shufflevector(x, x, 0, 1, 2, 3))
#define PG8_HI(x) __builtin_bit_cast(bf16x8, __builtin_shufflevector(x, x, 4, 5, 6, 7))
#define PG8_LDA(dst, b, h) do { _Pragma("unroll") for (int m = 0; m < 4; ++m) dst[m] = PG8_LD8(lds + PG8_SA(b, h) + aoff + m * 2048); } while (0)
#define PG8_LDB(dst, b, h) do { _Pragma("unroll") for (int n = 0; n < 2; ++n) dst[n] = PG8_LD8(lds + PG8_SB(b, h) + boff + n * 2048); } while (0)
#define PG8_MMA(ai, bj, At, Bt) do { __builtin_amdgcn_s_setprio(1); _Pragma("unroll") for (int m = 0; m < 4; ++m) _Pragma("unroll") for (int n = 0; n < 2; ++n) { \
        if constexpr (Epi::FP8) asm volatile("v_mfma_scale_f32_16x16x128_f8f6f4 %0, %1, %2, %0, %3, %4 op_sel_hi:[0,0,0]" : "+v"(acc[ai][bj][m][n]) : "v"(Bt[n]), "v"(At[m]), "v"(sc_w), "v"(sc_1)); \
        else { acc[ai][bj][m][n] = __builtin_amdgcn_mfma_f32_16x16x32_bf16(PG8_LO(Bt[n]), PG8_LO(At[m]), acc[ai][bj][m][n], 0, 0, 0); acc[ai][bj][m][n] = __builtin_amdgcn_mfma_f32_16x16x32_bf16(PG8_HI(Bt[n]), PG8_HI(At[m]), acc[ai][bj][m][n], 0, 0, 0); } } __builtin_amdgcn_s_setprio(0); } while (0)
#define PG8_WAIT_V(n) asm volatile("s_waitcnt vmcnt(" #n ")" ::: "memory")
#define PG8_WAIT_L(n) asm volatile("s_waitcnt lgkmcnt(" #n ")" ::: "memory")
#define PG8_BAR __builtin_amdgcn_s_barrier()
#define PG8_SCHED __builtin_amdgcn_sched_barrier(0)
    Unit cur, nxt; int ui = 0;
    if (!S.next(0, cur)) return;
    f32x4 acc[2][2][4][2];
#pragma unroll
    for (int a = 0; a < 2; ++a)
#pragma unroll
        for (int b = 0; b < 2; ++b)
#pragma unroll
            for (int m = 0; m < 4; ++m)
#pragma unroll
                for (int n = 0; n < 2; ++n) acc[a][b][m][n] = (f32x4){0.f, 0.f, 0.f, 0.f};
    i32x8 At[4], B0[2], B1[2];
    int sc_w = 0x7A7A7A7A  , sc_1 = 0x7F7F7F7F; asm volatile("" : "+v"(sc_w), "+v"(sc_1));
    const char* cA = S.a_ptr(cur); const char* cB = S.b_ptr(cur);
    unsigned vAc[2][2], vAn[2][2];
    LDS3 int* rtab = (LDS3 int*)(lds + LDS_TAB_OFF);
    if constexpr (Prob::GATHER) { const int* rw = S.rows(cur);
#pragma unroll
        for (int h = 0; h < 2; ++h)
#pragma unroll
            for (int i = 0; i < 2; ++i) vAc[h][i] = (unsigned)rw[h * HALF + Rrow[i]] + voffA[i];
    } else {
#pragma unroll
        for (int h = 0; h < 2; ++h)
#pragma unroll
            for (int i = 0; i < 2; ++i) vAc[h][i] = voffA[i] + (unsigned)(h * hstep);
    }
#pragma unroll
    for (int h = 0; h < 2; ++h)
#pragma unroll
        for (int i = 0; i < 2; ++i) vAn[h][i] = vAc[h][i];
    if constexpr (GEMM_SP2) {
        PG8_STAGE(PG8_SB(0, 0), cB, voffB); PG8_STAGE(PG8_SB(0, 1), cB + hstepB, voffB); PG8_STAGE(PG8_SA(0, 0), cA, vAc[0]); PG8_STAGE(PG8_SA(0, 1), cA, vAc[1]);
        if (wr == 1) PG8_BAR;
        PG8_WAIT_V(2); PG8_BAR;
        PG8_STAGE(PG8_SB(1, 0), cB + kstep, voffB); PG8_STAGE(PG8_SA(1, 0), cA + kstep, vAc[0]); PG8_STAGE(PG8_SB(1, 1), cB + hstepB + kstep, voffB);
        PG8_WAIT_V(6); PG8_BAR;
    } else {
    PG8_STAGE(PG8_SB(0, 0), cB, voffB); PG8_STAGE(PG8_SA(0, 0), cA, vAc[0]); PG8_STAGE(PG8_SB(0, 1), cB + hstepB, voffB); PG8_STAGE(PG8_SA(0, 1), cA, vAc[1]);
    if (wr == 1) PG8_BAR;
    PG8_WAIT_V(4); PG8_BAR;
    PG8_STAGE(PG8_SB(1, 0), cB + kstep, voffB); PG8_STAGE(PG8_SA(1, 0), cA + kstep, vAc[0]); PG8_STAGE(PG8_SB(1, 1), cB + hstepB + kstep, voffB);
    PG8_WAIT_V(6); PG8_BAR;
    }
    for (;;) {
        const bool has_next = S.next(ui + 1, nxt);
        const char* nA = has_next ? S.a_ptr(nxt) : cA; const char* nB = has_next ? S.b_ptr(nxt) : cB;
        if constexpr (Prob::GATHER) { if (has_next && wid < 4) __builtin_amdgcn_global_load_lds((const unsigned*)(S.rows(nxt) + wid * 64 + lane), (LDS3 unsigned*)(lds + LDS_TAB_OFF + wid * 256), 4, 0, 0); }
        for (int t = 0; t < nt; t += 2) {
            const bool last = (t == nt - 2);
            const char* a1 = cA + (size_t)(t + 1) * kstep;
            const char* a2 = last ? nA : cA + (size_t)(t + 2) * kstep; const char* b2 = last ? nB : cB + (size_t)(t + 2) * kstep;
            const char* a3 = a2 + kstep; const char* b3 = b2 + kstep;
            if constexpr (Prob::GATHER) { if (last && has_next) {
#pragma unroll
                for (int h = 0; h < 2; ++h)
#pragma unroll
                    for (int i = 0; i < 2; ++i) vAn[h][i] = (unsigned)rtab[h * HALF + Rrow[i]] + voffA[i]; } }
            unsigned vS[2][2];
#pragma unroll
            for (int h = 0; h < 2; ++h)
#pragma unroll
                for (int i = 0; i < 2; ++i) vS[h][i] = last ? vAn[h][i] : vAc[h][i];
            if constexpr (GEMM_SP2) {
            PG8_LDB(B0, 0, 0); PG8_LDB(B1, 0, 1); PG8_SCHED; PG8_LDA(At, 0, 0); PG8_STAGE(PG8_SA(1, 1), a1, vAc[1]);
            PG8_WAIT_V(8); PG8_WAIT_L(0); PG8_BAR; PG8_MMA(0, 0, At, B0); PG8_MMA(0, 1, At, B1); PG8_BAR; PG8_SCHED;
            PG8_LDA(At, 0, 1); PG8_STAGE(PG8_SB(0, 0), b2, voffB); PG8_STAGE(PG8_SB(0, 1), b2 + hstepB, voffB); PG8_STAGE(PG8_SA(0, 0), a2, vS[0]);
            PG8_WAIT_V(8); PG8_WAIT_L(0); PG8_BAR; PG8_MMA(1, 0, At, B0); PG8_MMA(1, 1, At, B1); PG8_BAR; PG8_SCHED;
            PG8_LDB(B0, 1, 0); PG8_LDB(B1, 1, 1); PG8_SCHED; PG8_LDA(At, 1, 0); PG8_STAGE(PG8_SA(0, 1), a2, vS[1]);
            PG8_WAIT_V(8); PG8_WAIT_L(0); PG8_BAR; PG8_MMA(0, 0, At, B0); PG8_MMA(0, 1, At, B1); PG8_BAR; PG8_SCHED;
            PG8_LDA(At, 1, 1); PG8_STAGE(PG8_SB(1, 0), b3, voffB); PG8_STAGE(PG8_SB(1, 1), b3 + hstepB, voffB); PG8_STAGE(PG8_SA(1, 0), a3, vS[0]);
            PG8_WAIT_V(8); PG8_WAIT_L(0); PG8_BAR; PG8_MMA(1, 0, At, B0); PG8_MMA(1, 1, At, B1); PG8_BAR; PG8_SCHED;
            } else {
            PG8_LDB(B0, 0, 0); PG8_SCHED; PG8_LDA(At, 0, 0); PG8_STAGE(PG8_SA(1, 1), a1, vAc[1]);
            PG8_WAIT_L(8); PG8_BAR; PG8_WAIT_L(0); PG8_MMA(0, 0, At, B0); PG8_BAR; PG8_SCHED;
            PG8_LDB(B1, 0, 1); PG8_STAGE(PG8_SB(0, 0), b2, voffB);
            PG8_BAR; PG8_WAIT_L(0); PG8_MMA(0, 1, At, B1); PG8_BAR;
            PG8_LDA(At, 0, 1); PG8_STAGE(PG8_SA(0, 0), a2, vS[0]);
            PG8_BAR; PG8_WAIT_L(0); PG8_MMA(1, 0, At, B0); PG8_BAR; PG8_SCHED;
            PG8_STAGE(PG8_SB(0, 1), b2 + hstepB, voffB);
            PG8_WAIT_V(6); PG8_BAR; PG8_MMA(1, 1, At, B1); PG8_BAR;
            PG8_LDB(B0, 1, 0); PG8_SCHED; PG8_LDA(At, 1, 0); PG8_STAGE(PG8_SA(0, 1), a2, vS[1]);
            PG8_WAIT_L(8); PG8_BAR; PG8_WAIT_L(0); PG8_MMA(0, 0, At, B0); PG8_BAR; PG8_SCHED;
            PG8_LDB(B1, 1, 1); PG8_STAGE(PG8_SB(1, 0), b3, voffB);
            PG8_BAR; PG8_WAIT_L(0); PG8_MMA(0, 1, At, B1); PG8_BAR;
            PG8_LDA(At, 1, 1); PG8_STAGE(PG8_SA(1, 0), a3, vS[0]);
            PG8_BAR; PG8_WAIT_L(0); PG8_MMA(1, 0, At, B0); PG8_BAR; PG8_SCHED;
            PG8_STAGE(PG8_SB(1, 1), b3 + hstepB, voffB);
            PG8_WAIT_V(6); PG8_BAR; PG8_MMA(1, 1, At, B1); PG8_BAR;
            }
        }
        if constexpr (GEMM_ALIGN_EPI) { if (wr == 0) PG8_BAR; }
        if constexpr (Epi::FP8) asm volatile("s_nop 15\n\ts_nop 15" ::: "memory");
        E(acc, cur, wr, wc, fr, fq);
        if (!has_next) break;
#pragma unroll
        for (int a = 0; a < 2; ++a)
#pragma unroll
            for (int b = 0; b < 2; ++b)
#pragma unroll
                for (int m = 0; m < 4; ++m)
#pragma unroll
                    for (int n = 0; n < 2; ++n) acc[a][b][m][n] = (f32x4){0.f, 0.f, 0.f, 0.f};
        if constexpr (Epi::FP8) asm volatile("s_nop 7" ::: "memory");
        cur = nxt; cA = nA; cB = nB; ++ui;
#pragma unroll
        for (int h = 0; h < 2; ++h)
#pragma unroll
            for (int i = 0; i < 2; ++i) vAc[h][i] = vAn[h][i];
        if constexpr (GEMM_ALIGN_EPI) { if (wr == 1) PG8_BAR; }
    }
    PG8_WAIT_V(0);
    if constexpr (!GEMM_ALIGN_EPI) { if (wr == 0) PG8_BAR; }
    PG8_BAR;
#undef PG8_SA
#undef PG8_SB
#undef PG8_STAGE
#undef PG8_LDA
#undef PG8_LDB
#undef PG8_MMA
#undef PG8_LD8
#undef PG8_LO
#undef PG8_HI
#undef PG8_WAIT_V
#undef PG8_WAIT_L
#undef PG8_BAR
#undef PG8_SCHED
}
}
using pg8::Unit;

extern __shared__ __attribute__((aligned(16))) char smem[];
__device__ __forceinline__ char* smem_base() { return smem; }

constexpr int EPI_LDS = 131072;
__device__ __forceinline__ char* epi_slot(int wr, int wc) { return smem_base() + EPI_LDS + (wr * 4 + wc) * 2048; }
__device__ __forceinline__ void slot_put(char* slot, int fr, int fq, u32x4 w0, u32x4 w1) {
    *(u32x4*)(slot + fr * 128 + (((fq) ^ (fr & 7)) << 4)) = w0; *(u32x4*)(slot + fr * 128 + (((4 + fq) ^ (fr & 7)) << 4)) = w1; }
__device__ __forceinline__ u32x4 slot_get(const char* slot, int half, int lane) { const int row = half * 8 + (lane >> 3), ch = lane & 7; return *(const u32x4*)(slot + row * 128 + ((ch ^ (row & 7)) << 4)); }

#define EPI_ROWS(ai, m) for (int ai = 0; ai < 2; ++ai) _Pragma("unroll") for (int m = 0; m < 4; ++m)

template <bool F8_> struct EpiProjT {
    static constexpr bool PERM = true, FP8 = F8_;
    unsigned char* ws;
    __device__ __forceinline__ void operator()(const f32x4 (&acc)[2][2][4][2], const Unit& u, int wr, int wc, int fr, int fq) const {
        const int pn = u.pn; const int lane = fq * 16 + fr; char* slot = epi_slot(wr, wc);
        const int rowq = u.pm * 256 + wr * 64 + (lane >> 3);
        if (pn < 12 || (pn >= 30 && pn < 38)) {
            size_t boff; int ld, col0, act;
            if (pn < 2) { boff = WS_GQ; ld = 512; col0 = pn * 256; act = 0; }
            else if (pn < 4) { boff = WS_GK; ld = 512; col0 = (pn - 2) * 256; act = 0; }
            else if (pn < 8) { boff = WS_GV; ld = 1024; col0 = (pn - 4) * 256; act = 0; }
            else if (pn < 12) { boff = WS_GR; ld = 1024; col0 = (pn - 8) * 256; act = 1; }
            else if (pn < 34) { boff = WS_SG; ld = 1024; col0 = (pn - 30) * 256; act = 2; }
            else { boff = WS_SA; ld = 1024; col0 = (pn - 34) * 256; act = 2; }
            bf16_t* base = (bf16_t*)(ws + boff) + col0 + wc * 64 + (lane & 7) * 8;
#pragma unroll
            EPI_ROWS(ai, m) { u32x4 w[2];
#pragma unroll
                for (int bj = 0; bj < 2; ++bj) { float v[8];
#pragma unroll
                    for (int j = 0; j < 4; ++j) { v[j] = acc[ai][bj][m][0][j]; v[4 + j] = acc[ai][bj][m][1][j]; }
                    if (act == 1) {
#pragma unroll
                        for (int j = 0; j < 8; ++j) v[j] = v[j] * sigmoidf_(v[j]); }
                    if (act == 2) {
#pragma unroll
                        for (int j = 0; j < 8; ++j) v[j] = sigmoidf_(v[j]); }
                    w[bj] = pack8(v); }
                slot_put(slot, fr, fq, w[0], w[1]);
#pragma unroll
                for (int half = 0; half < 2; ++half) st_nt(base + (size_t)(rowq + ai * 128 + m * 16 + half * 8) * ld, slot_get(slot, half, lane)); }
        } else if (pn < 30) {
            const int which = (pn - 12) / 6, t6 = (pn - 12) % 6, sh = (t6 >> 1) * 2, dmask = (1 << sh) - 1, NL = SEQ >> sh;
            unsigned char* base = ws + WS_AQ + (size_t)which * ((size_t)NTOK * 1536 * 2) + (lane & 3) * 16;
            const bool rot = (which < 2) && (fq < 2);
            f32x4 frev;
#pragma unroll
            for (int q = 0; q < 4; ++q) frev[q] = rot ? __builtin_amdgcn_exp2f(-(float)(4 * fq + q) * (0.125f * 18.931568569324174f)) * 0.15915494309189535f : 0.f;
            const int head = t6 * 4 + wc;
            const int rowq4 = u.pm * 256 + wr * 64 + (lane >> 2);
#pragma unroll
            EPI_ROWS(ai, m) { const int s = (u.pm * 256 + wr * 64 + fr + ai * 128 + m * 16) & (SEQ - 1);
                f32x4 cs, sn;
#pragma unroll
                for (int q = 0; q < 4; ++q) { const float rev = __builtin_amdgcn_fractf((float)s * frev[q]); cs[q] = __builtin_amdgcn_cosf(rev); sn[q] = __builtin_amdgcn_sinf(rev); }
#pragma unroll
                for (int bj = 0; bj < 2; ++bj) { float v[8];
#pragma unroll
                    for (int j = 0; j < 4; ++j) { v[j] = acc[ai][bj][m][0][j]; v[4 + j] = acc[ai][bj][m][1][j]; }
                    if (bj == 0) { const float a0 = v[0] * cs[0] - v[1] * sn[0], a1 = v[1] * cs[0] + v[0] * sn[0], a2 = v[2] * cs[1] - v[3] * sn[1], a3 = v[3] * cs[1] + v[2] * sn[1];
                      const float a4 = v[4] * cs[2] - v[5] * sn[2], a5 = v[5] * cs[2] + v[4] * sn[2], a6 = v[6] * cs[3] - v[7] * sn[3], a7 = v[7] * cs[3] + v[6] * sn[3];
                      v[0] = a0; v[1] = a1; v[2] = a2; v[3] = a3; v[4] = a4; v[5] = a5; v[6] = a6; v[7] = a7; }
                    u32x2 w8; w8.x = (unsigned)pk4_fp8(v[0], v[1], v[2], v[3]); w8.y = (unsigned)pk4_fp8(v[4], v[5], v[6], v[7]);
                    *(u32x2*)(slot + fr * 64 + bj * 32 + 8 * fq) = w8; }
                const u32x4 o = *(const u32x4*)(slot + (lane >> 2) * 64 + (lane & 3) * 16);
                const int row = rowq4 + ai * 128 + m * 16, b = row >> 12, s2 = row & (SEQ - 1), r = s2 & dmask, n = s2 >> sh;
                st_nt(base + ((size_t)(b * 24 + head) * SEQ + (size_t)r * NL + n) * 64, o); }
        } else {
            const int row0 = u.pm * 256 + wr * 64 + fr;
            if (wc == 0 && fq < 2) { float* glr = (float*)(ws + WS_GLR);
#pragma unroll
                EPI_ROWS(ai, m) { float* rowp = glr + (size_t)(row0 + ai * 128 + m * 16) * 16 + 8 * fq; *(f32x4*)rowp = acc[ai][0][m][0]; *(f32x4*)(rowp + 4) = acc[ai][0][m][1]; } }
        }
    }
};

template <int MODE> struct EpiGate {
    static constexpr bool PERM = true, FP8 = false;
    const bf16_t* gate; const bf16_t* t1; bf16_t* out;
    __device__ __forceinline__ void operator()(const f32x4 (&acc)[2][2][4][2], const Unit& u, int wr, int wc, int fr, int fq) const {
        const int lane = fq * 16 + fr; char* slot = epi_slot(wr, wc);
        const size_t off0 = (size_t)(u.pm * 256 + wr * 64 + (lane >> 3)) * 1024 + u.pn * 256 + wc * 64 + (lane & 7) * 8;
#pragma unroll
        for (int ai = 0; ai < 2; ++ai) { u32x4 gw[4][2], tw[4][2];
#pragma unroll
            for (int m = 0; m < 4; ++m)
#pragma unroll
                for (int half = 0; half < 2; ++half) { const size_t off = off0 + (size_t)(ai * 128 + m * 16 + half * 8) * 1024; gw[m][half] = *(const u32x4*)(gate + off); if (MODE == 1) tw[m][half] = *(const u32x4*)(t1 + off); }
#pragma unroll
            for (int m = 0; m < 4; ++m) { u32x4 w[2];
#pragma unroll
                for (int bj = 0; bj < 2; ++bj) { float v[8];
#pragma unroll
                    for (int j = 0; j < 4; ++j) { v[j] = acc[ai][bj][m][0][j]; v[4 + j] = acc[ai][bj][m][1][j]; }
                    w[bj] = pack8(v); }
                slot_put(slot, fr, fq, w[0], w[1]);
#pragma unroll
                for (int half = 0; half < 2; ++half) { float a[8], g[8]; unpack8(slot_get(slot, half, lane), a); unpack8(gw[m][half], g);
#pragma unroll
                    for (int j = 0; j < 8; ++j) a[j] *= g[j];
                    if (MODE == 1) { float t[8]; unpack8(tw[m][half], t);
#pragma unroll
                        for (int j = 0; j < 8; ++j) a[j] += t[j]; }
                    *(u32x4*)(out + off0 + (size_t)(ai * 128 + m * 16 + half * 8) * 1024) = pack8(a); } } }
    }
};

struct EpiResid {
    static constexpr bool PERM = false, FP8 = false;
    const float* x; bf16_t* h;
    __device__ __forceinline__ void operator()(const f32x4 (&acc)[2][2][4][2], const Unit& u, int wr, int wc, int fr, int fq) const {
        const int lane = fq * 16 + fr; char* slot = epi_slot(wr, wc);
        const size_t off0 = (size_t)(u.pm * 256 + wr * 64 + (lane >> 3)) * 1024 + u.pn * 256 + wc * 32 + (lane & 7) * 4;
#pragma unroll
        for (int ai = 0; ai < 2; ++ai)
#pragma unroll
            for (int bj = 0; bj < 2; ++bj) { f32x4 xv[4][2];
#pragma unroll
                for (int m = 0; m < 4; ++m)
#pragma unroll
                    for (int half = 0; half < 2; ++half) xv[m][half] = *(const f32x4*)(x + off0 + (size_t)(ai * 128 + m * 16 + half * 8) * 1024 + bj * 128);
#pragma unroll
                for (int m = 0; m < 4; ++m) { slot_put(slot, fr, fq, __builtin_bit_cast(u32x4, acc[ai][bj][m][0]), __builtin_bit_cast(u32x4, acc[ai][bj][m][1]));
#pragma unroll
                    for (int half = 0; half < 2; ++half) { const f32x4 a = __builtin_bit_cast(f32x4, slot_get(slot, half, lane));
                        const f32x4 r = a + xv[m][half]; u32x2 w2; w2.x = cvt_pk_bf16(r[0], r[1]); w2.y = cvt_pk_bf16(r[2], r[3]);
                        *(u32x2*)(h + off0 + (size_t)(ai * 128 + m * 16 + half * 8) * 1024 + bj * 128) = w2; } } }
    }
};

struct EpiAct {
    static constexpr bool PERM = true, FP8 = true;
    const float* bgu; const int* tile_e; unsigned char* act;
    __device__ __forceinline__ void operator()(const f32x4 (&acc)[2][2][4][2], const Unit& u, int wr, int wc, int fr, int fq) const {
        const int e = tile_e[u.pm]; const int row0 = u.pm * 256 + wr * 64 + fr; const int j0 = u.pn * 128 + wc * 32 + 8 * fq;
        float bg[8], bu[8];
        { const float* bp = bgu + (size_t)e * 2048 + 2 * j0;
#pragma unroll
          for (int q = 0; q < 4; ++q) { const f32x4 t = *(const f32x4*)(bp + 4 * q); bg[2 * q] = t[0]; bu[2 * q] = t[1]; bg[2 * q + 1] = t[2]; bu[2 * q + 1] = t[3]; } }
#pragma unroll
        EPI_ROWS(ai, m) { float v[8];
#pragma unroll
            for (int j = 0; j < 8; ++j) { const float gt = acc[ai][0][m][j >> 2][j & 3] + bg[j], up = acc[ai][1][m][j >> 2][j & 3] + bu[j];
                const float g = fminf(gt, 7.0f), uu = fminf(fmaxf(up, -7.0f), 7.0f); v[j] = (uu + 1.0f) * (g * sigmoidf_(1.702f * g)); }
            u32x2 w8; w8.x = (unsigned)pk4_fp8(v[0], v[1], v[2], v[3]); w8.y = (unsigned)pk4_fp8(v[4], v[5], v[6], v[7]);
            *(u32x2*)(act + (size_t)(row0 + ai * 128 + m * 16) * 1024 + j0) = w8; }
    }
};

struct EpiDown {
    static constexpr bool PERM = true, FP8 = true;
    const float* bd; const int* tile_e; unsigned char* y;
    __device__ __forceinline__ void operator()(const f32x4 (&acc)[2][2][4][2], const Unit& u, int wr, int wc, int fr, int fq) const {
        const int e = tile_e[u.pm]; const int lane = fq * 16 + fr; char* slot = epi_slot(wr, wc); const int col0 = u.pn * 256 + wc * 64 + 8 * fq;
        f32x4 b[2][2];
#pragma unroll
        for (int bj = 0; bj < 2; ++bj)
#pragma unroll
            for (int n = 0; n < 2; ++n) b[bj][n] = *(const f32x4*)(bd + (size_t)e * 1024 + col0 + bj * 32 + 4 * n);
        unsigned char* base = y + (size_t)(u.pm * 256 + wr * 64 + (lane >> 2)) * 1024 + u.pn * 256 + wc * 64 + (lane & 3) * 16;
#pragma unroll
        EPI_ROWS(ai, m) { u32x2 w[2];
#pragma unroll
            for (int bj = 0; bj < 2; ++bj) { const f32x4 v0 = acc[ai][bj][m][0] + b[bj][0], v1 = acc[ai][bj][m][1] + b[bj][1];
                w[bj].x = (unsigned)pk4_fp8(v0[0], v0[1], v0[2], v0[3]); w[bj].y = (unsigned)pk4_fp8(v1[0], v1[1], v1[2], v1[3]); }
            *(u32x2*)(slot + fr * 64 + 8 * fq) = w[0]; *(u32x2*)(slot + fr * 64 + 32 + 8 * fq) = w[1];
            const u32x4 o = *(const u32x4*)(slot + (lane >> 2) * 64 + (lane & 3) * 16);
            *(u32x4*)(base + (size_t)(ai * 128 + m * 16) * 1024) = o; }
    }
};

__device__ __forceinline__ int win_colmap(int n) {
    if (n < 3072) return n;
    if (n < 7680) { const int off = n - 3072, which = off / 1536, hcol = off % 1536, head = hcol >> 6, p = hcol & 63;
        int dim = p; if (which < 2 && p < 16) dim = (p & 1) ? (p >> 1) + 8 : (p >> 1);
        return 3088 + which * 1536 + head * 64 + dim; }
    if (n < 9728) return 7696 + (n - 7680);
    if (n < 9744) return 3072 + (n - 9728);
    return -1;
}
__device__ __forceinline__ int gu_colmap(int n) { const int t = n >> 8, w = n & 255, wc = w >> 6, bj = (w >> 5) & 1, rho = w & 31; return 2 * (128 * t + 32 * wc + rho) + bj; }

__device__ __forceinline__ void transpose_tile(const float* src, int ld_src, bf16_t* dst, int K, int n0, int k0, int scol, char* lds) {
    const int t = tid_(), nl = t & 127, kq = t >> 7;
#pragma unroll
    for (int cc = 0; cc < 4; ++cc) { const int c = kq * 4 + cc; float v[8];
#pragma unroll
        for (int j = 0; j < 8; ++j) v[j] = scol >= 0 ? src[(size_t)(k0 + c * 8 + j) * ld_src + scol] : 0.f;
        *(u32x4*)(lds + nl * 256 + ((c ^ (nl & 15)) << 4)) = pack8(v); }
    __syncthreads();
#pragma unroll
    for (int pass = 0; pass < 4; ++pass) { const int idx = t + 512 * pass, n2 = idx >> 4, c2 = idx & 15;
        *(u32x4*)(dst + (size_t)(n0 + n2) * K + k0 + c2 * 8) = *(const u32x4*)(lds + n2 * 256 + ((c2 ^ (n2 & 15)) << 4)); }
    __syncthreads();
}

__device__ __forceinline__ void transpose_tile8(const float* src, int ld_src, unsigned char* dst, int K, int n0, int k0, int scol, float scale, char* lds) {
    const int t = tid_(), nl = t & 127, kq = t >> 7;
#pragma unroll
    for (int cc = 0; cc < 4; ++cc) { const int c = kq * 4 + cc; float v[16];
#pragma unroll
        for (int j = 0; j < 16; ++j) v[j] = scol >= 0 ? src[(size_t)(k0 + c * 16 + j) * ld_src + scol] * scale : 0.f;
        u32x4 w; w.x = (unsigned)pk4_fp8(v[0], v[1], v[2], v[3]); w.y = (unsigned)pk4_fp8(v[4], v[5], v[6], v[7]); w.z = (unsigned)pk4_fp8(v[8], v[9], v[10], v[11]); w.w = (unsigned)pk4_fp8(v[12], v[13], v[14], v[15]);
        *(u32x4*)(lds + nl * 256 + ((c ^ (nl & 15)) << 4)) = w; }
    __syncthreads();
#pragma unroll
    for (int pass = 0; pass < 4; ++pass) { const int idx = t + 512 * pass, n2 = idx >> 4, c2 = idx & 15;
        *(u32x4*)(dst + (size_t)(n0 + n2) * K + k0 + c2 * 16) = *(const u32x4*)(lds + n2 * 256 + ((c2 ^ (n2 & 15)) << 4)); }
    __syncthreads();
}

template <int MAP> __device__ __forceinline__ int tile_rowmap(int o) {
    if (MAP == 1) { const int d = o & 63; const int pp = d < 16 ? (d < 8 ? 2 * d : 2 * (d - 8) + 1) : d; return (o & 64) + pp; }
    if (MAP == 2) { const int wcl = o >> 6, w = o & 63; return 64 * wcl + 32 * (w & 1) + (w >> 1); }
    return o;
}
template <int MAP, bool F8> __device__ __forceinline__ void transpose_fast(const float* src  , int ld_src, unsigned char* dst, int Kb  , int n0, int k0, float scale, char* lds) {
    constexpr int KPT = F8 ? 16 : 8;
    const int t = tid_(), ng = t & 31, kg = t >> 5;
    f32x4 v[KPT];
#pragma unroll
    for (int j = 0; j < KPT; ++j) v[j] = *(const f32x4*)(src + (size_t)(k0 + kg * KPT + j) * ld_src + 4 * ng);
#pragma unroll
    for (int i = 0; i < 4; ++i) { const int row = tile_rowmap<MAP>(4 * ng + i); u32x4 w;
        if (F8) { w.x = (unsigned)pk4_fp8(v[0][i] * scale, v[1][i] * scale, v[2][i] * scale, v[3][i] * scale); w.y = (unsigned)pk4_fp8(v[4][i] * scale, v[5][i] * scale, v[6][i] * scale, v[7][i] * scale);
                  w.z = (unsigned)pk4_fp8(v[8 % KPT][i] * scale, v[9 % KPT][i] * scale, v[10 % KPT][i] * scale, v[11 % KPT][i] * scale); w.w = (unsigned)pk4_fp8(v[12 % KPT][i] * scale, v[13 % KPT][i] * scale, v[14 % KPT][i] * scale, v[15 % KPT][i] * scale); }
        else { w.x = cvt_pk_bf16(v[0][i], v[1][i]); w.y = cvt_pk_bf16(v[2][i], v[3][i]); w.z = cvt_pk_bf16(v[4][i], v[5][i]); w.w = cvt_pk_bf16(v[6][i], v[7][i]); }
        *(u32x4*)(lds + row * 256 + ((kg ^ (row & 15)) << 4)) = w; }
    __syncthreads();
#pragma unroll
    for (int pass = 0; pass < 4; ++pass) { const int idx = t + 512 * pass, n2 = idx >> 4, c2 = idx & 15;
        *(u32x4*)(dst + (size_t)(n0 + n2) * Kb + (size_t)k0 * (F8 ? 1 : 2) + c2 * 16) = *(const u32x4*)(lds + n2 * 256 + ((c2 ^ (n2 & 15)) << 4)); }
    __syncthreads();
}

constexpr int N_EXPERT_TILES_P0 = 0;
__device__ __forceinline__ void expert_convert(const Params& p, char* lds, int first, int stride, int lo, int hi);
__device__ __forceinline__ void phase_prologue(const Params& p, char* lds) {
    unsigned char* ws = opaque(p.ws);
    const int tid = tid_(), lane = tid & 63, wid = tid >> 6, G = gridDim.x, bid = blockIdx.x;
    { bf16_t* xn = (bf16_t*)(ws + WS_XN); unsigned char* xn8 = ws + WS_XN8;
      for (int row = bid * 8 + wid; row < NTOK; row += G * 8) { const float* xr = p.x + (size_t)row * 1024; f32x4 v[4]; float ss = 0.f;
#pragma unroll
          for (int i = 0; i < 4; ++i) { v[i] = *(const f32x4*)(xr + i * 256 + lane * 4); ss += v[i][0] * v[i][0] + v[i][1] * v[i][1] + v[i][2] * v[i][2] + v[i][3] * v[i][3]; }
          ss = wave_sum(ss); const float rs = rsqrtf(ss * (1.0f / 1024.0f) + EPS);
#pragma unroll
          for (int i = 0; i < 4; ++i) { const f32x4 g = *(const f32x4*)(p.norm_mix_g + i * 256 + lane * 4); const float y0 = v[i][0] * rs * g[0], y1 = v[i][1] * rs * g[1], y2 = v[i][2] * rs * g[2], y3 = v[i][3] * rs * g[3];
              u32x2 w; w.x = cvt_pk_bf16(y0, y1); w.y = cvt_pk_bf16(y2, y3);
              *(u32x2*)(xn + (size_t)row * 1024 + i * 256 + lane * 4) = w; *(unsigned*)(xn8 + (size_t)row * 1024 + i * 256 + lane * 4) = (unsigned)pk4_fp8(y0, y1, y2, y3); } } }
    { float* rwg = (float*)(ws + WS_RWG);
      for (int i = bid * 512 + tid; i < 1024 * 32; i += G * 512) rwg[i] = p.router_w[i] * p.norm_ffn_g[i >> 5]; }
    { constexpr int T0 = 78 * 8, T1 = T0 + 64, T2 = T1 + 32, T3 = T2 + 64, T4 = T3 + 32 * 64, T5 = T4 + 32 * 32;
      const int nl = tid & 127;
      for (int tile = bid; tile < T3; tile += G) {
          if (tile < T0) { const int nt_ = tile >> 3, kt = tile & 7; const int t256 = nt_ >> 1; const bool sens = ((SENSMASK >> t256) & 1ull) != 0ull;
              bf16_t* d = (bf16_t*)(ws + WS_W_IN); unsigned char* d16 = ws + WS_W_IN; unsigned char* d8 = ws + WS_WIN8;
              const float* srcg = nt_ < 24 ? p.w_in + nt_ * 128 : (nt_ < 60 ? p.w_in + 3088 + (nt_ - 24) * 128 : p.w_in + 7696 + (nt_ - 60) * 128); const bool rotmap = nt_ >= 24 && nt_ < 48;
              if (sens) {
                  if (nt_ >= 76) transpose_tile(p.w_in, INW, d, 1024, nt_ * 128, kt * 128, win_colmap(nt_ * 128 + nl), lds);
                  else if (rotmap) transpose_fast<1, false>(srcg, INW, d16, 2048, nt_ * 128, kt * 128, 1.f, lds);
                  else transpose_fast<0, false>(srcg, INW, d16, 2048, nt_ * 128, kt * 128, 1.f, lds);
              } else if (kt < 4) {
                  if (nt_ >= 76) transpose_tile8(p.w_in, INW, d8, 1024, nt_ * 128, kt * 256, win_colmap(nt_ * 128 + nl), 32.f, lds);
                  else if (rotmap) transpose_fast<1, true>(srcg, INW, d8, 1024, nt_ * 128, kt * 256, 32.f, lds);
                  else transpose_fast<0, true>(srcg, INW, d8, 1024, nt_ * 128, kt * 256, 32.f, lds);
              } }
          else if (tile < T1) { const int q = tile - T0, nt_ = q >> 3, kt = q & 7; transpose_fast<0, false>(p.w_branch_gla + nt_ * 128, 1024, ws + WS_W_G, 2048, nt_ * 128, kt * 128, 1.f, lds); }
          else if (tile < T2) { const int q = tile - T1, nt_ = q >> 2, kt = q & 3; transpose_fast<0, false>(p.w_branch_att + nt_ * 128, 1024, ws + WS_W_A, 1024, nt_ * 128, kt * 128, 1.f, lds); }
          else if (tile < T3) { const int q = tile - T2, nt_ = q >> 3, kt = q & 7; transpose_fast<0, false>(p.w_mix_out + nt_ * 128, 1024, ws + WS_W_MIX, 2048, nt_ * 128, kt * 128, 1.f, lds); }
      } }
    expert_convert(p, lds, bid, G, 0, N_EXPERT_TILES_P0);
}

constexpr int N_EXPERT_TILES = 32 * 64 + 32 * 32;
__device__ __forceinline__ void expert_convert(const Params& p, char* lds, int first, int stride, int lo, int hi) {
    unsigned char* ws = opaque(p.ws);
    for (int q0 = lo + first; q0 < hi; q0 += stride) {
        if (q0 < 32 * 64) { const int q = q0, e = q >> 6, r = q & 63, nt_ = r >> 2, kt = r & 3;
            transpose_fast<2, true>(p.e_w_gu + (size_t)e * 1024 * 2048 + nt_ * 128, 2048, ws + WS_W_GU + (size_t)e * 2048 * 1024, 1024, nt_ * 128, kt * 256, 32.0f, lds); }
        else { const int q = q0 - 32 * 64, e = q >> 5, r = q & 31, nt_ = r >> 2, kt = r & 3;
            transpose_fast<0, true>(p.e_w_d + (size_t)e * 1024 * 1024 + nt_ * 128, 1024, ws + WS_W_D + (size_t)e * 1024 * 1024, 1024, nt_ * 128, kt * 256, 32.0f, lds); }
    }
}

constexpr int AT_KCS = 385 * 16;
constexpr int AT_VH = 385 * 64;
constexpr int AT_K = 0, AT_V = 8 * AT_KCS, AT_WL = AT_V + 2 * AT_VH, AT_STG = AT_WL + 8 * 128, AT_END = AT_STG + 8 * 4096;
static_assert(AT_END <= LDS_BYTES, "attention LDS");
struct AttnPre { u32x4 k[3], v[3]; u32x2 q[4]; };
__device__ __forceinline__ void attn_fetch(const Params& p, int item, AttnPre& r) {
    unsigned char* ws = opaque(p.ws); const int tid = tid_();
    const int jj = item & 15, bh = item >> 4, head = bh % 24, g = head >> 3, sh = 2 * g, NL = SEQ >> sh, ppr = 16 >> sh; const int rr_ = jj / ppr, j = jj % ppr;
    const size_t hb = ((size_t)bh * SEQ + (size_t)rr_ * NL) * 64; const unsigned char* Kg = ws + WS_AK + hb; const unsigned char* Vg = ws + WS_AV + hb; const int kn0 = 256 * j - 128;
    { const int lane = tid & 63, r32 = lane & 31, hi = lane >> 5, w = tid >> 6; const unsigned char* Q = ws + WS_AQ + hb;
#pragma unroll
      for (int d0 = 0; d0 < 4; ++d0) r.q[d0] = *(const u32x2*)(Q + (size_t)(256 * j + 32 * w + r32) * 64 + d0 * 16 + hi * 8); }
#pragma unroll
    for (int i = 0; i < 3; ++i) { const int idx = tid + 512 * i, key = idx >> 2, c = idx & 3;
        if (kn0 + key >= 0) { r.k[i] = *(const u32x4*)(Kg + (ptrdiff_t)(kn0 + key) * 64 + c * 16); r.v[i] = *(const u32x4*)(Vg + (ptrdiff_t)(kn0 + key) * 64 + c * 16); } }
}
__device__ __forceinline__ u32x4 fp8x8_to_bf16(unsigned lo, unsigned hi_, float sc) {
    const f32x2 a = __builtin_amdgcn_cvt_pk_f32_fp8((int)lo, false), b = __builtin_amdgcn_cvt_pk_f32_fp8((int)lo, true), c = __builtin_amdgcn_cvt_pk_f32_fp8((int)hi_, false), d = __builtin_amdgcn_cvt_pk_f32_fp8((int)hi_, true);
    u32x4 w; w.x = cvt_pk_bf16(a[0] * sc, a[1] * sc); w.y = cvt_pk_bf16(b[0] * sc, b[1] * sc); w.z = cvt_pk_bf16(c[0] * sc, c[1] * sc); w.w = cvt_pk_bf16(d[0] * sc, d[1] * sc); return w; }
__device__ __forceinline__ void attn_item(const Params& p, int item, int nitem, bool has_next, AttnPre& pre, char* lds) {
    unsigned char* ws = opaque(p.ws);
    const int tid = tid_(), lane = tid & 63, r32 = lane & 31, hi = lane >> 5; const int w = __builtin_amdgcn_readfirstlane(tid >> 6);
    const int jj = item & 15, bh = item >> 4, head = bh % 24, b = bh / 24, g = head >> 3, sh = 2 * g, d = 1 << sh, NL = SEQ >> sh, ppr = 16 >> sh;
    const int r = jj / ppr, j = jj % ppr;
    const size_t hb = ((size_t)bh * SEQ + (size_t)r * NL) * 64;
    const bf16_t* Q = (const bf16_t*)(ws + WS_AQ) + hb;
    const int kn0 = 256 * j - 128;
    bf16x8 qf[4];
#pragma unroll
    for (int d0 = 0; d0 < 4; ++d0) qf[d0] = __builtin_bit_cast(bf16x8, fp8x8_to_bf16(pre.q[d0].x, pre.q[d0].y, QSCALE));
#pragma unroll
    for (int i = 0; i < 3; ++i) { const int idx = tid + 512 * i, key = idx >> 2, c4 = idx & 3;
        if (kn0 + key >= 0) {
#pragma unroll
            for (int hh = 0; hh < 2; ++hh) { const int c = 2 * c4 + hh;
                *(u32x4*)(lds + AT_K + c * AT_KCS + key * 16) = fp8x8_to_bf16(hh ? pre.k[i].z : pre.k[i].x, hh ? pre.k[i].w : pre.k[i].y, 1.0f);
                *(u32x4*)(lds + AT_V + (c >> 2) * AT_VH + key * 64 + (c & 3) * 16) = fp8x8_to_bf16(hh ? pre.v[i].z : pre.v[i].x, hh ? pre.v[i].w : pre.v[i].y, 1.0f); } } }
    __syncthreads();
    if (has_next) attn_fetch(p, nitem, pre);
    const LDS3 char* l3 = (const LDS3 char*)lds;
    f32x16 s[5]; const int ktmin = (j == 0) ? 4 : 0;
#pragma unroll
    for (int t5 = 0; t5 < 5; ++t5) { const int kt = w + t5;
        if (kt >= ktmin) { f32x16 a = {};
#pragma unroll
            for (int d0 = 0; d0 < 4; ++d0) { const bf16x8 kf = *(const LDS3 bf16x8*)(l3 + AT_K + (2 * d0 + hi) * AT_KCS + (kt * 32 + r32) * 16); a = MFMA32(kf, qf[d0], a); }
            s[t5] = a; }
        else {
#pragma unroll
            for (int rr = 0; rr < 16; ++rr) s[t5][rr] = -1e30f; } }
#pragma unroll
    for (int rr = 0; rr < 16; ++rr) { const int c = crow(rr, hi); if (c < r32) s[0][rr] = -1e30f; if (c > r32) s[4][rr] = -1e30f; }
    float mx = -1e30f;
#pragma unroll
    for (int t5 = 0; t5 < 5; ++t5)
#pragma unroll
        for (int rr = 0; rr < 16; ++rr) mx = fmaxf(mx, s[t5][rr]);
    mx = fmaxf(mx, __shfl_xor(mx, 32));
    float l = 0.f;
#pragma unroll
    for (int t5 = 0; t5 < 5; ++t5)
#pragma unroll
        for (int rr = 0; rr < 16; ++rr) { const float e = __builtin_amdgcn_exp2f(s[t5][rr] - mx); s[t5][rr] = e; l += e; }
    l += __shfl_xor(l, 32);
    f32x16 o[2]; o[0] = f32x16{}; o[1] = f32x16{};
    const int blk = (lane >> 4) & 1, q4 = (lane & 15) >> 2, p4 = lane & 3;
#pragma unroll
    for (int t5 = 0; t5 < 5; ++t5) { const int kt = w + t5;
        if (kt >= ktmin) {
#pragma unroll
            for (int ss = 0; ss < 2; ++ss) { float pv[8];
#pragma unroll
                for (int q = 0; q < 8; ++q) pv[q] = s[t5][8 * ss + q];
                const bf16x8 pa = __builtin_bit_cast(bf16x8, pack8(pv));
#pragma unroll
                for (int dh = 0; dh < 2; ++dh) { const LDS3 char* vp = l3 + AT_V + dh * AT_VH + (kt * 32 + 16 * ss + 4 * hi + q4) * 64 + (16 * blk + 4 * p4) * 2;
                    const bf16x8 vf = cat8(tr16(vp), tr16(vp + 8 * 64)); o[dh] = MFMA32(pa, vf, o[dh]); } } } }
    const int n_q = 256 * j + 32 * w + r32; const int tok = b * SEQ + n_q * d + r;
    if (hi == 0) { ((float*)(ws + WS_LSE))[((size_t)g * NTOK + tok) * 8 + (head & 7)] = (mx + __builtin_amdgcn_logf(l)) * LN2;
        ((float*)(lds + AT_WL))[w * 32 + r32] = __builtin_amdgcn_rcpf(l); }
    bf16_t* stg = (bf16_t*)(lds + AT_STG) + w * 2048;
#pragma unroll
    for (int rr = 0; rr < 16; ++rr) { const int qr = crow(rr, hi); const float rl = ((const float*)(lds + AT_WL))[w * 32 + qr];
#pragma unroll
        for (int dh = 0; dh < 2; ++dh) stg[qr * 64 + dh * 32 + r32] = (bf16_t)(cvt_pk_bf16(o[dh][rr] * rl, 0.f) & 0xffffu); }
    bf16_t* og = (bf16_t*)(ws + WS_OATT) + (size_t)g * NTOK * 512;
#pragma unroll
    for (int i = 0; i < 4; ++i) { const int idx = i * 64 + lane, row = idx >> 3, ch = idx & 7; const int tk = b * SEQ + (256 * j + 32 * w + row) * d + r;
        *(u32x4*)(og + (size_t)tk * 512 + (head & 7) * 64 + ch * 8) = *(const u32x4*)(stg + row * 64 + ch * 8); }
    __syncthreads();
}

constexpr int G1_BB = 0;
constexpr int G1_QE = G1_BB + 64 * 128 * 4;
constexpr int G1_KE = G1_QE + 64 * 272;
constexpr int G1_KD = G1_KE + 64 * 272;
constexpr int G1_V = G1_KD + 64 * 320;
constexpr int G1_GLR = G1_V + 64 * 576;
constexpr int G1_GUP = G1_GLR + 64 * 16 * 4;
constexpr int G1_SEG = G1_GUP + 16 * 128 * 4;
constexpr int G1_BIAS = G1_SEG + 4 * 128 * 4;
constexpr int G1_END = G1_BIAS + 128 * 4;
constexpr int G1_SU = 0;
constexpr int G1_SO = 128 * 528;
static_assert(G1_SO + 64 * 528 <= G1_GLR, "gla1 staging");
static_assert(G1_END <= LDS_BYTES, "gla1 LDS");
__device__ __forceinline__ float logsigmoidf_(float z) { return fminf(z, 0.f) - log1pf(__expf(-fabsf(z))); }
struct G1Pre { u32x4 q[2], k[2], v[4]; float glr[2]; };
__device__ __forceinline__ void gla1_fetch(const Params& p, int item, G1Pre& r) {
    unsigned char* ws = opaque(p.ws); const int tid = tid_();
    const int n = item & 63, bh = item >> 6, h = bh & 3, b = bh >> 2; const int tok0 = b * SEQ + n * 64;
    const bf16_t* gq = (const bf16_t*)(ws + WS_GQ); const bf16_t* gk = (const bf16_t*)(ws + WS_GK); const bf16_t* gv = (const bf16_t*)(ws + WS_GV);
#pragma unroll
    for (int pp = 0; pp < 2; ++pp) { const int idx = tid + 512 * pp, i = idx >> 4, c = idx & 15; const size_t go = (size_t)(tok0 + i) * 512 + h * 128 + c * 8; r.q[pp] = *(const u32x4*)(gq + go); r.k[pp] = *(const u32x4*)(gk + go);
        r.glr[pp] = ((const float*)(ws + WS_GLR))[(size_t)tok0 * 16 + idx]; }
#pragma unroll
    for (int pp = 0; pp < 4; ++pp) { const int idx = tid + 512 * pp, jv = idx >> 5, c = idx & 31; r.v[pp] = *(const u32x4*)(gv + (size_t)(tok0 + jv) * 1024 + h * 256 + c * 8); }
}
__device__ __forceinline__ void gla1_head_operands(const Params& p, int h, char* lds) {
    const int tid = tid_(); float* GUP = (float*)(lds + G1_GUP); float* BIAS = (float*)(lds + G1_BIAS);
    for (int i = tid; i < 16 * 128; i += 512) GUP[i] = p.gla_gate_up[(i >> 7) * 512 + h * 128 + (i & 127)];
    if (tid < 128) BIAS[tid] = p.gla_gate_bias[h * 128 + tid];
}
__device__ __forceinline__ void gla1_item(const Params& p, int item, int nitem, bool has_next, bool reload_head, G1Pre& pre, char* lds) {
    unsigned char* ws = opaque(p.ws);
    const int tid = tid_(), lane = tid & 63, r32 = lane & 31, hi = lane >> 5; const int w = __builtin_amdgcn_readfirstlane(tid >> 6);
    const int n = item & 63, bh = item >> 6, h = bh & 3, b = bh >> 2; const int tok0 = b * SEQ + n * 64;
    float* BB = (float*)(lds + G1_BB); float* GLRs = (float*)(lds + G1_GLR); float* GUP = (float*)(lds + G1_GUP); float* SEGs = (float*)(lds + G1_SEG); float* BIAS = (float*)(lds + G1_BIAS);
    u32x4 qraw[2], kraw[2], vraw[4];
#pragma unroll
    for (int pp = 0; pp < 2; ++pp) { qraw[pp] = pre.q[pp]; kraw[pp] = pre.k[pp]; GLRs[tid + 512 * pp] = pre.glr[pp]; }
#pragma unroll
    for (int pp = 0; pp < 4; ++pp) vraw[pp] = pre.v[pp];
    if (reload_head) gla1_head_operands(p, h, lds);
    __syncthreads();
    if (has_next) gla1_fetch(p, nitem, pre);
    { const int d = tid & 127, seg = tid >> 7; float gu[16];
#pragma unroll
      for (int r = 0; r < 16; ++r) gu[r] = GUP[r * 128 + d];
      const float bias = BIAS[d]; float run = 0.f;
#pragma unroll 4
      for (int ii = 0; ii < 16; ++ii) { const int i = seg * 16 + ii; float z = bias;
#pragma unroll
          for (int r4 = 0; r4 < 4; ++r4) { const f32x4 gl = *(const f32x4*)(GLRs + i * 16 + r4 * 4); z += gl[0] * gu[r4 * 4] + gl[1] * gu[r4 * 4 + 1] + gl[2] * gu[r4 * 4 + 2] + gl[3] * gu[r4 * 4 + 3]; }
          run += logsigmoidf_(z) * (1.0f / 16.0f); BB[i * 128 + d] = run; }
      SEGs[seg * 128 + d] = run;
      __syncthreads();
      float off = 0.f; for (int s2 = 0; s2 < seg; ++s2) off += SEGs[s2 * 128 + d];
      if (seg > 0) { for (int ii = 0; ii < 16; ++ii) BB[(seg * 16 + ii) * 128 + d] += off; }
      __syncthreads(); }
    { const bf16_t* gq = (const bf16_t*)(ws + WS_GQ); const bf16_t* gk = (const bf16_t*)(ws + WS_GK); const bf16_t* gv = (const bf16_t*)(ws + WS_GV); bf16_t* qeg = (bf16_t*)(ws + WS_QE);
#pragma unroll
      for (int pp = 0; pp < 2; ++pp) { const int idx = tid + 512 * pp, i = idx >> 4, c = idx & 15, d0 = c * 8; const size_t go = (size_t)(tok0 + i) * 512 + h * 128 + d0;
          float q[8], k[8], qe[8], ke[8], kd[8]; unpack8(qraw[pp], q); unpack8(kraw[pp], k);
#pragma unroll
          for (int j = 0; j < 8; ++j) { const float bb = BB[i * 128 + d0 + j], bl = BB[63 * 128 + d0 + j]; qe[j] = q[j] * __expf(bb) * 0.08838834764831845f; ke[j] = k[j] * __expf(-bb); kd[j] = k[j] * __expf(bl - bb); }
          const u32x4 qw = pack8(qe); *(u32x4*)(lds + G1_QE + i * 272 + c * 16) = qw; *(u32x4*)(qeg + go) = qw;
          *(u32x4*)(lds + G1_KE + i * 272 + c * 16) = pack8(ke); *(u32x4*)(lds + G1_KD + i * 320 + c * 16) = pack8(kd); }
#pragma unroll
      for (int pp = 0; pp < 4; ++pp) { const int idx = tid + 512 * pp, jv = idx >> 5, c = idx & 31; *(u32x4*)(lds + G1_V + jv * 576 + c * 16) = vraw[pp]; }
      if (tid < 128) ((float*)(ws + WS_DEC))[(size_t)item * 128 + tid] = __expf(BB[63 * 128 + tid]);
      __syncthreads(); }
    const LDS3 char* l3 = (const LDS3 char*)lds; const int blk = (lane >> 4) & 1, q4 = (lane & 15) >> 2, p4 = lane & 3;
    {
      const int it = w & 1, vq = w >> 1; f32x16 oi[2]; oi[0] = f32x16{}; oi[1] = f32x16{};
#pragma unroll
      for (int jt = 0; jt < 2; ++jt) { if (jt <= it) { f32x16 x = {};
#pragma unroll
          for (int s = 0; s < 8; ++s) { const bf16x8 a = *(const LDS3 bf16x8*)(l3 + G1_KE + (jt * 32 + r32) * 272 + (16 * s + 8 * hi) * 2), bq = *(const LDS3 bf16x8*)(l3 + G1_QE + (it * 32 + r32) * 272 + (16 * s + 8 * hi) * 2); x = MFMA32(a, bq, x); }
          if (jt == it) {
#pragma unroll
              for (int rr = 0; rr < 16; ++rr) if (crow(rr, hi) > r32) x[rr] = 0.f; }
#pragma unroll
          for (int ss = 0; ss < 2; ++ss) { float xv[8];
#pragma unroll
              for (int q = 0; q < 8; ++q) xv[q] = x[8 * ss + q];
              const bf16x8 xa = __builtin_bit_cast(bf16x8, pack8(xv));
#pragma unroll
              for (int vi = 0; vi < 2; ++vi) { const int vt = 2 * vq + vi; const LDS3 char* vp = l3 + G1_V + (jt * 32 + 16 * ss + 4 * hi + q4) * 576 + (vt * 32 + 16 * blk + 4 * p4) * 2;
                  const bf16x8 vf = cat8(tr16(vp), tr16(vp + 8 * 576)); oi[vi] = MFMA32(xa, vf, oi[vi]); } } } }
      const int dt = w & 3, vg = w >> 2; f32x16 uu[4]; uu[0] = f32x16{}; uu[1] = f32x16{}; uu[2] = f32x16{}; uu[3] = f32x16{};
#pragma unroll
      for (int ks = 0; ks < 4; ++ks) { const LDS3 char* ap = l3 + G1_KD + (16 * ks + 8 * hi + q4) * 320 + (dt * 32 + 16 * blk + 4 * p4) * 2; const bf16x8 a = cat8(tr16(ap), tr16(ap + 4 * 320));
#pragma unroll
          for (int vi = 0; vi < 4; ++vi) { const int vt = 4 * vg + vi; const LDS3 char* vp = l3 + G1_V + (16 * ks + 8 * hi + q4) * 576 + (vt * 32 + 16 * blk + 4 * p4) * 2; const bf16x8 vf = cat8(tr16(vp), tr16(vp + 4 * 576)); uu[vi] = MFMA32(a, vf, uu[vi]); } }
      __syncthreads();
      bf16_t* SU = (bf16_t*)(lds + G1_SU); bf16_t* SO = (bf16_t*)(lds + G1_SO);
#pragma unroll
      for (int vi = 0; vi < 4; ++vi)
#pragma unroll
          for (int rr = 0; rr < 16; ++rr) SU[(dt * 32 + crow(rr, hi)) * 264 + (4 * vg + vi) * 32 + r32] = (bf16_t)(cvt_pk_bf16(uu[vi][rr], 0.f) & 0xffffu);
#pragma unroll
      for (int vi = 0; vi < 2; ++vi)
#pragma unroll
          for (int rr = 0; rr < 16; ++rr) SO[(it * 32 + crow(rr, hi)) * 264 + (2 * vq + vi) * 32 + r32] = (bf16_t)(cvt_pk_bf16(oi[vi][rr], 0.f) & 0xffffu);
      __syncthreads();
      bf16_t* ug = (bf16_t*)(ws + WS_U) + (size_t)item * 128 * 256; bf16_t* og = (bf16_t*)(ws + WS_OINTRA);
#pragma unroll
      for (int pp = 0; pp < 8; ++pp) { const int idx = tid + 512 * pp, row = idx >> 5, c = idx & 31; *(u32x4*)(ug + (size_t)row * 256 + c * 8) = *(const u32x4*)(SU + row * 264 + c * 8); }
#pragma unroll
      for (int pp = 0; pp < 4; ++pp) { const int idx = tid + 512 * pp, row = idx >> 5, c = idx & 31; *(u32x4*)(og + (size_t)(tok0 + row) * 1024 + h * 256 + c * 8) = *(const u32x4*)(SO + row * 264 + c * 8); } }
    __syncthreads();
}

__device__ __forceinline__ void phase_scan_combine(const Params& p) {
    unsigned char* ws = opaque(p.ws); const int G = gridDim.x;
    { const bf16_t* U = (const bf16_t*)(ws + WS_U); bf16_t* PV = (bf16_t*)(ws + WS_PREV); const float* DEC = (const float*)(ws + WS_DEC);
      for (int idx = blockIdx.x * 512 + tid_(); idx < 16 * 128 * 64; idx += G * 512) { const int bh = idx >> 13, rem = idx & 8191, d = rem >> 6, vq = rem & 63;
          float st[4] = {0.f, 0.f, 0.f, 0.f}; const size_t e0 = ((size_t)bh * 64 * 128 + d) * 256 + vq * 4;
#pragma unroll 8
          for (int n = 0; n < 64; ++n) { const size_t e = e0 + (size_t)n * 128 * 256; const u32x2 uw = *(const u32x2*)(U + e); const float dc = DEC[(size_t)(bh * 64 + n) * 128 + d];
              u32x2 pw; pw.x = cvt_pk_bf16(st[0], st[1]); pw.y = cvt_pk_bf16(st[2], st[3]); *(u32x2*)(PV + e) = pw;
              st[0] = dc * st[0] + bf_lo(uw.x); st[1] = dc * st[1] + bf_hi(uw.x); st[2] = dc * st[2] + bf_lo(uw.y); st[3] = dc * st[3] + bf_hi(uw.y); } } }
    { const bf16_t* OG = (const bf16_t*)(ws + WS_OATT); const float* LSE = (const float*)(ws + WS_LSE); bf16_t* YA = (bf16_t*)(ws + WS_YATT);
#pragma unroll 2
      for (int idx = blockIdx.x * 512 + tid_(); idx < NTOK * 64; idx += G * 512) { const int tok = idx >> 6, jc = idx & 63, jh = jc >> 3;
          const float l0 = LSE[(size_t)tok * 8 + jh], l1 = LSE[((size_t)NTOK + tok) * 8 + jh], l2 = LSE[((size_t)2 * NTOK + tok) * 8 + jh];
          const float m = fmaxf(l0, fmaxf(l1, l2)); float a0 = __expf(l0 - m), a1 = __expf(l1 - m), a2 = __expf(l2 - m); const float inv = __builtin_amdgcn_rcpf(a0 + a1 + a2); a0 *= inv; a1 *= inv; a2 *= inv;
          float o0[8], o1[8], o2[8], y[8]; const size_t off = (size_t)tok * 512 + jc * 8;
          unpack8(*(const u32x4*)(OG + off), o0); unpack8(*(const u32x4*)(OG + (size_t)NTOK * 512 + off), o1); unpack8(*(const u32x4*)(OG + (size_t)2 * NTOK * 512 + off), o2);
#pragma unroll
          for (int q = 0; q < 8; ++q) y[q] = a0 * o0[q] + a1 * o1[q] + a2 * o2[q];
          *(u32x4*)(YA + off) = pack8(y); } }
}

constexpr int G3_PREV = 0;
constexpr int G3_SS = G3_PREV + 128 * 576;
constexpr int G3_OI = G3_SS + 8 * 32 * 4;
constexpr int G3_GR = G3_OI + 64 * 528;
constexpr int G3_END = G3_GR + 64 * 528;
static_assert(G3_END <= LDS_XB, "gla3 LDS");
struct G3Pre { u32x4 pv[8], oi[4], gr[4]; };
__device__ __forceinline__ void gla3_fetch(const Params& p, int item, G3Pre& r) {
    unsigned char* ws = opaque(p.ws); const int tid = tid_();
    const int n = item & 63, bh = item >> 6, h = bh & 3, b = bh >> 2; const int tok0 = b * SEQ + n * 64;
    const bf16_t* PV = (const bf16_t*)(ws + WS_PREV) + (size_t)item * 128 * 256;
#pragma unroll
    for (int pp = 0; pp < 8; ++pp) { const int idx = tid + 512 * pp, d = idx >> 5, c = idx & 31; r.pv[pp] = *(const u32x4*)(PV + (size_t)d * 256 + c * 8); }
#pragma unroll
    for (int pp = 0; pp < 4; ++pp) { const int idx = tid + 512 * pp, row = idx >> 5, c = idx & 31; const size_t go = (size_t)(tok0 + row) * 1024 + h * 256 + c * 8;
        r.oi[pp] = *(const u32x4*)((const bf16_t*)(ws + WS_OINTRA) + go); r.gr[pp] = *(const u32x4*)((const bf16_t*)(ws + WS_GR) + go); }
}
__device__ __forceinline__ void gla3_item(const Params& p, int item, int nitem, bool has_next, G3Pre& pre, char* lds) {
    unsigned char* ws = opaque(p.ws);
    const int tid = tid_(), lane = tid & 63, r32 = lane & 31, hi = lane >> 5; const int w = __builtin_amdgcn_readfirstlane(tid >> 6);
    const int n = item & 63, bh = item >> 6, h = bh & 3, b = bh >> 2; const int tok0 = b * SEQ + n * 64;
    bf16_t* SOI = (bf16_t*)(lds + G3_OI); bf16_t* SGR = (bf16_t*)(lds + G3_GR);
#pragma unroll
    for (int pp = 0; pp < 8; ++pp) { const int idx = tid + 512 * pp, d = idx >> 5, c = idx & 31; *(u32x4*)(lds + G3_PREV + d * 576 + c * 16) = pre.pv[pp]; }
#pragma unroll
    for (int pp = 0; pp < 4; ++pp) { const int idx = tid + 512 * pp, row = idx >> 5, c = idx & 31; *(u32x4*)(SOI + row * 264 + c * 8) = pre.oi[pp]; *(u32x4*)(SGR + row * 264 + c * 8) = pre.gr[pp]; }
    const int it = w & 1, vq = w >> 1; const bf16_t* qeg = (const bf16_t*)(ws + WS_QE) + (size_t)(tok0 + it * 32 + r32) * 512 + h * 128;
    bf16x8 qa[8];
#pragma unroll
    for (int s = 0; s < 8; ++s) qa[s] = *(const bf16x8*)(qeg + 16 * s + 8 * hi);
    __syncthreads();
    if (has_next) gla3_fetch(p, nitem, pre);
    const LDS3 char* l3 = (const LDS3 char*)lds; const int blk = (lane >> 4) & 1, q4 = (lane & 15) >> 2, p4 = lane & 3;
    f32x16 o[2];
#pragma unroll
    for (int vi = 0; vi < 2; ++vi)
#pragma unroll
        for (int rr = 0; rr < 16; ++rr) o[vi][rr] = bf2f(SOI[(it * 32 + crow(rr, hi)) * 264 + (2 * vq + vi) * 32 + r32]);
#pragma unroll
    for (int s = 0; s < 8; ++s)
#pragma unroll
        for (int vi = 0; vi < 2; ++vi) { const int vt = 2 * vq + vi; const LDS3 char* pp_ = l3 + G3_PREV + (16 * s + 8 * hi + q4) * 576 + (vt * 32 + 16 * blk + 4 * p4) * 2; const bf16x8 pf = cat8(tr16(pp_), tr16(pp_ + 4 * 576)); o[vi] = MFMA32(qa[s], pf, o[vi]); }
    float* SS = (float*)(lds + G3_SS);
#pragma unroll
    for (int rr = 0; rr < 16; ++rr) { float q = o[0][rr] * o[0][rr] + o[1][rr] * o[1][rr]; q += __shfl_xor(q, 16); q += __shfl_xor(q, 8); q += __shfl_xor(q, 4); q += __shfl_xor(q, 2); q += __shfl_xor(q, 1);
        if (r32 == 0) SS[w * 32 + crow(rr, hi)] = q; }
    __syncthreads();
    float ng[2]; ng[0] = p.gla_norm_g[(2 * vq) * 32 + r32]; ng[1] = p.gla_norm_g[(2 * vq + 1) * 32 + r32];
#pragma unroll
    for (int rr = 0; rr < 16; ++rr) { const int row = crow(rr, hi); const float tot = SS[(it + 0) * 32 + row] + SS[(it + 2) * 32 + row] + SS[(it + 4) * 32 + row] + SS[(it + 6) * 32 + row];
        const float rs = rsqrtf(tot * (1.0f / 256.0f) + EPS);
#pragma unroll
        for (int vi = 0; vi < 2; ++vi) { const int li = (it * 32 + row) * 264 + (2 * vq + vi) * 32 + r32; const float y = o[vi][rr] * rs * ng[vi] * bf2f(SGR[li]); SOI[li] = (bf16_t)(cvt_pk_bf16(y, 0.f) & 0xffffu); } }
    __syncthreads();
    bf16_t* yg = (bf16_t*)(ws + WS_YGLA);
#pragma unroll
    for (int pp = 0; pp < 4; ++pp) { const int idx = tid + 512 * pp, row = idx >> 5, c = idx & 31; *(u32x4*)(yg + (size_t)(tok0 + row) * 1024 + h * 256 + c * 8) = *(const u32x4*)(SOI + row * 264 + c * 8); }
    __syncthreads();
}

constexpr int RT_RW = 0;
constexpr int RT_RSTD = 131072;
constexpr int RT_LOG = RT_RSTD + 256;
constexpr int RT_CNT = RT_LOG + 64 * 32 * 4;
constexpr int RT_SSH = RT_CNT + 128;
static_assert(RT_SSH + 512 <= 147456, "router LDS");
__device__ __forceinline__ void route_group(const Params& p, int grp, char* lds) {
    unsigned char* ws = opaque(p.ws); const int tid = tid_(), lane = tid & 63; const int w = __builtin_amdgcn_readfirstlane(tid >> 6);
    const bf16_t* H = (const bf16_t*)(ws + WS_H); const float* RWG = (const float*)(ws + WS_RWG);
    float* RSTD = (float*)(lds + RT_RSTD); float* LOGS = (float*)(lds + RT_LOG); int* LCNT = (int*)(lds + RT_CNT); float* SSH = (float*)(lds + RT_SSH);
    const int tok0 = grp * 64;
    if (tid < 32) LCNT[tid] = 0;
    { float* RW = (float*)(lds + RT_RW);
#pragma unroll
      for (int i = 0; i < 16; ++i) { const int idx = tid + 512 * i; *(f32x4*)(RW + idx * 4) = *(const f32x4*)(RWG + idx * 4); } }
    __syncthreads();
    { const int tg = w & 3, kh = w >> 2; const int tl = lane & 15, kq = lane >> 4; const bf16_t* hr = H + (size_t)(tok0 + tg * 16 + tl) * 1024 + kh * 512 + kq * 128; const float* br = (const float*)(lds + RT_RW) + (size_t)(kh * 512 + kq * 128) * 32 + tl;
        f32x4 a0 = {0.f, 0.f, 0.f, 0.f}, a1 = {0.f, 0.f, 0.f, 0.f}; float ss = 0.f;
#pragma unroll 4
        for (int m4 = 0; m4 < 32; ++m4) { const f32x4 hv = bf4_to_f32(*(const u32x2*)(hr + m4 * 4));
#pragma unroll
            for (int q = 0; q < 4; ++q) { const float b0 = br[(m4 * 4 + q) * 32], b1 = br[(m4 * 4 + q) * 32 + 16];
                a0 = __builtin_amdgcn_mfma_f32_16x16x4f32(hv[q], b0, a0, 0, 0, 0); a1 = __builtin_amdgcn_mfma_f32_16x16x4f32(hv[q], b1, a1, 0, 0, 0); ss += hv[q] * hv[q]; } }
        ss += __shfl_xor(ss, 16); ss += __shfl_xor(ss, 32);
        if (kq == 0) SSH[kh * 64 + tg * 16 + tl] = ss;
        if (kh == 1) {
#pragma unroll
            for (int rg = 0; rg < 4; ++rg) { const int t = tg * 16 + 4 * kq + rg; LOGS[t * 32 + tl] = a0[rg]; LOGS[t * 32 + 16 + tl] = a1[rg]; } }
        __syncthreads();
        if (kh == 0) {
#pragma unroll
            for (int rg = 0; rg < 4; ++rg) { const int t = tg * 16 + 4 * kq + rg; LOGS[t * 32 + tl] += a0[rg]; LOGS[t * 32 + 16 + tl] += a1[rg]; } } }
    __syncthreads();
    if (tid < 64) { const int tok = tok0 + tid; const float rs = rsqrtf((SSH[tid] + SSH[64 + tid]) * (1.0f / 1024.0f) + EPS); RSTD[tid] = rs; float lg[32];
#pragma unroll
        for (int e = 0; e < 32; ++e) lg[e] = LOGS[tid * 32 + e] * rs + p.router_b[e];
        int be[4]; float bv[4];
#pragma unroll
        for (int k = 0; k < 4; ++k) { float best = -3.0e38f; int bi = 0;
#pragma unroll
            for (int e = 0; e < 32; ++e) { const bool tk = lg[e] > best; best = tk ? lg[e] : best; bi = tk ? e : bi; }
            be[k] = bi; bv[k] = best;
#pragma unroll
            for (int e = 0; e < 32; ++e) lg[e] = (e == bi) ? -3.0e38f : lg[e]; }
        const float e1 = __expf(bv[1] - bv[0]), e2 = __expf(bv[2] - bv[0]), e3 = __expf(bv[3] - bv[0]); const float inv = 1.0f / (1.0f + e1 + e2 + e3);
        const float gt[4] = {inv, e1 * inv, e2 * inv, e3 * inv};
#pragma unroll
        for (int k = 0; k < 4; ++k) { const int pos = atomicAdd(&LCNT[be[k]], 1);
            ((int*)(ws + WS_TOPE))[tok * 4 + k] = be[k]; ((float*)(ws + WS_TOPG))[tok * 4 + k] = gt[k]; ((int*)(ws + WS_TOPP))[tok * 4 + k] = pos; } }
    __syncthreads();
    { unsigned char* HN = ws + WS_HN;
#pragma unroll 2
      for (int i = 0; i < 8; ++i) { const int idx = tid + 512 * i, t = idx >> 6, c = idx & 63; const float rs = RSTD[t]; const size_t off = (size_t)(tok0 + t) * 1024 + c * 16; u32x4 wv;
#pragma unroll
          for (int q = 0; q < 4; ++q) { const f32x4 h0 = bf4_to_f32(*(const u32x2*)(H + off + 4 * q)), g0 = *(const f32x4*)(p.norm_ffn_g + c * 16 + 4 * q); wv[q] = (unsigned)pk4_fp8(h0[0] * rs * g0[0], h0[1] * rs * g0[1], h0[2] * rs * g0[2], h0[3] * rs * g0[3]); }
          *(u32x4*)(HN + off) = wv; } }
    __syncthreads();
    if (tid < 32) ((int*)(ws + WS_CNT))[grp * 32 + tid] = LCNT[tid];
    __syncthreads();
}

constexpr int DP_TOT = 0;
constexpr int DP_PART = 512;
__device__ __forceinline__ void dispatch_tables(const Params& p, int grp, char* lds) {
    unsigned char* ws = opaque(p.ws); const int tid = tid_(); const int* CNT = (const int*)(ws + WS_CNT); int* T = (int*)(lds + DP_TOT); int* PART = (int*)(lds + DP_PART);
    { const int e = tid & 31, part = tid >> 5; int tot = 0, pre = 0;
      for (int g2 = part * 16; g2 < part * 16 + 16; ++g2) { const int c = CNT[g2 * 32 + e]; tot += c; if (g2 < grp) pre += c; }
      PART[part * 32 + e] = tot; PART[512 + part * 32 + e] = pre; }
    __syncthreads();
    if (tid < 32) { int tot = 0, pre = 0; for (int q = 0; q < 16; ++q) { tot += PART[q * 32 + tid]; pre += PART[512 + q * 32 + tid]; } T[tid] = tot; T[64 + tid] = pre; }
    __syncthreads();
    if (tid == 0) { int base = 0; for (int e = 0; e < 32; ++e) { T[32 + e] = base; base += (T[e] + 255) >> 8; } T[96] = base; }
    __syncthreads();
}
__device__ __forceinline__ void dispatch_group(const Params& p, int grp, char* lds) {
    unsigned char* ws = opaque(p.ws); const int tid = tid_();
    dispatch_tables(p, grp, lds);
    const int* T = (const int*)(lds + DP_TOT); int* DEST = (int*)(lds + DP_PART + 4096);
    if (tid < 256) { const int tok = grp * 64 + (tid >> 2); const int e = ((const int*)(ws + WS_TOPE))[tok * 4 + (tid & 3)], lp = ((const int*)(ws + WS_TOPP))[tok * 4 + (tid & 3)];
        const int dest = T[32 + e] * 256 + T[64 + e] + lp; DEST[tid] = dest; ((int*)(ws + WS_SLOT))[tok * 4 + (tid & 3)] = dest; }
    __syncthreads();
    if (tid < 256) ((int*)(ws + WS_XPAD))[DEST[tid]] = (grp * 64 + (tid >> 2)) * 1024;
    __syncthreads();
}

__device__ __forceinline__ void phase_combine(const Params& p) {
    unsigned char* ws = opaque(p.ws); const int tid = tid_(), lane = tid & 63, wid = tid >> 6, G = gridDim.x;
    const bf16_t* H = (const bf16_t*)(ws + WS_H); const unsigned char* YP = ws + WS_YPAD;
    for (int tok = blockIdx.x * 8 + wid; tok < NTOK; tok += G * 8) {
        int sl[4]; float gt[4];
#pragma unroll
        for (int k = 0; k < 4; ++k) { sl[k] = ((const int*)(ws + WS_SLOT))[tok * 4 + k]; gt[k] = ((const float*)(ws + WS_TOPG))[tok * 4 + k]; }
        f32x4 v[4]; float ss = 0.f;
#pragma unroll
        for (int i = 0; i < 4; ++i) { const int col = i * 256 + lane * 4; v[i] = bf4_to_f32(*(const u32x2*)(H + (size_t)tok * 1024 + col));
#pragma unroll
            for (int k = 0; k < 4; ++k) { const unsigned yw = *(const unsigned*)(YP + (size_t)sl[k] * 1024 + col); const f32x2 lo = __builtin_amdgcn_cvt_pk_f32_fp8((int)yw, false), hi2 = __builtin_amdgcn_cvt_pk_f32_fp8((int)yw, true); v[i][0] += gt[k] * lo[0]; v[i][1] += gt[k] * lo[1]; v[i][2] += gt[k] * hi2[0]; v[i][3] += gt[k] * hi2[1]; }
            ss += v[i][0] * v[i][0] + v[i][1] * v[i][1] + v[i][2] * v[i][2] + v[i][3] * v[i][3]; }
        ss = wave_sum(ss); const float rs = rsqrtf(ss * (1.0f / 1024.0f) + EPS);
#pragma unroll
        for (int i = 0; i < 4; ++i) { const int col = i * 256 + lane * 4; const f32x4 g = *(const f32x4*)(p.norm_final_g + col); f32x4 o; o[0] = v[i][0] * rs * g[0]; o[1] = v[i][1] * rs * g[1]; o[2] = v[i][2] * rs * g[2]; o[3] = v[i][3] * rs * g[3];
            *(f32x4*)(p.out + (size_t)tok * 1024 + col) = o; } }
}


#define XB_TMO      128
#define XB_XCNT(j)  (256  + 64 * (j))
#define XB_XSUB(j)  (1280 + 64 * (j))
#define XB_XGEN(j)  (2304 + 64 * (j))
#define XB_TOP      3328
#define XB_TOPGEN   3392
#define XCD_BAR_WORDS 3456
#define XB_SPIN_CAP (1u << 18)
__device__ __forceinline__ unsigned xb_ld(unsigned* p)              { return __hip_atomic_load(p, __ATOMIC_RELAXED, __HIP_MEMORY_SCOPE_AGENT); }
__device__ __forceinline__ unsigned xb_add(unsigned* p, unsigned v) { return __hip_atomic_fetch_add(p, v, __ATOMIC_RELAXED, __HIP_MEMORY_SCOPE_AGENT); }
__device__ __forceinline__ unsigned xb_xcc_id() { return (unsigned)__builtin_amdgcn_s_getreg((3 << 11) | 20) & 0xFu; }
#define XB_SPIN(cond, bar) do { unsigned _sp = 0; while (cond) { __builtin_amdgcn_s_sleep(1); \
    if ((++_sp & 255u) == 0u) { if (xb_ld(&(bar)[XB_TMO])) break; if (_sp > XB_SPIN_CAP) { atomicAdd(&(bar)[XB_TMO], 1u); break; } } } } while (0)
struct XcdBarrier { unsigned* bar; unsigned x; volatile LDS3 unsigned* st; };
__device__ __forceinline__ XcdBarrier xcd_barrier_post(unsigned* bar, volatile LDS3 unsigned* st) {
    XcdBarrier b; b.bar = bar; b.x = xb_xcc_id(); b.st = st;
    if (tid_() == 0) (void)xb_add(&bar[XB_XCNT(b.x)], 1u);
    return b;
}
__device__ __forceinline__ void xcd_barrier_complete(unsigned* bar, unsigned x, unsigned& nloc, unsigned& nx) {
    const unsigned G = gridDim.x * gridDim.y * gridDim.z;
    unsigned sum, cnt, mine, sp = 0u;
    for (;;) {
        sum = 0u; cnt = 0u; mine = 0u;
#pragma unroll
        for (unsigned j = 0; j < 16; ++j) { const unsigned c = xb_ld(&bar[XB_XCNT(j)]); sum += c; cnt += (c > 0u) ? 1u : 0u; mine = (j == x) ? c : mine; }
        if (sum == G) break;
        __builtin_amdgcn_s_sleep(1);
        if ((++sp & 255u) == 0u) { if (xb_ld(&bar[XB_TMO])) break; if (sp > XB_SPIN_CAP) { atomicAdd(&bar[XB_TMO], 1u); break; } }
    }
    nloc = mine > 0u ? mine : 1u; nx = cnt > 0u ? cnt : 1u;
}
__device__ __forceinline__ void xcd_barrier(const XcdBarrier& b) {
    asm volatile("s_waitcnt vmcnt(0)" ::: "memory");
    __syncthreads();
    if (tid_() == 0) {
        unsigned* bar = b.bar;
        __builtin_amdgcn_s_waitcnt(0);
        unsigned nloc = b.st[0], nx = b.st[1];
        if (nloc == 0u) { xcd_barrier_complete(bar, b.x, nloc, nx); b.st[0] = nloc; b.st[1] = nx; }
        const unsigned old = xb_add(&bar[XB_XSUB(b.x)], 1u);
        const unsigned gen = old / nloc;
        if (old + 1u == (gen + 1u) * nloc) {
            __builtin_amdgcn_fence(__ATOMIC_RELEASE, "agent");
            asm volatile("s_waitcnt vmcnt(0)" ::: "memory");
            const unsigned og = xb_add(&bar[XB_TOP], 1u);
            const unsigned tg = og / nx;
            if (og + 1u == (tg + 1u) * nx) xb_add(&bar[XB_TOPGEN], 1u);
            else XB_SPIN(xb_ld(&bar[XB_TOPGEN]) == tg, bar);
            __builtin_amdgcn_fence(__ATOMIC_ACQUIRE, "agent");
            xb_add(&bar[XB_XGEN(b.x)], 1u);
            asm volatile("s_waitcnt vmcnt(0)" ::: "memory");
        } else {
            XB_SPIN(xb_ld(&bar[XB_XGEN(b.x)]) == gen, bar);
            __builtin_amdgcn_fence(__ATOMIC_ACQUIRE, "agent");
            asm volatile("s_waitcnt vmcnt(0)" ::: "memory");
        }
    }
    __syncthreads();
}

__global__ void __launch_bounds__(512, 2) mega_fwd(Params p) {
    cg::grid_group grid = cg::this_grid();
    char* lds = smem; LDS3 unsigned char* lds3 = (LDS3 unsigned char*)smem;
    const int G = gridDim.x, bid = blockIdx.x;
    if (tid_() < 4) ((volatile LDS3 unsigned*)(lds3 + LDS_XB))[tid_()] = 0u;
    __syncthreads();
    const XcdBarrier xb = xcd_barrier_post((unsigned*)(p.ws + WS_BAR), (volatile LDS3 unsigned*)(lds3 + LDS_XB));
    for (int rep = 0; rep < REP_P0; ++rep) phase_prologue(p, lds);
    if (p.ws == nullptr) grid.sync();
    xcd_barrier(xb);
    for (int rep = 0; rep < REP_P1; ++rep) { const int nconv = (G >= 64) ? G / 4 : 0, ngemm = G - nconv;
      if (bid >= ngemm) { expert_convert(p, lds, bid - ngemm, nconv, N_EXPERT_TILES_P0, N_EXPERT_TILES); }
      else { unsigned char* ws = opaque(p.ws);
        { pg8::DenseProbT<1> S; S.init(ws + WS_XN, ws + WS_W_IN, NTOK, pg8::sens_count() * 256, 1024, ngemm, bid);
          EpiProjT<false> E; E.ws = ws; pg8::gemm_phase(lds3, S, E); }
        { pg8::DenseProbT<2> S; S.init(ws + WS_XN8, ws + WS_WIN8, NTOK, (39 - pg8::sens_count()) * 256, 512  , ngemm, bid);
          EpiProjT<true> E; E.ws = ws; pg8::gemm_phase(lds3, S, E); } }
      if (nconv == 0) expert_convert(p, lds, bid, G, N_EXPERT_TILES_P0, N_EXPERT_TILES); }
    xcd_barrier(xb);
    {
      constexpr int NIT = 4 * 24 * 16; const bool xmap = (G == 256);
      auto amap = [&](int k) -> int { return xmap ? (((k * 16 + 2 * (bid & 7) + ((bid >> 3) >> 4)) << 4) + ((bid >> 3) & 15)) : (k * G + bid); };
      AttnPre pre; if (amap(0) < NIT) attn_fetch(p, amap(0), pre);
      for (int k = 0; amap(k) < NIT; ++k) attn_item(p, amap(k), amap(k + 1), amap(k + 1) < NIT, pre, lds); }
    for (int rep = 0; rep < REP_GLA1; ++rep) { G1Pre pre; if (bid < 1024) gla1_fetch(p, bid, pre); int hprev = -1;
        for (int item = bid; item < 1024; item += G) { const int h = (item >> 6) & 3; gla1_item(p, item, item + G, item + G < 1024, h != hprev, pre, lds); hprev = h; } }
    xcd_barrier(xb);
    for (int rep = 0; rep < REP_P3; ++rep) phase_scan_combine(p);
    xcd_barrier(xb);
    for (int rep = 0; rep < REP_P4; ++rep) { G3Pre pre; if (bid < 1024) gla3_fetch(p, bid, pre);
        for (int item = bid; item < 1024; item += G) gla3_item(p, item, item + G, item + G < 1024, pre, lds); }
    xcd_barrier(xb);
    for (int rep = 0; rep < REP_P5; ++rep) {
    { unsigned char* ws = opaque(p.ws); pg8::DenseProb S; S.init(ws + WS_YATT, ws + WS_W_A, NTOK, 1024, 512, G, bid);
      EpiGate<0> E; E.gate = (const bf16_t*)(ws + WS_SA); E.t1 = nullptr; E.out = (bf16_t*)(ws + WS_T1);
      pg8::gemm_phase(lds3, S, E); }
    { unsigned char* ws = opaque(p.ws); pg8::DenseProb S; S.init(ws + WS_YGLA, ws + WS_W_G, NTOK, 1024, 1024, G, bid);
      EpiGate<1> E; E.gate = (const bf16_t*)(ws + WS_SG); E.t1 = (const bf16_t*)(ws + WS_T1); E.out = (bf16_t*)(ws + WS_MERGED);
      pg8::gemm_phase(lds3, S, E); }
    }
    xcd_barrier(xb);
    for (int rep = 0; rep < REP_P6; ++rep) { unsigned char* ws = opaque(p.ws); pg8::DenseProb S; S.init(ws + WS_MERGED, ws + WS_W_MIX, NTOK, 1024, 1024, G, bid);
      EpiResid E; E.x = p.x; E.h = (bf16_t*)(ws + WS_H);
      pg8::gemm_phase(lds3, S, E); }
    xcd_barrier(xb);
    for (int rep = 0; rep < REP_P7; ++rep) for (int grp = bid; grp < 256; grp += G) route_group(p, grp, lds);
    xcd_barrier(xb);
    for (int rep = 0; rep < REP_P8; ++rep) for (int grp = bid; grp < 256; grp += G) dispatch_group(p, grp, lds);
    if (bid == 0) { unsigned char* ws = opaque(p.ws); dispatch_tables(p, -1, lds); const int* T = (const int*)(lds + DP_TOT); int* TE = (int*)(ws + WS_TILEE);
        if (tid_() < 32) { const int e = tid_(); for (int t = T[32 + e]; t < T[32 + e] + ((T[e] + 255) >> 8); ++t) TE[16 + t] = e; }
        if (tid_() == 0) TE[0] = T[96];
        for (int e = 0; e < 32; ++e) { const int nt_ = (T[e] + 255) >> 8; int* ro = (int*)(ws + WS_XPAD) + T[32 + e] * 256; for (int r = T[e] + tid_(); r < nt_ * 256; r += 512) ro[r] = 0; } }
    xcd_barrier(xb);
    for (int rep = 0; rep < REP_P9; ++rep) { unsigned char* ws = opaque(p.ws); const int* TE = (const int*)(ws + WS_TILEE);
      pg8::MoeProbT<true> S; S.A = (const char*)(ws + WS_HN); S.rowoff = (const int*)(ws + WS_XPAD); S.Bt = (const char*)(ws + WS_W_GU); S.K = 512  ; S.nN = 8; S.T = TE[0]; S.G = G; S.c = bid; S.estride = (size_t)2048 * 1024; S.tile_e = TE + 16;
      EpiAct E; E.bgu = p.e_b_gu; E.tile_e = TE + 16; E.act = ws + WS_ACT;
      pg8::gemm_phase(lds3, S, E); }
    xcd_barrier(xb);
    for (int rep = 0; rep < REP_P10; ++rep) { unsigned char* ws = opaque(p.ws); const int* TE = (const int*)(ws + WS_TILEE);
      pg8::MoeProbT<false> S; S.rowoff = nullptr; S.A = (const char*)(ws + WS_ACT); S.Bt = (const char*)(ws + WS_W_D); S.K = 512  ; S.nN = 4; S.T = TE[0]; S.G = G; S.c = bid; S.estride = (size_t)1024 * 1024; S.tile_e = TE + 16;
      EpiDown E; E.bd = p.e_b_d; E.tile_e = TE + 16; E.y = ws + WS_YPAD;
      pg8::gemm_phase(lds3, S, E); }
    xcd_barrier(xb);
    for (int rep = 0; rep < REP_P11; ++rep) phase_combine(p);
}

extern "C" void kernel_launch(void* const* d_in, const int* in_sizes, int n_in, void* d_out, int out_size, void* d_ws, size_t ws_size, hipStream_t stream) {
    static int grid = 0;
    if (grid == 0) {
        if (n_in != 17 || ws_size < WS_END) { fprintf(stderr, "kernel_launch: expected 17 inputs and >= %zu bytes of workspace (got %d, %zu); nothing launched\n", (size_t)WS_END, n_in, ws_size); grid = -1; return; }
        int dev = 0, cus = 0, per_cu = 0;
        if (hipGetDevice(&dev) != hipSuccess || hipDeviceGetAttribute(&cus, hipDeviceAttributeMultiprocessorCount, dev) != hipSuccess) { fprintf(stderr, "kernel_launch: device query failed\n"); grid = -1; return; }
        if (hipFuncSetAttribute((const void*)mega_fwd, hipFuncAttributeMaxDynamicSharedMemorySize, LDS_BYTES) != hipSuccess) { fprintf(stderr, "kernel_launch: hipFuncSetAttribute failed\n"); grid = -1; return; }
        if (hipOccupancyMaxActiveBlocksPerMultiprocessor(&per_cu, (const void*)mega_fwd, 512, LDS_BYTES) != hipSuccess || per_cu < 1) { fprintf(stderr, "kernel_launch: occupancy query failed (%d)\n", per_cu); grid = -1; return; }
        grid = cus;
    }
    if (grid < 0) return;
    Params p{};
    p.x = (const float*)d_in[0]; p.norm_mix_g = (const float*)d_in[1]; p.w_in = (const float*)d_in[2]; p.gla_gate_up = (const float*)d_in[3]; p.gla_gate_bias = (const float*)d_in[4]; p.gla_norm_g = (const float*)d_in[5];
    p.w_branch_gla = (const float*)d_in[6]; p.w_branch_att = (const float*)d_in[7]; p.w_mix_out = (const float*)d_in[8]; p.norm_ffn_g = (const float*)d_in[9]; p.router_w = (const float*)d_in[10]; p.router_b = (const float*)d_in[11];
    p.e_w_gu = (const float*)d_in[12]; p.e_b_gu = (const float*)d_in[13]; p.e_w_d = (const float*)d_in[14]; p.e_b_d = (const float*)d_in[15]; p.norm_final_g = (const float*)d_in[16];
    p.out = (float*)d_out; p.ws = (unsigned char*)d_ws;
    if (hipMemsetAsync((char*)d_ws + WS_BAR, 0, 3456 * 4, stream) != hipSuccess) { fprintf(stderr, "kernel_launch: memset of the barrier words failed\n"); return; }
    void* args[] = {&p};
    hipError_t e = hipLaunchCooperativeKernel((const void*)mega_fwd, dim3(grid), dim3(512), args, LDS_BYTES, stream);
    if (e != hipSuccess) fprintf(stderr, "kernel_launch: cooperative launch failed: %s (grid %d)\n", hipGetErrorString(e), grid);
}
```
